# Optimizing an MI355X kernel written in HIP

```python
import jax, jax.numpy as jnp
from jax import lax
import numpy as np

D_MODEL = 1024
BATCH = 4
SEQ = 4096
DEPTH = 4

EXPAND = 2
D_MIX = EXPAND * D_MODEL
NORM_EPS = 1e-5

FOX_WIDTH = D_MIX // 2
FOX_HEAD_DIM = 128
FOX_HEADS = FOX_WIDTH // FOX_HEAD_DIM
FOX_BLOCK = 128

SSD_WIDTH = D_MIX - FOX_WIDTH
SSD_HEAD_DIM = 64
SSD_HEADS = SSD_WIDTH // SSD_HEAD_DIM
SSD_GROUPS = 2
SSD_HPG = SSD_HEADS // SSD_GROUPS
SSD_STATE = 128
SSD_CONV = 4
SSD_CHUNK = 128
SSD_CONV_DIM = SSD_WIDTH + 2 * SSD_GROUPS * SSD_STATE

HGRN_WIDTH = D_MIX
HGRN_KEY_DIM = 128
HGRN_HEADS = HGRN_WIDTH // HGRN_KEY_DIM
HGRN_VAL_DIM = HGRN_WIDTH // HGRN_HEADS
HGRN_CHUNK = 64

N_EVEN = (DEPTH + 1) // 2
N_ODD = DEPTH // 2

EVEN_SIZES = [FOX_WIDTH, FOX_WIDTH, FOX_WIDTH, FOX_WIDTH, FOX_HEADS,
              SSD_WIDTH, SSD_CONV_DIM, SSD_HEADS]
EVEN_IN = sum(EVEN_SIZES)
ODD_SIZES = [HGRN_WIDTH, HGRN_WIDTH, HGRN_WIDTH, HGRN_WIDTH]
ODD_IN = sum(ODD_SIZES)

kernel_name = "fox_ssd_hgrn2_hybrid_trunk"


def _split(y, sizes):
    offs = [int(o) for o in np.cumsum(sizes)[:-1]]
    return jnp.split(y, offs, axis=-1)


def rmsnorm(x, w):
    xf = x.astype(jnp.float32)
    y = xf * lax.rsqrt(jnp.mean(xf * xf, axis=-1, keepdims=True) + NORM_EPS)
    return (y * w.astype(jnp.float32)).astype(x.dtype)


def fox_attention(q, k, v, log_f):
    T, Dh = q.shape[1], q.shape[3]
    scale = Dh ** -0.5
    c = jnp.transpose(jnp.cumsum(log_f, axis=1), (0, 2, 1))
    outs = []
    for blk in range(T // FOX_BLOCK):
        s0 = blk * FOX_BLOCK
        s1 = s0 + FOX_BLOCK
        logits = jnp.einsum('bqhd,bkhd->bhqk', q[:, s0:s1], k[:, :s1]).astype(jnp.float32) * scale
        logits = logits + c[:, :, s0:s1, None] - c[:, :, None, :s1]
        causal = jnp.arange(s1)[None, :] <= jnp.arange(s0, s1)[:, None]
        logits = jnp.where(causal, logits, -jnp.inf)
        p = jax.nn.softmax(logits, axis=-1).astype(v.dtype)
        outs.append(jnp.einsum('bhqk,bkhd->bqhd', p, v[:, :s1]))
    return jnp.concatenate(outs, axis=1)


def causal_depthwise_conv(x, w, b):
    C = x.shape[-1]
    y = lax.conv_general_dilated(x, w.astype(x.dtype)[:, None, :], window_strides=(1,),
                                 padding=[(SSD_CONV - 1, 0)],
                                 dimension_numbers=('NWC', 'WIO', 'NWC'),
                                 feature_group_count=C)
    return y + b.astype(x.dtype)


def segsum(a):
    L = a.shape[-1]
    cs = jnp.cumsum(a, axis=-1)
    diff = cs[..., :, None] - cs[..., None, :]
    return jnp.where(jnp.tril(jnp.ones((L, L), dtype=bool)), diff, -jnp.inf)


def ssd_scan(x, dt, A, Bm, Cm):
    f32 = jnp.float32
    Bsz, T, G, J, P = x.shape
    N = Bm.shape[-1]
    Lc = SSD_CHUNK
    nc = T // Lc
    xd = (x.astype(f32) * dt[..., None]).reshape(Bsz, nc, Lc, G, J, P)
    a = (dt * A).reshape(Bsz, nc, Lc, G, J).transpose(0, 3, 4, 1, 2)
    Bc = Bm.astype(f32).reshape(Bsz, nc, Lc, G, N)
    Cc = Cm.astype(f32).reshape(Bsz, nc, Lc, G, N)
    a_cum = jnp.cumsum(a, axis=-1)
    Ldec = jnp.exp(segsum(a))
    cb = jnp.einsum('bclgn,bcsgn->bgcls', Cc, Bc)
    y_diag = jnp.einsum('bgjcls,bcsgjp->bclgjp', cb[:, :, None] * Ldec, xd)
    decay_states = jnp.exp(a_cum[..., -1:] - a_cum).transpose(0, 3, 4, 1, 2)
    states = jnp.einsum('bclgn,bclgjp->bcgjpn', Bc, xd * decay_states[..., None])
    chunk_a = jnp.pad(a_cum[..., -1], [(0, 0), (0, 0), (0, 0), (1, 0)])
    dec_chunk = jnp.exp(segsum(chunk_a))
    states = jnp.pad(states, [(0, 0), (1, 0), (0, 0), (0, 0), (0, 0), (0, 0)])
    new_states = jnp.einsum('bgjzc,bcgjpn->bzgjpn', dec_chunk, states)
    prev_states = new_states[:, :-1]
    out_decay = jnp.exp(a_cum).transpose(0, 3, 4, 1, 2)
    y_off = jnp.einsum('bclgn,bcgjpn->bclgjp', Cc, prev_states) * out_decay[..., None]
    return (y_diag + y_off).reshape(Bsz, T, G, J, P)


def hgrn2_chunk_scan(q, k, v, g):
    Bsz, T, H, K = q.shape
    V = v.shape[-1]
    Lc = HGRN_CHUNK
    nc = T // Lc

    def to_chunks(a):
        return a.reshape(Bsz, nc, Lc, H, a.shape[-1]).transpose(1, 0, 3, 2, 4)

    causal = jnp.tril(jnp.ones((Lc, Lc), dtype=bool))[:, :, None]

    def step(S, inp):
        qi, ki, vi, gi = inp
        bcum = jnp.cumsum(gi, axis=2)
        diff = bcum[:, :, :, None, :] - bcum[:, :, None, :, :]
        dec = jnp.exp(jnp.where(causal, diff, -jnp.inf))
        attn = jnp.einsum('bhtsk,bhsk->bhts', qi[:, :, :, None, :] * dec, ki)
        o = (jnp.einsum('bhts,bhsv->bhtv', attn, vi)
             + jnp.einsum('bhtk,bhkv->bhtv', qi * jnp.exp(bcum), S))
        b_last = bcum[:, :, -1:, :]
        S = (S * jnp.exp(b_last[:, :, 0, :])[..., None]
             + jnp.einsum('bhsk,bhsv->bhkv', ki * jnp.exp(b_last - bcum), vi))
        return S, o

    S0 = jnp.zeros((Bsz, H, K, V), jnp.float32)
    _, o = lax.scan(step, S0, (to_chunks(q), to_chunks(k), to_chunks(v), to_chunks(g)))
    return o.transpose(1, 0, 3, 2, 4).reshape(Bsz, T, H, V)


def hgrn_lower_bounds(lb_logits):
    p = jax.nn.softmax(lb_logits.astype(jnp.float32), axis=0)
    cs = jnp.cumsum(p, axis=0)
    return cs - cs[0:1]


def even_layer(u, w_in, w_out, f_bias, conv_w, conv_b, dt_bias, A_log, D_skip, ssd_norm_w):
    f32 = jnp.float32
    Bsz, T, _ = u.shape
    q, k, v, gate_a, f_logit, z, xbc, dt_raw = _split(u @ w_in.astype(u.dtype), EVEN_SIZES)
    hs = (Bsz, T, FOX_HEADS, FOX_HEAD_DIM)
    log_f = jax.nn.log_sigmoid(f_logit.astype(f32) + f_bias.astype(f32))
    o_a = fox_attention(q.reshape(hs), k.reshape(hs), v.reshape(hs), log_f)
    o_a = o_a.reshape(Bsz, T, FOX_WIDTH).astype(u.dtype) * jax.nn.silu(gate_a)
    xbc = jax.nn.silu(causal_depthwise_conv(xbc, conv_w, conv_b))
    xs, Bm, Cm = _split(xbc, [SSD_WIDTH, SSD_GROUPS * SSD_STATE, SSD_GROUPS * SSD_STATE])
    xs = xs.reshape(Bsz, T, SSD_GROUPS, SSD_HPG, SSD_HEAD_DIM)
    Bm = Bm.reshape(Bsz, T, SSD_GROUPS, SSD_STATE)
    Cm = Cm.reshape(Bsz, T, SSD_GROUPS, SSD_STATE)
    dt = jax.nn.softplus(dt_raw.astype(f32) + dt_bias.astype(f32)).reshape(Bsz, T, SSD_GROUPS, SSD_HPG)
    A = -jnp.exp(A_log.astype(f32)).reshape(SSD_GROUPS, SSD_HPG)
    y = ssd_scan(xs, dt, A, Bm, Cm) + D_skip.astype(f32).reshape(SSD_GROUPS, SSD_HPG)[:, :, None] * xs.astype(f32)
    y = y.reshape(Bsz, T, SSD_WIDTH).astype(u.dtype) * jax.nn.silu(z)
    y = rmsnorm(y.reshape(Bsz, T, SSD_GROUPS, SSD_WIDTH // SSD_GROUPS),
                ssd_norm_w.reshape(SSD_GROUPS, SSD_WIDTH // SSD_GROUPS)).reshape(Bsz, T, SSD_WIDTH)
    return jnp.concatenate([o_a, y], axis=-1) @ w_out.astype(u.dtype)


def odd_layer(u, w_in, w_out, lb, norm_w):
    f32 = jnp.float32
    Bsz, T, _ = u.shape
    q, f, i, gate = _split(u @ w_in.astype(u.dtype), ODD_SIZES)
    ks = (Bsz, T, HGRN_HEADS, HGRN_KEY_DIM)
    ff = f.astype(f32)
    log_f = jnp.logaddexp(jnp.log(lb), jnp.log1p(-lb) + jax.nn.log_sigmoid(ff))
    k_in = (1.0 - lb) * jax.nn.sigmoid(-ff)
    qf = jax.nn.silu(q.astype(f32))
    o = hgrn2_chunk_scan(qf.reshape(ks), k_in.reshape(ks), i.astype(f32).reshape(Bsz, T, HGRN_HEADS, HGRN_VAL_DIM),
                         log_f.reshape(ks))
    o = rmsnorm(o, norm_w).reshape(Bsz, T, HGRN_WIDTH).astype(u.dtype) * jax.nn.silu(gate)
    return o @ w_out.astype(u.dtype)


def setup_inputs(seed: int = 0) -> dict:
    key = jax.random.key(seed)
    ks = jax.random.split(key, 20)
    f32 = jnp.float32
    nrm = lambda k, s: jax.random.normal(k, s, f32)
    x = nrm(ks[0], (BATCH, SEQ, D_MODEL))
    norm_w = 1.0 + 0.02 * nrm(ks[1], (DEPTH, D_MODEL))
    final_norm_w = 1.0 + 0.02 * nrm(ks[2], (D_MODEL,))
    even_w_in = nrm(ks[3], (N_EVEN, D_MODEL, EVEN_IN)) * D_MODEL ** -0.5
    even_w_out = nrm(ks[4], (N_EVEN, D_MIX, D_MODEL)) * D_MIX ** -0.5
    fox_f_bias = 2.0 + 0.5 * nrm(ks[5], (N_EVEN, FOX_HEADS))
    ssd_conv_w = nrm(ks[6], (N_EVEN, SSD_CONV, SSD_CONV_DIM)) * SSD_CONV ** -0.5
    ssd_conv_b = 0.02 * nrm(ks[7], (N_EVEN, SSD_CONV_DIM))
    log_dt = jax.random.uniform(ks[8], (N_EVEN, SSD_HEADS), f32, np.log(1e-3), np.log(1e-1))
    dt0 = jnp.exp(log_dt)
    ssd_dt_bias = dt0 + jnp.log(-jnp.expm1(-dt0))
    ssd_A_log = jnp.log(jax.random.uniform(ks[9], (N_EVEN, SSD_HEADS), f32, 1.0, 16.0))
    ssd_D = 1.0 + 0.1 * nrm(ks[10], (N_EVEN, SSD_HEADS))
    ssd_norm_w = 1.0 + 0.02 * nrm(ks[11], (N_EVEN, SSD_WIDTH))
    odd_w_in = nrm(ks[12], (N_ODD, D_MODEL, ODD_IN)) * D_MODEL ** -0.5
    odd_w_out = nrm(ks[13], (N_ODD, HGRN_WIDTH, D_MODEL)) * HGRN_WIDTH ** -0.5
    hgrn_lb_logits = 0.5 * nrm(ks[14], (N_ODD, HGRN_WIDTH))
    hgrn_norm_w = 1.0 + 0.02 * nrm(ks[15], (N_ODD, HGRN_VAL_DIM))
    return {"x": x, "norm_w": norm_w, "final_norm_w": final_norm_w,
            "even_w_in": even_w_in, "even_w_out": even_w_out, "fox_f_bias": fox_f_bias,
            "ssd_conv_w": ssd_conv_w, "ssd_conv_b": ssd_conv_b, "ssd_dt_bias": ssd_dt_bias,
            "ssd_A_log": ssd_A_log, "ssd_D": ssd_D, "ssd_norm_w": ssd_norm_w,
            "odd_w_in": odd_w_in, "odd_w_out": odd_w_out,
            "hgrn_lb_logits": hgrn_lb_logits, "hgrn_norm_w": hgrn_norm_w}


def reference(x, norm_w, final_norm_w, even_w_in, even_w_out, fox_f_bias, ssd_conv_w, ssd_conv_b,
              ssd_dt_bias, ssd_A_log, ssd_D, ssd_norm_w, odd_w_in, odd_w_out, hgrn_lb_logits, hgrn_norm_w):
    lbs = hgrn_lower_bounds(hgrn_lb_logits)
    h = x
    for layer in range(DEPTH):
        u = rmsnorm(h, norm_w[layer])
        if layer % 2 == 0:
            e = layer // 2
            h = h + even_layer(u, even_w_in[e], even_w_out[e], fox_f_bias[e], ssd_conv_w[e], ssd_conv_b[e],
                               ssd_dt_bias[e], ssd_A_log[e], ssd_D[e], ssd_norm_w[e])
        else:
            o = layer // 2
            h = h + odd_layer(u, odd_w_in[o], odd_w_out[o], lbs[o].astype(jnp.float32), hgrn_norm_w[o])
    return rmsnorm(h, final_norm_w)
```

```cpp
#include <hip/hip_runtime.h>
#include <cstdio>
#include <cstdint>
namespace pg8 {
#define PG8_LAS __attribute__((address_space(3)))
typedef unsigned short bf16_t;
typedef short bf16x8 __attribute__((ext_vector_type(8)));
typedef float f32x4 __attribute__((ext_vector_type(4)));
typedef unsigned u32x4 __attribute__((ext_vector_type(4)));
constexpr int BM = 256, BK = 64, HALF = 128, HTB = HALF * BK * 2  , STAGE_BYTES = 8 * HTB, NXCD = 8, WGM = 8;

__host__ __device__ __forceinline__ int lds_byte(int r, int c) { const int st = (r >> 4) * 2 + (c >> 5), rr = r & 15, cc = c & 31, ob = rr * 64 + cc * 2; return st * 1024 + (ob ^ (((ob >> 9) & 1) << 5)); }
__host__ __device__ __forceinline__ void stage_rc(int b, int& R, int& C) { const int st = b / 1024, sb = b % 1024, swz = sb ^ (((sb >> 9) & 1) << 5); R = (st >> 1) * 16 + swz / 64; C = (st & 1) * 32 + (swz % 64) / 2; }
__host__ __device__ __forceinline__ int perm32(int rho) { const int n = rho >> 4, i = rho & 15; return 8 * (i >> 2) + 4 * n + (i & 3); }

struct Unit { int pm, pn; };
struct Gemm { const bf16_t* A; const bf16_t* Bt; int M, N, K, lda; };

struct StaticOrder {
    int nM, nN, nwg, G, c;
    __host__ __device__ void init(int M, int N, int G_, int c_) { nM = M / BM; nN = N / BM; nwg = nM * nN; G = G_; c = c_; }
    __host__ __device__ bool next(int i, Unit& u) const {
        const long L = (long)i * G + c; if (L >= nwg) return false;
        int wgid = (int)L; { const int q = nwg / NXCD, r = nwg % NXCD, xcd = wgid % NXCD, off = wgid / NXCD; wgid = (xcd < r ? xcd * (q + 1) : r * (q + 1) + (xcd - r) * q) + off; }
        const int nig = WGM * nN, gid = wgid / nig, fm = gid * WGM, gsz = (nM - fm) < WGM ? (nM - fm) : WGM;
        u.pm = fm + ((wgid % nig) % gsz); u.pn = (wgid % nig) / gsz; return true;
    }
    __device__ __forceinline__ void a_ready(const Unit&) const {}
    __device__ __forceinline__ void done(const Unit&) const {}
};

__device__ __forceinline__ unsigned cvt_pk_bf16(float lo, float hi) { unsigned r; asm volatile("v_cvt_pk_bf16_f32 %0, %1, %2" : "=v"(r) : "v"(lo), "v"(hi)); return r; }
__device__ __forceinline__ float bf_lo(unsigned w) { return __uint_as_float(w << 16); }
__device__ __forceinline__ float bf_hi(unsigned w) { return __uint_as_float(w & 0xffff0000u); }
typedef unsigned u32x2 __attribute__((ext_vector_type(2)));

struct EpiIn {
    static constexpr bool PERM = true, AFTER_DRAIN = false;
    bf16_t* O; int ldc; const float* SS; float* FDt; int fd_tile; int Mrows;
    __device__ __forceinline__ void operator()(const f32x4 (&acc)[2][2][4][2], const Unit& u, int wr, int wc, int fr, int fq) const {
        const int row0 = u.pm * BM + wr * 64 + fr;
        float rs[2][4];
#pragma unroll
        for (int ai = 0; ai < 2; ++ai)
#pragma unroll
            for (int m = 0; m < 4; ++m) { const int r = row0 + ai * HALF + m * 16; float s = 0.f;
#pragma unroll
                for (int p = 0; p < 16; ++p) s += SS[(size_t)p * Mrows + r];
                rs[ai][m] = rsqrtf(s * (1.0f / 1024.0f) + 1e-5f); }
        if (u.pn == fd_tile) {
            if (wc == 0 && fq < 3) {
#pragma unroll
                for (int ai = 0; ai < 2; ++ai)
#pragma unroll
                    for (int m = 0; m < 4; ++m) { const int r = row0 + ai * HALF + m * 16;
#pragma unroll
                        for (int n = 0; n < 2; ++n)
#pragma unroll
                            for (int j = 0; j < 4; ++j) FDt[(size_t)(8 * fq + 4 * n + j) * Mrows + r] = acc[ai][0][m][n][j] * rs[ai][m]; }
            }
            return;
        }
        const int col0 = u.pn * BM + wc * 32 + 8 * fq;
#pragma unroll
        for (int ai = 0; ai < 2; ++ai)
#pragma unroll
            for (int m = 0; m < 4; ++m) { bf16_t* rowp = O + (size_t)(row0 + ai * HALF + m * 16) * ldc + col0; const float s = rs[ai][m];
#pragma unroll
                for (int bj = 0; bj < 2; ++bj) { const f32x4 v0 = acc[ai][bj][m][0] * s, v1 = acc[ai][bj][m][1] * s;
                    u32x4 w; w.x = cvt_pk_bf16(v0[0], v0[1]); w.y = cvt_pk_bf16(v0[2], v0[3]); w.z = cvt_pk_bf16(v1[0], v1[1]); w.w = cvt_pk_bf16(v1[2], v1[3]);
                    *(u32x4*)(rowp + bj * HALF) = w; } }
    }
};
__device__ __forceinline__ float silu_f(float x) { return x / (1.0f + __expf(-x)); }
struct EpiGate {
    static constexpr bool PERM = true, AFTER_DRAIN = false;
    bf16_t* O; int ldc; const float* SS; int Mrows;
    __device__ __forceinline__ void operator()(const f32x4 (&acc)[2][2][4][2], const Unit& u, int wr, int wc, int fr, int fq) const {
        const int row0 = u.pm * BM + wr * 64 + fr;
        const int col0 = u.pn * BM + wc * 32 + 8 * fq;
#pragma unroll
        for (int ai = 0; ai < 2; ++ai)
#pragma unroll
            for (int m = 0; m < 4; ++m) { const int r = row0 + ai * HALF + m * 16; float s = 0.f;
#pragma unroll
                for (int p = 0; p < 16; ++p) s += SS[(size_t)p * Mrows + r];
                s = rsqrtf(s * (1.0f / 1024.0f) + 1e-5f);
                bf16_t* rowp = O + (size_t)r * ldc + col0;
#pragma unroll
                for (int bj = 0; bj < 2; ++bj) { const f32x4 g0 = acc[ai][bj][m][0] * s, g1 = acc[ai][bj][m][1] * s;
                    const u32x4 o = *(const u32x4*)(rowp + bj * HALF);
                    u32x4 w;
                    w.x = cvt_pk_bf16(bf_lo(o.x) * silu_f(g0[0]), bf_hi(o.x) * silu_f(g0[1])); w.y = cvt_pk_bf16(bf_lo(o.y) * silu_f(g0[2]), bf_hi(o.y) * silu_f(g0[3]));
                    w.z = cvt_pk_bf16(bf_lo(o.z) * silu_f(g1[0]), bf_hi(o.z) * silu_f(g1[1])); w.w = cvt_pk_bf16(bf_lo(o.w) * silu_f(g1[2]), bf_hi(o.w) * silu_f(g1[3]));
                    *(u32x4*)(rowp + bj * HALF) = w; } }
    }
};
struct EpiOut {
    static constexpr bool PERM = false, AFTER_DRAIN = false;
    bf16_t* hi; bf16_t* lo; float* SS; int Mrows;
    __device__ __forceinline__ void operator()(const f32x4 (&acc)[2][2][4][2], const Unit& u, int wr, int wc, int fr, int fq) const {
        const int row0 = u.pm * BM + wr * 64 + fr, col0 = u.pn * BM + wc * 32 + 4 * fq;
#pragma unroll
        for (int ai = 0; ai < 2; ++ai)
#pragma unroll
            for (int m = 0; m < 4; ++m) { const int r = row0 + ai * HALF + m * 16; float ssq = 0.f;
#pragma unroll
                for (int bj = 0; bj < 2; ++bj)
#pragma unroll
                    for (int n = 0; n < 2; ++n) { const size_t off = (size_t)r * 1024 + col0 + bj * HALF + n * 16;
                        const u32x2 a = *(const u32x2*)(hi + off), b = *(const u32x2*)(lo + off); const f32x4 c = acc[ai][bj][m][n];
                        const float h0 = bf_lo(a.x) + bf_lo(b.x) + c[0], h1 = bf_hi(a.x) + bf_hi(b.x) + c[1], h2 = bf_lo(a.y) + bf_lo(b.y) + c[2], h3 = bf_hi(a.y) + bf_hi(b.y) + c[3];
                        ssq += (h0 * h0 + h1 * h1) + (h2 * h2 + h3 * h3);
                        u32x2 nh; nh.x = cvt_pk_bf16(h0, h1); nh.y = cvt_pk_bf16(h2, h3);
                        u32x2 nl; nl.x = cvt_pk_bf16(h0 - bf_lo(nh.x), h1 - bf_hi(nh.x)); nl.y = cvt_pk_bf16(h2 - bf_lo(nh.y), h3 - bf_hi(nh.y));
                        *(u32x2*)(hi + off) = nh; *(u32x2*)(lo + off) = nl; }
                ssq += __shfl_xor(ssq, 16); ssq += __shfl_xor(ssq, 32);
                if (fq == 0) SS[(size_t)(u.pn * 4 + wc) * Mrows + r] = ssq; }
    }
};
template <class Epi, class Sched, bool ALIGN_EPI = false, bool SP2 = false>
__device__ __forceinline__ void gemm_phase(PG8_LAS unsigned char* lds, const Gemm g, const Sched& S, const Epi& E) {
    const int tid = threadIdx.x, wid = __builtin_amdgcn_readfirstlane(tid >> 6), lane = tid & 63, wr = wid >> 2, wc = wid & 3, fr = lane & 15, fq = lane >> 4;
    const int K = g.K, nt = K / BK;
    unsigned voffA[2], voffB[2];
#pragma unroll
    for (int i = 0; i < 2; ++i) { int R, C; stage_rc(tid * 16 + i * 8192, R, C); const int Rb = Epi::PERM ? ((R & ~31) + perm32(R & 31)) : R;
        voffA[i] = (unsigned)(R * g.lda + C) * 2u; voffB[i] = (unsigned)(Rb * K + C) * 2u; }
    const size_t kstep = (size_t)(BK * 2);
    const size_t hstepA = (size_t)HALF * g.lda * 2, hstepB = (size_t)HALF * K * 2;
    const size_t tstepA = 2 * hstepA, tstepB = 2 * hstepB;
    const unsigned ldsw = (unsigned)wid * 1024u;
    const int aoff = lds_byte(wr * 64 + fr, fq * 8), boff = lds_byte(wc * 32 + fr, fq * 8);
#define PG8_SA(b, h) (((b) * 2 + (h)) * HTB)
#define PG8_SB(b, h) ((4 + (b) * 2 + (h)) * HTB)
#define PG8_STAGE(bufoff, gbase, voff) do { _Pragma("unroll") for (int _i = 0; _i < 2; ++_i) \
        __builtin_amdgcn_global_load_lds((const unsigned*)((const char*)(gbase) + (voff)[_i]), (PG8_LAS unsigned*)(lds + (bufoff) + ldsw + _i * 8192), 16, 0, 0); } while (0)
#define PG8_LDA(dst, b, h) do { _Pragma("unroll") for (int m = 0; m < 4; ++m) _Pragma("unroll") for (int k = 0; k < 2; ++k) dst[m][k] = *(const PG8_LAS bf16x8*)(lds + PG8_SA(b, h) + aoff + m * 2048 + k * 1024); } while (0)
#define PG8_LDB(dst, b, h) do { _Pragma("unroll") for (int n = 0; n < 2; ++n) _Pragma("unroll") for (int k = 0; k < 2; ++k) dst[n][k] = *(const PG8_LAS bf16x8*)(lds + PG8_SB(b, h) + boff + n * 2048 + k * 1024); } while (0)
#define PG8_MMA(ai, bj, At, Bt) do { __builtin_amdgcn_s_setprio(1); _Pragma("unroll") for (int m = 0; m < 4; ++m) _Pragma("unroll") for (int n = 0; n < 2; ++n) _Pragma("unroll") for (int k = 0; k < 2; ++k) \
        acc[ai][bj][m][n] = __builtin_amdgcn_mfma_f32_16x16x32_bf16(Bt[n][k], At[m][k], acc[ai][bj][m][n], 0, 0, 0); __builtin_amdgcn_s_setprio(0); } while (0)
#define PG8_WAIT_V(n) asm volatile("s_waitcnt vmcnt(" #n ")" ::: "memory")
#define PG8_WAIT_L(n) asm volatile("s_waitcnt lgkmcnt(" #n ")" ::: "memory")
#define PG8_BAR __builtin_amdgcn_s_barrier()
#define PG8_SCHED __builtin_amdgcn_sched_barrier(0)
    Unit cur, nxt; int ui = 0;
    if (!S.next(0, cur)) return;
    f32x4 acc[2][2][4][2];
#pragma unroll
    for (int a = 0; a < 2; ++a)
#pragma unroll
        for (int b = 0; b < 2; ++b)
#pragma unroll
            for (int m = 0; m < 4; ++m)
#pragma unroll
                for (int n = 0; n < 2; ++n) acc[a][b][m][n] = (f32x4){0.f, 0.f, 0.f, 0.f};
    bf16x8 At[4][2], B0[2][2], B1[2][2];
    const char* cA = (const char*)g.A + (size_t)cur.pm * tstepA; const char* cB = (const char*)g.Bt + (size_t)cur.pn * tstepB;
    S.a_ready(cur);
    if constexpr (SP2) {
        PG8_STAGE(PG8_SB(0, 0), cB, voffB); PG8_STAGE(PG8_SB(0, 1), cB + hstepB, voffB); PG8_STAGE(PG8_SA(0, 0), cA, voffA); PG8_STAGE(PG8_SA(0, 1), cA + hstepA, voffA);
        if (wr == 1) PG8_BAR;
        PG8_WAIT_V(2); PG8_BAR;
        PG8_STAGE(PG8_SB(1, 0), cB + kstep, voffB); PG8_STAGE(PG8_SA(1, 0), cA + kstep, voffA); PG8_STAGE(PG8_SB(1, 1), cB + hstepB + kstep, voffB);
        PG8_WAIT_V(6); PG8_BAR;
    } else {
        PG8_STAGE(PG8_SB(0, 0), cB, voffB); PG8_STAGE(PG8_SA(0, 0), cA, voffA); PG8_STAGE(PG8_SB(0, 1), cB + hstepB, voffB); PG8_STAGE(PG8_SA(0, 1), cA + hstepA, voffA);
        if (wr == 1) PG8_BAR;
        PG8_WAIT_V(4); PG8_BAR;
        PG8_STAGE(PG8_SB(1, 0), cB + kstep, voffB); PG8_STAGE(PG8_SA(1, 0), cA + kstep, voffA); PG8_STAGE(PG8_SB(1, 1), cB + hstepB + kstep, voffB);
        PG8_WAIT_V(6); PG8_BAR;
    }
    for (;;) {
        const bool has_next = S.next(ui + 1, nxt);
        const char* nA = has_next ? (const char*)g.A + (size_t)nxt.pm * tstepA : cA; const char* nB = has_next ? (const char*)g.Bt + (size_t)nxt.pn * tstepB : cB;
        for (int t = 0; t < nt; t += 2) {
            const bool last = (t == nt - 2);
            const char* a1 = cA + (size_t)(t + 1) * kstep;
            const char* a2 = last ? nA : cA + (size_t)(t + 2) * kstep; const char* b2 = last ? nB : cB + (size_t)(t + 2) * kstep;
            const char* a3 = a2 + kstep; const char* b3 = b2 + kstep;
            if (last && has_next) S.a_ready(nxt);
            if constexpr (SP2) {
            PG8_LDB(B0, 0, 0); PG8_LDB(B1, 0, 1); PG8_SCHED; PG8_LDA(At, 0, 0); PG8_STAGE(PG8_SA(1, 1), a1 + hstepA, voffA);
            PG8_WAIT_V(8); PG8_WAIT_L(0); PG8_BAR; PG8_MMA(0, 0, At, B0); PG8_MMA(0, 1, At, B1); PG8_BAR; PG8_SCHED;
            PG8_LDA(At, 0, 1); PG8_STAGE(PG8_SB(0, 0), b2, voffB); PG8_STAGE(PG8_SB(0, 1), b2 + hstepB, voffB); PG8_STAGE(PG8_SA(0, 0), a2, voffA);
            PG8_WAIT_V(8); PG8_WAIT_L(0); PG8_BAR; PG8_MMA(1, 0, At, B0); PG8_MMA(1, 1, At, B1); PG8_BAR; PG8_SCHED;
            PG8_LDB(B0, 1, 0); PG8_LDB(B1, 1, 1); PG8_SCHED; PG8_LDA(At, 1, 0); PG8_STAGE(PG8_SA(0, 1), a2 + hstepA, voffA);
            PG8_WAIT_V(8); PG8_WAIT_L(0); PG8_BAR; PG8_MMA(0, 0, At, B0); PG8_MMA(0, 1, At, B1); PG8_BAR; PG8_SCHED;
            PG8_LDA(At, 1, 1); PG8_STAGE(PG8_SB(1, 0), b3, voffB); PG8_STAGE(PG8_SB(1, 1), b3 + hstepB, voffB); PG8_STAGE(PG8_SA(1, 0), a3, voffA);
            PG8_WAIT_V(8); PG8_WAIT_L(0); PG8_BAR; PG8_MMA(1, 0, At, B0); PG8_MMA(1, 1, At, B1); PG8_BAR; PG8_SCHED;
            } else {
            PG8_LDB(B0, 0, 0); PG8_SCHED; PG8_LDA(At, 0, 0); PG8_STAGE(PG8_SA(1, 1), a1 + hstepA, voffA);
            PG8_WAIT_L(8); PG8_BAR; PG8_WAIT_L(0); PG8_MMA(0, 0, At, B0); PG8_BAR; PG8_SCHED;
            PG8_LDB(B1, 0, 1); PG8_STAGE(PG8_SB(0, 0), b2, voffB);
            PG8_BAR; PG8_WAIT_L(0); PG8_MMA(0, 1, At, B1); PG8_BAR;
            PG8_LDA(At, 0, 1); PG8_STAGE(PG8_SA(0, 0), a2, voffA);
            PG8_BAR; PG8_WAIT_L(0); PG8_MMA(1, 0, At, B0); PG8_BAR; PG8_SCHED;
            PG8_STAGE(PG8_SB(0, 1), b2 + hstepB, voffB);
            PG8_WAIT_V(6); PG8_BAR; PG8_MMA(1, 1, At, B1); PG8_BAR;
            PG8_LDB(B0, 1, 0); PG8_SCHED; PG8_LDA(At, 1, 0); PG8_STAGE(PG8_SA(0, 1), a2 + hstepA, voffA);
            PG8_WAIT_L(8); PG8_BAR; PG8_WAIT_L(0); PG8_MMA(0, 0, At, B0); PG8_BAR; PG8_SCHED;
            PG8_LDB(B1, 1, 1); PG8_STAGE(PG8_SB(1, 0), b3, voffB);
            PG8_BAR; PG8_WAIT_L(0); PG8_MMA(0, 1, At, B1); PG8_BAR;
            PG8_LDA(At, 1, 1); PG8_STAGE(PG8_SA(1, 0), a3, voffA);
            PG8_BAR; PG8_WAIT_L(0); PG8_MMA(1, 0, At, B0); PG8_BAR; PG8_SCHED;
            PG8_STAGE(PG8_SB(1, 1), b3 + hstepB, voffB);
            PG8_WAIT_V(6); PG8_BAR; PG8_MMA(1, 1, At, B1); PG8_BAR;
            }
        }
        if constexpr (ALIGN_EPI) { if (wr == 0) PG8_BAR; }
        if constexpr (!Epi::AFTER_DRAIN) { E(acc, cur, wr, wc, fr, fq); S.done(cur); }
        if (!has_next) break;
#pragma unroll
        for (int a = 0; a < 2; ++a)
#pragma unroll
            for (int b = 0; b < 2; ++b)
#pragma unroll
                for (int m = 0; m < 4; ++m)
#pragma unroll
                    for (int n = 0; n < 2; ++n) acc[a][b][m][n] = (f32x4){0.f, 0.f, 0.f, 0.f};
        cur = nxt; cA = nA; cB = nB; ++ui;
        if constexpr (ALIGN_EPI) { if (wr == 1) PG8_BAR; }
    }
    PG8_WAIT_V(0);
    if constexpr (!ALIGN_EPI) { if (wr == 0) PG8_BAR; }
    PG8_BAR;
    if constexpr (Epi::AFTER_DRAIN) { E.fused(acc, cur, wr, wc, fr, fq, lds, wid, lane); S.done(cur); }
#undef PG8_SA
#undef PG8_SB
#undef PG8_STAGE
#undef PG8_LDA
#undef PG8_LDB
#undef PG8_MMA
#undef PG8_WAIT_V
#undef PG8_WAIT_L
#undef PG8_BAR
#undef PG8_SCHED
}
}
namespace hy {
typedef unsigned short bf16;
constexpr int B = 4, T = 4096, D = 1024, M = B * T;
constexpr int EVEN_IN = 6680, ODD_IN = 8192;
constexpr int NE = 6912;
constexpr int NE1 = 2816, NE2 = 4096;
constexpr int NO1 = 6144, NO2 = 2048;
constexpr size_t MiB = 1u << 20;
constexpr size_t WS_FDT = 1 * MiB, WS_SS = 3 * MiB, WS_CS = 4 * MiB, WS_WA = 5 * MiB, WS_WB = 21 * MiB, WS_AO = 25 * MiB, WS_Y = 89 * MiB, WS_YODD = 25 * MiB;
constexpr size_t WS_XC = WS_Y + 88 * MiB;
constexpr size_t WS_ORAW = WS_YODD + 192 * MiB;
constexpr size_t WS_TMP = 25 * MiB;

__device__ __forceinline__ unsigned f2bf(float f) { unsigned u = __float_as_uint(f); return (u + 0x7fffu + ((u >> 16) & 1u)) >> 16; }
__device__ __forceinline__ float bf2f(bf16 v) { return __uint_as_float((unsigned)v << 16); }
__device__ __forceinline__ float wave_sum(float v) {
#pragma unroll
    for (int o = 1; o < 64; o <<= 1) v += __shfl_xor(v, o);
    return v;
}
__device__ __forceinline__ float sigmoid_f(float x) { return 1.0f / (1.0f + __expf(-x)); }
__device__ __forceinline__ float silu_f(float x) { return x / (1.0f + __expf(-x)); }
__device__ __forceinline__ float log_sigmoid_f(float x) { return fminf(x, 0.f) - log1pf(__expf(-fabsf(x))); }
__device__ __forceinline__ float softplus_f(float x) { return fmaxf(x, 0.f) + log1pf(__expf(-fabsf(x))); }

__global__ void __launch_bounds__(256) k_prologue(const float* __restrict__ x, bf16* __restrict__ hi, bf16* __restrict__ lo, float* __restrict__ SS) {
    const int lane = threadIdx.x & 63, w = (blockIdx.x * blockDim.x + threadIdx.x) >> 6, nw = (gridDim.x * blockDim.x) >> 6;
    for (int m = w; m < M; m += nw) {
        float s = 0.f;
#pragma unroll
        for (int j = 0; j < 4; ++j) { const int c = j * 256 + lane * 4; const float4 v = *(const float4*)(x + (size_t)m * D + c);
            s += (v.x * v.x + v.y * v.y) + (v.z * v.z + v.w * v.w);
            const unsigned h0 = f2bf(v.x), h1 = f2bf(v.y), h2 = f2bf(v.z), h3 = f2bf(v.w);
            const unsigned l0 = f2bf(v.x - __uint_as_float(h0 << 16)), l1 = f2bf(v.y - __uint_as_float(h1 << 16)), l2 = f2bf(v.z - __uint_as_float(h2 << 16)), l3 = f2bf(v.w - __uint_as_float(h3 << 16));
            *(uint2*)(hi + (size_t)m * D + c) = make_uint2(h0 | (h1 << 16), h2 | (h3 << 16));
            *(uint2*)(lo + (size_t)m * D + c) = make_uint2(l0 | (l1 << 16), l2 | (l3 << 16)); }
        s = wave_sum(s);
        if (lane < 16) SS[(size_t)lane * M + m] = lane == 0 ? s : 0.f;
    }
}
__device__ __forceinline__ int even_map(int n) {
    if (n < 4096) return n;
    if (n < 5120) return 4104 + (n - 4096);
    if (n < 6656) return 5128 + (n - 5120);
    if (n < 6664) return 4096 + (n - 6656);
    if (n < 6680) return 6664 + (n - 6664);
    return -1;
}
template <int MAP>
__global__ void __launch_bounds__(256) k_convert_w(const float* __restrict__ W, int K, int Nsrc, int Ndst, const float* __restrict__ nw, bf16* __restrict__ Wt) {
    __shared__ float tile[32][33];
    const int tx = threadIdx.x & 31, ty = threadIdx.x >> 5;
    const int nb = Ndst / 32, kb = K / 32;
    for (int it = blockIdx.x; it < nb * kb; it += gridDim.x) {
        const int n0 = (it % nb) * 32, k0 = (it / nb) * 32;
        const int n = n0 + tx; const int sc = MAP == 1 ? even_map(n) : n;
#pragma unroll
        for (int i = 0; i < 4; ++i) { const int k = k0 + ty + 8 * i; float v = 0.f; if (sc >= 0) { v = W[(size_t)k * Nsrc + sc]; if (nw) v *= nw[k]; } tile[ty + 8 * i][tx] = v; }
        __syncthreads();
#pragma unroll
        for (int i = 0; i < 4; ++i) { const int nn = ty + 8 * i; Wt[(size_t)(n0 + nn) * K + k0 + tx] = (bf16)f2bf(tile[tx][nn]); }
        __syncthreads();
    }
}
template <class Epi>
__global__ void __launch_bounds__(512, 2) k_gemm(pg8::Gemm g, Epi E) {
    extern __shared__ __attribute__((aligned(16))) unsigned char lds[];
    pg8::StaticOrder S; S.init(g.M, g.N, (int)gridDim.x, (int)blockIdx.x);
    pg8::gemm_phase<Epi, pg8::StaticOrder, true, true>((PG8_LAS unsigned char*)lds, g, S, E);
}

__global__ void __launch_bounds__(64) k_fox_cumsum(const float* __restrict__ FDt, const float* __restrict__ f_bias, float* __restrict__ CS) {
    const int bh = blockIdx.x, b = bh >> 3, h = bh & 7, lane = threadIdx.x;
    const float* src = FDt + (size_t)h * M + (size_t)b * T + lane * 64; const float fb = f_bias[h];
    float s = 0.f;
    for (int i = 0; i < 64; ++i) s += log_sigmoid_f(src[i] + fb);
    float inc = s;
#pragma unroll
    for (int o = 1; o < 64; o <<= 1) { const float v = __shfl_up(inc, o); if (lane >= o) inc += v; }
    float run = inc - s;
    float* dst = CS + (size_t)bh * T + lane * 64;
    for (int i = 0; i < 64; ++i) { run += log_sigmoid_f(src[i] + fb); dst[i] = run; }
}
__global__ void __launch_bounds__(256) k_fox_attn(const bf16* __restrict__ Y2, const float* __restrict__ CS, bf16* __restrict__ AO) {
    __shared__ float qs[4][128];
    const int lane = threadIdx.x & 63, wv = threadIdx.x >> 6;
    const int row = blockIdx.x * 4 + wv;
    const int bh = row / T, t = row % T, b = bh >> 3, h = bh & 7;
    const size_t mq = (size_t)b * T + t;
    const bf16* qp = Y2 + mq * NE2 + h * 128;
    const float scale = 0.08838834764831845f;
    qs[wv][lane] = bf2f(qp[lane]) * scale; qs[wv][lane + 64] = bf2f(qp[lane + 64]) * scale;
    __syncthreads();
    const float* cs = CS + (size_t)bh * T; const float ct = cs[t];
    float mrun = -1e30f, l = 0.f, o0 = 0.f, o1 = 0.f;
    for (int j0 = 0; j0 <= t; j0 += 64) {
        const int j = j0 + lane; float s = -INFINITY;
        if (j <= t) {
            const bf16* kp = Y2 + ((size_t)b * T + j) * NE2 + 1024 + h * 128; float a = 0.f;
#pragma unroll 4
            for (int d = 0; d < 128; d += 8) { const uint4 kk = *(const uint4*)(kp + d);
                a += qs[wv][d + 0] * __uint_as_float(kk.x << 16) + qs[wv][d + 1] * __uint_as_float(kk.x & 0xffff0000u) + qs[wv][d + 2] * __uint_as_float(kk.y << 16) + qs[wv][d + 3] * __uint_as_float(kk.y & 0xffff0000u)
                   + qs[wv][d + 4] * __uint_as_float(kk.z << 16) + qs[wv][d + 5] * __uint_as_float(kk.z & 0xffff0000u) + qs[wv][d + 6] * __uint_as_float(kk.w << 16) + qs[wv][d + 7] * __uint_as_float(kk.w & 0xffff0000u); }
            s = a + (ct - cs[j]);
        }
        float tm = s;
#pragma unroll
        for (int o = 1; o < 64; o <<= 1) tm = fmaxf(tm, __shfl_xor(tm, o));
        const float mn = fmaxf(mrun, tm), alpha = __expf(mrun - mn); const float p = __expf(s - mn);
        l = l * alpha + wave_sum(p); o0 *= alpha; o1 *= alpha; mrun = mn;
        const int nk = min(64, t - j0 + 1);
        const bf16* vp = Y2 + ((size_t)b * T + j0) * NE2 + 2048 + h * 128;
        for (int jj = 0; jj < nk; ++jj) { const float pj = __shfl(p, jj); o0 += pj * bf2f(vp[(size_t)jj * NE2 + lane]); o1 += pj * bf2f(vp[(size_t)jj * NE2 + lane + 64]); }
    }
    const float inv = 1.0f / l; const bf16* gp = Y2 + mq * NE2 + 3072 + h * 128;
    AO[mq * 2048 + h * 128 + lane] = (bf16)f2bf(o0 * inv * silu_f(bf2f(gp[lane])));
    AO[mq * 2048 + h * 128 + lane + 64] = (bf16)f2bf(o1 * inv * silu_f(bf2f(gp[lane + 64])));
}

__global__ void __launch_bounds__(256) k_ssd_conv(const bf16* __restrict__ Y1, const float* __restrict__ cw, const float* __restrict__ cb, bf16* __restrict__ XC) {
    const size_t total = (size_t)M * 1536;
    for (size_t i = (size_t)blockIdx.x * blockDim.x + threadIdx.x; i < total; i += (size_t)gridDim.x * blockDim.x) {
        const int m = (int)(i / 1536), ch = (int)(i % 1536), t = m % T; float a = cb[ch];
#pragma unroll
        for (int k = 0; k < 4; ++k) { const int tt = t - 3 + k; if (tt >= 0) a += cw[k * 1536 + ch] * bf2f(Y1[(size_t)(m - 3 + k) * NE1 + 1024 + ch]); }
        XC[i] = (bf16)f2bf(silu_f(a));
    }
}
__global__ void __launch_bounds__(256) k_ssd_scan(const bf16* __restrict__ Y1, const bf16* __restrict__ XC, const float* __restrict__ FDt, const float* __restrict__ dt_bias,
                                                  const float* __restrict__ A_log, const float* __restrict__ Dsk, bf16* __restrict__ AO) {
    const int lane = threadIdx.x & 63, w = (blockIdx.x * blockDim.x + threadIdx.x) >> 6;
    const int p = w & 63, h = (w >> 6) & 15, b = w >> 10, g = h >> 3;
    const float A = -__expf(A_log[h]), dtb = dt_bias[h], Dh = Dsk[h];
    float s0 = 0.f, s1 = 0.f;
    for (int t = 0; t < T; ++t) {
        const size_t m = (size_t)b * T + t;
        const float dt = softplus_f(FDt[(size_t)(8 + h) * M + m] + dtb);
        const float xv = bf2f(XC[m * 1536 + h * 64 + p]);
        const float dec = __expf(dt * A), dx = dt * xv;
        const bf16* bp = XC + m * 1536 + 1024 + g * 128; const bf16* cp = XC + m * 1536 + 1280 + g * 128;
        s0 = dec * s0 + dx * bf2f(bp[lane]); s1 = dec * s1 + dx * bf2f(bp[lane + 64]);
        float y = wave_sum(bf2f(cp[lane]) * s0 + bf2f(cp[lane + 64]) * s1);
        if (lane == 0) { y = (y + Dh * xv) * silu_f(bf2f(Y1[m * NE1 + h * 64 + p])); AO[m * 2048 + 1024 + h * 64 + p] = (bf16)f2bf(y); }
    }
}
__global__ void __launch_bounds__(256) k_ssd_norm(bf16* __restrict__ AO, const float* __restrict__ nw) {
    const int lane = threadIdx.x & 63, w = (blockIdx.x * blockDim.x + threadIdx.x) >> 6;
    if (w >= M * 2) return;
    const int g = w & 1; const size_t m = w >> 1;
    bf16* p = AO + m * 2048 + 1024 + g * 512 + lane * 8;
    const uint4 v = *(const uint4*)p; float f[8] = {__uint_as_float(v.x << 16), __uint_as_float(v.x & 0xffff0000u), __uint_as_float(v.y << 16), __uint_as_float(v.y & 0xffff0000u),
                                                   __uint_as_float(v.z << 16), __uint_as_float(v.z & 0xffff0000u), __uint_as_float(v.w << 16), __uint_as_float(v.w & 0xffff0000u)};
    float s = 0.f;
#pragma unroll
    for (int i = 0; i < 8; ++i) s += f[i] * f[i];
    s = wave_sum(s); const float r = rsqrtf(s * (1.0f / 512.0f) + 1e-5f); const float* wp = nw + g * 512 + lane * 8;
    uint4 o; o.x = f2bf(f[0] * r * wp[0]) | (f2bf(f[1] * r * wp[1]) << 16); o.y = f2bf(f[2] * r * wp[2]) | (f2bf(f[3] * r * wp[3]) << 16);
    o.z = f2bf(f[4] * r * wp[4]) | (f2bf(f[5] * r * wp[5]) << 16); o.w = f2bf(f[6] * r * wp[6]) | (f2bf(f[7] * r * wp[7]) << 16);
    *(uint4*)p = o;
}

__global__ void __launch_bounds__(256) k_hgrn_scan(const bf16* __restrict__ Y, const float* __restrict__ lbl, int oi, int h0, bf16* __restrict__ ORAW) {
    const int lane = threadIdx.x & 63, w = (blockIdx.x * blockDim.x + threadIdx.x) >> 6;
    const int v = w & 127, hh = (w >> 7) & 7, b = w >> 10, h = h0 + hh;
    float lb0 = 0.f, lb1 = 0.f;
    if (oi == 1) { const int c0 = h * 128 + lane, c1 = c0 + 64; lb0 = sigmoid_f(lbl[2048 + c0] - lbl[c0]); lb1 = sigmoid_f(lbl[2048 + c1] - lbl[c1]); }
    float s0 = 0.f, s1 = 0.f;
    for (int t = 0; t < T; ++t) {
        const size_t m = (size_t)b * T + t; const bf16* yp = Y + m * NO1;
        const float q0 = silu_f(bf2f(yp[h * 128 + lane])), q1 = silu_f(bf2f(yp[h * 128 + lane + 64]));
        const float f0 = bf2f(yp[2048 + h * 128 + lane]), f1 = bf2f(yp[2048 + h * 128 + lane + 64]);
        const float iv = bf2f(yp[4096 + h * 128 + v]);
        const float g0 = lb0 + (1.f - lb0) * sigmoid_f(f0), g1 = lb1 + (1.f - lb1) * sigmoid_f(f1);
        const float k0 = (1.f - lb0) * sigmoid_f(-f0), k1 = (1.f - lb1) * sigmoid_f(-f1);
        s0 = g0 * s0 + k0 * iv; s1 = g1 * s1 + k1 * iv;
        const float o = wave_sum(q0 * s0 + q1 * s1);
        if (lane == 0) ORAW[m * 1024 + hh * 128 + v] = (bf16)f2bf(o);
    }
}
__global__ void __launch_bounds__(256) k_hgrn_norm(const bf16* __restrict__ ORAW, const float* __restrict__ nw, int h0, bf16* __restrict__ Y) {
    const int lane = threadIdx.x & 63, w = (blockIdx.x * blockDim.x + threadIdx.x) >> 6;
    if (w >= M * 8) return;
    const int hh = w & 7; const size_t m = w >> 3;
    const unsigned v = *(const unsigned*)(ORAW + m * 1024 + hh * 128 + lane * 2);
    const float a = __uint_as_float(v << 16), c = __uint_as_float(v & 0xffff0000u);
    const float s = wave_sum(a * a + c * c), r = rsqrtf(s * (1.0f / 128.0f) + 1e-5f);
    *(unsigned*)(Y + m * NO1 + (h0 + hh) * 128 + lane * 2) = f2bf(a * r * nw[lane * 2]) | (f2bf(c * r * nw[lane * 2 + 1]) << 16);
}
__global__ void __launch_bounds__(256) k_final(const bf16* __restrict__ hi, const bf16* __restrict__ lo, const float* __restrict__ SS, const float* __restrict__ fw, float* __restrict__ out) {
    const int lane = threadIdx.x & 63, w = (blockIdx.x * blockDim.x + threadIdx.x) >> 6, nw = (gridDim.x * blockDim.x) >> 6;
    for (int m = w; m < M; m += nw) {
        float s = 0.f;
#pragma unroll
        for (int p = 0; p < 16; ++p) s += SS[(size_t)p * M + m];
        const float r = rsqrtf(s * (1.0f / 1024.0f) + 1e-5f);
#pragma unroll
        for (int j = 0; j < 4; ++j) { const int c = j * 256 + lane * 4; const uint2 a = *(const uint2*)(hi + (size_t)m * D + c), bq = *(const uint2*)(lo + (size_t)m * D + c);
            const float4 wv = *(const float4*)(fw + c); float4 o;
            o.x = (__uint_as_float(a.x << 16) + __uint_as_float(bq.x << 16)) * r * wv.x; o.y = (__uint_as_float(a.x & 0xffff0000u) + __uint_as_float(bq.x & 0xffff0000u)) * r * wv.y;
            o.z = (__uint_as_float(a.y << 16) + __uint_as_float(bq.y << 16)) * r * wv.z; o.w = (__uint_as_float(a.y & 0xffff0000u) + __uint_as_float(bq.y & 0xffff0000u)) * r * wv.w;
            *(float4*)(out + (size_t)m * D + c) = o; }
    }
}
}

template <class Epi> static void launch_gemm(const pg8::Gemm& g, const Epi& E, hipStream_t s) {
    static bool done = false;
    if (!done) { done = true; (void)hipFuncSetAttribute((const void*)hy::k_gemm<Epi>, hipFuncAttributeMaxDynamicSharedMemorySize, 132096); }
    hipLaunchKernelGGL(hy::k_gemm<Epi>, dim3(256), dim3(512), 132096, s, g, E);
}
extern "C" void kernel_launch(void* const* d_in, const int* in_sizes, int n_in, void* d_out, int out_size, void* d_ws, size_t ws_size, hipStream_t stream) {
    using namespace hy;
    const float* x = (const float*)d_in[0]; const float* norm_w = (const float*)d_in[1]; const float* final_w = (const float*)d_in[2];
    const float* even_w_in = (const float*)d_in[3]; const float* even_w_out = (const float*)d_in[4]; const float* fox_f_bias = (const float*)d_in[5];
    const float* conv_w = (const float*)d_in[6]; const float* conv_b = (const float*)d_in[7]; const float* dt_bias = (const float*)d_in[8];
    const float* A_log = (const float*)d_in[9]; const float* ssd_D = (const float*)d_in[10]; const float* ssd_nw = (const float*)d_in[11];
    const float* odd_w_in = (const float*)d_in[12]; const float* odd_w_out = (const float*)d_in[13]; const float* lb_logits = (const float*)d_in[14]; const float* hgrn_nw = (const float*)d_in[15];
    unsigned char* ws = (unsigned char*)d_ws;
    bf16* hi = (bf16*)d_out; bf16* lo = hi + (size_t)M * D;
    float* FDt = (float*)(ws + WS_FDT); float* SS = (float*)(ws + WS_SS); float* CS = (float*)(ws + WS_CS);
    bf16* WA = (bf16*)(ws + WS_WA); bf16* WB = (bf16*)(ws + WS_WB); bf16* AO = (bf16*)(ws + WS_AO);
    bf16* Y = (bf16*)(ws + WS_Y); bf16* XC = (bf16*)(ws + WS_XC); bf16* YO = (bf16*)(ws + WS_YODD); bf16* ORAW = (bf16*)(ws + WS_ORAW);
    float* TMP = (float*)(ws + WS_TMP);
    k_prologue<<<1024, 256, 0, stream>>>(x, hi, lo, SS);
    for (int layer = 0; layer < 4; ++layer) {
        const int li = layer >> 1; const float* nw = norm_w + (size_t)layer * D;
        if ((layer & 1) == 0) {
            k_convert_w<1><<<2048, 256, 0, stream>>>(even_w_in + (size_t)li * D * EVEN_IN, D, EVEN_IN, NE, nw, WA);
            k_convert_w<0><<<2048, 256, 0, stream>>>(even_w_out + (size_t)li * 2048 * D, 2048, D, D, nullptr, WB);
            { pg8::Gemm g{hi, WA + (size_t)4096 * D, M, NE1, D, D}; pg8::EpiIn E{Y, NE1, SS, FDt, 10, M}; launch_gemm(g, E, stream); }
            k_ssd_conv<<<4096, 256, 0, stream>>>(Y, conv_w + (size_t)li * 4 * 1536, conv_b + (size_t)li * 1536, XC);
            k_ssd_scan<<<1024, 256, 0, stream>>>(Y, XC, FDt, dt_bias + li * 16, A_log + li * 16, ssd_D + li * 16, AO);
            k_ssd_norm<<<(M * 2) / 4, 256, 0, stream>>>(AO, ssd_nw + (size_t)li * 1024);
            k_fox_cumsum<<<32, 64, 0, stream>>>(FDt, fox_f_bias + li * 8, CS);
            { pg8::Gemm g{hi, WA, M, NE2, D, D}; pg8::EpiIn E{Y, NE2, SS, nullptr, -1, M}; launch_gemm(g, E, stream); }
            k_fox_attn<<<(B * 8 * T) / 4, 256, 0, stream>>>(Y, CS, AO);
            { pg8::Gemm g{AO, WB, M, D, 2048, 2048}; pg8::EpiOut E{hi, lo, SS, M}; launch_gemm(g, E, stream); }
        } else {
            k_convert_w<0><<<2048, 256, 0, stream>>>(odd_w_in + (size_t)li * D * ODD_IN, D, ODD_IN, ODD_IN, nw, WA);
            k_convert_w<0><<<2048, 256, 0, stream>>>(odd_w_out + (size_t)li * 2048 * D, 2048, D, D, nullptr, WB);
            { pg8::Gemm g{hi, WA, M, NO1, D, D}; pg8::EpiIn E{YO, NO1, SS, nullptr, -1, M}; launch_gemm(g, E, stream); }
            for (int h0 = 0; h0 < 16; h0 += 8) {
                k_hgrn_scan<<<1024, 256, 0, stream>>>(YO, lb_logits, li, h0, ORAW);
                k_hgrn_norm<<<(M * 8) / 4, 256, 0, stream>>>(ORAW, hgrn_nw + (size_t)li * 128, h0, YO);
            }
            { pg8::Gemm g{hi, WA + (size_t)6144 * D, M, NO2, D, D}; pg8::EpiGate E{YO, NO1, SS, M}; launch_gemm(g, E, stream); }
            { pg8::Gemm g{YO, WB, M, D, 2048, NO1}; pg8::EpiOut E{hi, lo, SS, M}; launch_gemm(g, E, stream); }
        }
    }
    k_final<<<1024, 256, 0, stream>>>(hi, lo, SS, final_w, TMP);
    (void)hipMemcpyAsync(d_out, TMP, (size_t)M * D * 4, hipMemcpyDeviceToDevice, stream);
}
```

```cpp
#include <hip/hip_runtime.h>
#include <cstdio>
#include <cstdint>
namespace pg8 {
#define PG8_LAS __attribute__((address_space(3)))
typedef unsigned short bf16_t;
typedef short bf16x8 __attribute__((ext_vector_type(8)));
typedef float f32x4 __attribute__((ext_vector_type(4)));
typedef unsigned u32x4 __attribute__((ext_vector_type(4)));
constexpr int BM = 256, BK = 64, HALF = 128, HTB = HALF * BK * 2  , STAGE_BYTES = 8 * HTB, NXCD = 8, WGM = 8, RSL_OFF = STAGE_BYTES + 8192  ;

__host__ __device__ __forceinline__ int lds_byte(int r, int c) { const int st = (r >> 4) * 2 + (c >> 5), rr = r & 15, cc = c & 31, ob = rr * 64 + cc * 2; return st * 1024 + (ob ^ (((ob >> 9) & 1) << 5)); }
__host__ __device__ __forceinline__ void stage_rc(int b, int& R, int& C) { const int st = b / 1024, sb = b % 1024, swz = sb ^ (((sb >> 9) & 1) << 5); R = (st >> 1) * 16 + swz / 64; C = (st & 1) * 32 + (swz % 64) / 2; }
__host__ __device__ __forceinline__ int perm32(int rho) { const int n = rho >> 4, i = rho & 15; return 8 * (i >> 2) + 4 * n + (i & 3); }

struct Unit { int pm, pn; };
struct Gemm { const bf16_t* A; const bf16_t* Bt; int M, N, K, lda; };

struct StaticOrder {
    int nM, nN, nwg, G, c, wv;
    __host__ __device__ void init(int M, int N, int G_, int c_) { nM = M / BM; nN = N / BM; nwg = nM * nN; G = G_; c = c_; }
    __host__ __device__ bool next(int i, Unit& u) const {
        const long L = (long)i * G + c; if (L >= nwg) return false;
        int wgid = (int)L; { const int q = nwg / NXCD, r = nwg % NXCD, xcd = wgid % NXCD, off = wgid / NXCD; wgid = (xcd < r ? xcd * (q + 1) : r * (q + 1) + (xcd - r) * q) + off; }
        const int nig = WGM * nN, gid = wgid / nig, fm = gid * WGM, gsz = (nM - fm) < WGM ? (nM - fm) : WGM;
        u.pm = fm + ((wgid % nig) % gsz); u.pn = (wgid % nig) / gsz; return true;
    }
    __device__ __forceinline__ void a_ready(const Unit&) const {}
    __device__ __forceinline__ void done(const Unit&) const {}
};

__device__ __forceinline__ unsigned cvt_pk_bf16(float lo, float hi) { unsigned r; asm volatile("v_cvt_pk_bf16_f32 %0, %1, %2" : "=v"(r) : "v"(lo), "v"(hi)); return r; }
__device__ __forceinline__ float bf_lo(unsigned w) { return __uint_as_float(w << 16); }
__device__ __forceinline__ float bf_hi(unsigned w) { return __uint_as_float(w & 0xffff0000u); }
typedef unsigned u32x2 __attribute__((ext_vector_type(2)));
__device__ __forceinline__ float lane_xor_f(float v, int mask, int lane) { return __int_as_float(__builtin_amdgcn_ds_bpermute((lane ^ mask) << 2, __float_as_int(v))); }

__device__ __forceinline__ float silu_f(float x) { return x * __builtin_amdgcn_rcpf(1.0f + __expf(-x)); }
struct EpiIn {
    static constexpr bool PERM = true, AFTER_DRAIN = false, RSL = true;
    bf16_t* O; int ldc; const float* RS; float* FDt; int fd_tile; int Mrows;
    PG8_LAS float* NP; float* NRM;
    int g_from; bf16_t* G0; bf16_t* G1; int ldg;
    __device__ __forceinline__ void operator()(const f32x4 (&acc)[2][2][4][2], const Unit& u, int wr, int wc, int fr, int fq, const PG8_LAS float* rsl) const {
        const int row0 = u.pm * BM + wr * 64 + fr;
        float rs[2][4];
#pragma unroll
        for (int ai = 0; ai < 2; ++ai)
#pragma unroll
            for (int m = 0; m < 4; ++m) rs[ai][m] = rsl[wr * 64 + fr + ai * HALF + m * 16];
        if (u.pn == fd_tile) {
            if (wc == 0 && fq < 3) {
#pragma unroll
                for (int ai = 0; ai < 2; ++ai)
#pragma unroll
                    for (int m = 0; m < 4; ++m) { const int r = row0 + ai * HALF + m * 16;
#pragma unroll
                        for (int n = 0; n < 2; ++n)
#pragma unroll
                            for (int j = 0; j < 4; ++j) FDt[(size_t)(8 * fq + 4 * n + j) * Mrows + r] = acc[ai][0][m][n][j] * rs[ai][m]; }
            }
            return;
        }
        if (u.pn >= g_from) {
            const int gi = u.pn - g_from; bf16_t* Gb = (gi < 4 ? G0 : G1) + (gi & 3) * BM + wc * 32 + 8 * fq;
#pragma unroll
            for (int ai = 0; ai < 2; ++ai)
#pragma unroll
                for (int m = 0; m < 4; ++m) { bf16_t* rowp = Gb + (size_t)(row0 + ai * HALF + m * 16) * ldg; const float s = rs[ai][m];
#pragma unroll
                    for (int bj = 0; bj < 2; ++bj) { const f32x4 v0 = acc[ai][bj][m][0] * s, v1 = acc[ai][bj][m][1] * s;
                        u32x4 w; w.x = cvt_pk_bf16(silu_f(v0[0]), silu_f(v0[1])); w.y = cvt_pk_bf16(silu_f(v0[2]), silu_f(v0[3])); w.z = cvt_pk_bf16(silu_f(v1[0]), silu_f(v1[1])); w.w = cvt_pk_bf16(silu_f(v1[2]), silu_f(v1[3]));
                        *(u32x4*)(rowp + bj * HALF) = w; } }
            return;
        }
        const int col0 = u.pn * BM + wc * 32 + 8 * fq;
        const bool nrm = NRM != nullptr && u.pn < 8;
#pragma unroll
        for (int ai = 0; ai < 2; ++ai)
#pragma unroll
            for (int m = 0; m < 4; ++m) { bf16_t* rowp = O + (size_t)(row0 + ai * HALF + m * 16) * ldc + col0; const float s = rs[ai][m];
#pragma unroll
                for (int bj = 0; bj < 2; ++bj) { const f32x4 v0 = acc[ai][bj][m][0] * s, v1 = acc[ai][bj][m][1] * s;
                    u32x4 w; w.x = cvt_pk_bf16(v0[0], v0[1]); w.y = cvt_pk_bf16(v0[2], v0[3]); w.z = cvt_pk_bf16(v1[0], v1[1]); w.w = cvt_pk_bf16(v1[2], v1[3]);
                    *(u32x4*)(rowp + bj * HALF) = w;
                    if (nrm) { float p = ((v0[0] * v0[0] + v0[1] * v0[1]) + (v0[2] * v0[2] + v0[3] * v0[3])) + ((v1[0] * v1[0] + v1[1] * v1[1]) + (v1[2] * v1[2] + v1[3] * v1[3]));
                        p += lane_xor_f(p, 16, fq * 16 + fr); p += lane_xor_f(p, 32, fq * 16 + fr);
                        if (fq == 0) NP[(wc * 256 + wr * 64 + fr + ai * HALF + m * 16) * 2 + bj] = p; } } }
        if (nrm) {
            asm volatile("s_waitcnt lgkmcnt(0)" ::: "memory"); __builtin_amdgcn_s_barrier();
            const int wid = wr * 4 + wc, lane = fq * 16 + fr, bjh = wid >> 2, tq = wid & 3, rl = 64 * tq + lane;
            float sq = (NP[(0 * 256 + rl) * 2 + bjh] + NP[(1 * 256 + rl) * 2 + bjh]) + (NP[(2 * 256 + rl) * 2 + bjh] + NP[(3 * 256 + rl) * 2 + bjh]);
#pragma unroll
            for (int o = 1; o < 64; o <<= 1) sq = fmaxf(sq, lane_xor_f(sq, o, lane));
            if (lane == 0) { const int b = u.pm >> 4, j = (u.pm & 15) * 4 + tq, h = (u.pn & 3) * 2 + bjh, which = u.pn < 4 ? 1 : 0;
                NRM[(size_t)(b * 8 + h) * 128 + which * 64 + j] = sqrtf(sq) * 1.003f; }
        }
    }
};
struct EpiGate {
    static constexpr bool PERM = true, AFTER_DRAIN = false, RSL = true;
    bf16_t* O; int ldc; const float* RS; int Mrows;
    __device__ __forceinline__ void operator()(const f32x4 (&acc)[2][2][4][2], const Unit& u, int wr, int wc, int fr, int fq, const PG8_LAS float* rsl) const {
        const int row0 = u.pm * BM + wr * 64 + fr;
        const int col0 = u.pn * BM + wc * 32 + 8 * fq;
        u32x4 ov[2][4][2]; float rs[2][4];
#pragma unroll
        for (int ai = 0; ai < 2; ++ai)
#pragma unroll
            for (int m = 0; m < 4; ++m) { const int r = row0 + ai * HALF + m * 16; rs[ai][m] = rsl[wr * 64 + fr + ai * HALF + m * 16]; const bf16_t* rowp = O + (size_t)r * ldc + col0;
#pragma unroll
                for (int bj = 0; bj < 2; ++bj) ov[ai][m][bj] = *(const u32x4*)(rowp + bj * HALF); }
        asm volatile("" ::: "memory");
#pragma unroll
        for (int ai = 0; ai < 2; ++ai)
#pragma unroll
            for (int m = 0; m < 4; ++m) { const int r = row0 + ai * HALF + m * 16; const float s = rs[ai][m]; bf16_t* rowp = O + (size_t)r * ldc + col0;
#pragma unroll
                for (int bj = 0; bj < 2; ++bj) { const f32x4 g0 = acc[ai][bj][m][0] * s, g1 = acc[ai][bj][m][1] * s; const u32x4 o = ov[ai][m][bj];
                    u32x4 w;
                    w.x = cvt_pk_bf16(bf_lo(o.x) * silu_f(g0[0]), bf_hi(o.x) * silu_f(g0[1])); w.y = cvt_pk_bf16(bf_lo(o.y) * silu_f(g0[2]), bf_hi(o.y) * silu_f(g0[3]));
                    w.z = cvt_pk_bf16(bf_lo(o.z) * silu_f(g1[0]), bf_hi(o.z) * silu_f(g1[1])); w.w = cvt_pk_bf16(bf_lo(o.w) * silu_f(g1[2]), bf_hi(o.w) * silu_f(g1[3]));
                    *(u32x4*)(rowp + bj * HALF) = w; } }
    }
};
struct EpiOut {
    static constexpr bool PERM = true, AFTER_DRAIN = false, RSL = false;
    bf16_t* hi; float* SS; int Mrows; bf16_t* ho; int ho_pitch;
    __device__ __forceinline__ void operator()(const f32x4 (&acc)[2][2][4][2], const Unit& u, int wr, int wc, int fr, int fq, const PG8_LAS float*) const {
        const int row0 = u.pm * BM + wr * 64 + fr, col0 = u.pn * BM + wc * 32 + 8 * fq;
        u32x4 ah[2][4][2];
#pragma unroll
        for (int ai = 0; ai < 2; ++ai)
#pragma unroll
            for (int m = 0; m < 4; ++m) { const size_t off = (size_t)(row0 + ai * HALF + m * 16) * 1024 + col0;
#pragma unroll
                for (int bj = 0; bj < 2; ++bj) ah[ai][m][bj] = *(const u32x4*)(hi + off + bj * HALF); }
        asm volatile("" ::: "memory");
#pragma unroll
        for (int ai = 0; ai < 2; ++ai)
#pragma unroll
            for (int m = 0; m < 4; ++m) { const int r = row0 + ai * HALF + m * 16; const size_t off = (size_t)r * 1024 + col0; float ssq = 0.f;
#pragma unroll
                for (int bj = 0; bj < 2; ++bj) { const u32x4 a = ah[ai][m][bj]; const f32x4 c0 = acc[ai][bj][m][0], c1 = acc[ai][bj][m][1];
                    const float h0 = bf_lo(a.x) + c0[0], h1 = bf_hi(a.x) + c0[1], h2 = bf_lo(a.y) + c0[2], h3 = bf_hi(a.y) + c0[3];
                    const float h4 = bf_lo(a.z) + c1[0], h5 = bf_hi(a.z) + c1[1], h6 = bf_lo(a.w) + c1[2], h7 = bf_hi(a.w) + c1[3];
                    ssq += ((h0 * h0 + h1 * h1) + (h2 * h2 + h3 * h3)) + ((h4 * h4 + h5 * h5) + (h6 * h6 + h7 * h7));
                    { u32x4 nh; nh.x = cvt_pk_bf16(h0, h1); nh.y = cvt_pk_bf16(h2, h3); nh.z = cvt_pk_bf16(h4, h5); nh.w = cvt_pk_bf16(h6, h7); *(u32x4*)(ho + (size_t)r * ho_pitch + col0 + bj * HALF) = nh; } }
                ssq += lane_xor_f(ssq, 16, fq * 16 + fr); ssq += lane_xor_f(ssq, 32, fq * 16 + fr);
                if (fq == 0) SS[(size_t)(u.pn * 4 + wc) * Mrows + r] = ssq; }
    }
};
template <class Epi, class Sched, bool ALIGN_EPI = false, bool SP2 = false>
__device__ __forceinline__ void gemm_phase(PG8_LAS unsigned char* lds, const Gemm g, const Sched& S, const Epi& E) {
    int l_ = __builtin_amdgcn_mbcnt_hi(~0u, __builtin_amdgcn_mbcnt_lo(~0u, 0u)); asm volatile("" : "+v"(l_)); const int wid = S.wv, tid = wid * 64 + l_, lane = tid & 63, wr = wid >> 2, wc = wid & 3, fr = lane & 15, fq = lane >> 4;
    const int K = g.K, nt = K / BK;
    unsigned voffA[2], voffB[2];
#pragma unroll
    for (int i = 0; i < 2; ++i) { int R, C; stage_rc(tid * 16 + i * 8192, R, C); const int Rb = Epi::PERM ? ((R & ~31) + perm32(R & 31)) : R;
        voffA[i] = (unsigned)(R * g.lda + C) * 2u; voffB[i] = (unsigned)(Rb * K + C) * 2u; }
    const size_t kstep = (size_t)(BK * 2);
    const size_t hstepA = (size_t)HALF * g.lda * 2, hstepB = (size_t)HALF * K * 2;
    const size_t tstepA = 2 * hstepA, tstepB = 2 * hstepB;
    const unsigned ldsw = (unsigned)wid * 1024u;
    const int aoff = lds_byte(wr * 64 + fr, fq * 8), boff = lds_byte(wc * 32 + fr, fq * 8);
#define PG8_SA(b, h) (((b) * 2 + (h)) * HTB)
#define PG8_SB(b, h) ((4 + (b) * 2 + (h)) * HTB)
#define PG8_STAGE(bufoff, gbase, voff) do { _Pragma("unroll") for (int _i = 0; _i < 2; ++_i) \
        __builtin_amdgcn_global_load_lds((const unsigned*)((const char*)(gbase) + (voff)[_i]), (PG8_LAS unsigned*)(lds + (bufoff) + ldsw + _i * 8192), 16, 0, 0); } while (0)
#define PG8_LDA(dst, b, h) do { _Pragma("unroll") for (int m = 0; m < 4; ++m) _Pragma("unroll") for (int k = 0; k < 2; ++k) dst[m][k] = *(const PG8_LAS bf16x8*)(lds + PG8_SA(b, h) + aoff + m * 2048 + k * 1024); } while (0)
#define PG8_LDB(dst, b, h) do { _Pragma("unroll") for (int n = 0; n < 2; ++n) _Pragma("unroll") for (int k = 0; k < 2; ++k) dst[n][k] = *(const PG8_LAS bf16x8*)(lds + PG8_SB(b, h) + boff + n * 2048 + k * 1024); } while (0)
#define PG8_MMA(ai, bj, At, Bt) do { __builtin_amdgcn_s_setprio(1); _Pragma("unroll") for (int m = 0; m < 4; ++m) _Pragma("unroll") for (int n = 0; n < 2; ++n) _Pragma("unroll") for (int k = 0; k < 2; ++k) \
        acc[ai][bj][m][n] = __builtin_amdgcn_mfma_f32_16x16x32_bf16(Bt[n][k], At[m][k], acc[ai][bj][m][n], 0, 0, 0); __builtin_amdgcn_s_setprio(0); } while (0)
#define PG8_WAIT_V(n) asm volatile("s_waitcnt vmcnt(" #n ")" ::: "memory")
#define PG8_WAIT_L(n) asm volatile("s_waitcnt lgkmcnt(" #n ")" ::: "memory")
#define PG8_BAR __builtin_amdgcn_s_barrier()
#define PG8_SCHED __builtin_amdgcn_sched_barrier(0)
    Unit cur, nxt; int ui = 0;
    if (!S.next(0, cur)) return;
    f32x4 acc[2][2][4][2];
#pragma unroll
    for (int a = 0; a < 2; ++a)
#pragma unroll
        for (int b = 0; b < 2; ++b)
#pragma unroll
            for (int m = 0; m < 4; ++m)
#pragma unroll
                for (int n = 0; n < 2; ++n) acc[a][b][m][n] = (f32x4){0.f, 0.f, 0.f, 0.f};
    bf16x8 At[4][2], B0[2][2], B1[2][2];
    const char* cA = (const char*)g.A + (size_t)cur.pm * tstepA; const char* cB = (const char*)g.Bt + (size_t)cur.pn * tstepB;
    S.a_ready(cur);
#define PG8_RS_STAGE(pm_, slot_) do { if (wid < 4) __builtin_amdgcn_global_load_lds((const unsigned*)(E.RS + (size_t)(pm_) * BM + wid * 64 + lane), (PG8_LAS unsigned*)(lds + RSL_OFF + (slot_) * 1024 + wid * 256), 4, 0, 0); } while (0)
    if constexpr (Epi::RSL) PG8_RS_STAGE(cur.pm, 0);
    if constexpr (SP2) {
        PG8_STAGE(PG8_SB(0, 0), cB, voffB); PG8_STAGE(PG8_SB(0, 1), cB + hstepB, voffB); PG8_STAGE(PG8_SA(0, 0), cA, voffA); PG8_STAGE(PG8_SA(0, 1), cA + hstepA, voffA);
        if (wr == 1) PG8_BAR;
        PG8_WAIT_V(2); PG8_BAR;
        PG8_STAGE(PG8_SB(1, 0), cB + kstep, voffB); PG8_STAGE(PG8_SA(1, 0), cA + kstep, voffA); PG8_STAGE(PG8_SB(1, 1), cB + hstepB + kstep, voffB);
        PG8_WAIT_V(6); PG8_BAR;
    } else {
        PG8_STAGE(PG8_SB(0, 0), cB, voffB); PG8_STAGE(PG8_SA(0, 0), cA, voffA); PG8_STAGE(PG8_SB(0, 1), cB + hstepB, voffB); PG8_STAGE(PG8_SA(0, 1), cA + hstepA, voffA);
        if (wr == 1) PG8_BAR;
        PG8_WAIT_V(4); PG8_BAR;
        PG8_STAGE(PG8_SB(1, 0), cB + kstep, voffB); PG8_STAGE(PG8_SA(1, 0), cA + kstep, voffA); PG8_STAGE(PG8_SB(1, 1), cB + hstepB + kstep, voffB);
        PG8_WAIT_V(6); PG8_BAR;
    }
    for (;;) {
        const bool has_next = S.next(ui + 1, nxt);
        const char* nA = has_next ? (const char*)g.A + (size_t)nxt.pm * tstepA : cA; const char* nB = has_next ? (const char*)g.Bt + (size_t)nxt.pn * tstepB : cB;
        for (int t = 0; t < nt; t += 2) {
            const bool last = (t == nt - 2);
            const char* a1 = cA + (size_t)(t + 1) * kstep;
            const char* a2 = last ? nA : cA + (size_t)(t + 2) * kstep; const char* b2 = last ? nB : cB + (size_t)(t + 2) * kstep;
            const char* a3 = a2 + kstep; const char* b3 = b2 + kstep;
            if (last && has_next) { S.a_ready(nxt); if constexpr (Epi::RSL) PG8_RS_STAGE(nxt.pm, (ui + 1) & 1); }
            if constexpr (SP2) {
            PG8_LDB(B0, 0, 0); PG8_LDB(B1, 0, 1); PG8_SCHED; PG8_LDA(At, 0, 0); PG8_STAGE(PG8_SA(1, 1), a1 + hstepA, voffA);
            PG8_WAIT_V(8); PG8_WAIT_L(0); PG8_BAR; PG8_MMA(0, 0, At, B0); PG8_MMA(0, 1, At, B1); PG8_BAR; PG8_SCHED;
            PG8_LDA(At, 0, 1); PG8_STAGE(PG8_SB(0, 0), b2, voffB); PG8_STAGE(PG8_SB(0, 1), b2 + hstepB, voffB); PG8_STAGE(PG8_SA(0, 0), a2, voffA);
            PG8_WAIT_V(8); PG8_WAIT_L(0); PG8_BAR; PG8_MMA(1, 0, At, B0); PG8_MMA(1, 1, At, B1); PG8_BAR; PG8_SCHED;
            PG8_LDB(B0, 1, 0); PG8_LDB(B1, 1, 1); PG8_SCHED; PG8_LDA(At, 1, 0); PG8_STAGE(PG8_SA(0, 1), a2 + hstepA, voffA);
            PG8_WAIT_V(8); PG8_WAIT_L(0); PG8_BAR; PG8_MMA(0, 0, At, B0); PG8_MMA(0, 1, At, B1); PG8_BAR; PG8_SCHED;
            PG8_LDA(At, 1, 1); PG8_STAGE(PG8_SB(1, 0), b3, voffB); PG8_STAGE(PG8_SB(1, 1), b3 + hstepB, voffB); PG8_STAGE(PG8_SA(1, 0), a3, voffA);
            PG8_WAIT_V(8); PG8_WAIT_L(0); PG8_BAR; PG8_MMA(1, 0, At, B0); PG8_MMA(1, 1, At, B1); PG8_BAR; PG8_SCHED;
            } else {
            PG8_LDB(B0, 0, 0); PG8_SCHED; PG8_LDA(At, 0, 0); PG8_STAGE(PG8_SA(1, 1), a1 + hstepA, voffA);
            PG8_WAIT_L(8); PG8_BAR; PG8_WAIT_L(0); PG8_MMA(0, 0, At, B0); PG8_BAR; PG8_SCHED;
            PG8_LDB(B1, 0, 1); PG8_STAGE(PG8_SB(0, 0), b2, voffB);
            PG8_BAR; PG8_WAIT_L(0); PG8_MMA(0, 1, At, B1); PG8_BAR;
            PG8_LDA(At, 0, 1); PG8_STAGE(PG8_SA(0, 0), a2, voffA);
            PG8_BAR; PG8_WAIT_L(0); PG8_MMA(1, 0, At, B0); PG8_BAR; PG8_SCHED;
            PG8_STAGE(PG8_SB(0, 1), b2 + hstepB, voffB);
            PG8_WAIT_V(6); PG8_BAR; PG8_MMA(1, 1, At, B1); PG8_BAR;
            PG8_LDB(B0, 1, 0); PG8_SCHED; PG8_LDA(At, 1, 0); PG8_STAGE(PG8_SA(0, 1), a2 + hstepA, voffA);
            PG8_WAIT_L(8); PG8_BAR; PG8_WAIT_L(0); PG8_MMA(0, 0, At, B0); PG8_BAR; PG8_SCHED;
            PG8_LDB(B1, 1, 1); PG8_STAGE(PG8_SB(1, 0), b3, voffB);
            PG8_BAR; PG8_WAIT_L(0); PG8_MMA(0, 1, At, B1); PG8_BAR;
            PG8_LDA(At, 1, 1); PG8_STAGE(PG8_SA(1, 0), a3, voffA);
            PG8_BAR; PG8_WAIT_L(0); PG8_MMA(1, 0, At, B0); PG8_BAR; PG8_SCHED;
            PG8_STAGE(PG8_SB(1, 1), b3 + hstepB, voffB);
            PG8_WAIT_V(6); PG8_BAR; PG8_MMA(1, 1, At, B1); PG8_BAR;
            }
        }
        if constexpr (ALIGN_EPI) { if (wr == 0) PG8_BAR; }
        if constexpr (!Epi::AFTER_DRAIN) { E(acc, cur, wr, wc, fr, fq, (const PG8_LAS float*)(lds + RSL_OFF + (ui & 1) * 1024)); S.done(cur); }
        if (!has_next) break;
#pragma unroll
        for (int a = 0; a < 2; ++a)
#pragma unroll
            for (int b = 0; b < 2; ++b)
#pragma unroll
                for (int m = 0; m < 4; ++m)
#pragma unroll
                    for (int n = 0; n < 2; ++n) acc[a][b][m][n] = (f32x4){0.f, 0.f, 0.f, 0.f};
        cur = nxt; cA = nA; cB = nB; ++ui;
        if constexpr (ALIGN_EPI) { if (wr == 1) PG8_BAR; }
    }
    PG8_WAIT_V(0);
    if constexpr (!ALIGN_EPI) { if (wr == 0) PG8_BAR; }
    PG8_BAR;
    if constexpr (Epi::AFTER_DRAIN) { E.fused(acc, cur, wr, wc, fr, fq, lds, wid, lane); S.done(cur); }
#undef PG8_RS_STAGE
#undef PG8_SA
#undef PG8_SB
#undef PG8_STAGE
#undef PG8_LDA
#undef PG8_LDB
#undef PG8_MMA
#undef PG8_WAIT_V
#undef PG8_WAIT_L
#undef PG8_BAR
#undef PG8_SCHED
}
}
namespace fa {
typedef unsigned short bf16;
typedef short bf16x8 __attribute__((ext_vector_type(8)));
typedef short s16x4 __attribute__((ext_vector_type(4)));
typedef float f32x16 __attribute__((ext_vector_type(16)));
typedef float f32x4 __attribute__((ext_vector_type(4)));
typedef unsigned u32x4 __attribute__((ext_vector_type(4)));
typedef unsigned u32x2 __attribute__((ext_vector_type(2)));
constexpr int D = 128, NW = 8, QBLK = 32, KVBLK = 64, QB = NW * QBLK, SEQ = 4096;
constexpr int PQ = 4160, PO = 2048;
constexpr int SHM_V = KVBLK * D * 2, SHM_K = KVBLK * D * 2;
constexpr int LDS_WS = 2 * SHM_V + 2 * SHM_K, LDS_CS = LDS_WS + NW * 64 * 4, LDS_Q = LDS_CS + SEQ * 4, LDS_ITEM = LDS_Q + NW * (8 - 7) * 1024, LDS_BYTES = LDS_ITEM + 16 + 256;
constexpr int QREG = 7;
constexpr float SCALE = 0.08838834764831845f, THR = 8.f;
#define KSWZ(row, colB) ((row) * 256 + ((colB) ^ (((row) & 7) << 4)))
#define SBAR() __builtin_amdgcn_sched_barrier(0)
__device__ __forceinline__ int v_st(int k, int c) { const int kk = (k & ~0xC) | ((k & 4) << 1) | ((k & 8) >> 1); return ((kk >> 3) * 4 + (c >> 5)) * 512 + ((kk & 7) * 32 + (c & 31)) * 2; }
__device__ __forceinline__ int v_rd_base(int lane) { return ((lane & 3) << 3) | (((lane >> 2) & 3) << 6) | (((lane >> 4) & 1) << 5) | (((lane >> 5) & 1) << 8); }
constexpr int v_rd_off(int d0, int ks, int half) { return d0 * 512 + ks * 4096 + half * 2048; }
__device__ __forceinline__ int crow(int r, int hi) { return (r & 3) + 8 * (r >> 2) + 4 * hi; }
__device__ __forceinline__ unsigned cvtpk(float lo, float hi) {
    unsigned r; asm volatile("v_cvt_pk_bf16_f32 %0, %1, %2" : "=v"(r) : "v"(lo), "v"(hi)); return r;
}
__device__ __forceinline__ bf16x8 pack8(f32x4 a, f32x4 b) {
    u32x4 w = {cvtpk(a[0], a[1]), cvtpk(a[2], a[3]), cvtpk(b[0], b[1]), cvtpk(b[2], b[3])};
    return *reinterpret_cast<bf16x8*>(&w);
}
__device__ __forceinline__ bf16x8 ld8(const unsigned short* p) { return *reinterpret_cast<const bf16x8*>(p); }
__device__ __forceinline__ void mask_tile(f32x16& p0, f32x16& p1, int dq, unsigned W) {
    const float NEG = -__builtin_inff();
#pragma unroll
    for (int r = 0; r < 16; ++r) {
        const int c = (r & 3) + 8 * (r >> 2);
        if ((unsigned)(dq - c) >= W) p0[r] = NEG;
        if ((unsigned)(dq - c - 32) >= W) p1[r] = NEG;
    }
}
__device__ __forceinline__ void partialSM(f32x16& p0, f32x16& p1, float& m_reg, float& mn, float& alpha) {
    float pmax = p0[0]; for (int r = 1; r < 16; ++r) pmax = fmaxf(pmax, p0[r]); for (int r = 0; r < 16; ++r) pmax = fmaxf(pmax, p1[r]);
    { auto rr = __builtin_amdgcn_permlane32_swap(__float_as_uint(pmax), __float_as_uint(pmax), false, false);
      pmax = fmaxf(__uint_as_float(rr[0]), __uint_as_float(rr[1])); }
    constexpr float C2 = 1.4426950408889634f * SCALE;
    if (__builtin_expect(__all((pmax - m_reg) * SCALE <= THR), 1)) { mn = m_reg; alpha = 1.f; }
    else { mn = fmaxf(m_reg, pmax); alpha = __builtin_amdgcn_exp2f((m_reg - mn) * C2); m_reg = mn; }
    const float mnL = -mn * C2;
    for (int r = 0; r < 16; ++r) p0[r] = fmaf(p0[r], C2, mnL); for (int r = 0; r < 16; ++r) p1[r] = fmaf(p1[r], C2, mnL);
    for (int r = 0; r < 16; ++r) p0[r] = __builtin_amdgcn_exp2f(p0[r]);
}
__device__ __forceinline__ void finishSM(f32x16& p0, f32x16& p1, float alpha, float& l_reg, bf16x8& pa0, bf16x8& pa1, bf16x8& pa2, bf16x8& pa3) {
    for (int r = 0; r < 16; ++r) p1[r] = __builtin_amdgcn_exp2f(p1[r]);
    float ps = 0; for (int r = 0; r < 16; ++r) ps += p0[r]; for (int r = 0; r < 16; ++r) ps += p1[r];
    { auto rr = __builtin_amdgcn_permlane32_swap(__float_as_uint(ps), __float_as_uint(ps), false, false);
      ps = __uint_as_float(rr[0]) + __uint_as_float(rr[1]); }
    l_reg = l_reg * alpha + ps;
#define PK4(P, B_, OUT) do { unsigned a0 = cvtpk(P[B_+0], P[B_+1]), a1 = cvtpk(P[B_+2], P[B_+3]);                          \
        unsigned b0 = cvtpk(P[B_+4], P[B_+5]), b1 = cvtpk(P[B_+6], P[B_+7]);                                             \
        auto r0 = __builtin_amdgcn_permlane32_swap(a0, b0, false, false); auto r1 = __builtin_amdgcn_permlane32_swap(a1, b1, false, false); \
        u32x4 w = {r0[0], r1[0], r0[1], r1[1]}; OUT = *reinterpret_cast<bf16x8*>(&w); } while (0)
    PK4(p0, 0, pa0); PK4(p0, 8, pa1); PK4(p1, 0, pa2); PK4(p1, 8, pa3);
#undef PK4
}
template <int KB>
__device__ __forceinline__ void qkt(f32x16& p0, f32x16& p1, const char* K_lds, const float* nck, int r32, int hi, const bf16x8* qr, const char* q_lds) {
#pragma unroll
    for (int g = 0; g < 4; ++g) { const f32x4 a = *(const f32x4*)(nck + 8 * g + 4 * hi), b = *(const f32x4*)(nck + 32 + 8 * g + 4 * hi);
#pragma unroll
        for (int j = 0; j < 4; ++j) { p0[4 * g + j] = a[j]; p1[4 * g + j] = b[j]; } }
    const char* kb[4];
#pragma unroll
    for (int dd = 0; dd < 4; ++dd) kb[dd] = K_lds + KB * SHM_K + KSWZ(r32, (dd * 16 + hi * 8) * 2);
#pragma unroll
    for (int d0 = 0; d0 < 8; ++d0) { const char* a = kb[d0 & 3] + (d0 >> 2) * 128;
        bf16x8 b0 = *reinterpret_cast<const bf16x8*>(a);
        bf16x8 b1 = *reinterpret_cast<const bf16x8*>(a + 32 * 256);
        const bf16x8 qf = d0 < QREG ? qr[d0] : *reinterpret_cast<const bf16x8*>(q_lds + (d0 - QREG) * 1024);
        p0 = __builtin_amdgcn_mfma_f32_32x32x16_bf16(b0, qf, p0, 0, 0, 0);
        p1 = __builtin_amdgcn_mfma_f32_32x32x16_bf16(b1, qf, p1, 0, 0, 0); }
}
template <int VB, bool SK>
__device__ __forceinline__ void pv_tile(f32x16* o, int vb0, bf16x8 pa0, bf16x8 pa1, bf16x8 pa2, bf16x8 pa3, bool act) {
    if (SK && !act) return;
#define TRRD(dst, off) asm volatile("ds_read_b64_tr_b16 %0, %1 offset:%2" : "=&v"(dst) : "v"(vb0), "i"(off) : "memory")
#define PV_D0(d0) do { s16x4 l0, l1, l2, l3, h0, h1, h2, h3; constexpr int b_ = VB * SHM_V + v_rd_off(d0, 0, 0);     \
        TRRD(l0, b_); TRRD(h0, b_ + 2048); TRRD(l1, b_ + 4096); TRRD(h1, b_ + 6144); TRRD(l2, b_ + 8192); TRRD(h2, b_ + 10240); TRRD(l3, b_ + 12288); TRRD(h3, b_ + 14336); \
        asm volatile("s_waitcnt lgkmcnt(0)" ::: "memory"); SBAR();                 \
        o[d0] = __builtin_amdgcn_mfma_f32_32x32x16_bf16(pa0, (bf16x8){l0[0], l0[1], l0[2], l0[3], h0[0], h0[1], h0[2], h0[3]}, o[d0], 0, 0, 0);   \
        o[d0] = __builtin_amdgcn_mfma_f32_32x32x16_bf16(pa1, (bf16x8){l1[0], l1[1], l1[2], l1[3], h1[0], h1[1], h1[2], h1[3]}, o[d0], 0, 0, 0);   \
        o[d0] = __builtin_amdgcn_mfma_f32_32x32x16_bf16(pa2, (bf16x8){l2[0], l2[1], l2[2], l2[3], h2[0], h2[1], h2[2], h2[3]}, o[d0], 0, 0, 0);   \
        o[d0] = __builtin_amdgcn_mfma_f32_32x32x16_bf16(pa3, (bf16x8){l3[0], l3[1], l3[2], l3[3], h3[0], h3[1], h3[2], h3[3]}, o[d0], 0, 0, 0); } while (0)
    PV_D0(0); PV_D0(1); PV_D0(2); PV_D0(3);
#undef PV_D0
#undef TRRD
}
struct BlockRef { const bf16* Q; const bf16* K; const bf16* V; const bf16* G; bf16* O; int P0; int jlo; int bh; int jw; float kn; };
struct Seam { bf16x8 qr[8]; bf16x8 st_v0, st_v1, st_k0, st_k1; };
#define ROW(p, k0, rr) ((p) + (size_t)((k0) + (rr)) * PQ + sc)
#define VMW() asm volatile("s_waitcnt vmcnt(0)" ::: "memory")
#define VMWN(n) asm volatile("s_waitcnt vmcnt(%0)" :: "i"(n) : "memory")
#define SLOAD_H(Kp, Vp, k0) do { S.st_v0 = ld8(ROW(Vp, k0, sr)); S.st_v1 = ld8(ROW(Vp, k0, 32 + sr)); S.st_k0 = ld8(ROW(Kp, k0, sr)); S.st_k1 = ld8(ROW(Kp, k0, 32 + sr)); } while (0)
#define SWRITE_HK(bf) do { *(bf16x8*)(K_lds + (bf) * SHM_K + kws) = S.st_k0; *(bf16x8*)(K_lds + (bf) * SHM_K + kws + 32 * 256) = S.st_k1; } while (0)
#define SWRITE_HV(bf) do { *(bf16x8*)(V_lds + (bf) * SHM_V + vst0) = S.st_v0; *(bf16x8*)(V_lds + (bf) * SHM_V + vst1) = S.st_v1; } while (0)
#define SWRITE_H(bf) do { SWRITE_HV(bf); SWRITE_HK(bf); } while (0)
__device__ __forceinline__ void fox_prime(const BlockRef& cur, char* lds, Seam& S, int tid) {
    const int wid = __builtin_amdgcn_readfirstlane(tid >> 6), lane = tid & 63, r32 = lane & 31, hi = lane >> 5;
    const int sr = tid >> 4, sc = (tid & 15) * 8, kws = KSWZ(sr, sc * 2); char* K_lds = lds + 2 * SHM_V;
#pragma unroll
    for (int d0 = 0; d0 < 8; ++d0) S.qr[d0] = ld8(cur.Q + (size_t)(wid * QBLK + r32) * PQ + d0 * 16 + hi * 8);
    SLOAD_H(cur.K, cur.V, cur.P0 + 3 * KVBLK); VMW(); SWRITE_HK(0);
    __syncthreads();
}
__device__ __forceinline__ void fox_block(const BlockRef& cur, const BlockRef& nxt, char* lds, Seam& S, int tid, const float* ncs_next  ) {
    const int wid = __builtin_amdgcn_readfirstlane(tid >> 6), lane = tid & 63, r32 = lane & 31, hi = lane >> 5;
    const int NT = cur.P0 / KVBLK + 4 - cur.jlo;
    const unsigned W = 1u << 30;
    const int koff = cur.jlo * KVBLK, klo_w = (cur.jw - cur.jlo) * KVBLK;
    const int qlo = cur.P0 - koff + wid * QBLK, qm = qlo + r32 - 4 * hi;
    char* V_lds = lds; char* K_lds = lds + 2 * SHM_V;
    float* ws = (float*)(lds + LDS_WS) + wid * 64; float* li_l = ws, * al_l = ws + 32;
    const float* cs_l = (const float*)(lds + LDS_CS) + koff;
    float m_reg = -1e30f, l_reg = 0; f32x16 o[4] = {};
    const int sr = tid >> 4, sc = (tid & 15) * 8, vst0 = v_st(sr, sc), vst1 = v_st(32 + sr, sc), kws = KSWZ(sr, sc * 2);
    const int vb0 = (int)(uintptr_t)V_lds + v_rd_base(lane);
    char* q_lds = lds + LDS_Q + wid * (8 - QREG) * 1024 + lane * 16;
    const bf16* Kh = cur.K + (size_t)koff * PQ; const bf16* Vh = cur.V + (size_t)koff * PQ;
#define RESC(a) do { if (__any((a) < 1.f)) { if (hi == 0) al_l[r32] = (a); asm volatile("s_waitcnt lgkmcnt(0)" ::: "memory");              \
                     for (int d_ = 0; d_ < 4; ++d_) for (int r = 0; r < 16; ++r) o[d_][r] *= al_l[crow(r, hi)]; } } while (0)
#define KBASE(t) ((NT - 1 - (t)) * KVBLK)
#define ACT(t) (KBASE(t) <= qlo + QBLK - 1 && KBASE(t) >= klo_w)
#define MASKT(P0_, P1_, t) do { const int kb_ = KBASE(t); if (kb_ + KVBLK - 1 > qlo) mask_tile(P0_, P1_, qm - kb_, W); } while (0)
#define SEAM_K0() do { VMWN(8); SWRITE_HK(0); SBAR(); } while (0)
    f32x16 pA0, pA1, pB0, pB1; float mnA, mnB, alA, alB; bf16x8 pa0, pa1, pa2, pa3;
    float qn_row; { float s_ = 0.f;
#pragma unroll
        for (int d0 = 0; d0 < 8; ++d0) { const u32x4 v_ = __builtin_bit_cast(u32x4, S.qr[d0]);
#pragma unroll
            for (int e_ = 0; e_ < 4; ++e_) { const float lo_ = __uint_as_float(v_[e_] << 16), hi_ = __uint_as_float(v_[e_] & 0xffff0000u); s_ = fmaf(lo_, lo_, s_); s_ = fmaf(hi_, hi_, s_); } }
        auto rr_ = __builtin_amdgcn_permlane32_swap(__float_as_uint(s_), __float_as_uint(s_), false, false);
        qn_row = sqrtf(__uint_as_float(rr_[0]) + __uint_as_float(rr_[1])) * 1.001f; }
    const float kn_v = cur.kn; const int jtop = cur.jlo + NT - 1;
#define DYN(t) __all((fmaf(qn_row, __builtin_bit_cast(float, __builtin_amdgcn_readlane(__builtin_bit_cast(int, kn_v), jtop - (t))), cs_l[KBASE(t) + KVBLK - 1]) - m_reg) * SCALE < -30.0f)
    bool aA, aB;
    SWRITE_HV(0);
#pragma unroll
    for (int d0 = QREG; d0 < 8; ++d0) *(bf16x8*)(q_lds + (d0 - QREG) * 1024) = S.qr[d0];
    SBAR();
    if (NT > 1) SLOAD_H(Kh, Vh, KBASE(1));
    aA = ACT(0); aB = false;
    SBAR(); if (aA) { qkt<0>(pA0, pA1, K_lds, cs_l + KBASE(0), r32, hi, S.qr, q_lds);
        MASKT(pA0, pA1, 0); partialSM(pA0, pA1, m_reg, mnA, alA); } else { alA = 1.f; mnA = m_reg; }
    if (NT > 1) { VMW(); SWRITE_H(1); }
    __syncthreads();
#define HALF_STEP(PX0, PX1, mnX, alX, aX, PY0, PY1, alY, aY, t, KB, VB, SB) do {                                                      \
        SBAR(); if ((t) + 1 < NT) { SLOAD_H(Kh, Vh, KBASE((t) + 1)); SBAR(); }     \
        aX = ACT(t) && !DYN(t); const bool ax_ = aX, ay_ = aY;                                                                \
        if (ax_) qkt<KB>(PX0, PX1, K_lds, cs_l + KBASE(t), r32, hi, S.qr, q_lds);                                        \
        if (ay_) finishSM(PY0, PY1, alY, l_reg, pa0, pa1, pa2, pa3); SBAR();                                                  \
        if (ay_) pv_tile<VB, false>(o, vb0, pa0, pa1, pa2, pa3, true);                                                        \
        if (ax_) { MASKT(PX0, PX1, (t)); partialSM(PX0, PX1, m_reg, mnX, alX); } else { alX = 1.f; mnX = m_reg; }             \
        __syncthreads();                                                                                                      \
        if ((t) + 1 < NT) { VMW(); SWRITE_H(SB); }                                                                            \
        RESC(alX); __syncthreads(); } while (0)
    for (int t = 1; t + 1 < NT; t += 2) {
        HALF_STEP(pB0, pB1, mnB, alB, aB, pA0, pA1, alA, aA, t, 1, 0, 0);
        HALF_STEP(pA0, pA1, mnA, alA, aA, pB0, pB1, alB, aB, t + 1, 0, 1, 1);
    }
    const bool even = (NT & 1) == 0;
    const bool aA_ = aA;
    bool aL_ = false; if (even) aL_ = ACT(NT - 1) && !DYN(NT - 1);
    if (even) { SBAR(); if (aL_) qkt<1>(pB0, pB1, K_lds, cs_l + KBASE(NT - 1), r32, hi, S.qr, q_lds); SBAR(); }
    SLOAD_H(nxt.K, nxt.V, nxt.P0 + 3 * KVBLK); SBAR();
#pragma unroll
    for (int d0 = 0; d0 < 8; ++d0) S.qr[d0] = ld8(nxt.Q + (size_t)(wid * QBLK + r32) * PQ + d0 * 16 + hi * 8);
    SBAR();
    if (aA_) finishSM(pA0, pA1, alA, l_reg, pa0, pa1, pa2, pa3); SBAR();
    if (aA_) pv_tile<0, false>(o, vb0, pa0, pa1, pa2, pa3, true);
    if (even) { if (aL_) { MASKT(pB0, pB1, NT - 1); partialSM(pB0, pB1, m_reg, mnB, alB); } else { alB = 1.f; mnB = m_reg; } __syncthreads(); RESC(alB);
        if (aL_) { finishSM(pB0, pB1, alB, l_reg, pa0, pa1, pa2, pa3); SBAR(); pv_tile<1, false>(o, vb0, pa0, pa1, pa2, pa3, true); } }
    SBAR(); SEAM_K0();
    if (ncs_next) { const f32x4* src_ = (const f32x4*)ncs_next; f32x4* dst_ = (f32x4*)(lds + LDS_CS);
        dst_[tid] = src_[tid]; dst_[tid + 512] = src_[tid + 512]; }
    if (hi == 0) li_l[r32] = l_reg; asm volatile("s_waitcnt lgkmcnt(0)" ::: "memory");
    float rli[16];
#pragma unroll
    for (int r = 0; r < 16; ++r) rli[r] = __builtin_amdgcn_rcpf(li_l[crow(r, hi)]);
    typedef float f32x2_t __attribute__((ext_vector_type(2))); typedef __bf16 bf16x2_t __attribute__((ext_vector_type(2)));
#define FA_CVT(lo_, hi_) __builtin_bit_cast(unsigned, __builtin_convertvector((f32x2_t){lo_, hi_}, bf16x2_t))
    { const unsigned selx = (r32 & 1) ? 0x03020706u : 0x05040100u;
      const bool b1 = (r32 & 2) != 0;
      bf16* Ow = cur.O + (size_t)(wid * QBLK + 4 * hi + (r32 & 3)) * PO + (r32 & ~3);
      const bf16* Gw = cur.G + (size_t)(wid * QBLK + 4 * hi + (r32 & 3)) * PQ + (r32 & ~3);
      u32x2 gl[4][4];
#pragma unroll
      for (int g4 = 0; g4 < 4; ++g4)
#pragma unroll
          for (int d0 = 0; d0 < 4; ++d0) gl[g4][d0] = *(const u32x2*)(Gw + (size_t)(8 * g4) * PQ + d0 * 32);
#pragma unroll
      for (int g4 = 0; g4 < 4; ++g4)
#pragma unroll
          for (int d0 = 0; d0 < 4; ++d0) {
              const unsigned w01 = FA_CVT(o[d0][4 * g4] * rli[4 * g4], o[d0][4 * g4 + 1] * rli[4 * g4 + 1]), w23 = FA_CVT(o[d0][4 * g4 + 2] * rli[4 * g4 + 2], o[d0][4 * g4 + 3] * rli[4 * g4 + 3]);
              const unsigned n01 = (unsigned)__builtin_amdgcn_update_dpp(0, (int)w01, 0xB1, 0xF, 0xF, false), n23 = (unsigned)__builtin_amdgcn_update_dpp(0, (int)w23, 0xB1, 0xF, 0xF, false);
              const unsigned a = __builtin_amdgcn_perm(n01, w01, selx), bq = __builtin_amdgcn_perm(n23, w23, selx);
              const unsigned x = b1 ? a : bq;
              const unsigned y = (unsigned)__builtin_amdgcn_update_dpp(0, (int)x, 0x4E, 0xF, 0xF, false);
              const u32x2 ov = b1 ? (u32x2){y, bq} : (u32x2){a, y}; const u32x2 gv = gl[g4][d0];
#define FA_LO(w_) __uint_as_float((w_) << 16)
#define FA_HI(w_) __uint_as_float((w_) & 0xffff0000u)
              const u32x2 og = (u32x2){FA_CVT(FA_LO(ov.x) * FA_LO(gv.x), FA_HI(ov.x) * FA_HI(gv.x)), FA_CVT(FA_LO(ov.y) * FA_LO(gv.y), FA_HI(ov.y) * FA_HI(gv.y))};
#undef FA_LO
#undef FA_HI
              *(u32x2*)(Ow + (size_t)(8 * g4) * PO + d0 * 32) = og; }
    }
#undef FA_CVT
    __syncthreads();
#undef RESC
#undef KBASE
#undef ACT
#undef DYN
#undef MASKT
#undef SEAM_K0
#undef HALF_STEP
}
#undef ROW
#undef VMW
#undef VMWN
#undef SLOAD_H
#undef SWRITE_HK
#undef SWRITE_HV
#undef SWRITE_H
__device__ __forceinline__ int fox_jlo(const float* ncs, const float* KN, const float* QN, int qb, int lane, int wid, int& jw, float& knl) {
    float qn = 0.f, kd = 0.f;
#pragma unroll
    for (int i = 0; i < 4; ++i) { qn = fmaxf(qn, QN[4 * qb + i]); kd = fmaxf(kd, KN[4 * qb + i]); }
    knl = KN[lane]; float a_ = qn * (knl + kd); asm volatile("" : "+v"(a_));
    const float ce = ncs[64 * lane + 63];
    const float bound = SCALE * (a_ + (ce - ncs[qb * QB]));
    const float bound_w = SCALE * (a_ + (ce - ncs[qb * QB + QBLK * wid]));
    const bool need = lane >= 4 * qb || !(bound < -30.0f);
    const bool need_w = lane >= 4 * qb || !(bound_w < -30.0f);
    jw = (int)__builtin_ctzll(__ballot(need_w));
    return (int)__builtin_ctzll(__ballot(need));
}
__device__ __forceinline__ BlockRef fox_ref(int item, int lane, int wid, const int* ord, const bf16* Y2, const float* CSR, const float* NRM, bf16* AO) {
    BlockRef r; int k, qb; const int x = item >> 6, i = item & 63;
    if (i < 48) { k = i / 12; qb = 15 - (i - k * 12); } else { const int j = i - 48; k = j >> 2; qb = 3 - (j & 3); }
    const int rank = k == 0 ? x : k == 1 ? 15 - x : k == 2 ? 16 + x : 31 - x;
    const int bh = __builtin_amdgcn_readfirstlane(ord[rank]), b = bh >> 3, h = bh & 7;
    const bf16* base = Y2 + (size_t)b * SEQ * PQ + h * D;
    int jw_; r.bh = bh; r.P0 = qb * QB; r.jlo = __builtin_amdgcn_readfirstlane(fox_jlo(CSR + (size_t)bh * SEQ, NRM + (size_t)bh * 128, NRM + (size_t)bh * 128 + 64, qb, lane, wid, jw_, r.kn)); { const int j0_ = __builtin_amdgcn_readfirstlane(jw_); r.jw = j0_ < r.jlo ? r.jlo : j0_; }
    r.Q = base + (size_t)r.P0 * PQ; r.K = base + 1024; r.V = base + 2048; r.G = r.Q + 3072; r.O = AO + ((size_t)b * SEQ + r.P0) * PO + h * D;
    return r;
}
__device__ __forceinline__ int fox_fetch(unsigned* qc  , int x, int lane) {
    unsigned i0 = 0; if (lane == 0) i0 = __hip_atomic_fetch_add(qc + x * 64, 1u, __ATOMIC_RELAXED, __HIP_MEMORY_SCOPE_AGENT);
    i0 = __builtin_amdgcn_readfirstlane(i0);
    if (i0 < 64u) return x * 64 + (int)i0;
    for (int tries = 0; tries < 8; ++tries) {
        unsigned cv = 64u; if (lane < 8) cv = __hip_atomic_load(qc + lane * 64, __ATOMIC_RELAXED, __HIP_MEMORY_SCOPE_AGENT);
        const unsigned m = (unsigned)__builtin_amdgcn_ballot_w64(cv < 64u) & 0xffu;
        if (m == 0u) return -1;
        const unsigned rot = ((m >> x) | (m << (8 - x))) & 0xffu;
        const int y = (x + __builtin_ctz(rot)) & 7;
        unsigned iy = 0; if (lane == 0) iy = __hip_atomic_fetch_add(qc + y * 64, 1u, __ATOMIC_RELAXED, __HIP_MEMORY_SCOPE_AGENT);
        iy = __builtin_amdgcn_readfirstlane(iy);
        if (iy < 64u) return y * 64 + (int)iy;
    }
    return -1;
}
__device__ __forceinline__ void fox_phase(char* lds, int tid, int bid, int G, const bf16* Y2, const float* CSR, const float* NRM, bf16* AO, unsigned* qcnt) {
    (void)bid; (void)G;
    volatile int* slot = (volatile int*)(lds + LDS_ITEM); const int lane = tid & 63;
    const int xcd = (int)(__builtin_amdgcn_s_getreg((3 << 11) | 20) & 7u);
    float* rk = (float*)(lds + LDS_ITEM + 16); int* ord = (int*)(lds + LDS_ITEM + 16 + 128);
    if (tid < 32) rk[tid] = CSR[(size_t)tid * SEQ + SEQ - 1];
    __syncthreads();
    if (tid < 32) { const float r = rk[tid]; int c = 0;
        for (int j = 0; j < 32; ++j) { const float rj = rk[j]; c += (rj < r || (rj == r && j < tid)) ? 1 : 0; }
        ord[c] = tid; }
    if (tid < 64) { const int it_ = fox_fetch(qcnt, xcd, lane); if (lane == 0) slot[0] = it_; }
    __syncthreads();
    const int item0 = __builtin_amdgcn_readfirstlane(slot[0]);
    if (item0 < 0) return;
    BlockRef cur = fox_ref(item0, lane, __builtin_amdgcn_readfirstlane(tid >> 6), ord, Y2, CSR, NRM, AO);
    { const f32x4* src = (const f32x4*)(CSR + (size_t)cur.bh * SEQ); f32x4* dst = (f32x4*)(lds + LDS_CS); dst[tid] = src[tid]; dst[tid + 512] = src[tid + 512]; }
    Seam S;
    fox_prime(cur, lds, S, tid);
    for (;;) {
        if (tid < 64) { const int it_ = fox_fetch(qcnt, xcd, lane); if (lane == 0) slot[1] = it_; }
        __syncthreads();
        const int nitem = __builtin_amdgcn_readfirstlane(slot[1]); const bool last = nitem < 0;
        int tid2 = tid; asm volatile("" : "+v"(tid2));
        const BlockRef nxt = last ? cur : fox_ref(nitem, tid2 & 63, __builtin_amdgcn_readfirstlane(tid2 >> 6), ord, Y2, CSR, NRM, AO);
        fox_block(cur, nxt, lds, S, tid2, (!last && nxt.bh != cur.bh) ? CSR + (size_t)nxt.bh * SEQ : nullptr);
        if (last) break;
        cur = nxt;
    }
}
__device__ __forceinline__ void fox_norms(int gw, int ngw, int lane, const bf16* Y2, float* NRM) {
    for (int task = gw; task < 32 * 2 * 64; task += ngw) {
        const int j = task & 63, which = (task >> 6) & 1, bh = task >> 7, b = bh >> 3, h = bh & 7;
        const bf16* p = Y2 + ((size_t)b * SEQ + 64 * j + lane) * PQ + (which ? 0 : 1024) + h * D;
        float s = 0.f;
#pragma unroll
        for (int i = 0; i < 16; ++i) { const u32x4 v = *(const u32x4*)(p + 8 * i);
            const float a0 = __uint_as_float(v.x << 16), a1 = __uint_as_float(v.x & 0xffff0000u), a2 = __uint_as_float(v.y << 16), a3 = __uint_as_float(v.y & 0xffff0000u),
                        a4 = __uint_as_float(v.z << 16), a5 = __uint_as_float(v.z & 0xffff0000u), a6 = __uint_as_float(v.w << 16), a7 = __uint_as_float(v.w & 0xffff0000u);
            s += (a0 * a0 + a1 * a1) + (a2 * a2 + a3 * a3) + (a4 * a4 + a5 * a5) + (a6 * a6 + a7 * a7); }
#pragma unroll
        for (int o = 1; o < 64; o <<= 1) s = fmaxf(s, __int_as_float(__builtin_amdgcn_ds_bpermute((lane ^ o) << 2, __float_as_int(s))));
        if (lane == 0) NRM[(size_t)bh * 128 + which * 64 + j] = sqrtf(s) * 1.0001f;
    }
}
#undef KSWZ
#undef SBAR
}
namespace hg {
typedef unsigned short bf16;
typedef short bf16x8 __attribute__((ext_vector_type(8)));
typedef float f32x4 __attribute__((ext_vector_type(4)));
typedef unsigned u32x4 __attribute__((ext_vector_type(4)));
typedef unsigned u32x2 __attribute__((ext_vector_type(2)));
typedef float f2 __attribute__((ext_vector_type(2)));
constexpr int T = 4096, NSEG = 4, SEGLEN = T / NSEG, NCH = SEGLEN / 64, PY = 6144;
constexpr int LQ = 136, LS = 72, LO = 132;
constexpr int O_QX = 0, O_KX = O_QX + 64 * LQ * 2, O_KT = O_KX + 64 * LQ * 2, O_VT = O_KT + 128 * LS * 2, O_AM = O_VT + 128 * LS * 2, O_TOT = O_AM + 64 * LS * 2, O_E1 = O_TOT + 4096, O_E2 = O_E1 + 512,
              O_OSTF = O_E2 + 512, O_NW = O_OSTF + 64 * LO * 4, O_OSTF1 = O_NW + 512, LDS_BYTES = O_OSTF1 + 64 * LO * 4;
constexpr float LOG2E = 1.4426950408889634f;
typedef float f32x2_t __attribute__((ext_vector_type(2))); typedef __bf16 bf16x2_t __attribute__((ext_vector_type(2)));
__device__ __forceinline__ unsigned cvtpk(float lo, float hi) { f32x2_t v = {lo, hi}; bf16x2_t b = __builtin_convertvector(v, bf16x2_t); return __builtin_bit_cast(unsigned, b); }
__device__ __forceinline__ f2 ex2(f2 x) { return (f2){__builtin_amdgcn_exp2f(x.x), __builtin_amdgcn_exp2f(x.y)}; }
__device__ __forceinline__ f2 rcp2(f2 x) { return (f2){__builtin_amdgcn_rcpf(x.x), __builtin_amdgcn_rcpf(x.y)}; }
__device__ __forceinline__ f2 lg2(f2 x) { return (f2){__builtin_amdgcn_logf(x.x), __builtin_amdgcn_logf(x.y)}; }
__device__ __forceinline__ f2 max2(f2 a, float b) { return (f2){fmaxf(a.x, b), fmaxf(a.y, b)}; }
__device__ __forceinline__ f2 min2(f2 a, float b) { return (f2){fminf(a.x, b), fminf(a.y, b)}; }
__device__ __forceinline__ f2 clamp2(f2 a, float lim) { return (f2){fminf(fmaxf(a.x, -lim), lim), fminf(fmaxf(a.y, -lim), lim)}; }
__device__ __forceinline__ f2 bf2(unsigned w) { return (f2){__uint_as_float(w << 16), __uint_as_float(w & 0xffff0000u)}; }
__device__ __forceinline__ unsigned pk2(f2 v) { return cvtpk(v.x, v.y); }
#define HG_BAR() __syncthreads()

template <bool STATE_ONLY>
__device__ __forceinline__ void hgrn_stream(char* lds, int tid, int stream, bf16* Y, const float* lbl, int oi, const float* nw, float* SLOC, float* DSEG, const bf16* GA = nullptr, const bf16* GB = nullptr, bf16* Yo = nullptr, int po = PY) {
    const int lane = tid & 63, w = __builtin_amdgcn_readfirstlane(tid >> 6), c = lane & 15, q = lane >> 4;
    const int seg = stream & 3, h = (stream >> 2) & 15, b = stream >> 6;
    if (STATE_ONLY && seg == NSEG - 1) return;
    f2 lbv = (f2){0.f, 0.f};
    if (oi == 1) { const float2 l0 = *(const float2*)(lbl + h * 128 + 2 * lane), l1 = *(const float2*)(lbl + 2048 + h * 128 + 2 * lane);
        lbv = (f2){1.0f / (1.0f + __builtin_amdgcn_exp2f((l0.x - l1.x) * LOG2E)), 1.0f / (1.0f + __builtin_amdgcn_exp2f((l0.y - l1.y) * LOG2E))}; }
    const f2 oml = 1.0f - lbv;
    const size_t row0 = (size_t)b * T + (size_t)seg * SEGLEN;
    bf16* Yq = Y + row0 * PY + h * 128; const bf16* Yf = Yq + 2048; const bf16* Yv = Yq + 4096;
    f32x4 S[8];
#pragma unroll
    for (int i = 0; i < 8; ++i) S[i] = (f32x4){0.f, 0.f, 0.f, 0.f};
    if (!STATE_ONLY && seg > 0) {
        const int s0 = stream - seg;
        float sl[3][32]; f32x4 dd[3][8];
#pragma unroll
        for (int k = 0; k < 3; ++k) { const int sp = seg - 3 + k, spc = sp < 0 ? 0 : sp;
            const float* slp = SLOC + (size_t)(s0 + spc) * 16384 + w * 64 + lane; const float* dg = DSEG + (size_t)(s0 + spc) * 128;
#pragma unroll
            for (int i = 0; i < 8; ++i) { dd[k][i] = *(const f32x4*)(dg + 16 * i + 4 * q);
#pragma unroll
                for (int r = 0; r < 4; ++r) sl[k][i * 4 + r] = slp[(size_t)(i * 4 + r) * 512]; } }
#pragma unroll
        for (int k = 0; k < 3; ++k) { const bool valid = seg - 3 + k >= 0;
#pragma unroll
            for (int i = 0; i < 8; ++i)
#pragma unroll
                for (int r = 0; r < 4; ++r) S[i][r] = S[i][r] * dd[k][i][r] + (valid ? sl[k][i * 4 + r] : 0.f); }
    }
    if (!STATE_ONLY && tid < 128) ((float*)(lds + O_NW))[tid] = nw[tid];
    f2 bseg; { float one_ = 1.f; asm volatile("" : "+v"(one_)); bseg = (f2){one_, one_}; }
    unsigned qraw[8], fraw[8]; u32x4 vraw[2];
    unsigned fraw2[STATE_ONLY ? 8 : 1]; u32x4 vraw2[STATE_ONLY ? 2 : 1];
#define HG_LOADX(cc, FR, VR) do { const size_t r_ = (size_t)(cc) * 64; \
        _Pragma("unroll") for (int j = 0; j < 8; ++j) { FR[j] = *(const unsigned*)(Yf + (r_ + 8 * w + j) * PY + 2 * lane); if (!STATE_ONLY) qraw[j] = *(const unsigned*)(Yq + (r_ + 8 * w + j) * PY + 2 * lane); } \
        _Pragma("unroll") for (int i = 0; i < 2; ++i) VR[i] = *(const u32x4*)(Yv + (r_ + 2 * (tid >> 4) + i) * PY + (tid & 15) * 8); } while (0)
    const bf16* Gu = STATE_ONLY ? nullptr : (h < 8 ? GA : GB) + row0 * 1024 + (h & 7) * 128;
    auto chunk = [&](const int ch, unsigned (&fr)[8], u32x4 (&vr)[2], const int ld_ch) {
        u32x4 gt0, gt1;
        if (!STATE_ONLY) { const bf16* gp = Gu + (size_t)ch * 64 * 1024; const int go = (tid >> 3) * 1024 + (tid & 7) * 16; gt0 = *(const u32x4*)(gp + go); gt1 = *(const u32x4*)(gp + go + 8); }
        f2 fj[8], kin[8], qs[8];
        float* TOT = (float*)(lds + O_TOT);
        { f2 tot;
#pragma unroll
          for (int j = 0; j < 8; ++j) { const f2 e = ex2(min2(bf2(fr[j]) * (-LOG2E), 64.f)), sig = rcp2(1.0f + e);
              fj[j] = lbv + oml * sig; kin[j] = oml - oml * sig; tot = j == 0 ? fj[0] : tot * fj[j];
              if (!STATE_ONLY) { const f2 qq = bf2(qraw[j]); qs[j] = qq * rcp2(1.0f + ex2(min2(qq * (-LOG2E), 64.f))); } }
          *(f2*)(TOT + w * 128 + 2 * lane) = tot; }
        HG_BAR();
        { const int s2 = tid >> 4, v0 = (tid & 15) * 8;
          unsigned* vt = (unsigned*)((bf16*)(lds + O_VT) + v0 * LS + ((((s2 >> 2) ^ (tid & 7)) & 7) << 3) + 2 * (s2 & 3));
          vt[0 * (LS / 2)] = (vr[0].x & 0xffffu) | (vr[1].x << 16); vt[1 * (LS / 2)] = (vr[0].x >> 16) | (vr[1].x & 0xffff0000u);
          vt[2 * (LS / 2)] = (vr[0].y & 0xffffu) | (vr[1].y << 16); vt[3 * (LS / 2)] = (vr[0].y >> 16) | (vr[1].y & 0xffff0000u);
          vt[4 * (LS / 2)] = (vr[0].z & 0xffffu) | (vr[1].z << 16); vt[5 * (LS / 2)] = (vr[0].z >> 16) | (vr[1].z & 0xffff0000u);
          vt[6 * (LS / 2)] = (vr[0].w & 0xffffu) | (vr[1].w << 16); vt[7 * (LS / 2)] = (vr[0].w >> 16) | (vr[1].w & 0xffff0000u); }
        if (ld_ch < NCH) HG_LOADX(ld_ch, fr, vr);
        f2 lo4, hi4, part; { float one_ = 1.f; asm volatile("" : "+v"(one_)); part = (f2){one_, one_}; }
#pragma unroll
        for (int g8 = 0; g8 < 8; ++g8) { const f2 t_ = *(const f2*)(TOT + g8 * 128 + 2 * lane); if (g8 == 0) lo4 = t_; else if (g8 < 4) lo4 *= t_; else if (g8 == 4) hi4 = t_; else hi4 *= t_;
            const bool in_ = STATE_ONLY ? (g8 > w) : (w < 4 ? (g8 > w && g8 < 4) : (g8 >= 4 && g8 < w)); if (in_) part *= t_; }
        if (w == 0) {
            if (STATE_ONLY) { const f2 tt = lo4 * hi4; bseg *= tt; *(f2*)((float*)(lds + O_E1) + 2 * lane) = tt; }
            else { *(f2*)((float*)(lds + O_E1) + 2 * lane) = lo4; *(f2*)((float*)(lds + O_E2) + 2 * lane) = hi4; } }
        { f2 kt[8];
          const float TINY = 7.888609052210118e-31f;
          if (STATE_ONLY) {
              f2 s = part;
#pragma unroll
              for (int j = 7; j >= 0; --j) { kt[j] = kin[j] * s; s *= fj[j]; }
          } else {
              unsigned* QX = (unsigned*)((bf16*)(lds + O_QX) + (8 * w) * LQ + 2 * lane); unsigned* KX = (unsigned*)((bf16*)(lds + O_KX) + (8 * w) * LQ + 2 * lane);
              if (w < 4) { f2 s = part;
#pragma unroll
                  for (int j = 7; j >= 0; --j) { const f2 uc = max2(s, TINY), ed = rcp2(uc); kt[j] = kin[j] * uc; QX[j * (LQ / 2)] = pk2(qs[j] * ed); KX[j * (LQ / 2)] = pk2(kt[j]); s *= fj[j]; }
              } else { f2 p = part;
#pragma unroll
                  for (int j = 0; j < 8; ++j) { p *= fj[j]; const f2 wc = max2(p, TINY); kt[j] = kin[j] * rcp2(wc); QX[j * (LQ / 2)] = pk2(qs[j] * wc); KX[j * (LQ / 2)] = pk2(kt[j]); } }
          }
          u32x4* kd = (u32x4*)((bf16*)(lds + O_KT) + (2 * lane) * LS + 8 * w);
          kd[0] = (u32x4){cvtpk(kt[0].x, kt[1].x), cvtpk(kt[2].x, kt[3].x), cvtpk(kt[4].x, kt[5].x), cvtpk(kt[6].x, kt[7].x)};
          *(u32x4*)((bf16*)kd + LS) = (u32x4){cvtpk(kt[0].y, kt[1].y), cvtpk(kt[2].y, kt[3].y), cvtpk(kt[4].y, kt[5].y), cvtpk(kt[6].y, kt[7].y)}; }
        HG_BAR();
        f32x4 O[4];
        if (!STATE_ONLY) {
            for (int ti = w; ti < 12; ti += 8) {
                int I, J; if (ti < 1) { I = 0; J = 0; } else if (ti < 3) { I = 1; J = ti - 1; } else if (ti < 6) { I = 2; J = ti - 3; } else if (ti < 10) { I = 3; J = ti - 6; } else { I = (ti - 10) * 2; J = I + 1; }
                f32x4 acc = (f32x4){0.f, 0.f, 0.f, 0.f};
                if (ti < 10) {
                    const bf16* Kt = (const bf16*)(lds + O_KX) + (16 * J + c) * LQ + 8 * q; const bf16* Qt = (const bf16*)(lds + O_QX) + (16 * I + c) * LQ + 8 * q;
                    bf16x8 ka[4], qa[4];
#pragma unroll
                    for (int ks = 0; ks < 4; ++ks) { ka[ks] = *(const bf16x8*)(Kt + 32 * ks); qa[ks] = *(const bf16x8*)(Qt + 32 * ks); }
                    __builtin_amdgcn_sched_barrier(0);
#pragma unroll
                    for (int ks = 0; ks < 4; ++ks) acc = __builtin_amdgcn_mfma_f32_16x16x32_bf16(ka[ks], qa[ks], acc, 0, 0, 0);
                    if (I == J) {
#pragma unroll
                        for (int r = 0; r < 4; ++r) if (4 * q + r > c) acc[r] = 0.f; }
                }
                *(u32x2*)((bf16*)(lds + O_AM) + (16 * I + c) * LS + 16 * J + 4 * q) = (u32x2){cvtpk(acc[0], acc[1]), cvtpk(acc[2], acc[3])};
            }
            HG_BAR();
        }
        const bf16* VTw = (const bf16*)(lds + O_VT) + (16 * w + c) * LS; const int vsw = (2 * w + (c >> 3)) & 7;
        const float* E1 = (const float*)(lds + O_E1);
        if (!STATE_ONLY) {
            f32x4 e1[8]; u32x4 qa[4][4];
            const bf16x8 bv0 = *(const bf16x8*)(VTw + 8 * (q ^ vsw)), bv1 = *(const bf16x8*)(VTw + 8 * ((4 + q) ^ vsw));
#pragma unroll
            for (int kt_ = 0; kt_ < 8; ++kt_) e1[kt_] = *(const f32x4*)(E1 + 16 * kt_ + 4 * q);
#pragma unroll
            for (int ks = 0; ks < 4; ++ks)
#pragma unroll
                for (int mt = 0; mt < 4; ++mt) { const bf16* qh = (const bf16*)(lds + O_QX) + (16 * mt + c) * LQ + 32 * ks + 4 * q;
                    const u32x2 a0 = *(const u32x2*)qh, a1 = *(const u32x2*)(qh + 16); qa[ks][mt] = (u32x4){a0.x, a0.y, a1.x, a1.y}; }
            __builtin_amdgcn_sched_barrier(0);
#pragma unroll
            for (int kt_ = 0; kt_ < 8; ++kt_) S[kt_] = S[kt_] * e1[kt_];
#pragma unroll
            for (int mt = 0; mt < 4; ++mt) O[mt] = (f32x4){0.f, 0.f, 0.f, 0.f};
#pragma unroll
            for (int ks = 0; ks < 4; ++ks) {
                const u32x4 sb = (u32x4){cvtpk(S[2 * ks][0], S[2 * ks][1]), cvtpk(S[2 * ks][2], S[2 * ks][3]), cvtpk(S[2 * ks + 1][0], S[2 * ks + 1][1]), cvtpk(S[2 * ks + 1][2], S[2 * ks + 1][3])};
                const bf16x8 bS = __builtin_bit_cast(bf16x8, sb);
#pragma unroll
                for (int mt = 0; mt < 4; ++mt) O[mt] = __builtin_amdgcn_mfma_f32_16x16x32_bf16(__builtin_bit_cast(bf16x8, qa[ks][mt]), bS, O[mt], 0, 0, 0);
            }
            __builtin_amdgcn_sched_barrier(0);
            bf16x8 am[6], kh[8][2]; f32x4 e2[8];
#pragma unroll
            for (int mt = 0; mt < 4; ++mt) { const bf16* amp = (const bf16*)(lds + O_AM) + (16 * mt + c) * LS + 8 * q;
                am[mt] = *(const bf16x8*)amp; if (mt >= 2) am[2 + mt] = *(const bf16x8*)(amp + 32); }
#pragma unroll
            for (int kt_ = 0; kt_ < 4; ++kt_) { const bf16* khp = (const bf16*)(lds + O_KT) + (16 * kt_ + c) * LS + 8 * q; kh[kt_][0] = *(const bf16x8*)khp; kh[kt_][1] = *(const bf16x8*)(khp + 32); }
            __builtin_amdgcn_sched_barrier(0);
#pragma unroll
            for (int mt = 0; mt < 4; ++mt) { O[mt] = __builtin_amdgcn_mfma_f32_16x16x32_bf16(am[mt], bv0, O[mt], 0, 0, 0);
                if (mt >= 2) O[mt] = __builtin_amdgcn_mfma_f32_16x16x32_bf16(am[2 + mt], bv1, O[mt], 0, 0, 0); }
#pragma unroll
            for (int kt_ = 4; kt_ < 8; ++kt_) { const bf16* khp = (const bf16*)(lds + O_KT) + (16 * kt_ + c) * LS + 8 * q; kh[kt_][0] = *(const bf16x8*)khp; kh[kt_][1] = *(const bf16x8*)(khp + 32); }
            { const float* E2 = (const float*)(lds + O_E2);
#pragma unroll
              for (int kt_ = 0; kt_ < 8; ++kt_) e2[kt_] = *(const f32x4*)(E2 + 16 * kt_ + 4 * q); }
            __builtin_amdgcn_sched_barrier(0);
#pragma unroll
            for (int kt_ = 0; kt_ < 8; ++kt_) { S[kt_] = __builtin_amdgcn_mfma_f32_16x16x32_bf16(kh[kt_][0], bv0, S[kt_], 0, 0, 0);
                S[kt_] = __builtin_amdgcn_mfma_f32_16x16x32_bf16(kh[kt_][1], bv1, S[kt_], 0, 0, 0); }
#pragma unroll
            for (int kt_ = 0; kt_ < 8; ++kt_) S[kt_] = S[kt_] * e2[kt_];
        } else {
            const bf16x8 bv0 = *(const bf16x8*)(VTw + 8 * (q ^ vsw)), bv1 = *(const bf16x8*)(VTw + 8 * ((4 + q) ^ vsw));
#pragma unroll
            for (int kt_ = 0; kt_ < 8; ++kt_) S[kt_] = S[kt_] * *(const f32x4*)(E1 + 16 * kt_ + 4 * q);
#pragma unroll
            for (int kt_ = 0; kt_ < 8; ++kt_) { const bf16* khp = (const bf16*)(lds + O_KT) + (16 * kt_ + c) * LS + 8 * q;
                S[kt_] = __builtin_amdgcn_mfma_f32_16x16x32_bf16(*(const bf16x8*)khp, bv0, S[kt_], 0, 0, 0);
                S[kt_] = __builtin_amdgcn_mfma_f32_16x16x32_bf16(*(const bf16x8*)(khp + 32), bv1, S[kt_], 0, 0, 0); }
        }
        if (!STATE_ONLY) {
            float* OS = (float*)(lds + O_OSTF);
#pragma unroll
            for (int mt = 0; mt < 4; ++mt)
#pragma unroll
                for (int r = 0; r < 4; ++r) OS[(16 * mt + 4 * q + r) * LO + 16 * w + c] = O[mt][r];
            HG_BAR();
            const int t = tid >> 3, v0 = (tid & 7) * 16; const float* orow = OS + t * LO + v0;
            f32x4 x[4]; float ss = 0.f;
#pragma unroll
            for (int i = 0; i < 4; ++i) { x[i] = *(const f32x4*)(orow + 4 * i); ss += (x[i][0] * x[i][0] + x[i][1] * x[i][1]) + (x[i][2] * x[i][2] + x[i][3] * x[i][3]); }
            ss += __int_as_float(__builtin_amdgcn_update_dpp(0, __float_as_int(ss), 0xB1, 0xF, 0xF, false));
            ss += __int_as_float(__builtin_amdgcn_update_dpp(0, __float_as_int(ss), 0x4E, 0xF, 0xF, false));
            ss += __int_as_float(__builtin_amdgcn_ds_swizzle(__float_as_int(ss), 0x101F));
            const float rs = rsqrtf(ss * (1.0f / 128.0f) + 1e-5f);
            u32x4 o0, o1; const float* wv = (const float*)(lds + O_NW) + v0;
#define HG_G(w_, i_) ((i_) ? __uint_as_float((w_) & 0xffff0000u) : __uint_as_float((w_) << 16))
            o0.x = cvtpk(x[0][0] * rs * wv[0] * HG_G(gt0.x, 0), x[0][1] * rs * wv[1] * HG_G(gt0.x, 1)); o0.y = cvtpk(x[0][2] * rs * wv[2] * HG_G(gt0.y, 0), x[0][3] * rs * wv[3] * HG_G(gt0.y, 1));
            o0.z = cvtpk(x[1][0] * rs * wv[4] * HG_G(gt0.z, 0), x[1][1] * rs * wv[5] * HG_G(gt0.z, 1)); o0.w = cvtpk(x[1][2] * rs * wv[6] * HG_G(gt0.w, 0), x[1][3] * rs * wv[7] * HG_G(gt0.w, 1));
            o1.x = cvtpk(x[2][0] * rs * wv[8] * HG_G(gt1.x, 0), x[2][1] * rs * wv[9] * HG_G(gt1.x, 1)); o1.y = cvtpk(x[2][2] * rs * wv[10] * HG_G(gt1.y, 0), x[2][3] * rs * wv[11] * HG_G(gt1.y, 1));
            o1.z = cvtpk(x[3][0] * rs * wv[12] * HG_G(gt1.z, 0), x[3][1] * rs * wv[13] * HG_G(gt1.z, 1)); o1.w = cvtpk(x[3][2] * rs * wv[14] * HG_G(gt1.w, 0), x[3][3] * rs * wv[15] * HG_G(gt1.w, 1));
#undef HG_G
            bf16* dst = (Yo ? Yo : Yq) + ((size_t)ch * 64 + t) * po + v0;
            *(u32x4*)dst = o0; *(u32x4*)(dst + 8) = o1;
        }
    };
    if (STATE_ONLY) {
        HG_LOADX(0, fraw, vraw); HG_LOADX(1, fraw2, vraw2);
        for (int ch = 0; ch < NCH; ch += 2) { chunk(ch, fraw, vraw, ch + 2); chunk(ch + 1, (unsigned (&)[8])fraw2, (u32x4 (&)[2])vraw2, ch + 3); }
    } else {
        HG_LOADX(0, fraw, vraw);
        for (int ch = 0; ch < NCH; ++ch) chunk(ch, fraw, vraw, ch + 1);
    }
    if (STATE_ONLY) {
        float* sl = SLOC + (size_t)stream * 16384 + w * 64 + lane;
#pragma unroll
        for (int i = 0; i < 8; ++i)
#pragma unroll
            for (int r = 0; r < 4; ++r) sl[(size_t)(i * 4 + r) * 512] = S[i][r];
        if (w == 0) *(f2*)(DSEG + (size_t)stream * 128 + 2 * lane) = bseg;
    }
#undef HG_LOADX
}

__device__ __forceinline__ void hgrn_state128(char* lds, int tid, int stream, const bf16* Y, const float* lbl, int oi, float* SLOC, float* DSEG) {
    const int lane = tid & 63, w = __builtin_amdgcn_readfirstlane(tid >> 6), c = lane & 15, q = lane >> 4;
    const int seg = stream & 3, h = (stream >> 2) & 15, b = stream >> 6;
    if (seg == NSEG - 1) return;
    constexpr int CH = 128, NC = SEGLEN / CH, L2 = CH + 8, P_KT = 0, P_VT = P_KT + 128 * L2 * 2, P_TOT = P_VT + 128 * L2 * 2, P_E1 = P_TOT + 4096;
    f2 lbv = (f2){0.f, 0.f};
    if (oi == 1) { const float2 l0 = *(const float2*)(lbl + h * 128 + 2 * lane), l1 = *(const float2*)(lbl + 2048 + h * 128 + 2 * lane);
        lbv = (f2){1.0f / (1.0f + __builtin_amdgcn_exp2f((l0.x - l1.x) * LOG2E)), 1.0f / (1.0f + __builtin_amdgcn_exp2f((l0.y - l1.y) * LOG2E))}; }
    const f2 oml = 1.0f - lbv;
    const size_t row0 = (size_t)b * T + (size_t)seg * SEGLEN;
    const bf16* Yf = Y + row0 * PY + h * 128 + 2048; const bf16* Yv = Yf + 2048;
    f32x4 S[8];
#pragma unroll
    for (int i = 0; i < 8; ++i) S[i] = (f32x4){0.f, 0.f, 0.f, 0.f};
    f2 bseg; { float one_ = 1.f; asm volatile("" : "+v"(one_)); bseg = (f2){one_, one_}; }
    unsigned fr[16]; u32x4 vr[4];
#define HA_LOAD(cc) do { const size_t r_ = (size_t)(cc) * CH; \
        _Pragma("unroll") for (int j = 0; j < 16; ++j) fr[j] = *(const unsigned*)(Yf + (r_ + 16 * w + j) * PY + 2 * lane); \
        _Pragma("unroll") for (int i = 0; i < 4; ++i) vr[i] = *(const u32x4*)(Yv + (r_ + 4 * (tid >> 4) + i) * PY + (tid & 15) * 8); } while (0)
    HA_LOAD(0);
    float* TOT = (float*)(lds + P_TOT); float* E1 = (float*)(lds + P_E1);
    for (int ch = 0; ch < NC; ++ch) {
        f2 fj[16], kin[16];
        { f2 tot;
#pragma unroll
          for (int j = 0; j < 16; ++j) { const f2 e = ex2(bf2(fr[j]) * (-LOG2E)), sig = rcp2(1.0f + e);
              fj[j] = lbv + oml * sig; kin[j] = oml - oml * sig; tot = j == 0 ? fj[0] : tot * fj[j]; }
          *(f2*)(TOT + w * 128 + 2 * lane) = tot; }
        __syncthreads();
        { const int s4 = tid >> 4, v0 = (tid & 15) * 8;
          bf16* vt = (bf16*)(lds + P_VT) + v0 * L2 + ((((s4 >> 1) ^ (tid & 7)) & 15) << 3) + 4 * (s4 & 1);
#define HA_VW(i_, comp, hi_) *(u32x2*)(vt + (i_) * L2) = (hi_) ? (u32x2){(vr[0].comp >> 16) | (vr[1].comp & 0xffff0000u), (vr[2].comp >> 16) | (vr[3].comp & 0xffff0000u)} \
                                                              : (u32x2){(vr[0].comp & 0xffffu) | (vr[1].comp << 16), (vr[2].comp & 0xffffu) | (vr[3].comp << 16)}
          HA_VW(0, x, 0); HA_VW(1, x, 1); HA_VW(2, y, 0); HA_VW(3, y, 1); HA_VW(4, z, 0); HA_VW(5, z, 1); HA_VW(6, w, 0); HA_VW(7, w, 1);
#undef HA_VW
        }
        if (ch + 1 < NC) HA_LOAD(ch + 1);
        f2 tt, part; { float one_ = 1.f; asm volatile("" : "+v"(one_)); part = (f2){one_, one_}; }
#pragma unroll
        for (int g8 = 0; g8 < 8; ++g8) { const f2 t_ = *(const f2*)(TOT + g8 * 128 + 2 * lane); tt = g8 == 0 ? t_ : tt * t_; if (g8 > w) part *= t_; }
        if (w == 0) { bseg *= tt; *(f2*)(E1 + 2 * lane) = tt; }
        { f2 kt[16]; f2 s = part;
#pragma unroll
          for (int j = 15; j >= 0; --j) { kt[j] = kin[j] * s; s *= fj[j]; }
          u32x4* kd = (u32x4*)((bf16*)(lds + P_KT) + (2 * lane) * L2 + 16 * w);
          kd[0] = (u32x4){cvtpk(kt[0].x, kt[1].x), cvtpk(kt[2].x, kt[3].x), cvtpk(kt[4].x, kt[5].x), cvtpk(kt[6].x, kt[7].x)};
          kd[1] = (u32x4){cvtpk(kt[8].x, kt[9].x), cvtpk(kt[10].x, kt[11].x), cvtpk(kt[12].x, kt[13].x), cvtpk(kt[14].x, kt[15].x)};
          u32x4* kd1 = (u32x4*)((bf16*)kd + L2);
          kd1[0] = (u32x4){cvtpk(kt[0].y, kt[1].y), cvtpk(kt[2].y, kt[3].y), cvtpk(kt[4].y, kt[5].y), cvtpk(kt[6].y, kt[7].y)};
          kd1[1] = (u32x4){cvtpk(kt[8].y, kt[9].y), cvtpk(kt[10].y, kt[11].y), cvtpk(kt[12].y, kt[13].y), cvtpk(kt[14].y, kt[15].y)}; }
        __syncthreads();
        { const int kh = w >> 2, vq = w & 3;
          bf16x8 bv[2][4];
#pragma unroll
          for (int nt = 0; nt < 2; ++nt) { const bf16* VTw = (const bf16*)(lds + P_VT) + (32 * vq + 16 * nt + c) * L2; const int vsw = (4 * vq + 2 * nt + (c >> 3)) & 7;
#pragma unroll
              for (int ks = 0; ks < 4; ++ks) bv[nt][ks] = *(const bf16x8*)(VTw + 8 * ((4 * ks + q) ^ vsw)); }
#pragma unroll
          for (int kt = 0; kt < 4; ++kt) { const f32x4 e = *(const f32x4*)(E1 + 64 * kh + 16 * kt + 4 * q); S[kt * 2] = S[kt * 2] * e; S[kt * 2 + 1] = S[kt * 2 + 1] * e; }
#pragma unroll
          for (int g2 = 0; g2 < 2; ++g2) {
              bf16x8 kf[2][4];
#pragma unroll
              for (int kk = 0; kk < 2; ++kk) { const bf16* khp = (const bf16*)(lds + P_KT) + (16 * (4 * kh + 2 * g2 + kk) + c) * L2 + 8 * q;
#pragma unroll
                  for (int ks = 0; ks < 4; ++ks) kf[kk][ks] = *(const bf16x8*)(khp + 32 * ks); }
              __builtin_amdgcn_sched_barrier(0);
#pragma unroll
              for (int kk = 0; kk < 2; ++kk)
#pragma unroll
                  for (int nt = 0; nt < 2; ++nt)
#pragma unroll
                      for (int ks = 0; ks < 4; ++ks) S[(2 * g2 + kk) * 2 + nt] = __builtin_amdgcn_mfma_f32_16x16x32_bf16(kf[kk][ks], bv[nt][ks], S[(2 * g2 + kk) * 2 + nt], 0, 0, 0);
              __builtin_amdgcn_sched_barrier(0);
          }
        }
    }
#undef HA_LOAD
    { const int kh = w >> 2, vq = w & 3;
      float* sl = SLOC + (size_t)stream * 16384 + lane;
#pragma unroll
      for (int kt = 0; kt < 4; ++kt)
#pragma unroll
          for (int nt = 0; nt < 2; ++nt)
#pragma unroll
              for (int r = 0; r < 4; ++r) sl[(size_t)((4 * kh + kt) * 4 + r) * 512 + (2 * vq + nt) * 64] = S[kt * 2 + nt][r]; }
    if (w == 0) *(f2*)(DSEG + (size_t)stream * 128 + 2 * lane) = bseg;
}

__device__ __forceinline__ void hgrn_passB(char* lds, int tid, int stream, bf16* Y, const float* lbl, int oi, const float* nw, const float* SLOC, const float* DSEG, const bf16* GA, const bf16* GB) {
    const int lane = tid & 63, w = __builtin_amdgcn_readfirstlane(tid >> 6), c = lane & 15, q = lane >> 4, kh = w >> 2, vq = w & 3;
    const int seg = stream & 3, h = (stream >> 2) & 15, b = stream >> 6;
    f2 lbv = (f2){0.f, 0.f};
    if (oi == 1) { const float2 l0 = *(const float2*)(lbl + h * 128 + 2 * lane), l1 = *(const float2*)(lbl + 2048 + h * 128 + 2 * lane);
        lbv = (f2){1.0f / (1.0f + __builtin_amdgcn_exp2f((l0.x - l1.x) * LOG2E)), 1.0f / (1.0f + __builtin_amdgcn_exp2f((l0.y - l1.y) * LOG2E))}; }
    const f2 oml = 1.0f - lbv;
    const size_t row0 = (size_t)b * T + (size_t)seg * SEGLEN;
    bf16* Yq = Y + row0 * PY + h * 128; const bf16* Yf = Yq + 2048; const bf16* Yv = Yq + 4096;
    f32x4 S[8];
#pragma unroll
    for (int i = 0; i < 8; ++i) S[i] = (f32x4){0.f, 0.f, 0.f, 0.f};
    if (seg > 0) {
        const int s0 = stream - seg;
        float sl[3][32]; f32x4 dd[3][4];
#pragma unroll
        for (int k = 0; k < 3; ++k) { const int sp = seg - 3 + k, spc = sp < 0 ? 0 : sp;
            const float* slp = SLOC + (size_t)(s0 + spc) * 16384 + lane; const float* dg = DSEG + (size_t)(s0 + spc) * 128 + 64 * kh;
#pragma unroll
            for (int kt = 0; kt < 4; ++kt) { dd[k][kt] = *(const f32x4*)(dg + 16 * kt + 4 * q);
#pragma unroll
                for (int nt = 0; nt < 2; ++nt)
#pragma unroll
                    for (int r = 0; r < 4; ++r) sl[k][(kt * 2 + nt) * 4 + r] = slp[(size_t)((4 * kh + kt) * 4 + r) * 512 + (2 * vq + nt) * 64]; } }
#pragma unroll
        for (int k = 0; k < 3; ++k) { const bool valid = seg - 3 + k >= 0;
#pragma unroll
            for (int kt = 0; kt < 4; ++kt)
#pragma unroll
                for (int nt = 0; nt < 2; ++nt)
#pragma unroll
                    for (int r = 0; r < 4; ++r) S[kt * 2 + nt][r] = S[kt * 2 + nt][r] * dd[k][kt][r] + (valid ? sl[k][(kt * 2 + nt) * 4 + r] : 0.f); }
    }
    __builtin_amdgcn_sched_barrier(0);
    if (tid < 128) ((float*)(lds + O_NW))[tid] = nw[tid];
    unsigned qraw[8], fr[8]; u32x4 vr[2];
    const unsigned lo_f = (unsigned)lane * 4u, lo_v = (unsigned)((2 * (tid >> 4)) * PY + (tid & 15) * 8) * 2u, lo_o = (unsigned)((tid >> 3) * PY + (tid & 7) * 16) * 2u, lo_g = (unsigned)((tid >> 3) * 1024 + (tid & 7) * 16) * 2u;
#define HB_LOAD(cc) do { const size_t r_ = (size_t)(cc) * 64; \
        _Pragma("unroll") for (int j = 0; j < 8; ++j) { fr[j] = *(const unsigned*)((const char*)(Yf + (r_ + 8 * w + j) * PY) + lo_f); qraw[j] = *(const unsigned*)((const char*)(Yq + (r_ + 8 * w + j) * PY) + lo_f); } \
        _Pragma("unroll") for (int i = 0; i < 2; ++i) vr[i] = *(const u32x4*)((const char*)(Yv + (r_ + i) * PY) + lo_v); } while (0)
    const bf16* Gu = (h < 8 ? GA : GB) + row0 * 1024 + (h & 7) * 128;
    float* TOT = (float*)(lds + O_TOT);
    f2 fj[8], kin[8], qs[8];
#define HB_P2() do { f2 tot; \
        _Pragma("unroll") for (int j = 0; j < 8; ++j) { const f2 e = ex2(bf2(fr[j]) * (-LOG2E)), sig = rcp2(1.0f + e); \
            fj[j] = lbv + oml * sig; kin[j] = oml - oml * sig; tot = j == 0 ? fj[0] : tot * fj[j]; \
            const f2 qq = bf2(qraw[j]); qs[j] = qq * rcp2(1.0f + ex2(qq * (-LOG2E))); } \
        *(f2*)(TOT + w * 128 + 2 * lane) = tot; } while (0)
#define HB_PREP(ld_ch) do { \
        { const int s2 = tid >> 4, v0 = (tid & 15) * 8; \
          unsigned* vt = (unsigned*)((bf16*)(lds + O_VT) + v0 * LS + ((((s2 >> 2) ^ (tid & 7)) & 7) << 3) + 2 * (s2 & 3)); \
          vt[0 * (LS / 2)] = (vr[0].x & 0xffffu) | (vr[1].x << 16); vt[1 * (LS / 2)] = (vr[0].x >> 16) | (vr[1].x & 0xffff0000u); \
          vt[2 * (LS / 2)] = (vr[0].y & 0xffffu) | (vr[1].y << 16); vt[3 * (LS / 2)] = (vr[0].y >> 16) | (vr[1].y & 0xffff0000u); \
          vt[4 * (LS / 2)] = (vr[0].z & 0xffffu) | (vr[1].z << 16); vt[5 * (LS / 2)] = (vr[0].z >> 16) | (vr[1].z & 0xffff0000u); \
          vt[6 * (LS / 2)] = (vr[0].w & 0xffffu) | (vr[1].w << 16); vt[7 * (LS / 2)] = (vr[0].w >> 16) | (vr[1].w & 0xffff0000u); } \
        if ((ld_ch) < NCH) HB_LOAD(ld_ch); \
        f2 lo4, hi4, part; { float one_ = 1.f; asm volatile("" : "+v"(one_)); part = (f2){one_, one_}; } \
        _Pragma("unroll") for (int g8 = 0; g8 < 8; ++g8) { const f2 t_ = *(const f2*)(TOT + g8 * 128 + 2 * lane); if (g8 == 0) lo4 = t_; else if (g8 < 4) lo4 *= t_; else if (g8 == 4) hi4 = t_; else hi4 *= t_; \
            const bool in_ = w < 4 ? (g8 > w && g8 < 4) : (g8 >= 4 && g8 < w); if (in_) part *= t_; } \
        if (w == 0) { *(f2*)((float*)(lds + O_E1) + 2 * lane) = lo4; *(f2*)((float*)(lds + O_E2) + 2 * lane) = hi4; } \
        { f2 kt[8]; const float TINY = 7.888609052210118e-31f; \
          unsigned* QX = (unsigned*)((bf16*)(lds + O_QX) + (8 * w) * LQ + 2 * lane); unsigned* KX = (unsigned*)((bf16*)(lds + O_KX) + (8 * w) * LQ + 2 * lane); \
          if (w < 4) { f2 s = part; \
              _Pragma("unroll") for (int j = 7; j >= 0; --j) { const f2 uc = max2(s, TINY), ed = rcp2(uc); kt[j] = kin[j] * uc; QX[j * (LQ / 2)] = pk2(qs[j] * ed); KX[j * (LQ / 2)] = pk2(kt[j]); s *= fj[j]; } \
          } else { f2 p = part; \
              _Pragma("unroll") for (int j = 0; j < 8; ++j) { p *= fj[j]; const f2 wc = max2(p, TINY); kt[j] = kin[j] * rcp2(wc); QX[j * (LQ / 2)] = pk2(qs[j] * wc); KX[j * (LQ / 2)] = pk2(kt[j]); } } \
          u32x4* kd = (u32x4*)((bf16*)(lds + O_KT) + (2 * lane) * LS + 8 * w); \
          kd[0] = (u32x4){cvtpk(kt[0].x, kt[1].x), cvtpk(kt[2].x, kt[3].x), cvtpk(kt[4].x, kt[5].x), cvtpk(kt[6].x, kt[7].x)}; \
          *(u32x4*)((bf16*)kd + LS) = (u32x4){cvtpk(kt[0].y, kt[1].y), cvtpk(kt[2].y, kt[3].y), cvtpk(kt[4].y, kt[5].y), cvtpk(kt[6].y, kt[7].y)}; } } while (0)
#define HB_P6() do { \
        for (int ti = w; ti < 12; ti += 8) { \
            int I, J; if (ti < 1) { I = 0; J = 0; } else if (ti < 3) { I = 1; J = ti - 1; } else if (ti < 6) { I = 2; J = ti - 3; } else if (ti < 10) { I = 3; J = ti - 6; } else { I = (ti - 10) * 2; J = I + 1; } \
            f32x4 acc = (f32x4){0.f, 0.f, 0.f, 0.f}; \
            if (ti < 10) { \
                const bf16* Kt = (const bf16*)(lds + O_KX) + (16 * J + c) * LQ + 8 * q; const bf16* Qt = (const bf16*)(lds + O_QX) + (16 * I + c) * LQ + 8 * q; \
                bf16x8 ka[4], qa[4]; \
                _Pragma("unroll") for (int ks = 0; ks < 4; ++ks) { ka[ks] = *(const bf16x8*)(Kt + 32 * ks); qa[ks] = *(const bf16x8*)(Qt + 32 * ks); } \
                __builtin_amdgcn_sched_barrier(0); \
                _Pragma("unroll") for (int ks = 0; ks < 4; ++ks) acc = __builtin_amdgcn_mfma_f32_16x16x32_bf16(ka[ks], qa[ks], acc, 0, 0, 0); \
                if (I == J) { _Pragma("unroll") for (int r = 0; r < 4; ++r) if (4 * q + r > c) acc[r] = 0.f; } \
            } \
            *(u32x2*)((bf16*)(lds + O_AM) + (16 * I + c) * LS + 16 * J + 4 * q) = (u32x2){cvtpk(acc[0], acc[1]), cvtpk(acc[2], acc[3])}; \
        } } while (0)
    HB_LOAD(0);
    HB_P2();
    __syncthreads();
    HB_PREP(1);
    __syncthreads();
    HB_P6();
    __syncthreads();
    for (int ch = 0; ch < NCH; ++ch) {
        u32x4 gt0, gt1;
        { const char* gp = (const char*)(Gu + (size_t)ch * 64 * 1024); gt0 = *(const u32x4*)(gp + lo_g); gt1 = *(const u32x4*)(gp + lo_g + 16); }
        f32x4 O[8];
        { const float* E1 = (const float*)(lds + O_E1) + 64 * kh;
          bf16x8 bv[2][2];
#pragma unroll
          for (int nt = 0; nt < 2; ++nt) { const bf16* VTw = (const bf16*)(lds + O_VT) + (32 * vq + 16 * nt + c) * LS; const int vsw = (4 * vq + 2 * nt + (c >> 3)) & 7;
              bv[nt][0] = *(const bf16x8*)(VTw + 8 * (q ^ vsw)); bv[nt][1] = *(const bf16x8*)(VTw + 8 * ((4 + q) ^ vsw)); }
#pragma unroll
          for (int kt = 0; kt < 4; ++kt) { const f32x4 e = *(const f32x4*)(E1 + 16 * kt + 4 * q); S[kt * 2] = S[kt * 2] * e; S[kt * 2 + 1] = S[kt * 2 + 1] * e; }
#pragma unroll
          for (int i = 0; i < 8; ++i) O[i] = (f32x4){0.f, 0.f, 0.f, 0.f};
#pragma unroll
          for (int ks = 0; ks < 2; ++ks) {
              u32x4 qa[4];
#pragma unroll
              for (int mt = 0; mt < 4; ++mt) { const bf16* qh = (const bf16*)(lds + O_QX) + (16 * mt + c) * LQ + 64 * kh + 32 * ks + 4 * q;
                  const u32x2 a0 = *(const u32x2*)qh, a1 = *(const u32x2*)(qh + 16); qa[mt] = (u32x4){a0.x, a0.y, a1.x, a1.y}; }
              __builtin_amdgcn_sched_barrier(0);
#pragma unroll
              for (int nt = 0; nt < 2; ++nt) { const f32x4 s0_ = S[(2 * ks) * 2 + nt], s1_ = S[(2 * ks + 1) * 2 + nt];
                  const u32x4 sb = (u32x4){cvtpk(s0_[0], s0_[1]), cvtpk(s0_[2], s0_[3]), cvtpk(s1_[0], s1_[1]), cvtpk(s1_[2], s1_[3])};
                  const bf16x8 bS = __builtin_bit_cast(bf16x8, sb);
#pragma unroll
                  for (int mt = 0; mt < 4; ++mt) O[mt * 2 + nt] = __builtin_amdgcn_mfma_f32_16x16x32_bf16(__builtin_bit_cast(bf16x8, qa[mt]), bS, O[mt * 2 + nt], 0, 0, 0); }
              __builtin_amdgcn_sched_barrier(0); }
          { bf16x8 am[4];
#pragma unroll
            for (int mt = 0; mt < 4; ++mt) if (mt >= 2 * kh) am[mt] = *(const bf16x8*)((const bf16*)(lds + O_AM) + (16 * mt + c) * LS + 8 * q + 32 * kh);
            __builtin_amdgcn_sched_barrier(0);
#pragma unroll
            for (int mt = 0; mt < 4; ++mt) if (mt >= 2 * kh) {
#pragma unroll
                for (int nt = 0; nt < 2; ++nt) O[mt * 2 + nt] = __builtin_amdgcn_mfma_f32_16x16x32_bf16(am[mt], kh ? bv[nt][1] : bv[nt][0], O[mt * 2 + nt], 0, 0, 0); }
            __builtin_amdgcn_sched_barrier(0); }
#pragma unroll
          for (int g2 = 0; g2 < 2; ++g2) {
              bf16x8 kf[2][2];
#pragma unroll
              for (int kk = 0; kk < 2; ++kk) { const bf16* khp = (const bf16*)(lds + O_KT) + (16 * (4 * kh + 2 * g2 + kk) + c) * LS + 8 * q; kf[kk][0] = *(const bf16x8*)khp; kf[kk][1] = *(const bf16x8*)(khp + 32); }
              __builtin_amdgcn_sched_barrier(0);
#pragma unroll
              for (int kk = 0; kk < 2; ++kk)
#pragma unroll
                  for (int nt = 0; nt < 2; ++nt) { const int si = (2 * g2 + kk) * 2 + nt;
                      S[si] = __builtin_amdgcn_mfma_f32_16x16x32_bf16(kf[kk][0], bv[nt][0], S[si], 0, 0, 0);
                      S[si] = __builtin_amdgcn_mfma_f32_16x16x32_bf16(kf[kk][1], bv[nt][1], S[si], 0, 0, 0); }
              __builtin_amdgcn_sched_barrier(0);
          }
          { const float* E2 = (const float*)(lds + O_E2) + 64 * kh;
#pragma unroll
            for (int kt = 0; kt < 4; ++kt) { const f32x4 e = *(const f32x4*)(E2 + 16 * kt + 4 * q); S[kt * 2] = S[kt * 2] * e; S[kt * 2 + 1] = S[kt * 2 + 1] * e; } }
        }
        { float* OS = (float*)(lds + (kh ? O_OSTF1 : O_OSTF));
#pragma unroll
          for (int mt = 0; mt < 4; ++mt)
#pragma unroll
              for (int nt = 0; nt < 2; ++nt)
#pragma unroll
                  for (int r = 0; r < 4; ++r) OS[(16 * mt + 4 * q + r) * LO + 32 * vq + 16 * nt + c] = O[mt * 2 + nt][r]; }
        if (ch + 1 < NCH) HB_P2();
        __syncthreads();
        { const float* OS = (const float*)(lds + O_OSTF);
          const int t = tid >> 3, v0 = (tid & 7) * 16; const float* orow = OS + t * LO + v0;
          f32x4 x[4]; float ss = 0.f;
#pragma unroll
          for (int i = 0; i < 4; ++i) { x[i] = *(const f32x4*)(orow + 4 * i) + *(const f32x4*)(orow + (O_OSTF1 - O_OSTF) / 4 + 4 * i); ss += (x[i][0] * x[i][0] + x[i][1] * x[i][1]) + (x[i][2] * x[i][2] + x[i][3] * x[i][3]); }
          ss += __int_as_float(__builtin_amdgcn_update_dpp(0, __float_as_int(ss), 0xB1, 0xF, 0xF, false));
          ss += __int_as_float(__builtin_amdgcn_update_dpp(0, __float_as_int(ss), 0x4E, 0xF, 0xF, false));
          ss += __int_as_float(__builtin_amdgcn_ds_swizzle(__float_as_int(ss), 0x101F));
          const float rs = rsqrtf(ss * (1.0f / 128.0f) + 1e-5f);
          u32x4 o0, o1; const float* wv = (const float*)(lds + O_NW) + v0;
#define HG_G(w_, i_) ((i_) ? __uint_as_float((w_) & 0xffff0000u) : __uint_as_float((w_) << 16))
          o0.x = cvtpk(x[0][0] * rs * wv[0] * HG_G(gt0.x, 0), x[0][1] * rs * wv[1] * HG_G(gt0.x, 1)); o0.y = cvtpk(x[0][2] * rs * wv[2] * HG_G(gt0.y, 0), x[0][3] * rs * wv[3] * HG_G(gt0.y, 1));
          o0.z = cvtpk(x[1][0] * rs * wv[4] * HG_G(gt0.z, 0), x[1][1] * rs * wv[5] * HG_G(gt0.z, 1)); o0.w = cvtpk(x[1][2] * rs * wv[6] * HG_G(gt0.w, 0), x[1][3] * rs * wv[7] * HG_G(gt0.w, 1));
          o1.x = cvtpk(x[2][0] * rs * wv[8] * HG_G(gt1.x, 0), x[2][1] * rs * wv[9] * HG_G(gt1.x, 1)); o1.y = cvtpk(x[2][2] * rs * wv[10] * HG_G(gt1.y, 0), x[2][3] * rs * wv[11] * HG_G(gt1.y, 1));
          o1.z = cvtpk(x[3][0] * rs * wv[12] * HG_G(gt1.z, 0), x[3][1] * rs * wv[13] * HG_G(gt1.z, 1)); o1.w = cvtpk(x[3][2] * rs * wv[14] * HG_G(gt1.w, 0), x[3][3] * rs * wv[15] * HG_G(gt1.w, 1));
#undef HG_G
          char* dst = (char*)(Yq + (size_t)ch * 64 * PY) + lo_o;
          *(u32x4*)dst = o0; *(u32x4*)(dst + 16) = o1; }
        if (ch + 1 < NCH) HB_PREP(ch + 2);
        __syncthreads();
        if (ch + 1 < NCH) HB_P6();
        __syncthreads();
    }
#undef HB_LOAD
#undef HB_P2
#undef HB_PREP
#undef HB_P6
}
#undef HG_BAR
}
namespace sd {
typedef unsigned short bf16;
typedef short bf16x8 __attribute__((ext_vector_type(8)));
typedef float f32x4 __attribute__((ext_vector_type(4)));
typedef unsigned u32x4 __attribute__((ext_vector_type(4)));
typedef unsigned u32x2 __attribute__((ext_vector_type(2)));
constexpr int T = 4096, M = 4 * T, PY1 = 2816, PAO = 2048, LB = 136, LT = 72;
constexpr int O_BM = 0, O_CM = O_BM + 64 * LB * 2, O_BT = O_CM + 64 * LB * 2, O_XT = O_BT + 128 * LT * 2, O_DT = O_XT + 8 * 64 * LT * 2, O_AC = O_DT + 2048, LDS_BYTES = O_AC + 2048;
__device__ __forceinline__ float bf2f(unsigned v) { return __uint_as_float(v << 16); }
__device__ __forceinline__ float bflo(unsigned w) { return __uint_as_float(w << 16); }
__device__ __forceinline__ float bfhi(unsigned w) { return __uint_as_float(w & 0xffff0000u); }
typedef float f32x2_t __attribute__((ext_vector_type(2))); typedef __bf16 bf16x2_t __attribute__((ext_vector_type(2)));
__device__ __forceinline__ unsigned cvtpk(float lo, float hi) { f32x2_t v = {lo, hi}; bf16x2_t b = __builtin_convertvector(v, bf16x2_t); return __builtin_bit_cast(unsigned, b); }
__device__ __forceinline__ float fexp(float x) { return __builtin_amdgcn_exp2f(x * 1.4426950408889634f); }
__device__ __forceinline__ float silu(float x) { return x * __builtin_amdgcn_rcpf(1.0f + fexp(-x)); }
__device__ __forceinline__ float lget(float v, int src) { return __int_as_float(__builtin_amdgcn_ds_bpermute(src << 2, __float_as_int(v))); }

template <bool STATE_ONLY>
__device__ __forceinline__ void ssd_stage(char* lds, int tid, int g, size_t m0, int tg0, const bf16* Y1, const float* cw, const float* cb) {
    u32x2 rawA[11], rawB[11];
#define SD_SRC(cq_) ((cq_) < 128 ? g * 512 + (cq_) * 4 : (cq_) < 160 ? 1024 + g * 128 + ((cq_) - 128) * 4 : 1280 + g * 128 + ((cq_) - 160) * 4)
#define SD_LOAD(RAW, t_) do { const int cq_ = (t_) % 192, l0_ = ((t_) / 192) * 8; const bf16* yp_ = Y1 + (m0 + l0_) * PY1 + 1024 + SD_SRC(cq_); \
        _Pragma("unroll") for (int r = 0; r < 11; ++r) { RAW[r] = (u32x2){0u, 0u}; if (!(STATE_ONLY && cq_ >= 160) && tg0 + l0_ + r - 3 >= 0) RAW[r] = *(const u32x2*)(yp_ + (ptrdiff_t)(r - 3) * PY1); } } while (0)
#define SD_TASK(RAW, t_) do { const int tk_ = (t_); const int cq = tk_ % 192, l0 = (tk_ / 192) * 8; \
        if (!(STATE_ONLY && cq >= 160)) {                                           \
        const int src = SD_SRC(cq); \
        const f32x4 w0 = *(const f32x4*)(cw + src), w1 = *(const f32x4*)(cw + 1536 + src), w2 = *(const f32x4*)(cw + 3072 + src), w3 = *(const f32x4*)(cw + 4608 + src), bb = *(const f32x4*)(cb + src); \
          \
        bf16* tdst = cq < 128 ? (bf16*)(lds + O_XT) + ((cq >> 4) * 64 + (cq & 15) * 4) * LT + l0 : (bf16*)(lds + O_BT) + ((cq - 128) & 31) * 4 * LT + l0; \
        bf16* rdst = (cq < 160 ? (bf16*)(lds + O_BM) + (cq - 128) * 4 : (bf16*)(lds + O_CM) + (cq - 160) * 4) + l0 * LB; \
        unsigned tp[4][4];                                                           \
        _Pragma("unroll") for (int r = 0; r < 8; r += 2) { \
            const f32x4 x0 = (f32x4){bflo(RAW[r].x), bfhi(RAW[r].x), bflo(RAW[r].y), bfhi(RAW[r].y)}, x1 = (f32x4){bflo(RAW[r + 1].x), bfhi(RAW[r + 1].x), bflo(RAW[r + 1].y), bfhi(RAW[r + 1].y)}, \
                        x2 = (f32x4){bflo(RAW[r + 2].x), bfhi(RAW[r + 2].x), bflo(RAW[r + 2].y), bfhi(RAW[r + 2].y)}, x3 = (f32x4){bflo(RAW[r + 3].x), bfhi(RAW[r + 3].x), bflo(RAW[r + 3].y), bfhi(RAW[r + 3].y)}, \
                        x4 = (f32x4){bflo(RAW[r + 4].x), bfhi(RAW[r + 4].x), bflo(RAW[r + 4].y), bfhi(RAW[r + 4].y)}; \
            const f32x4 a = bb + w0 * x0 + w1 * x1 + w2 * x2 + w3 * x3, b_ = bb + w0 * x1 + w1 * x2 + w2 * x3 + w3 * x4; \
            const f32x4 oa = (f32x4){silu(a[0]), silu(a[1]), silu(a[2]), silu(a[3])}, ob = (f32x4){silu(b_[0]), silu(b_[1]), silu(b_[2]), silu(b_[3])}; \
            _Pragma("unroll") for (int i = 0; i < 4; ++i) tp[i][r >> 1] = cvtpk(oa[i], ob[i]); \
            if (cq >= 128 && (!STATE_ONLY || cq >= 160)) { *(u32x2*)(rdst + r * LB) = (u32x2){cvtpk(oa[0], oa[1]), cvtpk(oa[2], oa[3])}; *(u32x2*)(rdst + (r + 1) * LB) = (u32x2){cvtpk(ob[0], ob[1]), cvtpk(ob[2], ob[3])}; } \
        } \
        if (cq < 160) { _Pragma("unroll") for (int i = 0; i < 4; ++i) *(u32x4*)(tdst + i * LT) = (u32x4){tp[i][0], tp[i][1], tp[i][2], tp[i][3]}; } \
        } } while (0)
    if (STATE_ONLY) {
#pragma unroll 1
        for (int t = tid; t < 192 * 8; t += 512) { SD_LOAD(rawA, t); SD_TASK(rawA, t); }
    } else {
        SD_LOAD(rawA, tid); SD_LOAD(rawB, tid + 512);
        SD_TASK(rawA, tid);
        SD_LOAD(rawA, tid + 1024);
        SD_TASK(rawB, tid + 512);
        SD_TASK(rawA, tid + 1024);
    }
#undef SD_SRC
#undef SD_LOAD
#undef SD_TASK
}

template <bool STATE_ONLY>
__device__ __forceinline__ void ssd_unit(char* lds, int tid, int u, const bf16* Y1, const float* FDt, const float* cw, const float* cb, const float* dt_bias, const float* A_log, const float* Dsk,
                                         const float* nw, u32x4* STL, float* DEC, bf16* AO) {
    const int lane = tid & 63, w = __builtin_amdgcn_readfirstlane(tid >> 6), c = lane & 15, q = lane >> 4;
    const int g = u & 1, cidx = (u >> 1) & 31, b = u >> 6, h = 8 * g + w;
    const size_t mc = (size_t)b * T + (size_t)cidx * 128;
    const float Ah = -fexp(A_log[h]), dtb = dt_bias[h], Dh = Dsk[h];
    f32x4 st[STATE_ONLY ? 32 : 1];
    u32x4 bS[STATE_ONLY ? 1 : 16];
    if (STATE_ONLY) {
#pragma unroll
        for (int i = 0; i < 32; ++i) st[i] = (f32x4){0.f, 0.f, 0.f, 0.f};
    } else {
        const u32x4* sl = STL + (size_t)u * 8192 + w * 64 + lane;
#pragma unroll
        for (int i = 0; i < 16; ++i) bS[i] = sl[(size_t)i * 512];
    }
    float fdv = FDt[(size_t)(8 + h) * M + mc + lane];
    ssd_stage<STATE_ONLY>(lds, tid, g, mc, cidx * 128, Y1, cw, cb);
    float atot_chunk = 0.f;
    bf16* XTw = (bf16*)(lds + O_XT) + w * 64 * LT;
    float* DTl = (float*)(lds + O_DT) + w * 64; float* ACl = (float*)(lds + O_AC) + w * 64;
#pragma unroll
    for (int sub = 0; sub < 2; ++sub) {
        const size_t m0 = mc + sub * 64; const int tg0 = cidx * 128 + sub * 64;
        int lane_s = tid & 63; asm volatile("" : "+v"(lane_s));
        const int lane = lane_s, c = lane & 15, q = lane >> 4; (void)tg0;
        float atot;
        { const float xx = fdv + dtb; const float u_ = fexp(-fabsf(xx)); const float dt = fmaxf(xx, 0.f) + (u_ < 1e-4f ? u_ * (1.0f - 0.5f * u_) : __builtin_amdgcn_logf(1.0f + u_) * 0.6931471805599453f);
          float ac = dt * Ah;
#pragma unroll
          for (int o_ = 1; o_ < 64; o_ <<= 1) { const float v = lget(ac, lane - o_); if (lane >= o_) ac += v; }
          DTl[lane] = dt; ACl[lane] = ac; atot = __int_as_float(__builtin_amdgcn_readlane(__float_as_int(ac), 63)); }
        atot_chunk += atot;
        __syncthreads();
        u32x4 z0, z1, z2; f32x4 n0, n1; int lo_ = 0;
        if (STATE_ONLY) {
            const float ea = fexp(atot);
#pragma unroll
            for (int i = 0; i < 32; ++i) st[i] = st[i] * ea;
#pragma unroll
            for (int ks2 = 0; ks2 < 2; ++ks2) {
                bf16x8 xw[4];
                { const f32x4 d0 = *(const f32x4*)(DTl + 32 * ks2 + 8 * q), d1 = *(const f32x4*)(DTl + 32 * ks2 + 8 * q + 4), a0 = *(const f32x4*)(ACl + 32 * ks2 + 8 * q), a1 = *(const f32x4*)(ACl + 32 * ks2 + 8 * q + 4);
                  float wl[8];
#pragma unroll
                  for (int j = 0; j < 4; ++j) { wl[j] = d0[j] * fexp(fminf(atot - a0[j], 0.f)); wl[4 + j] = d1[j] * fexp(fminf(atot - a1[j], 0.f)); }
#pragma unroll
                  for (int pt = 0; pt < 4; ++pt) { const u32x4 xv = *(const u32x4*)(XTw + (16 * pt + c) * LT + 32 * ks2 + 8 * q);
                      const u32x4 t_ = (u32x4){cvtpk(bflo(xv.x) * wl[0], bfhi(xv.x) * wl[1]), cvtpk(bflo(xv.y) * wl[2], bfhi(xv.y) * wl[3]), cvtpk(bflo(xv.z) * wl[4], bfhi(xv.z) * wl[5]), cvtpk(bflo(xv.w) * wl[6], bfhi(xv.w) * wl[7])};
                      xw[pt] = __builtin_bit_cast(bf16x8, t_); } }
#pragma unroll
                for (int nt = 0; nt < 8; ++nt) { const bf16x8 af = *(const bf16x8*)((const bf16*)(lds + O_BT) + (16 * nt + c) * LT + 32 * ks2 + 8 * q);
#pragma unroll
                    for (int pt = 0; pt < 4; ++pt) st[nt * 4 + pt] = __builtin_amdgcn_mfma_f32_16x16x32_bf16(af, xw[pt], st[nt * 4 + pt], 0, 0, 0); }
            }
        } else {
            u32x4 xw[8];
            if (sub == 0) {
#pragma unroll
                for (int ks2 = 0; ks2 < 2; ++ks2) {
                    const f32x4 d0 = *(const f32x4*)(DTl + 32 * ks2 + 8 * q), d1 = *(const f32x4*)(DTl + 32 * ks2 + 8 * q + 4), a0 = *(const f32x4*)(ACl + 32 * ks2 + 8 * q), a1 = *(const f32x4*)(ACl + 32 * ks2 + 8 * q + 4);
                    float wl[8];
#pragma unroll
                    for (int j = 0; j < 4; ++j) { wl[j] = d0[j] * fexp(fminf(atot - a0[j], 0.f)); wl[4 + j] = d1[j] * fexp(fminf(atot - a1[j], 0.f)); }
#pragma unroll
                    for (int pt = 0; pt < 4; ++pt) { const u32x4 xv = *(const u32x4*)(XTw + (16 * pt + c) * LT + 32 * ks2 + 8 * q);
                        xw[ks2 * 4 + pt] = (u32x4){cvtpk(bflo(xv.x) * wl[0], bfhi(xv.x) * wl[1]), cvtpk(bflo(xv.y) * wl[2], bfhi(xv.y) * wl[3]), cvtpk(bflo(xv.z) * wl[4], bfhi(xv.z) * wl[5]), cvtpk(bflo(xv.w) * wl[6], bfhi(xv.w) * wl[7])}; }
                }
            }
#pragma unroll
            for (int Ii = 0; Ii < 4; ++Ii) { const int I = 3 - Ii;
                f32x4 y[4];
#pragma unroll
                for (int pt = 0; pt < 4; ++pt) y[pt] = (f32x4){0.f, 0.f, 0.f, 0.f};
                u32x4 cfr[4]; bf16x8 cst[4], bfr[2][4];
#pragma unroll
                for (int ks = 0; ks < 4; ++ks) { const bf16* cp = (const bf16*)(lds + O_CM) + (16 * I + c) * LB + 32 * ks + 4 * q;
                    const u32x2 a0 = *(const u32x2*)cp, a1 = *(const u32x2*)(cp + 16); cfr[ks] = (u32x4){a0.x, a0.y, a1.x, a1.y}; }
                const f32x4 ac4 = *(const f32x4*)(ACl + 16 * I + 4 * q); const float acl = ACl[16 * I + c];
#pragma unroll
                for (int ks = 0; ks < 4; ++ks) { cst[ks] = *(const bf16x8*)((const bf16*)(lds + O_CM) + (16 * I + c) * LB + 8 * q + 32 * ks); bfr[0][ks] = *(const bf16x8*)((const bf16*)(lds + O_BM) + c * LB + 8 * q + 32 * ks); }
                __builtin_amdgcn_sched_barrier(0);
#pragma unroll
                for (int ks = 0; ks < 4; ++ks)
#pragma unroll
                    for (int pt = 0; pt < 4; ++pt) y[pt] = __builtin_amdgcn_mfma_f32_16x16x32_bf16(__builtin_bit_cast(bf16x8, cfr[ks]), __builtin_bit_cast(bf16x8, bS[ks * 4 + pt]), y[pt], 0, 0, 0);
                { const f32x4 e = (f32x4){fexp(ac4[0]), fexp(ac4[1]), fexp(ac4[2]), fexp(ac4[3])};
#pragma unroll
                  for (int pt = 0; pt < 4; ++pt) y[pt] = y[pt] * e; }
                u32x2 xp[4];
#pragma unroll
                for (int J = 0; J < 4; ++J) {
                    if (J > I) { xp[J] = (u32x2){0u, 0u}; continue; }
                    if (J + 1 <= I) {
#pragma unroll
                        for (int ks = 0; ks < 4; ++ks) bfr[(J + 1) & 1][ks] = *(const bf16x8*)((const bf16*)(lds + O_BM) + (16 * (J + 1) + c) * LB + 8 * q + 32 * ks); }
                    const f32x4 acs = *(const f32x4*)(ACl + 16 * J + 4 * q), dts = *(const f32x4*)(DTl + 16 * J + 4 * q);
                    __builtin_amdgcn_sched_barrier(0);
                    f32x4 acc = (f32x4){0.f, 0.f, 0.f, 0.f};
#pragma unroll
                    for (int ks = 0; ks < 4; ++ks) acc = __builtin_amdgcn_mfma_f32_16x16x32_bf16(bfr[J & 1][ks], cst[ks], acc, 0, 0, 0);
                    float v[4];
#pragma unroll
                    for (int r = 0; r < 4; ++r) { v[r] = acc[r] * fexp(fminf(acl - acs[r], 0.f)) * dts[r]; if (J == I && 4 * q + r > c) v[r] = 0.f; }
                    xp[J] = (u32x2){cvtpk(v[0], v[1]), cvtpk(v[2], v[3])};
                }
                { u32x4 xfr[2][4];
#pragma unroll
                  for (int ks2 = 0; ks2 < 2; ++ks2) {
                      if (ks2 == 1 && I < 2) continue;
#pragma unroll
                      for (int pt = 0; pt < 4; ++pt) { const bf16* xq = XTw + (16 * pt + c) * LT + 32 * ks2 + 4 * q;
                          const u32x2 b0 = *(const u32x2*)xq, b1 = *(const u32x2*)(xq + 16); xfr[ks2][pt] = (u32x4){b0.x, b0.y, b1.x, b1.y}; } }
                  __builtin_amdgcn_sched_barrier(0);
#pragma unroll
                  for (int ks2 = 0; ks2 < 2; ++ks2) {
                      if (ks2 == 1 && I < 2) continue;
                      const u32x4 aa = (u32x4){xp[2 * ks2].x, xp[2 * ks2].y, xp[2 * ks2 + 1].x, xp[2 * ks2 + 1].y}; const bf16x8 af = __builtin_bit_cast(bf16x8, aa);
#pragma unroll
                      for (int pt = 0; pt < 4; ++pt) y[pt] = __builtin_amdgcn_mfma_f32_16x16x32_bf16(af, __builtin_bit_cast(bf16x8, xfr[ks2][pt]), y[pt], 0, 0, 0); } }
                u32x2 xv[4];
#pragma unroll
                for (int pt = 0; pt < 4; ++pt) xv[pt] = *(const u32x2*)(XTw + (16 * pt + c) * LT + 16 * I + 4 * q);
#pragma unroll
                for (int pt = 0; pt < 4; ++pt) {
                    const float y0 = y[pt][0] + Dh * bflo(xv[pt].x), y1 = y[pt][1] + Dh * bfhi(xv[pt].x), y2 = y[pt][2] + Dh * bflo(xv[pt].y), y3 = y[pt][3] + Dh * bfhi(xv[pt].y);
                    *(u32x2*)(XTw + (8 * (c & 7) + 2 * pt + (c >> 3)) * LT + 16 * I + 4 * (q ^ (w & 3))) = (u32x2){cvtpk(y0, y1), cvtpk(y2, y3)}; }
            }
            if (sub == 0) {
                const float ea = fexp(atot);
#pragma unroll
                for (int ks = 0; ks < 4; ++ks) {
                    const bf16x8 a00 = *(const bf16x8*)((const bf16*)(lds + O_BT) + (16 * (2 * ks) + c) * LT + 8 * q), a01 = *(const bf16x8*)((const bf16*)(lds + O_BT) + (16 * (2 * ks) + c) * LT + 32 + 8 * q);
                    const bf16x8 a10 = *(const bf16x8*)((const bf16*)(lds + O_BT) + (16 * (2 * ks + 1) + c) * LT + 8 * q), a11 = *(const bf16x8*)((const bf16*)(lds + O_BT) + (16 * (2 * ks + 1) + c) * LT + 32 + 8 * q);
#pragma unroll
                    for (int pt = 0; pt < 4; ++pt) { const u32x4 p_ = bS[ks * 4 + pt];
                        f32x4 t0 = (f32x4){bflo(p_.x) * ea, bfhi(p_.x) * ea, bflo(p_.y) * ea, bfhi(p_.y) * ea}, t1 = (f32x4){bflo(p_.z) * ea, bfhi(p_.z) * ea, bflo(p_.w) * ea, bfhi(p_.w) * ea};
                        t0 = __builtin_amdgcn_mfma_f32_16x16x32_bf16(a00, __builtin_bit_cast(bf16x8, xw[pt]), t0, 0, 0, 0); t0 = __builtin_amdgcn_mfma_f32_16x16x32_bf16(a01, __builtin_bit_cast(bf16x8, xw[4 + pt]), t0, 0, 0, 0);
                        t1 = __builtin_amdgcn_mfma_f32_16x16x32_bf16(a10, __builtin_bit_cast(bf16x8, xw[pt]), t1, 0, 0, 0); t1 = __builtin_amdgcn_mfma_f32_16x16x32_bf16(a11, __builtin_bit_cast(bf16x8, xw[4 + pt]), t1, 0, 0, 0);
                        bS[ks * 4 + pt] = (u32x4){cvtpk(t0[0], t0[1]), cvtpk(t0[2], t0[3]), cvtpk(t1[0], t1[1]), cvtpk(t1[2], t1[3])}; }
                }
            }
            lo_ = lane; asm volatile("" : "+v"(lo_));
            { const bf16* zp = Y1 + (m0 + w) * PY1 + g * 512 + lo_ * 8; z0 = *(const u32x4*)zp; z1 = *(const u32x4*)(zp + (size_t)8 * PY1); z2 = *(const u32x4*)(zp + (size_t)16 * PY1); }
            { const float* nwp = nw + g * 512 + lo_ * 8; n0 = *(const f32x4*)nwp; n1 = *(const f32x4*)(nwp + 4); }
        }
        __syncthreads();
        if (!STATE_ONLY) {
            const bf16* ysl = (const bf16*)(lds + O_XT) + ((lo_ >> 3) * 64 + (lo_ & 7)) * LT;
            const int ysw = (lo_ >> 3) & 3;
            const bf16* zp = Y1 + (m0 + w) * PY1 + g * 512 + lo_ * 8; bf16* op = AO + (m0 + w) * PAO + 1024 + g * 512 + lo_ * 8;
#pragma unroll 1
            for (int i = 0; i < 8; ++i) { const int l = w + 8 * i; const u32x4 zv = z0; z0 = z1; z1 = z2;
                if (i + 3 < 8) z2 = *(const u32x4*)(zp + (size_t)(8 * (i + 3)) * PY1);
                const int lc = (l & ~15) | ((((l >> 2) & 3) ^ ysw) << 2) | (l & 3);
                u32x4 yv; yv.x = (unsigned)ysl[lc] | ((unsigned)ysl[8 * LT + lc] << 16); yv.y = (unsigned)ysl[16 * LT + lc] | ((unsigned)ysl[24 * LT + lc] << 16);
                yv.z = (unsigned)ysl[32 * LT + lc] | ((unsigned)ysl[40 * LT + lc] << 16); yv.w = (unsigned)ysl[48 * LT + lc] | ((unsigned)ysl[56 * LT + lc] << 16);
                float v[8] = {bflo(yv.x) * silu(bflo(zv.x)), bfhi(yv.x) * silu(bfhi(zv.x)), bflo(yv.y) * silu(bflo(zv.y)), bfhi(yv.y) * silu(bfhi(zv.y)),
                              bflo(yv.z) * silu(bflo(zv.z)), bfhi(yv.z) * silu(bfhi(zv.z)), bflo(yv.w) * silu(bflo(zv.w)), bfhi(yv.w) * silu(bfhi(zv.w))};
                float ss = 0.f;
#pragma unroll
                for (int j = 0; j < 8; ++j) ss += v[j] * v[j];
                ss += __int_as_float(__builtin_amdgcn_update_dpp(0, __float_as_int(ss), 0xB1, 0xF, 0xF, false));
                ss += __int_as_float(__builtin_amdgcn_update_dpp(0, __float_as_int(ss), 0x4E, 0xF, 0xF, false));
                ss += __int_as_float(__builtin_amdgcn_update_dpp(0, __float_as_int(ss), 0x141, 0xF, 0xF, false));
                ss += __int_as_float(__builtin_amdgcn_update_dpp(0, __float_as_int(ss), 0x140, 0xF, 0xF, false));
                ss = (__int_as_float(__builtin_amdgcn_readlane(__float_as_int(ss), 0)) + __int_as_float(__builtin_amdgcn_readlane(__float_as_int(ss), 16)))
                   + (__int_as_float(__builtin_amdgcn_readlane(__float_as_int(ss), 32)) + __int_as_float(__builtin_amdgcn_readlane(__float_as_int(ss), 48)));
                const float rs = rsqrtf(ss * (1.0f / 512.0f) + 1e-5f);
                const u32x4 ov = (u32x4){cvtpk(v[0] * rs * n0[0], v[1] * rs * n0[1]), cvtpk(v[2] * rs * n0[2], v[3] * rs * n0[3]), cvtpk(v[4] * rs * n1[0], v[5] * rs * n1[1]), cvtpk(v[6] * rs * n1[2], v[7] * rs * n1[3])};
                *(u32x4*)(op + (size_t)(8 * i) * PAO) = ov; }
            __syncthreads();
        }
        if (sub == 0) { fdv = FDt[(size_t)(8 + h) * M + mc + 64 + lane]; ssd_stage<STATE_ONLY>(lds, tid, g, mc + 64, cidx * 128 + 64, Y1, cw, cb); }
    }
    if (STATE_ONLY) {
        u32x4* sl = STL + (size_t)u * 8192 + w * 64 + lane;
#pragma unroll
        for (int ks = 0; ks < 4; ++ks)
#pragma unroll
            for (int pt = 0; pt < 4; ++pt) { const f32x4 s0 = st[(2 * ks) * 4 + pt], s1 = st[(2 * ks + 1) * 4 + pt];
                sl[(size_t)(ks * 4 + pt) * 512] = (u32x4){cvtpk(s0[0], s0[1]), cvtpk(s0[2], s0[3]), cvtpk(s1[0], s1[1]), cvtpk(s1[2], s1[3])}; }
        if (lane == 0) DEC[(size_t)(b * 32 + cidx) * 16 + h] = fexp(atot_chunk);
    }
}
__device__ __forceinline__ void ssd_scan(size_t gtid, size_t gsz, u32x4* STL, const float* DEC) {
    for (size_t col = gtid; col < (size_t)8 * 16384; col += gsz) {
        const int bg = (int)(col >> 14), e2 = (int)(col & 16383), b = bg >> 1, g = bg & 1, wv = (e2 >> 7) & 7;
        u32x2 v[32]; float d[32];
#pragma unroll
        for (int cc = 0; cc < 32; ++cc) { v[cc] = *((const u32x2*)(STL + (size_t)((b * 32 + cc) * 2 + g) * 8192) + e2); d[cc] = DEC[(size_t)(b * 32 + cc) * 16 + g * 8 + wv]; }
        float z_ = 0.f; asm volatile("" : "+v"(z_)); f32x4 run = (f32x4){z_, z_, z_, z_};
#pragma unroll
        for (int cc = 0; cc < 32; ++cc) { u32x2* p = (u32x2*)(STL + (size_t)((b * 32 + cc) * 2 + g) * 8192) + e2;
            *p = (u32x2){cvtpk(run[0], run[1]), cvtpk(run[2], run[3])};
            run = run * d[cc] + (f32x4){bflo(v[cc].x), bfhi(v[cc].x), bflo(v[cc].y), bfhi(v[cc].y)}; }
    }
}
}
#define LAS __attribute__((address_space(3)))
#define XB_TMO      128
#define XB_XCNT(j)  (256  + 64 * (j))
#define XB_XSUB(j)  (1280 + 64 * (j))
#define XB_XGEN(j)  (2304 + 64 * (j))
#define XB_TOP      3328
#define XB_TOPGEN   3392
#define XCD_BAR_WORDS 3456
#define XB_SPIN_CAP (1u << 18)

__device__ __forceinline__ unsigned xb_ld(unsigned* p)              { return __hip_atomic_load(p, __ATOMIC_RELAXED, __HIP_MEMORY_SCOPE_AGENT); }
__device__ __forceinline__ unsigned xb_add(unsigned* p, unsigned v) { return __hip_atomic_fetch_add(p, v, __ATOMIC_RELAXED, __HIP_MEMORY_SCOPE_AGENT); }
__device__ __forceinline__ unsigned xb_xcc_id() { return (unsigned)__builtin_amdgcn_s_getreg((3 << 11) | 20) & 0xFu; }
#define XB_SPIN(cond, bar) do { unsigned _sp = 0; while (cond) { __builtin_amdgcn_s_sleep(1); \
    if ((++_sp & 255u) == 0u) { if (xb_ld(&(bar)[XB_TMO])) break; if (_sp > XB_SPIN_CAP) { atomicAdd(&(bar)[XB_TMO], 1u); break; } } } } while (0)

struct XcdBarrier {
    unsigned* bar; unsigned x;
    volatile LAS unsigned* st;
};

__device__ __forceinline__ XcdBarrier xcd_barrier_post(unsigned* bar, volatile LAS unsigned* st) {
    XcdBarrier b; b.bar = bar; b.x = xb_xcc_id(); b.st = st;
    if (threadIdx.x == 0) (void)xb_add(&bar[XB_XCNT(b.x)], 1u);
    return b;
}
__device__ __forceinline__ void xcd_barrier_complete(unsigned* bar, unsigned x, unsigned& nloc, unsigned& nx) {
    const unsigned G = gridDim.x * gridDim.y * gridDim.z;
    unsigned sum, cnt, mine, sp = 0u;
    for (;;) {
        sum = 0u; cnt = 0u; mine = 0u;
#pragma unroll
        for (unsigned j = 0; j < 16; ++j) { const unsigned c = xb_ld(&bar[XB_XCNT(j)]); sum += c; cnt += (c > 0u) ? 1u : 0u; mine = (j == x) ? c : mine; }
        if (sum == G) break;
        __builtin_amdgcn_s_sleep(1);
        if ((++sp & 255u) == 0u) { if (xb_ld(&bar[XB_TMO])) break; if (sp > XB_SPIN_CAP) { atomicAdd(&bar[XB_TMO], 1u); break; } }
    }
    nloc = mine > 0u ? mine : 1u; nx = cnt > 0u ? cnt : 1u;
}

__device__ __forceinline__ void xcd_barrier(const XcdBarrier& b, const bool leader  ) {
    asm volatile("s_waitcnt vmcnt(0)" ::: "memory");
    __syncthreads();
    if (leader) {
        unsigned* bar = b.bar;
        __builtin_amdgcn_s_waitcnt(0);
        unsigned nloc = b.st[0], nx = b.st[1];
        if (nloc == 0u) { xcd_barrier_complete(bar, b.x, nloc, nx); b.st[0] = nloc; b.st[1] = nx; }
        const unsigned old = xb_add(&bar[XB_XSUB(b.x)], 1u);
        const unsigned gen = old / nloc;
        if (old + 1u == (gen + 1u) * nloc) {
            __builtin_amdgcn_fence(__ATOMIC_RELEASE, "agent");
            asm volatile("s_waitcnt vmcnt(0)" ::: "memory");
            const unsigned og = xb_add(&bar[XB_TOP], 1u);
            const unsigned tg = og / nx;
            if (og + 1u == (tg + 1u) * nx) xb_add(&bar[XB_TOPGEN], 1u);
            else XB_SPIN(xb_ld(&bar[XB_TOPGEN]) == tg, bar);
            __builtin_amdgcn_fence(__ATOMIC_ACQUIRE, "agent");
            xb_add(&bar[XB_XGEN(b.x)], 1u);
            asm volatile("s_waitcnt vmcnt(0)" ::: "memory");
        } else {
            XB_SPIN(xb_ld(&bar[XB_XGEN(b.x)]) == gen, bar);
            __builtin_amdgcn_fence(__ATOMIC_ACQUIRE, "agent");
            asm volatile("s_waitcnt vmcnt(0)" ::: "memory");
        }
    }
    __syncthreads();
}
namespace hy {
typedef unsigned short bf16;
constexpr int B = 4, T = 4096, D = 1024, M = B * T;
constexpr int EVEN_IN = 6680, ODD_IN = 8192;
constexpr int NE = 6912;
constexpr int NE1 = 2816, NE2 = 3072;
constexpr int NO1 = 6144, NO2 = 2048;
constexpr size_t MiB = 1u << 20;
constexpr size_t WS_CTL = 0, CTL_ZERO_BYTES = 64 * 1024;
constexpr size_t WS_RS = 512 * 1024, WS_FDT = 1 * MiB, WS_SS = 3 * MiB, WS_CS = 4 * MiB, WS_WA = 5 * MiB, WS_WB = 21 * MiB, WS_AO = 25 * MiB, WS_Y = 89 * MiB, WS_YODD = 25 * MiB;
constexpr size_t WS_NRM = WS_CS + 640 * 1024;
constexpr size_t WS_STL = WS_Y + 88 * MiB, WS_DEC = WS_CS + 512 * 1024;
constexpr size_t WS_SLOC = WS_WA, WS_GB = WS_YODD + 192 * MiB, WS_DSEG = WS_GB + 32 * MiB;
constexpr int CW_QCNT = 8192;
constexpr int CW_BAR = 4096;
constexpr int RING_BYTES = 155648, MISC_OFF = RING_BYTES + 320, LDS_BYTES = 157696;
constexpr int NT = 512, NWV = 8;

__device__ __forceinline__ unsigned f2bf(float f) { unsigned u = __float_as_uint(f); return (u + 0x7fffu + ((u >> 16) & 1u)) >> 16; }
__device__ __forceinline__ float bf2f(bf16 v) { return __uint_as_float((unsigned)v << 16); }
__device__ __forceinline__ float lx(float v, int mask, int lane) { return __int_as_float(__builtin_amdgcn_ds_bpermute((lane ^ mask) << 2, __float_as_int(v))); }
__device__ __forceinline__ float lget(float v, int src) { return __int_as_float(__builtin_amdgcn_ds_bpermute(src << 2, __float_as_int(v))); }
__device__ __forceinline__ float wave_sum(float v, int lane) {
#pragma unroll
    for (int o = 1; o < 64; o <<= 1) v += lx(v, o, lane);
    return v;
}
__device__ __forceinline__ float sigmoid_f(float x) { return 1.0f / (1.0f + __expf(-x)); }
__device__ __forceinline__ float silu_f(float x) { return x / (1.0f + __expf(-x)); }
__device__ __forceinline__ float log1p_fast(float u) { return u < 1e-4f ? u * (1.0f - 0.5f * u) : __builtin_amdgcn_logf(1.0f + u) * 0.6931471805599453f; }
__device__ __forceinline__ float log_sigmoid_f(float x) { return fminf(x, 0.f) - log1p_fast(__expf(-fabsf(x))); }
__device__ __forceinline__ float softplus_f(float x) { return fmaxf(x, 0.f) + log1p_fast(__expf(-fabsf(x))); }

__device__ __forceinline__ void ph_prologue(int gw, int ngw, int lane, const float* __restrict__ x, bf16* __restrict__ hi, float* __restrict__ RS) {
    for (int m0 = gw; m0 < M; m0 += 4 * ngw) {
        float4 v[4][4];
#pragma unroll
        for (int r = 0; r < 4; ++r)
#pragma unroll
            for (int j = 0; j < 4; ++j) v[r][j] = m0 + r * ngw < M ? *(const float4*)(x + (size_t)(m0 + r * ngw) * D + j * 256 + lane * 4) : make_float4(0.f, 0.f, 0.f, 0.f);
#pragma unroll
        for (int r = 0; r < 4; ++r) { const int m = m0 + r * ngw; float s = 0.f; if (m >= M) break;
#pragma unroll
            for (int j = 0; j < 4; ++j) { const float4 a = v[r][j]; s += (a.x * a.x + a.y * a.y) + (a.z * a.z + a.w * a.w);
                *(uint2*)(hi + (size_t)m * D + j * 256 + lane * 4) = make_uint2(f2bf(a.x) | (f2bf(a.y) << 16), f2bf(a.z) | (f2bf(a.w) << 16)); }
            s = wave_sum(s, lane);
            if (lane == 0) RS[m] = rsqrtf(s * (1.0f / 1024.0f) + 1e-5f); }
    }
}
__device__ __forceinline__ int even_map(int n) {
    if (n < 4096) return n;
    if (n < 5120) return 4104 + (n - 4096);
    if (n < 6656) return 5128 + (n - 5120);
    if (n < 6664) return 4096 + (n - 6656);
    if (n < 6680) return 6664 + (n - 6664);
    return -1;
}
template <int MAP, bool HAS_NW>
__device__ __forceinline__ void ph_convert_w(LAS float* tile_, int bid, int nb_grid, int tid, const float* __restrict__ W, int K, int Nsrc, int Ndst, const float* __restrict__ nw, bf16* __restrict__ Wt) {
    LAS unsigned char* tile = (LAS unsigned char*)tile_;
    const int l32 = tid & 31, kp = tid >> 5;
    const int nb = Ndst / 128, kb = K / 64, ntile = nb * kb;
    float4 v[2][2]; float wk[2][2];
#define CV_LOAD(it_) do { const int n0_ = ((it_) % nb) * 128, k0_ = ((it_) / nb) * 64; const int n_ = n0_ + 4 * l32; const int sc_ = MAP == 1 ? even_map(n_) : n_; \
        _Pragma("unroll") for (int p_ = 0; p_ < 2; ++p_) _Pragma("unroll") for (int e_ = 0; e_ < 2; ++e_) { const int k_ = k0_ + 2 * (kp + 16 * p_) + e_; \
            v[p_][e_] = sc_ >= 0 ? *(const float4*)(W + (size_t)k_ * Nsrc + sc_) : make_float4(0.f, 0.f, 0.f, 0.f); wk[p_][e_] = HAS_NW ? nw[k_] : 1.f; } } while (0)
    int it = bid;
    if (it < ntile) CV_LOAD(it);
    for (; it < ntile; it += nb_grid) {
        const int n0 = (it % nb) * 128, k0 = (it / nb) * 64;
#pragma unroll
        for (int p = 0; p < 2; ++p) { const float4 a = v[p][0], b = v[p][1]; const float wa = wk[p][0], wb = wk[p][1];
            LAS unsigned char* dst = tile + (4 * l32) * 132 + (kp + 16 * p) * 4;
            *(LAS unsigned*)(dst) = f2bf(a.x * wa) | (f2bf(b.x * wb) << 16); *(LAS unsigned*)(dst + 132) = f2bf(a.y * wa) | (f2bf(b.y * wb) << 16);
            *(LAS unsigned*)(dst + 264) = f2bf(a.z * wa) | (f2bf(b.z * wb) << 16); *(LAS unsigned*)(dst + 396) = f2bf(a.w * wa) | (f2bf(b.w * wb) << 16); }
        __syncthreads();
        if (it + nb_grid < ntile) CV_LOAD(it + nb_grid);
#pragma unroll
        for (int r = 0; r < 2; ++r) { const int c = tid + 512 * r, n = c >> 3, j = c & 7; const LAS unsigned* src = (const LAS unsigned*)(tile + n * 132 + j * 16);
            uint4 o; o.x = src[0]; o.y = src[1]; o.z = src[2]; o.w = src[3];
            *(uint4*)(Wt + (size_t)(n0 + n) * K + k0 + 8 * j) = o; }
        __syncthreads();
    }
#undef CV_LOAD
}

__device__ __forceinline__ void ph_rstd(size_t gtid, size_t gsz, const float* __restrict__ SS, float* __restrict__ RS) {
    for (size_t m = gtid; m < (size_t)M; m += gsz) { float s = 0.f;
#pragma unroll
        for (int p = 0; p < 16; ++p) s += SS[(size_t)p * M + m];
        RS[m] = rsqrtf(s * (1.0f / 1024.0f) + 1e-5f); }
}
__device__ __forceinline__ void ph_fox_cumsum(LAS float* red  , int bid, int tid, int lane, int wv, const float* __restrict__ FDt, const float* __restrict__ f_bias, float* __restrict__ CS) {
    if (bid >= 32) return;
    const int b = bid >> 3, h = bid & 7; const float fb = f_bias[h];
    const float4* src = (const float4*)(FDt + (size_t)h * M + (size_t)b * T) + tid * 2;
    const float4 x0 = src[0], x1 = src[1];
    float v[8] = {log_sigmoid_f(x0.x + fb), log_sigmoid_f(x0.y + fb), log_sigmoid_f(x0.z + fb), log_sigmoid_f(x0.w + fb), log_sigmoid_f(x1.x + fb), log_sigmoid_f(x1.y + fb), log_sigmoid_f(x1.z + fb), log_sigmoid_f(x1.w + fb)};
#pragma unroll
    for (int j = 1; j < 8; ++j) v[j] += v[j - 1];
    float inc = v[7];
#pragma unroll
    for (int o = 1; o < 64; o <<= 1) { const float u = lget(inc, lane - o); if (lane >= o) inc += u; }
    if (lane == 63) red[wv] = inc;
    __syncthreads();
    float pre = inc - v[7];
    for (int j = 0; j < wv; ++j) pre += red[j];
    const float sc = -11.313708498984761f;
    float4* dst = (float4*)(CS + (size_t)bid * T) + tid * 2;
    dst[0] = make_float4((pre + v[0]) * sc, (pre + v[1]) * sc, (pre + v[2]) * sc, (pre + v[3]) * sc);
    dst[1] = make_float4((pre + v[4]) * sc, (pre + v[5]) * sc, (pre + v[6]) * sc, (pre + v[7]) * sc);
    __syncthreads();
}
__device__ __forceinline__ void ph_fox_attn(LAS float* qsb  , int gw, int ngw, int wv, int lane, const bf16* __restrict__ Y2, const float* __restrict__ CS, bf16* __restrict__ AO) {
    LAS float* qs = qsb + wv * 128;
    for (int rr = gw; rr < B * 8 * T; rr += ngw) {
        const int bh = rr / T, tt = rr % T, t = (bh & 1) ? (T - 1 - tt) : tt, b = bh >> 3, h = bh & 7;
        const size_t mq = (size_t)b * T + t;
        const bf16* qp = Y2 + mq * NE2 + h * 128;
        const float scale = 0.08838834764831845f;
        __syncthreads();
        qs[lane] = bf2f(qp[lane]) * scale; qs[lane + 64] = bf2f(qp[lane + 64]) * scale;
        __syncthreads();
        const float* cs = CS + (size_t)bh * T; const float ct = cs[t];
        float mrun = -1e30f, l = 0.f, o0 = 0.f, o1 = 0.f;
        for (int j0 = 0; j0 <= t; j0 += 64) {
            const int j = j0 + lane; float s = -INFINITY;
            if (j <= t) {
                const bf16* kp = Y2 + ((size_t)b * T + j) * NE2 + 1024 + h * 128; float a = 0.f;
#pragma unroll 4
                for (int d = 0; d < 128; d += 8) { const uint4 kk = *(const uint4*)(kp + d);
                    a += qs[d + 0] * __uint_as_float(kk.x << 16) + qs[d + 1] * __uint_as_float(kk.x & 0xffff0000u) + qs[d + 2] * __uint_as_float(kk.y << 16) + qs[d + 3] * __uint_as_float(kk.y & 0xffff0000u)
                       + qs[d + 4] * __uint_as_float(kk.z << 16) + qs[d + 5] * __uint_as_float(kk.z & 0xffff0000u) + qs[d + 6] * __uint_as_float(kk.w << 16) + qs[d + 7] * __uint_as_float(kk.w & 0xffff0000u); }
                s = a + (ct - cs[j]);
            }
            float tm = s;
#pragma unroll
            for (int o = 1; o < 64; o <<= 1) tm = fmaxf(tm, lx(tm, o, lane));
            const float mn = fmaxf(mrun, tm), alpha = __expf(mrun - mn); const float p = __expf(s - mn);
            l = l * alpha + wave_sum(p, lane); o0 *= alpha; o1 *= alpha; mrun = mn;
            const int nk = min(64, t - j0 + 1);
            const bf16* vp = Y2 + ((size_t)b * T + j0) * NE2 + 2048 + h * 128;
            for (int jj = 0; jj < nk; ++jj) { const float pj = __int_as_float(__builtin_amdgcn_readlane(__float_as_int(p), jj)); o0 += pj * bf2f(vp[(size_t)jj * NE2 + lane]); o1 += pj * bf2f(vp[(size_t)jj * NE2 + lane + 64]); }
        }
        const float inv = 1.0f / l; const bf16* gp = Y2 + mq * NE2 + 3072 + h * 128;
        AO[mq * 2048 + h * 128 + lane] = (bf16)f2bf(o0 * inv * silu_f(bf2f(gp[lane])));
        AO[mq * 2048 + h * 128 + lane + 64] = (bf16)f2bf(o1 * inv * silu_f(bf2f(gp[lane + 64])));
    }
}

__device__ __forceinline__ void ph_ssd_conv(size_t gtid, size_t gsz, const bf16* __restrict__ Y1, const float* __restrict__ cw, const float* __restrict__ cb, bf16* __restrict__ XC) {
    const size_t total = (size_t)M * 1536;
    for (size_t i = gtid; i < total; i += gsz) {
        const int m = (int)(i / 1536), ch = (int)(i % 1536), t = m % T; float a = cb[ch];
#pragma unroll
        for (int k = 0; k < 4; ++k) { const int tt = t - 3 + k; if (tt >= 0) a += cw[k * 1536 + ch] * bf2f(Y1[(size_t)(m - 3 + k) * NE1 + 1024 + ch]); }
        XC[i] = (bf16)f2bf(silu_f(a));
    }
}
__device__ __forceinline__ void ph_ssd_scan(int gw, int ngw, int lane, const bf16* __restrict__ Y1, const bf16* __restrict__ XC, const float* __restrict__ FDt, const float* __restrict__ dt_bias,
                                            const float* __restrict__ A_log, const float* __restrict__ Dsk, bf16* __restrict__ AO) {
    for (int w = gw; w < B * 16 * 64; w += ngw) {
        const int p = w & 63, h = (w >> 6) & 15, b = w >> 10, g = h >> 3;
        const float A = -__expf(A_log[h]), dtb = dt_bias[h], Dh = Dsk[h];
        float s0 = 0.f, s1 = 0.f;
        for (int t = 0; t < T; ++t) {
            const size_t m = (size_t)b * T + t;
            const float dt = softplus_f(FDt[(size_t)(8 + h) * M + m] + dtb);
            const float xv = bf2f(XC[m * 1536 + h * 64 + p]);
            const float dec = __expf(dt * A), dx = dt * xv;
            const bf16* bp = XC + m * 1536 + 1024 + g * 128; const bf16* cp = XC + m * 1536 + 1280 + g * 128;
            s0 = dec * s0 + dx * bf2f(bp[lane]); s1 = dec * s1 + dx * bf2f(bp[lane + 64]);
            float y = wave_sum(bf2f(cp[lane]) * s0 + bf2f(cp[lane + 64]) * s1, lane);
            if (lane == 0) { y = (y + Dh * xv) * silu_f(bf2f(Y1[m * NE1 + h * 64 + p])); AO[m * 2048 + 1024 + h * 64 + p] = (bf16)f2bf(y); }
        }
    }
}
__device__ __forceinline__ void ph_ssd_norm(int gw, int ngw, int lane, bf16* __restrict__ AO, const float* __restrict__ nw) {
    for (int w = gw; w < M * 2; w += ngw) {
        const int g = w & 1; const size_t m = w >> 1;
        bf16* p = AO + m * 2048 + 1024 + g * 512 + lane * 8;
        const uint4 v = *(const uint4*)p; float f[8] = {__uint_as_float(v.x << 16), __uint_as_float(v.x & 0xffff0000u), __uint_as_float(v.y << 16), __uint_as_float(v.y & 0xffff0000u),
                                                       __uint_as_float(v.z << 16), __uint_as_float(v.z & 0xffff0000u), __uint_as_float(v.w << 16), __uint_as_float(v.w & 0xffff0000u)};
        float s = 0.f;
#pragma unroll
        for (int i = 0; i < 8; ++i) s += f[i] * f[i];
        s = wave_sum(s, lane); const float r = rsqrtf(s * (1.0f / 512.0f) + 1e-5f); const float* wp = nw + g * 512 + lane * 8;
        uint4 o; o.x = f2bf(f[0] * r * wp[0]) | (f2bf(f[1] * r * wp[1]) << 16); o.y = f2bf(f[2] * r * wp[2]) | (f2bf(f[3] * r * wp[3]) << 16);
        o.z = f2bf(f[4] * r * wp[4]) | (f2bf(f[5] * r * wp[5]) << 16); o.w = f2bf(f[6] * r * wp[6]) | (f2bf(f[7] * r * wp[7]) << 16);
        *(uint4*)p = o;
    }
}

__device__ __forceinline__ void ph_hgrn_scan(int gw, int ngw, int lane, const bf16* __restrict__ Y, const float* __restrict__ lbl, int oi, int h0, bf16* __restrict__ ORAW) {
    for (int w = gw; w < B * 8 * 128; w += ngw) {
        const int v = w & 127, hh = (w >> 7) & 7, b = w >> 10, h = h0 + hh;
        float lb0 = 0.f, lb1 = 0.f;
        if (oi == 1) { const int c0 = h * 128 + lane, c1 = c0 + 64; lb0 = sigmoid_f(lbl[2048 + c0] - lbl[c0]); lb1 = sigmoid_f(lbl[2048 + c1] - lbl[c1]); }
        float s0 = 0.f, s1 = 0.f;
        for (int t = 0; t < T; ++t) {
            const size_t m = (size_t)b * T + t; const bf16* yp = Y + m * NO1;
            const float q0 = silu_f(bf2f(yp[h * 128 + lane])), q1 = silu_f(bf2f(yp[h * 128 + lane + 64]));
            const float f0 = bf2f(yp[2048 + h * 128 + lane]), f1 = bf2f(yp[2048 + h * 128 + lane + 64]);
            const float iv = bf2f(yp[4096 + h * 128 + v]);
            const float g0 = lb0 + (1.f - lb0) * sigmoid_f(f0), g1 = lb1 + (1.f - lb1) * sigmoid_f(f1);
            const float k0 = (1.f - lb0) * sigmoid_f(-f0), k1 = (1.f - lb1) * sigmoid_f(-f1);
            s0 = g0 * s0 + k0 * iv; s1 = g1 * s1 + k1 * iv;
            const float o = wave_sum(q0 * s0 + q1 * s1, lane);
            if (lane == 0) ORAW[m * 1024 + hh * 128 + v] = (bf16)f2bf(o);
        }
    }
}
__device__ __forceinline__ void ph_hgrn_norm(int gw, int ngw, int lane, const bf16* __restrict__ ORAW, const float* __restrict__ nw, int h0, bf16* __restrict__ Y) {
    for (int w = gw; w < M * 8; w += ngw) {
        const int hh = w & 7; const size_t m = w >> 3;
        const unsigned v = *(const unsigned*)(ORAW + m * 1024 + hh * 128 + lane * 2);
        const float a = __uint_as_float(v << 16), c = __uint_as_float(v & 0xffff0000u);
        const float s = wave_sum(a * a + c * c, lane), r = rsqrtf(s * (1.0f / 128.0f) + 1e-5f);
        *(unsigned*)(Y + m * NO1 + (h0 + hh) * 128 + lane * 2) = f2bf(a * r * nw[lane * 2]) | (f2bf(c * r * nw[lane * 2 + 1]) << 16);
    }
}
__device__ __forceinline__ void ph_final(int gw, int ngw, int lane, const bf16* __restrict__ hf, const float* __restrict__ SS, const float* __restrict__ fw, float* __restrict__ out) {
    float4 wv[4];
#pragma unroll
    for (int j = 0; j < 4; ++j) wv[j] = *(const float4*)(fw + j * 256 + lane * 4);
    for (int m0 = gw; m0 < M; m0 += 4 * ngw) {
        uint2 a[4][4]; float s[4];
#pragma unroll
        for (int r = 0; r < 4; ++r) { const int m = min(m0 + r * ngw, M - 1); s[r] = lane < 16 ? SS[(size_t)lane * M + m] : 0.f;
#pragma unroll
            for (int j = 0; j < 4; ++j) a[r][j] = *(const uint2*)(hf + (size_t)m * NO1 + j * 256 + lane * 4); }
#pragma unroll
        for (int r = 0; r < 4; ++r) { const int m = m0 + r * ngw; if (m >= M) break;
            const float rr = rsqrtf(wave_sum(s[r], lane) * (1.0f / 1024.0f) + 1e-5f);
#pragma unroll
            for (int j = 0; j < 4; ++j) { const uint2 q = a[r][j];
                *(float4*)(out + (size_t)m * D + j * 256 + lane * 4) = make_float4(__uint_as_float(q.x << 16) * rr * wv[j].x, __uint_as_float(q.x & 0xffff0000u) * rr * wv[j].y, __uint_as_float(q.y << 16) * rr * wv[j].z, __uint_as_float(q.y & 0xffff0000u) * rr * wv[j].w); } }
    }
}
struct Params {
    const float* x; const float* norm_w; const float* final_w; const float* even_w_in; const float* even_w_out; const float* fox_f_bias;
    const float* conv_w; const float* conv_b; const float* dt_bias; const float* A_log; const float* ssd_D; const float* ssd_nw;
    const float* odd_w_in; const float* odd_w_out; const float* lb_logits; const float* hgrn_nw;
    float* out; unsigned char* ws;
};

typedef const __attribute__((address_space(4))) Params* ParamsK;
__device__ __forceinline__ ParamsK kargs() { ParamsK p = (ParamsK)__builtin_amdgcn_kernarg_segment_ptr(); asm volatile("" : "+s"(p)); return p; }
__device__ __forceinline__ int tid_fresh(int wv0) { int l = __builtin_amdgcn_mbcnt_hi(~0u, __builtin_amdgcn_mbcnt_lo(~0u, 0u)); asm volatile("" : "+v"(l)); return wv0 * 64 + l; }
#define PH_IDS() const int tid = tid_fresh(wv0), lane = tid & 63, wv = wv0; int G_ = gridDim.x, bid_ = blockIdx.x; asm volatile("" : "+s"(G_), "+s"(bid_)); const int G = G_, bid = bid_, gw = bid * NWV + wv, ngw = G * NWV; \
    const size_t gtid = (size_t)bid * NT + tid, gsz = (size_t)G * NT; (void)lane; (void)gw; (void)ngw; (void)gtid; (void)gsz; (void)wv
#define GP(T, p) ((T*)(__attribute__((address_space(1))) T*)(p))
#define PH_PTRS() ParamsK P = kargs(); unsigned char* ws = GP(unsigned char, P->ws); bf16* hi = GP(bf16, P->out); bf16* lo = hi + (size_t)M * D; \
    float* FDt = (float*)(ws + WS_FDT); float* SS = (float*)(ws + WS_SS); float* CS = (float*)(ws + WS_CS); float* RS = (float*)(ws + WS_RS); (void)RS; \
    bf16* WA = (bf16*)(ws + WS_WA); bf16* WB = (bf16*)(ws + WS_WB); bf16* AO = (bf16*)(ws + WS_AO); \
    bf16* Y = (bf16*)(ws + WS_Y); sd::u32x4* STL = (sd::u32x4*)(ws + WS_STL); float* DEC = (float*)(ws + WS_DEC); bf16* YO = (bf16*)(ws + WS_YODD); float* SLOC = (float*)(ws + WS_SLOC); float* DSEG = (float*)(ws + WS_DSEG); bf16* HFB = (bf16*)(ws + WS_YODD) + 2048; float* NRM = (float*)(ws + WS_NRM); \
    (void)hi; (void)lo; (void)FDt; (void)SS; (void)CS; (void)WA; (void)WB; (void)AO; (void)Y; (void)STL; (void)DEC; (void)YO; (void)SLOC; (void)DSEG; (void)HFB; (void)NRM
#define PF(field) GP(const float, P->field)
#define GRID_BAR() do { ParamsK Pb = kargs(); XcdBarrier bar_; bar_.bar = (unsigned*)(GP(unsigned char, Pb->ws) + WS_CTL) + CW_BAR; bar_.x = xb_xcc_id(); \
    bar_.st = (volatile LAS unsigned*)((LAS unsigned char*)lds + MISC_OFF) + 8; xcd_barrier(bar_, tid_fresh(wv0) == 0); } while (0)

__global__ void __launch_bounds__(512, 2) mega_fwd(Params Pval) {
    extern __shared__ __attribute__((aligned(16))) unsigned char lds[];
#define LL ((LAS unsigned char*)lds)
#define SCR ((LAS float*)lds)
    const int wv0 = __builtin_amdgcn_readfirstlane((int)threadIdx.x >> 6);
    { const int tid0 = threadIdx.x;
      for (int u = tid0; u < (LDS_BYTES - RING_BYTES) / 4; u += NT) ((LAS unsigned*)(LL + RING_BYTES))[u] = 0u;
      __syncthreads();
      ParamsK Pb = kargs(); (void)xcd_barrier_post((unsigned*)(GP(unsigned char, Pb->ws) + WS_CTL) + CW_BAR, (volatile LAS unsigned*)(LL + MISC_OFF) + 8); }
    for (int li = 0; li < 2; ++li) {
        { PH_IDS(); PH_PTRS();
          ph_convert_w<1, true>(SCR, bid, G, tid, PF(even_w_in) + (size_t)li * D * EVEN_IN, D, EVEN_IN, NE, PF(norm_w) + (size_t)(2 * li) * D, WA);
          ph_convert_w<0, false>(SCR, bid, G, tid, PF(even_w_out) + (size_t)li * 2048 * D, 2048, D, D, nullptr, WB);
          if (li == 0) ph_prologue(gw, ngw, lane, PF(x), hi, RS); else ph_rstd(gtid, gsz, SS, RS); }
        GRID_BAR();
        { PH_PTRS(); int G_ = gridDim.x, bid_ = blockIdx.x; asm volatile("" : "+s"(G_), "+s"(bid_)); const int G = G_, bid = bid_;
          pg8::Gemm g{hi, WA + (size_t)4096 * D, M, NE1, D, D}; pg8::EpiIn E{Y, NE1, RS, FDt, 10, M, nullptr, nullptr, 1 << 30, nullptr, nullptr, 0}; pg8::StaticOrder S; S.init(M, NE1, G, bid); S.wv = wv0;
          pg8::gemm_phase<pg8::EpiIn, pg8::StaticOrder, true, true>(LL, g, S, E); }
        GRID_BAR();
        { PH_IDS(); PH_PTRS();
          if (bid < 256) sd::ssd_unit<true>((char*)lds, tid, bid, Y, FDt, PF(conv_w) + (size_t)li * 4 * 1536, PF(conv_b) + (size_t)li * 1536, PF(dt_bias) + li * 16, PF(A_log) + li * 16, PF(ssd_D) + li * 16,
                                            PF(ssd_nw) + (size_t)li * 1024, STL, DEC, AO);
          ph_fox_cumsum(SCR, bid, tid, lane, wv, FDt, PF(fox_f_bias) + li * 8, CS); }
        GRID_BAR();
        { PH_IDS(); PH_PTRS(); sd::ssd_scan(gtid, gsz, STL, DEC); }
        GRID_BAR();
        { PH_IDS(); PH_PTRS();
          if (bid < 256) sd::ssd_unit<false>((char*)lds, tid, bid, Y, FDt, PF(conv_w) + (size_t)li * 4 * 1536, PF(conv_b) + (size_t)li * 1536, PF(dt_bias) + li * 16, PF(A_log) + li * 16, PF(ssd_D) + li * 16,
                                             PF(ssd_nw) + (size_t)li * 1024, STL, DEC, AO); }
        GRID_BAR();
        { PH_PTRS(); int G_ = gridDim.x, bid_ = blockIdx.x; asm volatile("" : "+s"(G_), "+s"(bid_)); const int G = G_, bid = bid_;
          pg8::Gemm g{hi, WA, M, 4096, D, D}; pg8::EpiIn E{Y, 4160, RS, nullptr, -1, M, (LAS float*)(LL + pg8::STAGE_BYTES), NRM, 12, Y + 3072, nullptr, 4160};     pg8::StaticOrder S; S.init(M, 4096, G, bid); S.wv = wv0;
          pg8::gemm_phase<pg8::EpiIn, pg8::StaticOrder, true, true>(LL, g, S, E); }
        GRID_BAR();
        { PH_IDS(); PH_PTRS(); fa::fox_phase((char*)lds, tid, bid, G, Y, CS, NRM, AO, (unsigned*)(ws + WS_CTL) + CW_QCNT + 512 * li); }
        GRID_BAR();
        { PH_PTRS(); int G_ = gridDim.x, bid_ = blockIdx.x; asm volatile("" : "+s"(G_), "+s"(bid_)); const int G = G_, bid = bid_;
          pg8::Gemm g{AO, WB, M, D, 2048, 2048}; pg8::EpiOut E{hi, SS, M, hi, 1024}; pg8::StaticOrder S; S.init(M, D, G, bid); S.wv = wv0;
          pg8::gemm_phase<pg8::EpiOut, pg8::StaticOrder, true, true>(LL, g, S, E); }
        GRID_BAR();
        { PH_IDS(); PH_PTRS();
          ph_convert_w<0, true>(SCR, bid, G, tid, PF(odd_w_in) + (size_t)li * D * ODD_IN, D, ODD_IN, ODD_IN, PF(norm_w) + (size_t)(2 * li + 1) * D, WA);
          ph_convert_w<0, false>(SCR, bid, G, tid, PF(odd_w_out) + (size_t)li * 2048 * D, 2048, D, D, nullptr, WB); ph_rstd(gtid, gsz, SS, RS); }
        GRID_BAR();
        { PH_PTRS(); int G_ = gridDim.x, bid_ = blockIdx.x; asm volatile("" : "+s"(G_), "+s"(bid_)); const int G = G_, bid = bid_;
          pg8::Gemm g{hi, WA, M, ODD_IN, D, D}; pg8::EpiIn E{YO, NO1, RS, nullptr, -1, M, nullptr, nullptr, NO1 / 256, lo, (bf16*)(ws + WS_GB), 1024}; pg8::StaticOrder S; S.init(M, ODD_IN, G, bid); S.wv = wv0;
          pg8::gemm_phase<pg8::EpiIn, pg8::StaticOrder, true, true>(LL, g, S, E); }
        GRID_BAR();
        { PH_IDS(); PH_PTRS(); if (bid < 256) hg::hgrn_state128((char*)lds, tid, bid, YO, PF(lb_logits), li, SLOC, DSEG); }
        GRID_BAR();
        { PH_IDS(); PH_PTRS(); if (bid < 256) hg::hgrn_passB((char*)lds, tid, bid, YO, PF(lb_logits), li, PF(hgrn_nw) + (size_t)li * 128, SLOC, DSEG, lo, (const bf16*)(ws + WS_GB)); }
        GRID_BAR();
        { PH_PTRS(); int G_ = gridDim.x, bid_ = blockIdx.x; asm volatile("" : "+s"(G_), "+s"(bid_)); const int G = G_, bid = bid_;
          pg8::Gemm g{YO, WB, M, D, 2048, NO1}; pg8::EpiOut E{hi, SS, M, li == 1 ? HFB : hi, li == 1 ? NO1 : 1024}; pg8::StaticOrder S; S.init(M, D, G, bid); S.wv = wv0;
          pg8::gemm_phase<pg8::EpiOut, pg8::StaticOrder, true, true>(LL, g, S, E); }
        GRID_BAR();
    }
    { PH_IDS(); PH_PTRS(); ph_final(gw, ngw, lane, HFB, SS, PF(final_w), GP(float, P->out)); }
}
}

extern "C" void kernel_launch(void* const* d_in, const int* in_sizes, int n_in, void* d_out, int out_size, void* d_ws, size_t ws_size, hipStream_t stream) {
    using namespace hy;
    static int grid = 0;
    if (grid == 0) {
        int dev = 0, cus = 0;
        if (hipGetDevice(&dev) != hipSuccess || hipDeviceGetAttribute(&cus, hipDeviceAttributeMultiprocessorCount, dev) != hipSuccess || cus <= 0) cus = 256;
        (void)hipFuncSetAttribute((const void*)mega_fwd, hipFuncAttributeMaxDynamicSharedMemorySize, LDS_BYTES);
        (void)hipGetLastError();
        grid = cus;
    }
    (void)hipMemsetAsync((char*)d_ws + WS_CTL, 0, CTL_ZERO_BYTES, stream);
    Params p{};
    p.x = (const float*)d_in[0]; p.norm_w = (const float*)d_in[1]; p.final_w = (const float*)d_in[2]; p.even_w_in = (const float*)d_in[3]; p.even_w_out = (const float*)d_in[4];
    p.fox_f_bias = (const float*)d_in[5]; p.conv_w = (const float*)d_in[6]; p.conv_b = (const float*)d_in[7]; p.dt_bias = (const float*)d_in[8]; p.A_log = (const float*)d_in[9];
    p.ssd_D = (const float*)d_in[10]; p.ssd_nw = (const float*)d_in[11]; p.odd_w_in = (const float*)d_in[12]; p.odd_w_out = (const float*)d_in[13]; p.lb_logits = (const float*)d_in[14];
    p.hgrn_nw = (const float*)d_in[15]; p.out = (float*)d_out; p.ws = (unsigned char*)d_ws;
    hipLaunchKernelGGL(mega_fwd, dim3(grid), dim3(NT), LDS_BYTES, stream, p);
}
```

```cpp
#include <hip/hip_runtime.h>
#include <cstdio>
#include <cstdint>
namespace pg8 {
#define PG8_LAS __attribute__((address_space(3)))
typedef unsigned short bf16_t;
typedef short bf16x8 __attribute__((ext_vector_type(8)));
typedef float f32x4 __attribute__((ext_vector_type(4)));
typedef unsigned u32x4 __attribute__((ext_vector_type(4)));
constexpr int BM = 256, BK = 64, HALF = 128, HTB = HALF * BK * 2  , STAGE_BYTES = 8 * HTB, NXCD = 8, WGM = 8, RSL_OFF = STAGE_BYTES + 8192  ;

__host__ __device__ __forceinline__ int lds_byte(int r, int c) { const int st = (r >> 4) * 2 + (c >> 5), rr = r & 15, cc = c & 31, ob = rr * 64 + cc * 2; return st * 1024 + (ob ^ (((ob >> 9) & 1) << 5)); }
__host__ __device__ __forceinline__ void stage_rc(int b, int& R, int& C) { const int st = b / 1024, sb = b % 1024, swz = sb ^ (((sb >> 9) & 1) << 5); R = (st >> 1) * 16 + swz / 64; C = (st & 1) * 32 + (swz % 64) / 2; }
__host__ __device__ __forceinline__ int perm32(int rho) { const int n = rho >> 4, i = rho & 15; return 8 * (i >> 2) + 4 * n + (i & 3); }

struct Unit { int pm, pn; };
struct Gemm { const bf16_t* A; const bf16_t* Bt; int M, N, K, lda; };

struct StaticOrder {
    int nM, nN, nwg, G, c, wv;
    __host__ __device__ void init(int M, int N, int G_, int c_) { nM = M / BM; nN = N / BM; nwg = nM * nN; G = G_; c = c_; }
    __host__ __device__ bool next(int i, Unit& u) const {
        const long L = (long)i * G + c; if (L >= nwg) return false;
        int wgid = (int)L; { const int q = nwg / NXCD, r = nwg % NXCD, xcd = wgid % NXCD, off = wgid / NXCD; wgid = (xcd < r ? xcd * (q + 1) : r * (q + 1) + (xcd - r) * q) + off; }
        const int nig = WGM * nN, gid = wgid / nig, fm = gid * WGM, gsz = (nM - fm) < WGM ? (nM - fm) : WGM;
        u.pm = fm + ((wgid % nig) % gsz); u.pn = (wgid % nig) / gsz; return true;
    }
    __device__ __forceinline__ void a_ready(const Unit&) const {}
    __device__ __forceinline__ void done(const Unit&) const {}
};

__device__ __forceinline__ unsigned cvt_pk_bf16(float lo, float hi) { unsigned r; asm volatile("v_cvt_pk_bf16_f32 %0, %1, %2" : "=v"(r) : "v"(lo), "v"(hi)); return r; }
__device__ __forceinline__ float bf_lo(unsigned w) { return __uint_as_float(w << 16); }
__device__ __forceinline__ float bf_hi(unsigned w) { return __uint_as_float(w & 0xffff0000u); }
typedef unsigned u32x2 __attribute__((ext_vector_type(2)));
__device__ __forceinline__ float lane_xor_f(float v, int mask, int lane) { return __int_as_float(__builtin_amdgcn_ds_bpermute((lane ^ mask) << 2, __float_as_int(v))); }

__device__ __forceinline__ float silu_f(float x) { return x * __builtin_amdgcn_rcpf(1.0f + __expf(-x)); }
struct EpiIn {
    static constexpr bool PERM = true, AFTER_DRAIN = false, RSL = true;
    bf16_t* O; int ldc; const float* RS; float* FDt; int fd_tile; int Mrows;
    PG8_LAS float* NP; float* NRM;
    int g_from; bf16_t* G0; bf16_t* G1; int ldg;
    __device__ __forceinline__ void operator()(const f32x4 (&acc)[2][2][4][2], const Unit& u, int wr, int wc, int fr, int fq, const PG8_LAS float* rsl) const {
        const int row0 = u.pm * BM + wr * 64 + fr;
        float rs[2][4];
#pragma unroll
        for (int ai = 0; ai < 2; ++ai)
#pragma unroll
            for (int m = 0; m < 4; ++m) rs[ai][m] = rsl[wr * 64 + fr + ai * HALF + m * 16];
        if (u.pn == fd_tile) {
            if (wc == 0 && fq < 3) {
#pragma unroll
                for (int ai = 0; ai < 2; ++ai)
#pragma unroll
                    for (int m = 0; m < 4; ++m) { const int r = row0 + ai * HALF + m * 16;
#pragma unroll
                        for (int n = 0; n < 2; ++n)
#pragma unroll
                            for (int j = 0; j < 4; ++j) FDt[(size_t)(8 * fq + 4 * n + j) * Mrows + r] = acc[ai][0][m][n][j] * rs[ai][m]; }
            }
            return;
        }
        if (u.pn >= g_from) {
            const int gi = u.pn - g_from; bf16_t* Gb = (gi < 4 ? G0 : G1) + (gi & 3) * BM + wc * 32 + 8 * fq;
#pragma unroll
            for (int ai = 0; ai < 2; ++ai)
#pragma unroll
                for (int m = 0; m < 4; ++m) { bf16_t* rowp = Gb + (size_t)(row0 + ai * HALF + m * 16) * ldg; const float s = rs[ai][m];
#pragma unroll
                    for (int bj = 0; bj < 2; ++bj) { const f32x4 v0 = acc[ai][bj][m][0] * s, v1 = acc[ai][bj][m][1] * s;
                        u32x4 w; w.x = cvt_pk_bf16(silu_f(v0[0]), silu_f(v0[1])); w.y = cvt_pk_bf16(silu_f(v0[2]), silu_f(v0[3])); w.z = cvt_pk_bf16(silu_f(v1[0]), silu_f(v1[1])); w.w = cvt_pk_bf16(silu_f(v1[2]), silu_f(v1[3]));
                        *(u32x4*)(rowp + bj * HALF) = w; } }
            return;
        }
        const int col0 = u.pn * BM + wc * 32 + 8 * fq;
        const bool nrm = NRM != nullptr && u.pn < 8;
#pragma unroll
        for (int ai = 0; ai < 2; ++ai)
#pragma unroll
            for (int m = 0; m < 4; ++m) { bf16_t* rowp = O + (size_t)(row0 + ai * HALF + m * 16) * ldc + col0; const float s = rs[ai][m];
#pragma unroll
                for (int bj = 0; bj < 2; ++bj) { const f32x4 v0 = acc[ai][bj][m][0] * s, v1 = acc[ai][bj][m][1] * s;
                    u32x4 w; w.x = cvt_pk_bf16(v0[0], v0[1]); w.y = cvt_pk_bf16(v0[2], v0[3]); w.z = cvt_pk_bf16(v1[0], v1[1]); w.w = cvt_pk_bf16(v1[2], v1[3]);
                    *(u32x4*)(rowp + bj * HALF) = w;
                    if (nrm) { float p = ((v0[0] * v0[0] + v0[1] * v0[1]) + (v0[2] * v0[2] + v0[3] * v0[3])) + ((v1[0] * v1[0] + v1[1] * v1[1]) + (v1[2] * v1[2] + v1[3] * v1[3]));
                        p += lane_xor_f(p, 16, fq * 16 + fr); p += lane_xor_f(p, 32, fq * 16 + fr);
                        if (fq == 0) NP[(wc * 256 + wr * 64 + fr + ai * HALF + m * 16) * 2 + bj] = p; } } }
        if (nrm) {
            asm volatile("s_waitcnt lgkmcnt(0)" ::: "memory"); __builtin_amdgcn_s_barrier();
            const int wid = wr * 4 + wc, lane = fq * 16 + fr, bjh = wid >> 2, tq = wid & 3, rl = 64 * tq + lane;
            float sq = (NP[(0 * 256 + rl) * 2 + bjh] + NP[(1 * 256 + rl) * 2 + bjh]) + (NP[(2 * 256 + rl) * 2 + bjh] + NP[(3 * 256 + rl) * 2 + bjh]);
#pragma unroll
            for (int o = 1; o < 64; o <<= 1) sq = fmaxf(sq, lane_xor_f(sq, o, lane));
            if (lane == 0) { const int b = u.pm >> 4, j = (u.pm & 15) * 4 + tq, h = (u.pn & 3) * 2 + bjh, which = u.pn < 4 ? 1 : 0;
                NRM[(size_t)(b * 8 + h) * 128 + which * 64 + j] = sqrtf(sq) * 1.003f; }
        }
    }
};
struct EpiGate {
    static constexpr bool PERM = true, AFTER_DRAIN = false, RSL = true;
    bf16_t* O; int ldc; const float* RS; int Mrows;
    __device__ __forceinline__ void operator()(const f32x4 (&acc)[2][2][4][2], const Unit& u, int wr, int wc, int fr, int fq, const PG8_LAS float* rsl) const {
        const int row0 = u.pm * BM + wr * 64 + fr;
        const int col0 = u.pn * BM + wc * 32 + 8 * fq;
        u32x4 ov[2][4][2]; float rs[2][4];
#pragma unroll
        for (int ai = 0; ai < 2; ++ai)
#pragma unroll
            for (int m = 0; m < 4; ++m) { const int r = row0 + ai * HALF + m * 16; rs[ai][m] = rsl[wr * 64 + fr + ai * HALF + m * 16]; const bf16_t* rowp = O + (size_t)r * ldc + col0;
#pragma unroll
                for (int bj = 0; bj < 2; ++bj) ov[ai][m][bj] = *(const u32x4*)(rowp + bj * HALF); }
        asm volatile("" ::: "memory");
#pragma unroll
        for (int ai = 0; ai < 2; ++ai)
#pragma unroll
            for (int m = 0; m < 4; ++m) { const int r = row0 + ai * HALF + m * 16; const float s = rs[ai][m]; bf16_t* rowp = O + (size_t)r * ldc + col0;
#pragma unroll
                for (int bj = 0; bj < 2; ++bj) { const f32x4 g0 = acc[ai][bj][m][0] * s, g1 = acc[ai][bj][m][1] * s; const u32x4 o = ov[ai][m][bj];
                    u32x4 w;
                    w.x = cvt_pk_bf16(bf_lo(o.x) * silu_f(g0[0]), bf_hi(o.x) * silu_f(g0[1])); w.y = cvt_pk_bf16(bf_lo(o.y) * silu_f(g0[2]), bf_hi(o.y) * silu_f(g0[3]));
                    w.z = cvt_pk_bf16(bf_lo(o.z) * silu_f(g1[0]), bf_hi(o.z) * silu_f(g1[1])); w.w = cvt_pk_bf16(bf_lo(o.w) * silu_f(g1[2]), bf_hi(o.w) * silu_f(g1[3]));
                    *(u32x4*)(rowp + bj * HALF) = w; } }
    }
};
struct EpiOut {
    static constexpr bool PERM = true, AFTER_DRAIN = false, RSL = false;
    bf16_t* hi; float* SS; int Mrows; bf16_t* ho; int ho_pitch;
    __device__ __forceinline__ void operator()(const f32x4 (&acc)[2][2][4][2], const Unit& u, int wr, int wc, int fr, int fq, const PG8_LAS float*) const {
        const int row0 = u.pm * BM + wr * 64 + fr, col0 = u.pn * BM + wc * 32 + 8 * fq;
        u32x4 ah[2][4][2];
#pragma unroll
        for (int ai = 0; ai < 2; ++ai)
#pragma unroll
            for (int m = 0; m < 4; ++m) { const size_t off = (size_t)(row0 + ai * HALF + m * 16) * 1024 + col0;
#pragma unroll
                for (int bj = 0; bj < 2; ++bj) ah[ai][m][bj] = *(const u32x4*)(hi + off + bj * HALF); }
        asm volatile("" ::: "memory");
#pragma unroll
        for (int ai = 0; ai < 2; ++ai)
#pragma unroll
            for (int m = 0; m < 4; ++m) { const int r = row0 + ai * HALF + m * 16; const size_t off = (size_t)r * 1024 + col0; float ssq = 0.f;
#pragma unroll
                for (int bj = 0; bj < 2; ++bj) { const u32x4 a = ah[ai][m][bj]; const f32x4 c0 = acc[ai][bj][m][0], c1 = acc[ai][bj][m][1];
                    const float h0 = bf_lo(a.x) + c0[0], h1 = bf_hi(a.x) + c0[1], h2 = bf_lo(a.y) + c0[2], h3 = bf_hi(a.y) + c0[3];
                    const float h4 = bf_lo(a.z) + c1[0], h5 = bf_hi(a.z) + c1[1], h6 = bf_lo(a.w) + c1[2], h7 = bf_hi(a.w) + c1[3];
                    ssq += ((h0 * h0 + h1 * h1) + (h2 * h2 + h3 * h3)) + ((h4 * h4 + h5 * h5) + (h6 * h6 + h7 * h7));
                    { u32x4 nh; nh.x = cvt_pk_bf16(h0, h1); nh.y = cvt_pk_bf16(h2, h3); nh.z = cvt_pk_bf16(h4, h5); nh.w = cvt_pk_bf16(h6, h7); *(u32x4*)(ho + (size_t)r * ho_pitch + col0 + bj * HALF) = nh; } }
                ssq += lane_xor_f(ssq, 16, fq * 16 + fr); ssq += lane_xor_f(ssq, 32, fq * 16 + fr);
                if (fq == 0) SS[(size_t)(u.pn * 4 + wc) * Mrows + r] = ssq; }
    }
};
template <class Epi, class Sched, bool ALIGN_EPI = false, bool SP2 = false>
__device__ __forceinline__ void gemm_phase(PG8_LAS unsigned char* lds, const Gemm g, const Sched& S, const Epi& E) {
    int l_ = __builtin_amdgcn_mbcnt_hi(~0u, __builtin_amdgcn_mbcnt_lo(~0u, 0u)); asm volatile("" : "+v"(l_)); const int wid = S.wv, tid = wid * 64 + l_, lane = tid & 63, wr = wid >> 2, wc = wid & 3, fr = lane & 15, fq = lane >> 4;
    const int K = g.K, nt = K / BK;
    unsigned voffA[2], voffB[2];
#pragma unroll
    for (int i = 0; i < 2; ++i) { int R, C; stage_rc(tid * 16 + i * 8192, R, C); const int Rb = Epi::PERM ? ((R & ~31) + perm32(R & 31)) : R;
        voffA[i] = (unsigned)(R * g.lda + C) * 2u; voffB[i] = (unsigned)(Rb * K + C) * 2u; }
    const size_t kstep = (size_t)(BK * 2);
    const size_t hstepA = (size_t)HALF * g.lda * 2, hstepB = (size_t)HALF * K * 2;
    const size_t tstepA = 2 * hstepA, tstepB = 2 * hstepB;
    const unsigned ldsw = (unsigned)wid * 1024u;
    const int aoff = lds_byte(wr * 64 + fr, fq * 8), boff = lds_byte(wc * 32 + fr, fq * 8);
#define PG8_SA(b, h) (((b) * 2 + (h)) * HTB)
#define PG8_SB(b, h) ((4 + (b) * 2 + (h)) * HTB)
#define PG8_STAGE(bufoff, gbase, voff) do { _Pragma("unroll") for (int _i = 0; _i < 2; ++_i) \
        __builtin_amdgcn_global_load_lds((const unsigned*)((const char*)(gbase) + (voff)[_i]), (PG8_LAS unsigned*)(lds + (bufoff) + ldsw + _i * 8192), 16, 0, 0); } while (0)
#define PG8_LDA(dst, b, h) do { _Pragma("unroll") for (int m = 0; m < 4; ++m) _Pragma("unroll") for (int k = 0; k < 2; ++k) dst[m][k] = *(const PG8_LAS bf16x8*)(lds + PG8_SA(b, h) + aoff + m * 2048 + k * 1024); } while (0)
#define PG8_LDB(dst, b, h) do { _Pragma("unroll") for (int n = 0; n < 2; ++n) _Pragma("unroll") for (int k = 0; k < 2; ++k) dst[n][k] = *(const PG8_LAS bf16x8*)(lds + PG8_SB(b, h) + boff + n * 2048 + k * 1024); } while (0)
#define PG8_MMA(ai, bj, At, Bt) do { __builtin_amdgcn_s_setprio(1); _Pragma("unroll") for (int m = 0; m < 4; ++m) _Pragma("unroll") for (int n = 0; n < 2; ++n) _Pragma("unroll") for (int k = 0; k < 2; ++k) \
        acc[ai][bj][m][n] = __builtin_amdgcn_mfma_f32_16x16x32_bf16(Bt[n][k], At[m][k], acc[ai][bj][m][n], 0, 0, 0); __builtin_amdgcn_s_setprio(0); } while (0)
#define PG8_WAIT_V(n) asm volatile("s_waitcnt vmcnt(" #n ")" ::: "memory")
#define PG8_WAIT_L(n) asm volatile("s_waitcnt lgkmcnt(" #n ")" ::: "memory")
#define PG8_BAR __builtin_amdgcn_s_barrier()
#define PG8_SCHED __builtin_amdgcn_sched_barrier(0)
    Unit cur, nxt; int ui = 0;
    if (!S.next(0, cur)) return;
    f32x4 acc[2][2][4][2];
#pragma unroll
    for (int a = 0; a < 2; ++a)
#pragma unroll
        for (int b = 0; b < 2; ++b)
#pragma unroll
            for (int m = 0; m < 4; ++m)
#pragma unroll
                for (int n = 0; n < 2; ++n) acc[a][b][m][n] = (f32x4){0.f, 0.f, 0.f, 0.f};
    bf16x8 At[4][2], B0[2][2], B1[2][2];
    const char* cA = (const char*)g.A + (size_t)cur.pm * tstepA; const char* cB = (const char*)g.Bt + (size_t)cur.pn * tstepB;
    S.a_ready(cur);
#define PG8_RS_STAGE(pm_, slot_) do { if (wid < 4) __builtin_amdgcn_global_load_lds((const unsigned*)(E.RS + (size_t)(pm_) * BM + wid * 64 + lane), (PG8_LAS unsigned*)(lds + RSL_OFF + (slot_) * 1024 + wid * 256), 4, 0, 0); } while (0)
    if constexpr (Epi::RSL) PG8_RS_STAGE(cur.pm, 0);
    if constexpr (SP2) {
        PG8_STAGE(PG8_SB(0, 0), cB, voffB); PG8_STAGE(PG8_SB(0, 1), cB + hstepB, voffB); PG8_STAGE(PG8_SA(0, 0), cA, voffA); PG8_STAGE(PG8_SA(0, 1), cA + hstepA, voffA);
        if (wr == 1) PG8_BAR;
        PG8_WAIT_V(2); PG8_BAR;
        PG8_STAGE(PG8_SB(1, 0), cB + kstep, voffB); PG8_STAGE(PG8_SA(1, 0), cA + kstep, voffA); PG8_STAGE(PG8_SB(1, 1), cB + hstepB + kstep, voffB);
        PG8_WAIT_V(6); PG8_BAR;
    } else {
        PG8_STAGE(PG8_SB(0, 0), cB, voffB); PG8_STAGE(PG8_SA(0, 0), cA, voffA); PG8_STAGE(PG8_SB(0, 1), cB + hstepB, voffB); PG8_STAGE(PG8_SA(0, 1), cA + hstepA, voffA);
        if (wr == 1) PG8_BAR;
        PG8_WAIT_V(4); PG8_BAR;
        PG8_STAGE(PG8_SB(1, 0), cB + kstep, voffB); PG8_STAGE(PG8_SA(1, 0), cA + kstep, voffA); PG8_STAGE(PG8_SB(1, 1), cB + hstepB + kstep, voffB);
        PG8_WAIT_V(6); PG8_BAR;
    }
    for (;;) {
        const bool has_next = S.next(ui + 1, nxt);
        const char* nA = has_next ? (const char*)g.A + (size_t)nxt.pm * tstepA : cA; const char* nB = has_next ? (const char*)g.Bt + (size_t)nxt.pn * tstepB : cB;
        for (int t = 0; t < nt; t += 2) {
            const bool last = (t == nt - 2);
            const char* a1 = cA + (size_t)(t + 1) * kstep;
            const char* a2 = last ? nA : cA + (size_t)(t + 2) * kstep; const char* b2 = last ? nB : cB + (size_t)(t + 2) * kstep;
            const char* a3 = a2 + kstep; const char* b3 = b2 + kstep;
            if (last && has_next) { S.a_ready(nxt); if constexpr (Epi::RSL) PG8_RS_STAGE(nxt.pm, (ui + 1) & 1); }
            if constexpr (SP2) {
            PG8_LDB(B0, 0, 0); PG8_LDB(B1, 0, 1); PG8_SCHED; PG8_LDA(At, 0, 0); PG8_STAGE(PG8_SA(1, 1), a1 + hstepA, voffA);
            PG8_WAIT_V(8); PG8_WAIT_L(0); PG8_BAR; PG8_MMA(0, 0, At, B0); PG8_MMA(0, 1, At, B1); PG8_BAR; PG8_SCHED;
            PG8_LDA(At, 0, 1); PG8_STAGE(PG8_SB(0, 0), b2, voffB); PG8_STAGE(PG8_SB(0, 1), b2 + hstepB, voffB); PG8_STAGE(PG8_SA(0, 0), a2, voffA);
            PG8_WAIT_V(8); PG8_WAIT_L(0); PG8_BAR; PG8_MMA(1, 0, At, B0); PG8_MMA(1, 1, At, B1); PG8_BAR; PG8_SCHED;
            PG8_LDB(B0, 1, 0); PG8_LDB(B1, 1, 1); PG8_SCHED; PG8_LDA(At, 1, 0); PG8_STAGE(PG8_SA(0, 1), a2 + hstepA, voffA);
            PG8_WAIT_V(8); PG8_WAIT_L(0); PG8_BAR; PG8_MMA(0, 0, At, B0); PG8_MMA(0, 1, At, B1); PG8_BAR; PG8_SCHED;
            PG8_LDA(At, 1, 1); PG8_STAGE(PG8_SB(1, 0), b3, voffB); PG8_STAGE(PG8_SB(1, 1), b3 + hstepB, voffB); PG8_STAGE(PG8_SA(1, 0), a3, voffA);
            PG8_WAIT_V(8); PG8_WAIT_L(0); PG8_BAR; PG8_MMA(1, 0, At, B0); PG8_MMA(1, 1, At, B1); PG8_BAR; PG8_SCHED;
            } else {
            PG8_LDB(B0, 0, 0); PG8_SCHED; PG8_LDA(At, 0, 0); PG8_STAGE(PG8_SA(1, 1), a1 + hstepA, voffA);
            PG8_WAIT_L(8); PG8_BAR; PG8_WAIT_L(0); PG8_MMA(0, 0, At, B0); PG8_BAR; PG8_SCHED;
            PG8_LDB(B1, 0, 1); PG8_STAGE(PG8_SB(0, 0), b2, voffB);
            PG8_BAR; PG8_WAIT_L(0); PG8_MMA(0, 1, At, B1); PG8_BAR;
            PG8_LDA(At, 0, 1); PG8_STAGE(PG8_SA(0, 0), a2, voffA);
            PG8_BAR; PG8_WAIT_L(0); PG8_MMA(1, 0, At, B0); PG8_BAR; PG8_SCHED;
            PG8_STAGE(PG8_SB(0, 1), b2 + hstepB, voffB);
            PG8_WAIT_V(6); PG8_BAR; PG8_MMA(1, 1, At, B1); PG8_BAR;
            PG8_LDB(B0, 1, 0); PG8_SCHED; PG8_LDA(At, 1, 0); PG8_STAGE(PG8_SA(0, 1), a2 + hstepA, voffA);
            PG8_WAIT_L(8); PG8_BAR; PG8_WAIT_L(0); PG8_MMA(0, 0, At, B0); PG8_BAR; PG8_SCHED;
            PG8_LDB(B1, 1, 1); PG8_STAGE(PG8_SB(1, 0), b3, voffB);
            PG8_BAR; PG8_WAIT_L(0); PG8_MMA(0, 1, At, B1); PG8_BAR;
            PG8_LDA(At, 1, 1); PG8_STAGE(PG8_SA(1, 0), a3, voffA);
            PG8_BAR; PG8_WAIT_L(0); PG8_MMA(1, 0, At, B0); PG8_BAR; PG8_SCHED;
            PG8_STAGE(PG8_SB(1, 1), b3 + hstepB, voffB);
            PG8_WAIT_V(6); PG8_BAR; PG8_MMA(1, 1, At, B1); PG8_BAR;
            }
        }
        if constexpr (ALIGN_EPI) { if (wr == 0) PG8_BAR; }
        if constexpr (!Epi::AFTER_DRAIN) { E(acc, cur, wr, wc, fr, fq, (const PG8_LAS float*)(lds + RSL_OFF + (ui & 1) * 1024)); S.done(cur); }
        if (!has_next) break;
#pragma unroll
        for (int a = 0; a < 2; ++a)
#pragma unroll
            for (int b = 0; b < 2; ++b)
#pragma unroll
                for (int m = 0; m < 4; ++m)
#pragma unroll
                    for (int n = 0; n < 2; ++n) acc[a][b][m][n] = (f32x4){0.f, 0.f, 0.f, 0.f};
        cur = nxt; cA = nA; cB = nB; ++ui;
        if constexpr (ALIGN_EPI) { if (wr == 1) PG8_BAR; }
    }
    PG8_WAIT_V(0);
    if constexpr (!ALIGN_EPI) { if (wr == 0) PG8_BAR; }
    PG8_BAR;
    if constexpr (Epi::AFTER_DRAIN) { E.fused(acc, cur, wr, wc, fr, fq, lds, wid, lane); S.done(cur); }
#undef PG8_RS_STAGE
#undef PG8_SA
#undef PG8_SB
#undef PG8_STAGE
#undef PG8_LDA
#undef PG8_LDB
#undef PG8_MMA
#undef PG8_WAIT_V
#undef PG8_WAIT_L
#undef PG8_BAR
#undef PG8_SCHED
}
}
namespace fa {
typedef unsigned short bf16;
typedef short bf16x8 __attribute__((ext_vector_type(8)));
typedef short s16x4 __attribute__((ext_vector_type(4)));
typedef float f32x16 __attribute__((ext_vector_type(16)));
typedef float f32x4 __attribute__((ext_vector_type(4)));
typedef unsigned u32x4 __attribute__((ext_vector_type(4)));
typedef unsigned u32x2 __attribute__((ext_vector_type(2)));
constexpr int D = 128, NW = 8, QBLK = 32, KVBLK = 64, QB = NW * QBLK, SEQ = 4096;
constexpr int PQ = 4160, PO = 2048;
constexpr int SHM_V = KVBLK * D * 2, SHM_K = KVBLK * D * 2;
constexpr int LDS_WS = 2 * SHM_V + 2 * SHM_K, LDS_CS = LDS_WS + NW * 64 * 4, LDS_Q = LDS_CS + SEQ * 4, LDS_ITEM = LDS_Q + NW * (8 - 7) * 1024, LDS_BYTES = LDS_ITEM + 16 + 256;
constexpr int QREG = 8;
constexpr float SCALE = 0.08838834764831845f, THR = 8.f;
#define KSWZ(row, colB) ((row) * 256 + ((colB) ^ (((row) & 7) << 4)))
#define SBAR() __builtin_amdgcn_sched_barrier(0)
__device__ __forceinline__ int v_st(int k, int c) { const int kk = (k & ~0xC) | ((k & 4) << 1) | ((k & 8) >> 1); return ((kk >> 3) * 4 + (c >> 5)) * 512 + ((kk & 7) * 32 + (c & 31)) * 2; }
__device__ __forceinline__ int v_rd_base(int lane) { return ((lane & 3) << 3) | (((lane >> 2) & 3) << 6) | (((lane >> 4) & 1) << 5) | (((lane >> 5) & 1) << 8); }
constexpr int v_rd_off(int d0, int ks, int half) { return d0 * 512 + ks * 4096 + half * 2048; }
__device__ __forceinline__ int crow(int r, int hi) { return (r & 3) + 8 * (r >> 2) + 4 * hi; }
__device__ __forceinline__ unsigned cvtpk(float lo, float hi) {
    unsigned r; asm volatile("v_cvt_pk_bf16_f32 %0, %1, %2" : "=v"(r) : "v"(lo), "v"(hi)); return r;
}
__device__ __forceinline__ bf16x8 pack8(f32x4 a, f32x4 b) {
    u32x4 w = {cvtpk(a[0], a[1]), cvtpk(a[2], a[3]), cvtpk(b[0], b[1]), cvtpk(b[2], b[3])};
    return *reinterpret_cast<bf16x8*>(&w);
}
__device__ __forceinline__ bf16x8 ld8(const unsigned short* p) { return *reinterpret_cast<const bf16x8*>(p); }
__device__ __forceinline__ void mask_tile(f32x16& p0, f32x16& p1, int dq, unsigned W) {
    const float NEG = -__builtin_inff();
#pragma unroll
    for (int r = 0; r < 16; ++r) {
        const int c = (r & 3) + 8 * (r >> 2);
        if ((unsigned)(dq - c) >= W) p0[r] = NEG;
        if ((unsigned)(dq - c - 32) >= W) p1[r] = NEG;
    }
}
__device__ __forceinline__ void partialSM(f32x16& p0, f32x16& p1, float& m_reg, float& mn, float& alpha) {
    float pmax = p0[0]; for (int r = 1; r < 16; ++r) pmax = fmaxf(pmax, p0[r]); for (int r = 0; r < 16; ++r) pmax = fmaxf(pmax, p1[r]);
    { auto rr = __builtin_amdgcn_permlane32_swap(__float_as_uint(pmax), __float_as_uint(pmax), false, false);
      pmax = fmaxf(__uint_as_float(rr[0]), __uint_as_float(rr[1])); }
    constexpr float C2 = 1.4426950408889634f * SCALE;
    if (__builtin_expect(__all((pmax - m_reg) * SCALE <= THR), 1)) { mn = m_reg; alpha = 1.f; }
    else { mn = fmaxf(m_reg, pmax); alpha = __builtin_amdgcn_exp2f((m_reg - mn) * C2); m_reg = mn; }
    const float mnL = -mn * C2;
    for (int r = 0; r < 16; ++r) p0[r] = fmaf(p0[r], C2, mnL); for (int r = 0; r < 16; ++r) p1[r] = fmaf(p1[r], C2, mnL);
    for (int r = 0; r < 16; ++r) p0[r] = __builtin_amdgcn_exp2f(p0[r]);
}
__device__ __forceinline__ void finishSM(f32x16& p0, f32x16& p1, float alpha, float& l_reg, bf16x8& pa0, bf16x8& pa1, bf16x8& pa2, bf16x8& pa3) {
    for (int r = 0; r < 16; ++r) p1[r] = __builtin_amdgcn_exp2f(p1[r]);
    float ps = 0; for (int r = 0; r < 16; ++r) ps += p0[r]; for (int r = 0; r < 16; ++r) ps += p1[r];
    { auto rr = __builtin_amdgcn_permlane32_swap(__float_as_uint(ps), __float_as_uint(ps), false, false);
      ps = __uint_as_float(rr[0]) + __uint_as_float(rr[1]); }
    l_reg = l_reg * alpha + ps;
#define PK4(P, B_, OUT) do { unsigned a0 = cvtpk(P[B_+0], P[B_+1]), a1 = cvtpk(P[B_+2], P[B_+3]);                          \
        unsigned b0 = cvtpk(P[B_+4], P[B_+5]), b1 = cvtpk(P[B_+6], P[B_+7]);                                             \
        auto r0 = __builtin_amdgcn_permlane32_swap(a0, b0, false, false); auto r1 = __builtin_amdgcn_permlane32_swap(a1, b1, false, false); \
        u32x4 w = {r0[0], r1[0], r0[1], r1[1]}; OUT = *reinterpret_cast<bf16x8*>(&w); } while (0)
    PK4(p0, 0, pa0); PK4(p0, 8, pa1); PK4(p1, 0, pa2); PK4(p1, 8, pa3);
#undef PK4
}
template <int KB>
__device__ __forceinline__ void qkt(f32x16& p0, f32x16& p1, const char* K_lds, const float* nck, int r32, int hi, const bf16x8* qr, const char* q_lds) {
#pragma unroll
    for (int g = 0; g < 4; ++g) { const f32x4 a = *(const f32x4*)(nck + 8 * g + 4 * hi), b = *(const f32x4*)(nck + 32 + 8 * g + 4 * hi);
#pragma unroll
        for (int j = 0; j < 4; ++j) { p0[4 * g + j] = a[j]; p1[4 * g + j] = b[j]; } }
    const char* kb[4];
#pragma unroll
    for (int dd = 0; dd < 4; ++dd) kb[dd] = K_lds + KB * SHM_K + KSWZ(r32, (dd * 16 + hi * 8) * 2);
#pragma unroll
    for (int d0 = 0; d0 < 8; ++d0) { const char* a = kb[d0 & 3] + (d0 >> 2) * 128;
        bf16x8 b0 = *reinterpret_cast<const bf16x8*>(a);
        bf16x8 b1 = *reinterpret_cast<const bf16x8*>(a + 32 * 256);
        const bf16x8 qf = d0 < QREG ? qr[d0] : *reinterpret_cast<const bf16x8*>(q_lds + (d0 - QREG) * 1024);
        p0 = __builtin_amdgcn_mfma_f32_32x32x16_bf16(b0, qf, p0, 0, 0, 0);
        p1 = __builtin_amdgcn_mfma_f32_32x32x16_bf16(b1, qf, p1, 0, 0, 0); }
}
template <int VB, bool SK>
__device__ __forceinline__ void pv_tile(f32x16* o, int vb0, bf16x8 pa0, bf16x8 pa1, bf16x8 pa2, bf16x8 pa3, bool act) {
    if (SK && !act) return;
#define TRRD(dst, off) asm volatile("ds_read_b64_tr_b16 %0, %1 offset:%2" : "=&v"(dst) : "v"(vb0), "i"(off) : "memory")
#define PV_D0(d0) do { s16x4 l0, l1, l2, l3, h0, h1, h2, h3; constexpr int b_ = VB * SHM_V + v_rd_off(d0, 0, 0);     \
        TRRD(l0, b_); TRRD(h0, b_ + 2048); TRRD(l1, b_ + 4096); TRRD(h1, b_ + 6144); TRRD(l2, b_ + 8192); TRRD(h2, b_ + 10240); TRRD(l3, b_ + 12288); TRRD(h3, b_ + 14336); \
        asm volatile("s_waitcnt lgkmcnt(0)" ::: "memory"); SBAR();                 \
        o[d0] = __builtin_amdgcn_mfma_f32_32x32x16_bf16(pa0, (bf16x8){l0[0], l0[1], l0[2], l0[3], h0[0], h0[1], h0[2], h0[3]}, o[d0], 0, 0, 0);   \
        o[d0] = __builtin_amdgcn_mfma_f32_32x32x16_bf16(pa1, (bf16x8){l1[0], l1[1], l1[2], l1[3], h1[0], h1[1], h1[2], h1[3]}, o[d0], 0, 0, 0);   \
        o[d0] = __builtin_amdgcn_mfma_f32_32x32x16_bf16(pa2, (bf16x8){l2[0], l2[1], l2[2], l2[3], h2[0], h2[1], h2[2], h2[3]}, o[d0], 0, 0, 0);   \
        o[d0] = __builtin_amdgcn_mfma_f32_32x32x16_bf16(pa3, (bf16x8){l3[0], l3[1], l3[2], l3[3], h3[0], h3[1], h3[2], h3[3]}, o[d0], 0, 0, 0); } while (0)
    PV_D0(0); PV_D0(1); PV_D0(2); PV_D0(3);
#undef PV_D0
#undef TRRD
}
struct BlockRef { const bf16* Q; const bf16* K; const bf16* V; const bf16* G; bf16* O; int P0; int jlo; int bh; int jw; };
struct Seam { bf16x8 qr[8]; bf16x8 st_v0, st_v1, st_k0, st_k1; };
#define ROW(p, k0, rr) ((p) + (size_t)((k0) + (rr)) * PQ + sc)
#define VMW() asm volatile("s_waitcnt vmcnt(0)" ::: "memory")
#define VMWN(n) asm volatile("s_waitcnt vmcnt(%0)" :: "i"(n) : "memory")
#define SLOAD_H(Kp, Vp, k0) do { S.st_v0 = ld8(ROW(Vp, k0, sr)); S.st_v1 = ld8(ROW(Vp, k0, 32 + sr)); S.st_k0 = ld8(ROW(Kp, k0, sr)); S.st_k1 = ld8(ROW(Kp, k0, 32 + sr)); } while (0)
#define SWRITE_HK(bf) do { *(bf16x8*)(K_lds + (bf) * SHM_K + kws) = S.st_k0; *(bf16x8*)(K_lds + (bf) * SHM_K + kws + 32 * 256) = S.st_k1; } while (0)
#define SWRITE_HV(bf) do { *(bf16x8*)(V_lds + (bf) * SHM_V + vst0) = S.st_v0; *(bf16x8*)(V_lds + (bf) * SHM_V + vst1) = S.st_v1; } while (0)
#define SWRITE_H(bf) do { SWRITE_HV(bf); SWRITE_HK(bf); } while (0)
__device__ __forceinline__ void fox_prime(const BlockRef& cur, char* lds, Seam& S, int tid) {
    const int wid = __builtin_amdgcn_readfirstlane(tid >> 6), lane = tid & 63, r32 = lane & 31, hi = lane >> 5;
    const int sr = tid >> 4, sc = (tid & 15) * 8, kws = KSWZ(sr, sc * 2); char* K_lds = lds + 2 * SHM_V;
#pragma unroll
    for (int d0 = 0; d0 < 8; ++d0) S.qr[d0] = ld8(cur.Q + (size_t)(wid * QBLK + r32) * PQ + d0 * 16 + hi * 8);
    SLOAD_H(cur.K, cur.V, cur.P0 + 3 * KVBLK); VMW(); SWRITE_HK(0);
    __syncthreads();
}
__device__ __forceinline__ void fox_block(const BlockRef& cur, const BlockRef& nxt, char* lds, Seam& S, int tid, const float* ncs_next  ) {
    const int wid = __builtin_amdgcn_readfirstlane(tid >> 6), lane = tid & 63, r32 = lane & 31, hi = lane >> 5;
    const int NT = cur.P0 / KVBLK + 4 - cur.jlo;
    const unsigned W = 1u << 30;
    const int koff = cur.jlo * KVBLK, klo_w = (cur.jw - cur.jlo) * KVBLK;
    const int qlo = cur.P0 - koff + wid * QBLK, qm = qlo + r32 - 4 * hi;
    char* V_lds = lds; char* K_lds = lds + 2 * SHM_V;
    float* ws = (float*)(lds + LDS_WS) + wid * 64; float* li_l = ws, * al_l = ws + 32;
    const float* cs_l = (const float*)(lds + LDS_CS) + koff;
    float m_reg = -1e30f, l_reg = 0; f32x16 o[4] = {};
    const int sr = tid >> 4, sc = (tid & 15) * 8, vst0 = v_st(sr, sc), vst1 = v_st(32 + sr, sc), kws = KSWZ(sr, sc * 2);
    const int vb0 = (int)(uintptr_t)V_lds + v_rd_base(lane);
    char* q_lds = lds + LDS_Q + wid * (8 - QREG) * 1024 + lane * 16;
    const bf16* Kh = cur.K + (size_t)koff * PQ; const bf16* Vh = cur.V + (size_t)koff * PQ;
#define RESC(a) do { if (__any((a) < 1.f)) { if (hi == 0) al_l[r32] = (a); asm volatile("s_waitcnt lgkmcnt(0)" ::: "memory");              \
                     for (int d_ = 0; d_ < 4; ++d_) for (int r = 0; r < 16; ++r) o[d_][r] *= al_l[crow(r, hi)]; } } while (0)
#define KBASE(t) ((NT - 1 - (t)) * KVBLK)
#define ACT(t) (KBASE(t) <= qlo + QBLK - 1 && KBASE(t) >= klo_w)
#define MASKT(P0_, P1_, t) do { const int kb_ = KBASE(t); if (kb_ + KVBLK - 1 > qlo) mask_tile(P0_, P1_, qm - kb_, W); } while (0)
#define SEAM_K0() do { VMWN(8); SWRITE_HK(0); SBAR(); } while (0)
    f32x16 pA0, pA1, pB0, pB1; float mnA, mnB, alA, alB; bf16x8 pa0, pa1, pa2, pa3;
    SWRITE_HV(0);
#pragma unroll
    for (int d0 = QREG; d0 < 8; ++d0) *(bf16x8*)(q_lds + (d0 - QREG) * 1024) = S.qr[d0];
    SBAR();
    if (NT > 1) SLOAD_H(Kh, Vh, KBASE(1));
    SBAR(); if (ACT(0)) { qkt<0>(pA0, pA1, K_lds, cs_l + KBASE(0), r32, hi, S.qr, q_lds);
        MASKT(pA0, pA1, 0); partialSM(pA0, pA1, m_reg, mnA, alA); } else { alA = 1.f; mnA = m_reg; }
    if (NT > 1) { VMW(); SWRITE_H(1); }
    __syncthreads();
#define HALF_STEP(PX0, PX1, mnX, alX, PY0, PY1, alY, t, KB, VB, SB) do {                                                      \
        SBAR(); if ((t) + 1 < NT) { SLOAD_H(Kh, Vh, KBASE((t) + 1)); SBAR(); }     \
        const bool ax_ = ACT(t), ay_ = ACT((t) - 1);                                                                          \
        if (ax_) qkt<KB>(PX0, PX1, K_lds, cs_l + KBASE(t), r32, hi, S.qr, q_lds);                                        \
        if (ay_) finishSM(PY0, PY1, alY, l_reg, pa0, pa1, pa2, pa3); SBAR();                                                  \
        if (ay_) pv_tile<VB, false>(o, vb0, pa0, pa1, pa2, pa3, true);                                                        \
        if (ax_) { MASKT(PX0, PX1, (t)); partialSM(PX0, PX1, m_reg, mnX, alX); } else { alX = 1.f; mnX = m_reg; }             \
        __syncthreads();                                                                                                      \
        if ((t) + 1 < NT) { VMW(); SWRITE_H(SB); }                                                                            \
        RESC(alX); __syncthreads(); } while (0)
    for (int t = 1; t + 1 < NT; t += 2) {
        HALF_STEP(pB0, pB1, mnB, alB, pA0, pA1, alA, t, 1, 0, 0);
        HALF_STEP(pA0, pA1, mnA, alA, pB0, pB1, alB, t + 1, 0, 1, 1);
    }
    const bool even = (NT & 1) == 0;
    const bool aL_ = ACT(NT - 1), aA_ = even ? ACT(NT - 2) : aL_;
    if (even) { SBAR(); if (aL_) qkt<1>(pB0, pB1, K_lds, cs_l + KBASE(NT - 1), r32, hi, S.qr, q_lds); SBAR(); }
    SLOAD_H(nxt.K, nxt.V, nxt.P0 + 3 * KVBLK); SBAR();
#pragma unroll
    for (int d0 = 0; d0 < 8; ++d0) S.qr[d0] = ld8(nxt.Q + (size_t)(wid * QBLK + r32) * PQ + d0 * 16 + hi * 8);
    SBAR();
    if (aA_) finishSM(pA0, pA1, alA, l_reg, pa0, pa1, pa2, pa3); SBAR();
    if (aA_) pv_tile<0, false>(o, vb0, pa0, pa1, pa2, pa3, true);
    if (even) { if (aL_) { MASKT(pB0, pB1, NT - 1); partialSM(pB0, pB1, m_reg, mnB, alB); } else { alB = 1.f; mnB = m_reg; } __syncthreads(); RESC(alB);
        if (aL_) { finishSM(pB0, pB1, alB, l_reg, pa0, pa1, pa2, pa3); SBAR(); pv_tile<1, false>(o, vb0, pa0, pa1, pa2, pa3, true); } }
    SBAR(); SEAM_K0();
    if (ncs_next) { const f32x4* src_ = (const f32x4*)ncs_next; f32x4* dst_ = (f32x4*)(lds + LDS_CS);
        dst_[tid] = src_[tid]; dst_[tid + 512] = src_[tid + 512]; }
    if (hi == 0) li_l[r32] = l_reg; asm volatile("s_waitcnt lgkmcnt(0)" ::: "memory");
    float rli[16];
#pragma unroll
    for (int r = 0; r < 16; ++r) rli[r] = __builtin_amdgcn_rcpf(li_l[crow(r, hi)]);
    typedef float f32x2_t __attribute__((ext_vector_type(2))); typedef __bf16 bf16x2_t __attribute__((ext_vector_type(2)));
#define FA_CVT(lo_, hi_) __builtin_bit_cast(unsigned, __builtin_convertvector((f32x2_t){lo_, hi_}, bf16x2_t))
    { const unsigned selx = (r32 & 1) ? 0x03020706u : 0x05040100u;
      const bool b1 = (r32 & 2) != 0;
      bf16* Ow = cur.O + (size_t)(wid * QBLK + 4 * hi + (r32 & 3)) * PO + (r32 & ~3);
      const bf16* Gw = cur.G + (size_t)(wid * QBLK + 4 * hi + (r32 & 3)) * PQ + (r32 & ~3);
      u32x2 gl[4][4];
#pragma unroll
      for (int g4 = 0; g4 < 4; ++g4)
#pragma unroll
          for (int d0 = 0; d0 < 4; ++d0) gl[g4][d0] = *(const u32x2*)(Gw + (size_t)(8 * g4) * PQ + d0 * 32);
#pragma unroll
      for (int g4 = 0; g4 < 4; ++g4)
#pragma unroll
          for (int d0 = 0; d0 < 4; ++d0) {
              const unsigned w01 = FA_CVT(o[d0][4 * g4] * rli[4 * g4], o[d0][4 * g4 + 1] * rli[4 * g4 + 1]), w23 = FA_CVT(o[d0][4 * g4 + 2] * rli[4 * g4 + 2], o[d0][4 * g4 + 3] * rli[4 * g4 + 3]);
              const unsigned n01 = (unsigned)__builtin_amdgcn_update_dpp(0, (int)w01, 0xB1, 0xF, 0xF, false), n23 = (unsigned)__builtin_amdgcn_update_dpp(0, (int)w23, 0xB1, 0xF, 0xF, false);
              const unsigned a = __builtin_amdgcn_perm(n01, w01, selx), bq = __builtin_amdgcn_perm(n23, w23, selx);
              const unsigned x = b1 ? a : bq;
              const unsigned y = (unsigned)__builtin_amdgcn_update_dpp(0, (int)x, 0x4E, 0xF, 0xF, false);
              const u32x2 ov = b1 ? (u32x2){y, bq} : (u32x2){a, y}; const u32x2 gv = gl[g4][d0];
#define FA_LO(w_) __uint_as_float((w_) << 16)
#define FA_HI(w_) __uint_as_float((w_) & 0xffff0000u)
              const u32x2 og = (u32x2){FA_CVT(FA_LO(ov.x) * FA_LO(gv.x), FA_HI(ov.x) * FA_HI(gv.x)), FA_CVT(FA_LO(ov.y) * FA_LO(gv.y), FA_HI(ov.y) * FA_HI(gv.y))};
#undef FA_LO
#undef FA_HI
              *(u32x2*)(Ow + (size_t)(8 * g4) * PO + d0 * 32) = og; }
    }
#undef FA_CVT
    __syncthreads();
#undef RESC
#undef KBASE
#undef ACT
#undef MASKT
#undef SEAM_K0
#undef HALF_STEP
}
#undef ROW
#undef VMW
#undef VMWN
#undef SLOAD_H
#undef SWRITE_HK
#undef SWRITE_HV
#undef SWRITE_H
__device__ __forceinline__ int fox_jlo(const float* ncs, const float* KN, const float* QN, int qb, int lane, int wid, int& jw) {
    float qn = 0.f, kd = 0.f;
#pragma unroll
    for (int i = 0; i < 4; ++i) { qn = fmaxf(qn, QN[4 * qb + i]); kd = fmaxf(kd, KN[4 * qb + i]); }
    float a_ = qn * (KN[lane] + kd); asm volatile("" : "+v"(a_));
    const float ce = ncs[64 * lane + 63];
    const float bound = SCALE * (a_ + (ce - ncs[qb * QB]));
    const float bound_w = SCALE * (a_ + (ce - ncs[qb * QB + QBLK * wid]));
    const bool need = lane >= 4 * qb || !(bound < -30.0f);
    const bool need_w = lane >= 4 * qb || !(bound_w < -30.0f);
    jw = (int)__builtin_ctzll(__ballot(need_w));
    return (int)__builtin_ctzll(__ballot(need));
}
__device__ __forceinline__ BlockRef fox_ref(int item, int lane, int wid, const int* ord, const bf16* Y2, const float* CSR, const float* NRM, bf16* AO) {
    BlockRef r; int k, qb; const int x = item >> 6, i = item & 63;
    if (i < 48) { k = i / 12; qb = 15 - (i - k * 12); } else { const int j = i - 48; k = j >> 2; qb = 3 - (j & 3); }
    const int rank = k == 0 ? x : k == 1 ? 15 - x : k == 2 ? 16 + x : 31 - x;
    const int bh = __builtin_amdgcn_readfirstlane(ord[rank]), b = bh >> 3, h = bh & 7;
    const bf16* base = Y2 + (size_t)b * SEQ * PQ + h * D;
    int jw_; r.bh = bh; r.P0 = qb * QB; r.jlo = __builtin_amdgcn_readfirstlane(fox_jlo(CSR + (size_t)bh * SEQ, NRM + (size_t)bh * 128, NRM + (size_t)bh * 128 + 64, qb, lane, wid, jw_)); { const int j0_ = __builtin_amdgcn_readfirstlane(jw_); r.jw = j0_ < r.jlo ? r.jlo : j0_; }
    r.Q = base + (size_t)r.P0 * PQ; r.K = base + 1024; r.V = base + 2048; r.G = r.Q + 3072; r.O = AO + ((size_t)b * SEQ + r.P0) * PO + h * D;
    return r;
}
__device__ __forceinline__ int fox_fetch(unsigned* qc  , int x, int lane) {
    unsigned i0 = 0; if (lane == 0) i0 = __hip_atomic_fetch_add(qc + x * 64, 1u, __ATOMIC_RELAXED, __HIP_MEMORY_SCOPE_AGENT);
    i0 = __builtin_amdgcn_readfirstlane(i0);
    if (i0 < 64u) return x * 64 + (int)i0;
    for (int tries = 0; tries < 8; ++tries) {
        unsigned cv = 64u; if (lane < 8) cv = __hip_atomic_load(qc + lane * 64, __ATOMIC_RELAXED, __HIP_MEMORY_SCOPE_AGENT);
        const unsigned m = (unsigned)__builtin_amdgcn_ballot_w64(cv < 64u) & 0xffu;
        if (m == 0u) return -1;
        const unsigned rot = ((m >> x) | (m << (8 - x))) & 0xffu;
        const int y = (x + __builtin_ctz(rot)) & 7;
        unsigned iy = 0; if (lane == 0) iy = __hip_atomic_fetch_add(qc + y * 64, 1u, __ATOMIC_RELAXED, __HIP_MEMORY_SCOPE_AGENT);
        iy = __builtin_amdgcn_readfirstlane(iy);
        if (iy < 64u) return y * 64 + (int)iy;
    }
    return -1;
}
__device__ __forceinline__ void fox_phase(char* lds, int tid, int bid, int G, const bf16* Y2, const float* CSR, const float* NRM, bf16* AO, unsigned* qcnt) {
    (void)bid; (void)G;
    volatile int* slot = (volatile int*)(lds + LDS_ITEM); const int lane = tid & 63;
    const int xcd = (int)(__builtin_amdgcn_s_getreg((3 << 11) | 20) & 7u);
    float* rk = (float*)(lds + LDS_ITEM + 16); int* ord = (int*)(lds + LDS_ITEM + 16 + 128);
    if (tid < 32) rk[tid] = CSR[(size_t)tid * SEQ + SEQ - 1];
    __syncthreads();
    if (tid < 32) { const float r = rk[tid]; int c = 0;
        for (int j = 0; j < 32; ++j) { const float rj = rk[j]; c += (rj < r || (rj == r && j < tid)) ? 1 : 0; }
        ord[c] = tid; }
    if (tid < 64) { const int it_ = fox_fetch(qcnt, xcd, lane); if (lane == 0) slot[0] = it_; }
    __syncthreads();
    const int item0 = __builtin_amdgcn_readfirstlane(slot[0]);
    if (item0 < 0) return;
    BlockRef cur = fox_ref(item0, lane, __builtin_amdgcn_readfirstlane(tid >> 6), ord, Y2, CSR, NRM, AO);
    { const f32x4* src = (const f32x4*)(CSR + (size_t)cur.bh * SEQ); f32x4* dst = (f32x4*)(lds + LDS_CS); dst[tid] = src[tid]; dst[tid + 512] = src[tid + 512]; }
    Seam S;
    fox_prime(cur, lds, S, tid);
    for (;;) {
        if (tid < 64) { const int it_ = fox_fetch(qcnt, xcd, lane); if (lane == 0) slot[1] = it_; }
        __syncthreads();
        const int nitem = __builtin_amdgcn_readfirstlane(slot[1]); const bool last = nitem < 0;
        int tid2 = tid; asm volatile("" : "+v"(tid2));
        const BlockRef nxt = last ? cur : fox_ref(nitem, tid2 & 63, __builtin_amdgcn_readfirstlane(tid2 >> 6), ord, Y2, CSR, NRM, AO);
        fox_block(cur, nxt, lds, S, tid2, (!last && nxt.bh != cur.bh) ? CSR + (size_t)nxt.bh * SEQ : nullptr);
        if (last) break;
        cur = nxt;
    }
}
__device__ __forceinline__ void fox_norms(int gw, int ngw, int lane, const bf16* Y2, float* NRM) {
    for (int task = gw; task < 32 * 2 * 64; task += ngw) {
        const int j = task & 63, which = (task >> 6) & 1, bh = task >> 7, b = bh >> 3, h = bh & 7;
        const bf16* p = Y2 + ((size_t)b * SEQ + 64 * j + lane) * PQ + (which ? 0 : 1024) + h * D;
        float s = 0.f;
#pragma unroll
        for (int i = 0; i < 16; ++i) { const u32x4 v = *(const u32x4*)(p + 8 * i);
            const float a0 = __uint_as_float(v.x << 16), a1 = __uint_as_float(v.x & 0xffff0000u), a2 = __uint_as_float(v.y << 16), a3 = __uint_as_float(v.y & 0xffff0000u),
                        a4 = __uint_as_float(v.z << 16), a5 = __uint_as_float(v.z & 0xffff0000u), a6 = __uint_as_float(v.w << 16), a7 = __uint_as_float(v.w & 0xffff0000u);
            s += (a0 * a0 + a1 * a1) + (a2 * a2 + a3 * a3) + (a4 * a4 + a5 * a5) + (a6 * a6 + a7 * a7); }
#pragma unroll
        for (int o = 1; o < 64; o <<= 1) s = fmaxf(s, __int_as_float(__builtin_amdgcn_ds_bpermute((lane ^ o) << 2, __float_as_int(s))));
        if (lane == 0) NRM[(size_t)bh * 128 + which * 64 + j] = sqrtf(s) * 1.0001f;
    }
}
#undef KSWZ
#undef SBAR
}
namespace hg {
typedef unsigned short bf16;
typedef short bf16x8 __attribute__((ext_vector_type(8)));
typedef float f32x4 __attribute__((ext_vector_type(4)));
typedef unsigned u32x4 __attribute__((ext_vector_type(4)));
typedef unsigned u32x2 __attribute__((ext_vector_type(2)));
typedef float f2 __attribute__((ext_vector_type(2)));
constexpr int T = 4096, NSEG = 4, SEGLEN = T / NSEG, NCH = SEGLEN / 64, PY = 6144;
constexpr int LQ = 136, LS = 72, LO = 132;
constexpr int O_QX = 0, O_KX = O_QX + 64 * LQ * 2, O_KT = O_KX + 64 * LQ * 2, O_VT = O_KT + 128 * LS * 2, O_AM = O_VT + 128 * LS * 2, O_TOT = O_AM + 64 * LS * 2, O_E1 = O_TOT + 4096, O_E2 = O_E1 + 512,
              O_OSTF = O_E2 + 512, O_NW = O_OSTF + 64 * LO * 4, O_OSTF1 = O_NW + 512, LDS_BYTES = O_OSTF1 + 64 * LO * 4;
constexpr float LOG2E = 1.4426950408889634f;
typedef float f32x2_t __attribute__((ext_vector_type(2))); typedef __bf16 bf16x2_t __attribute__((ext_vector_type(2)));
__device__ __forceinline__ unsigned cvtpk(float lo, float hi) { f32x2_t v = {lo, hi}; bf16x2_t b = __builtin_convertvector(v, bf16x2_t); return __builtin_bit_cast(unsigned, b); }
__device__ __forceinline__ f2 ex2(f2 x) { return (f2){__builtin_amdgcn_exp2f(x.x), __builtin_amdgcn_exp2f(x.y)}; }
__device__ __forceinline__ f2 rcp2(f2 x) { return (f2){__builtin_amdgcn_rcpf(x.x), __builtin_amdgcn_rcpf(x.y)}; }
__device__ __forceinline__ f2 lg2(f2 x) { return (f2){__builtin_amdgcn_logf(x.x), __builtin_amdgcn_logf(x.y)}; }
__device__ __forceinline__ f2 max2(f2 a, float b) { return (f2){fmaxf(a.x, b), fmaxf(a.y, b)}; }
__device__ __forceinline__ f2 min2(f2 a, float b) { return (f2){fminf(a.x, b), fminf(a.y, b)}; }
__device__ __forceinline__ f2 clamp2(f2 a, float lim) { return (f2){fminf(fmaxf(a.x, -lim), lim), fminf(fmaxf(a.y, -lim), lim)}; }
__device__ __forceinline__ f2 bf2(unsigned w) { return (f2){__uint_as_float(w << 16), __uint_as_float(w & 0xffff0000u)}; }
__device__ __forceinline__ unsigned pk2(f2 v) { return cvtpk(v.x, v.y); }
#define HG_BAR() __syncthreads()

template <bool STATE_ONLY>
__device__ __forceinline__ void hgrn_stream(char* lds, int tid, int stream, bf16* Y, const float* lbl, int oi, const float* nw, float* SLOC, float* DSEG, const bf16* GA = nullptr, const bf16* GB = nullptr, bf16* Yo = nullptr, int po = PY) {
    const int lane = tid & 63, w = __builtin_amdgcn_readfirstlane(tid >> 6), c = lane & 15, q = lane >> 4;
    const int seg = stream & 3, h = (stream >> 2) & 15, b = stream >> 6;
    if (STATE_ONLY && seg == NSEG - 1) return;
    f2 lbv = (f2){0.f, 0.f};
    if (oi == 1) { const float2 l0 = *(const float2*)(lbl + h * 128 + 2 * lane), l1 = *(const float2*)(lbl + 2048 + h * 128 + 2 * lane);
        lbv = (f2){1.0f / (1.0f + __builtin_amdgcn_exp2f((l0.x - l1.x) * LOG2E)), 1.0f / (1.0f + __builtin_amdgcn_exp2f((l0.y - l1.y) * LOG2E))}; }
    const f2 oml = 1.0f - lbv;
    const size_t row0 = (size_t)b * T + (size_t)seg * SEGLEN;
    bf16* Yq = Y + row0 * PY + h * 128; const bf16* Yf = Yq + 2048; const bf16* Yv = Yq + 4096;
    f32x4 S[8];
#pragma unroll
    for (int i = 0; i < 8; ++i) S[i] = (f32x4){0.f, 0.f, 0.f, 0.f};
    if (!STATE_ONLY && seg > 0) {
        const int s0 = stream - seg;
        float sl[3][32]; f32x4 dd[3][8];
#pragma unroll
        for (int k = 0; k < 3; ++k) { const int sp = seg - 3 + k, spc = sp < 0 ? 0 : sp;
            const float* slp = SLOC + (size_t)(s0 + spc) * 16384 + w * 64 + lane; const float* dg = DSEG + (size_t)(s0 + spc) * 128;
#pragma unroll
            for (int i = 0; i < 8; ++i) { dd[k][i] = *(const f32x4*)(dg + 16 * i + 4 * q);
#pragma unroll
                for (int r = 0; r < 4; ++r) sl[k][i * 4 + r] = slp[(size_t)(i * 4 + r) * 512]; } }
#pragma unroll
        for (int k = 0; k < 3; ++k) { const bool valid = seg - 3 + k >= 0;
#pragma unroll
            for (int i = 0; i < 8; ++i)
#pragma unroll
                for (int r = 0; r < 4; ++r) S[i][r] = S[i][r] * dd[k][i][r] + (valid ? sl[k][i * 4 + r] : 0.f); }
    }
    if (!STATE_ONLY && tid < 128) ((float*)(lds + O_NW))[tid] = nw[tid];
    f2 bseg; { float one_ = 1.f; asm volatile("" : "+v"(one_)); bseg = (f2){one_, one_}; }
    unsigned qraw[8], fraw[8]; u32x4 vraw[2];
    unsigned fraw2[STATE_ONLY ? 8 : 1]; u32x4 vraw2[STATE_ONLY ? 2 : 1];
#define HG_LOADX(cc, FR, VR) do { const size_t r_ = (size_t)(cc) * 64; \
        _Pragma("unroll") for (int j = 0; j < 8; ++j) { FR[j] = *(const unsigned*)(Yf + (r_ + 8 * w + j) * PY + 2 * lane); if (!STATE_ONLY) qraw[j] = *(const unsigned*)(Yq + (r_ + 8 * w + j) * PY + 2 * lane); } \
        _Pragma("unroll") for (int i = 0; i < 2; ++i) VR[i] = *(const u32x4*)(Yv + (r_ + 2 * (tid >> 4) + i) * PY + (tid & 15) * 8); } while (0)
    const bf16* Gu = STATE_ONLY ? nullptr : (h < 8 ? GA : GB) + row0 * 1024 + (h & 7) * 128;
    auto chunk = [&](const int ch, unsigned (&fr)[8], u32x4 (&vr)[2], const int ld_ch) {
        u32x4 gt0, gt1;
        if (!STATE_ONLY) { const bf16* gp = Gu + (size_t)ch * 64 * 1024; const int go = (tid >> 3) * 1024 + (tid & 7) * 16; gt0 = *(const u32x4*)(gp + go); gt1 = *(const u32x4*)(gp + go + 8); }
        f2 fj[8], kin[8], qs[8];
        float* TOT = (float*)(lds + O_TOT);
        { f2 tot;
#pragma unroll
          for (int j = 0; j < 8; ++j) { const f2 e = ex2(min2(bf2(fr[j]) * (-LOG2E), 64.f)), sig = rcp2(1.0f + e);
              fj[j] = lbv + oml * sig; kin[j] = oml - oml * sig; tot = j == 0 ? fj[0] : tot * fj[j];
              if (!STATE_ONLY) { const f2 qq = bf2(qraw[j]); qs[j] = qq * rcp2(1.0f + ex2(min2(qq * (-LOG2E), 64.f))); } }
          *(f2*)(TOT + w * 128 + 2 * lane) = tot; }
        HG_BAR();
        { const int s2 = tid >> 4, v0 = (tid & 15) * 8;
          unsigned* vt = (unsigned*)((bf16*)(lds + O_VT) + v0 * LS + ((((s2 >> 2) ^ (tid & 7)) & 7) << 3) + 2 * (s2 & 3));
          vt[0 * (LS / 2)] = (vr[0].x & 0xffffu) | (vr[1].x << 16); vt[1 * (LS / 2)] = (vr[0].x >> 16) | (vr[1].x & 0xffff0000u);
          vt[2 * (LS / 2)] = (vr[0].y & 0xffffu) | (vr[1].y << 16); vt[3 * (LS / 2)] = (vr[0].y >> 16) | (vr[1].y & 0xffff0000u);
          vt[4 * (LS / 2)] = (vr[0].z & 0xffffu) | (vr[1].z << 16); vt[5 * (LS / 2)] = (vr[0].z >> 16) | (vr[1].z & 0xffff0000u);
          vt[6 * (LS / 2)] = (vr[0].w & 0xffffu) | (vr[1].w << 16); vt[7 * (LS / 2)] = (vr[0].w >> 16) | (vr[1].w & 0xffff0000u); }
        if (ld_ch < NCH) HG_LOADX(ld_ch, fr, vr);
        f2 lo4, hi4, part; { float one_ = 1.f; asm volatile("" : "+v"(one_)); part = (f2){one_, one_}; }
#pragma unroll
        for (int g8 = 0; g8 < 8; ++g8) { const f2 t_ = *(const f2*)(TOT + g8 * 128 + 2 * lane); if (g8 == 0) lo4 = t_; else if (g8 < 4) lo4 *= t_; else if (g8 == 4) hi4 = t_; else hi4 *= t_;
            const bool in_ = STATE_ONLY ? (g8 > w) : (w < 4 ? (g8 > w && g8 < 4) : (g8 >= 4 && g8 < w)); if (in_) part *= t_; }
        if (w == 0) {
            if (STATE_ONLY) { const f2 tt = lo4 * hi4; bseg *= tt; *(f2*)((float*)(lds + O_E1) + 2 * lane) = tt; }
            else { *(f2*)((float*)(lds + O_E1) + 2 * lane) = lo4; *(f2*)((float*)(lds + O_E2) + 2 * lane) = hi4; } }
        { f2 kt[8];
          const float TINY = 7.888609052210118e-31f;
          if (STATE_ONLY) {
              f2 s = part;
#pragma unroll
              for (int j = 7; j >= 0; --j) { kt[j] = kin[j] * s; s *= fj[j]; }
          } else {
              unsigned* QX = (unsigned*)((bf16*)(lds + O_QX) + (8 * w) * LQ + 2 * lane); unsigned* KX = (unsigned*)((bf16*)(lds + O_KX) + (8 * w) * LQ + 2 * lane);
              if (w < 4) { f2 s = part;
#pragma unroll
                  for (int j = 7; j >= 0; --j) { const f2 uc = max2(s, TINY), ed = rcp2(uc); kt[j] = kin[j] * uc; QX[j * (LQ / 2)] = pk2(qs[j] * ed); KX[j * (LQ / 2)] = pk2(kt[j]); s *= fj[j]; }
              } else { f2 p = part;
#pragma unroll
                  for (int j = 0; j < 8; ++j) { p *= fj[j]; const f2 wc = max2(p, TINY); kt[j] = kin[j] * rcp2(wc); QX[j * (LQ / 2)] = pk2(qs[j] * wc); KX[j * (LQ / 2)] = pk2(kt[j]); } }
          }
          u32x4* kd = (u32x4*)((bf16*)(lds + O_KT) + (2 * lane) * LS + 8 * w);
          kd[0] = (u32x4){cvtpk(kt[0].x, kt[1].x), cvtpk(kt[2].x, kt[3].x), cvtpk(kt[4].x, kt[5].x), cvtpk(kt[6].x, kt[7].x)};
          *(u32x4*)((bf16*)kd + LS) = (u32x4){cvtpk(kt[0].y, kt[1].y), cvtpk(kt[2].y, kt[3].y), cvtpk(kt[4].y, kt[5].y), cvtpk(kt[6].y, kt[7].y)}; }
        HG_BAR();
        f32x4 O[4];
        if (!STATE_ONLY) {
            for (int ti = w; ti < 12; ti += 8) {
                int I, J; if (ti < 1) { I = 0; J = 0; } else if (ti < 3) { I = 1; J = ti - 1; } else if (ti < 6) { I = 2; J = ti - 3; } else if (ti < 10) { I = 3; J = ti - 6; } else { I = (ti - 10) * 2; J = I + 1; }
                f32x4 acc = (f32x4){0.f, 0.f, 0.f, 0.f};
                if (ti < 10) {
                    const bf16* Kt = (const bf16*)(lds + O_KX) + (16 * J + c) * LQ + 8 * q; const bf16* Qt = (const bf16*)(lds + O_QX) + (16 * I + c) * LQ + 8 * q;
                    bf16x8 ka[4], qa[4];
#pragma unroll
                    for (int ks = 0; ks < 4; ++ks) { ka[ks] = *(const bf16x8*)(Kt + 32 * ks); qa[ks] = *(const bf16x8*)(Qt + 32 * ks); }
                    __builtin_amdgcn_sched_barrier(0);
#pragma unroll
                    for (int ks = 0; ks < 4; ++ks) acc = __builtin_amdgcn_mfma_f32_16x16x32_bf16(ka[ks], qa[ks], acc, 0, 0, 0);
                    if (I == J) {
#pragma unroll
                        for (int r = 0; r < 4; ++r) if (4 * q + r > c) acc[r] = 0.f; }
                }
                *(u32x2*)((bf16*)(lds + O_AM) + (16 * I + c) * LS + 16 * J + 4 * q) = (u32x2){cvtpk(acc[0], acc[1]), cvtpk(acc[2], acc[3])};
            }
            HG_BAR();
        }
        const bf16* VTw = (const bf16*)(lds + O_VT) + (16 * w + c) * LS; const int vsw = (2 * w + (c >> 3)) & 7;
        const float* E1 = (const float*)(lds + O_E1);
        if (!STATE_ONLY) {
            f32x4 e1[8]; u32x4 qa[4][4];
            const bf16x8 bv0 = *(const bf16x8*)(VTw + 8 * (q ^ vsw)), bv1 = *(const bf16x8*)(VTw + 8 * ((4 + q) ^ vsw));
#pragma unroll
            for (int kt_ = 0; kt_ < 8; ++kt_) e1[kt_] = *(const f32x4*)(E1 + 16 * kt_ + 4 * q);
#pragma unroll
            for (int ks = 0; ks < 4; ++ks)
#pragma unroll
                for (int mt = 0; mt < 4; ++mt) { const bf16* qh = (const bf16*)(lds + O_QX) + (16 * mt + c) * LQ + 32 * ks + 4 * q;
                    const u32x2 a0 = *(const u32x2*)qh, a1 = *(const u32x2*)(qh + 16); qa[ks][mt] = (u32x4){a0.x, a0.y, a1.x, a1.y}; }
            __builtin_amdgcn_sched_barrier(0);
#pragma unroll
            for (int kt_ = 0; kt_ < 8; ++kt_) S[kt_] = S[kt_] * e1[kt_];
#pragma unroll
            for (int mt = 0; mt < 4; ++mt) O[mt] = (f32x4){0.f, 0.f, 0.f, 0.f};
#pragma unroll
            for (int ks = 0; ks < 4; ++ks) {
                const u32x4 sb = (u32x4){cvtpk(S[2 * ks][0], S[2 * ks][1]), cvtpk(S[2 * ks][2], S[2 * ks][3]), cvtpk(S[2 * ks + 1][0], S[2 * ks + 1][1]), cvtpk(S[2 * ks + 1][2], S[2 * ks + 1][3])};
                const bf16x8 bS = __builtin_bit_cast(bf16x8, sb);
#pragma unroll
                for (int mt = 0; mt < 4; ++mt) O[mt] = __builtin_amdgcn_mfma_f32_16x16x32_bf16(__builtin_bit_cast(bf16x8, qa[ks][mt]), bS, O[mt], 0, 0, 0);
            }
            __builtin_amdgcn_sched_barrier(0);
            bf16x8 am[6], kh[8][2]; f32x4 e2[8];
#pragma unroll
            for (int mt = 0; mt < 4; ++mt) { const bf16* amp = (const bf16*)(lds + O_AM) + (16 * mt + c) * LS + 8 * q;
                am[mt] = *(const bf16x8*)amp; if (mt >= 2) am[2 + mt] = *(const bf16x8*)(amp + 32); }
#pragma unroll
            for (int kt_ = 0; kt_ < 4; ++kt_) { const bf16* khp = (const bf16*)(lds + O_KT) + (16 * kt_ + c) * LS + 8 * q; kh[kt_][0] = *(const bf16x8*)khp; kh[kt_][1] = *(const bf16x8*)(khp + 32); }
            __builtin_amdgcn_sched_barrier(0);
#pragma unroll
            for (int mt = 0; mt < 4; ++mt) { O[mt] = __builtin_amdgcn_mfma_f32_16x16x32_bf16(am[mt], bv0, O[mt], 0, 0, 0);
                if (mt >= 2) O[mt] = __builtin_amdgcn_mfma_f32_16x16x32_bf16(am[2 + mt], bv1, O[mt], 0, 0, 0); }
#pragma unroll
            for (int kt_ = 4; kt_ < 8; ++kt_) { const bf16* khp = (const bf16*)(lds + O_KT) + (16 * kt_ + c) * LS + 8 * q; kh[kt_][0] = *(const bf16x8*)khp; kh[kt_][1] = *(const bf16x8*)(khp + 32); }
            { const float* E2 = (const float*)(lds + O_E2);
#pragma unroll
              for (int kt_ = 0; kt_ < 8; ++kt_) e2[kt_] = *(const f32x4*)(E2 + 16 * kt_ + 4 * q); }
            __builtin_amdgcn_sched_barrier(0);
#pragma unroll
            for (int kt_ = 0; kt_ < 8; ++kt_) { S[kt_] = __builtin_amdgcn_mfma_f32_16x16x32_bf16(kh[kt_][0], bv0, S[kt_], 0, 0, 0);
                S[kt_] = __builtin_amdgcn_mfma_f32_16x16x32_bf16(kh[kt_][1], bv1, S[kt_], 0, 0, 0); }
#pragma unroll
            for (int kt_ = 0; kt_ < 8; ++kt_) S[kt_] = S[kt_] * e2[kt_];
        } else {
            const bf16x8 bv0 = *(const bf16x8*)(VTw + 8 * (q ^ vsw)), bv1 = *(const bf16x8*)(VTw + 8 * ((4 + q) ^ vsw));
#pragma unroll
            for (int kt_ = 0; kt_ < 8; ++kt_) S[kt_] = S[kt_] * *(const f32x4*)(E1 + 16 * kt_ + 4 * q);
#pragma unroll
            for (int kt_ = 0; kt_ < 8; ++kt_) { const bf16* khp = (const bf16*)(lds + O_KT) + (16 * kt_ + c) * LS + 8 * q;
                S[kt_] = __builtin_amdgcn_mfma_f32_16x16x32_bf16(*(const bf16x8*)khp, bv0, S[kt_], 0, 0, 0);
                S[kt_] = __builtin_amdgcn_mfma_f32_16x16x32_bf16(*(const bf16x8*)(khp + 32), bv1, S[kt_], 0, 0, 0); }
        }
        if (!STATE_ONLY) {
            float* OS = (float*)(lds + O_OSTF);
#pragma unroll
            for (int mt = 0; mt < 4; ++mt)
#pragma unroll
                for (int r = 0; r < 4; ++r) OS[(16 * mt + 4 * q + r) * LO + 16 * w + c] = O[mt][r];
            HG_BAR();
            const int t = tid >> 3, v0 = (tid & 7) * 16; const float* orow = OS + t * LO + v0;
            f32x4 x[4]; float ss = 0.f;
#pragma unroll
            for (int i = 0; i < 4; ++i) { x[i] = *(const f32x4*)(orow + 4 * i); ss += (x[i][0] * x[i][0] + x[i][1] * x[i][1]) + (x[i][2] * x[i][2] + x[i][3] * x[i][3]); }
            ss += __int_as_float(__builtin_amdgcn_update_dpp(0, __float_as_int(ss), 0xB1, 0xF, 0xF, false));
            ss += __int_as_float(__builtin_amdgcn_update_dpp(0, __float_as_int(ss), 0x4E, 0xF, 0xF, false));
            ss += __int_as_float(__builtin_amdgcn_ds_swizzle(__float_as_int(ss), 0x101F));
            const float rs = rsqrtf(ss * (1.0f / 128.0f) + 1e-5f);
            u32x4 o0, o1; const float* wv = (const float*)(lds + O_NW) + v0;
#define HG_G(w_, i_) ((i_) ? __uint_as_float((w_) & 0xffff0000u) : __uint_as_float((w_) << 16))
            o0.x = cvtpk(x[0][0] * rs * wv[0] * HG_G(gt0.x, 0), x[0][1] * rs * wv[1] * HG_G(gt0.x, 1)); o0.y = cvtpk(x[0][2] * rs * wv[2] * HG_G(gt0.y, 0), x[0][3] * rs * wv[3] * HG_G(gt0.y, 1));
            o0.z = cvtpk(x[1][0] * rs * wv[4] * HG_G(gt0.z, 0), x[1][1] * rs * wv[5] * HG_G(gt0.z, 1)); o0.w = cvtpk(x[1][2] * rs * wv[6] * HG_G(gt0.w, 0), x[1][3] * rs * wv[7] * HG_G(gt0.w, 1));
            o1.x = cvtpk(x[2][0] * rs * wv[8] * HG_G(gt1.x, 0), x[2][1] * rs * wv[9] * HG_G(gt1.x, 1)); o1.y = cvtpk(x[2][2] * rs * wv[10] * HG_G(gt1.y, 0), x[2][3] * rs * wv[11] * HG_G(gt1.y, 1));
            o1.z = cvtpk(x[3][0] * rs * wv[12] * HG_G(gt1.z, 0), x[3][1] * rs * wv[13] * HG_G(gt1.z, 1)); o1.w = cvtpk(x[3][2] * rs * wv[14] * HG_G(gt1.w, 0), x[3][3] * rs * wv[15] * HG_G(gt1.w, 1));
#undef HG_G
            bf16* dst = (Yo ? Yo : Yq) + ((size_t)ch * 64 + t) * po + v0;
            *(u32x4*)dst = o0; *(u32x4*)(dst + 8) = o1;
        }
    };
    if (STATE_ONLY) {
        HG_LOADX(0, fraw, vraw); HG_LOADX(1, fraw2, vraw2);
        for (int ch = 0; ch < NCH; ch += 2) { chunk(ch, fraw, vraw, ch + 2); chunk(ch + 1, (unsigned (&)[8])fraw2, (u32x4 (&)[2])vraw2, ch + 3); }
    } else {
        HG_LOADX(0, fraw, vraw);
        for (int ch = 0; ch < NCH; ++ch) chunk(ch, fraw, vraw, ch + 1);
    }
    if (STATE_ONLY) {
        float* sl = SLOC + (size_t)stream * 16384 + w * 64 + lane;
#pragma unroll
        for (int i = 0; i < 8; ++i)
#pragma unroll
            for (int r = 0; r < 4; ++r) sl[(size_t)(i * 4 + r) * 512] = S[i][r];
        if (w == 0) *(f2*)(DSEG + (size_t)stream * 128 + 2 * lane) = bseg;
    }
#undef HG_LOADX
}

__device__ __forceinline__ void hgrn_state128(char* lds, int tid, int stream, const bf16* Y, const float* lbl, int oi, float* SLOC, float* DSEG) {
    const int lane = tid & 63, w = __builtin_amdgcn_readfirstlane(tid >> 6), c = lane & 15, q = lane >> 4;
    const int seg = stream & 3, h = (stream >> 2) & 15, b = stream >> 6;
    if (seg == NSEG - 1) return;
    constexpr int CH = 128, NC = SEGLEN / CH, L2 = CH + 8, P_KT = 0, P_VT = P_KT + 128 * L2 * 2, P_TOT = P_VT + 128 * L2 * 2, P_E1 = P_TOT + 4096;
    f2 lbv = (f2){0.f, 0.f};
    if (oi == 1) { const float2 l0 = *(const float2*)(lbl + h * 128 + 2 * lane), l1 = *(const float2*)(lbl + 2048 + h * 128 + 2 * lane);
        lbv = (f2){1.0f / (1.0f + __builtin_amdgcn_exp2f((l0.x - l1.x) * LOG2E)), 1.0f / (1.0f + __builtin_amdgcn_exp2f((l0.y - l1.y) * LOG2E))}; }
    const f2 oml = 1.0f - lbv;
    const size_t row0 = (size_t)b * T + (size_t)seg * SEGLEN;
    const bf16* Yf = Y + row0 * PY + h * 128 + 2048; const bf16* Yv = Yf + 2048;
    f32x4 S[8];
#pragma unroll
    for (int i = 0; i < 8; ++i) S[i] = (f32x4){0.f, 0.f, 0.f, 0.f};
    f2 bseg; { float one_ = 1.f; asm volatile("" : "+v"(one_)); bseg = (f2){one_, one_}; }
    unsigned fr[16]; u32x4 vr[4];
#define HA_LOAD(cc) do { const size_t r_ = (size_t)(cc) * CH; \
        _Pragma("unroll") for (int j = 0; j < 16; ++j) fr[j] = *(const unsigned*)(Yf + (r_ + 16 * w + j) * PY + 2 * lane); \
        _Pragma("unroll") for (int i = 0; i < 4; ++i) vr[i] = *(const u32x4*)(Yv + (r_ + 4 * (tid >> 4) + i) * PY + (tid & 15) * 8); } while (0)
    HA_LOAD(0);
    float* TOT = (float*)(lds + P_TOT); float* E1 = (float*)(lds + P_E1);
    for (int ch = 0; ch < NC; ++ch) {
        f2 fj[16], kin[16];
        { f2 tot;
#pragma unroll
          for (int j = 0; j < 16; ++j) { const f2 e = ex2(bf2(fr[j]) * (-LOG2E)), sig = rcp2(1.0f + e);
              fj[j] = lbv + oml * sig; kin[j] = oml - oml * sig; tot = j == 0 ? fj[0] : tot * fj[j]; }
          *(f2*)(TOT + w * 128 + 2 * lane) = tot; }
        __syncthreads();
        { const int s4 = tid >> 4, v0 = (tid & 15) * 8;
          bf16* vt = (bf16*)(lds + P_VT) + v0 * L2 + ((((s4 >> 1) ^ (tid & 7)) & 15) << 3) + 4 * (s4 & 1);
#define HA_VW(i_, comp, hi_) *(u32x2*)(vt + (i_) * L2) = (hi_) ? (u32x2){(vr[0].comp >> 16) | (vr[1].comp & 0xffff0000u), (vr[2].comp >> 16) | (vr[3].comp & 0xffff0000u)} \
                                                              : (u32x2){(vr[0].comp & 0xffffu) | (vr[1].comp << 16), (vr[2].comp & 0xffffu) | (vr[3].comp << 16)}
          HA_VW(0, x, 0); HA_VW(1, x, 1); HA_VW(2, y, 0); HA_VW(3, y, 1); HA_VW(4, z, 0); HA_VW(5, z, 1); HA_VW(6, w, 0); HA_VW(7, w, 1);
#undef HA_VW
        }
        if (ch + 1 < NC) HA_LOAD(ch + 1);
        f2 tt, part; { float one_ = 1.f; asm volatile("" : "+v"(one_)); part = (f2){one_, one_}; }
#pragma unroll
        for (int g8 = 0; g8 < 8; ++g8) { const f2 t_ = *(const f2*)(TOT + g8 * 128 + 2 * lane); tt = g8 == 0 ? t_ : tt * t_; if (g8 > w) part *= t_; }
        if (w == 0) { bseg *= tt; *(f2*)(E1 + 2 * lane) = tt; }
        { f2 kt[16]; f2 s = part;
#pragma unroll
          for (int j = 15; j >= 0; --j) { kt[j] = kin[j] * s; s *= fj[j]; }
          u32x4* kd = (u32x4*)((bf16*)(lds + P_KT) + (2 * lane) * L2 + 16 * w);
          kd[0] = (u32x4){cvtpk(kt[0].x, kt[1].x), cvtpk(kt[2].x, kt[3].x), cvtpk(kt[4].x, kt[5].x), cvtpk(kt[6].x, kt[7].x)};
          kd[1] = (u32x4){cvtpk(kt[8].x, kt[9].x), cvtpk(kt[10].x, kt[11].x), cvtpk(kt[12].x, kt[13].x), cvtpk(kt[14].x, kt[15].x)};
          u32x4* kd1 = (u32x4*)((bf16*)kd + L2);
          kd1[0] = (u32x4){cvtpk(kt[0].y, kt[1].y), cvtpk(kt[2].y, kt[3].y), cvtpk(kt[4].y, kt[5].y), cvtpk(kt[6].y, kt[7].y)};
          kd1[1] = (u32x4){cvtpk(kt[8].y, kt[9].y), cvtpk(kt[10].y, kt[11].y), cvtpk(kt[12].y, kt[13].y), cvtpk(kt[14].y, kt[15].y)}; }
        __syncthreads();
        { const int kh = w >> 2, vq = w & 3;
          bf16x8 bv[2][4];
#pragma unroll
          for (int nt = 0; nt < 2; ++nt) { const bf16* VTw = (const bf16*)(lds + P_VT) + (32 * vq + 16 * nt + c) * L2; const int vsw = (4 * vq + 2 * nt + (c >> 3)) & 7;
#pragma unroll
              for (int ks = 0; ks < 4; ++ks) bv[nt][ks] = *(const bf16x8*)(VTw + 8 * ((4 * ks + q) ^ vsw)); }
#pragma unroll
          for (int kt = 0; kt < 4; ++kt) { const f32x4 e = *(const f32x4*)(E1 + 64 * kh + 16 * kt + 4 * q); S[kt * 2] = S[kt * 2] * e; S[kt * 2 + 1] = S[kt * 2 + 1] * e; }
#pragma unroll
          for (int g2 = 0; g2 < 2; ++g2) {
              bf16x8 kf[2][4];
#pragma unroll
              for (int kk = 0; kk < 2; ++kk) { const bf16* khp = (const bf16*)(lds + P_KT) + (16 * (4 * kh + 2 * g2 + kk) + c) * L2 + 8 * q;
#pragma unroll
                  for (int ks = 0; ks < 4; ++ks) kf[kk][ks] = *(const bf16x8*)(khp + 32 * ks); }
              __builtin_amdgcn_sched_barrier(0);
#pragma unroll
              for (int kk = 0; kk < 2; ++kk)
#pragma unroll
                  for (int nt = 0; nt < 2; ++nt)
#pragma unroll
                      for (int ks = 0; ks < 4; ++ks) S[(2 * g2 + kk) * 2 + nt] = __builtin_amdgcn_mfma_f32_16x16x32_bf16(kf[kk][ks], bv[nt][ks], S[(2 * g2 + kk) * 2 + nt], 0, 0, 0);
              __builtin_amdgcn_sched_barrier(0);
          }
        }
    }
#undef HA_LOAD
    { const int kh = w >> 2, vq = w & 3;
      float* sl = SLOC + (size_t)stream * 16384 + lane;
#pragma unroll
      for (int kt = 0; kt < 4; ++kt)
#pragma unroll
          for (int nt = 0; nt < 2; ++nt)
#pragma unroll
              for (int r = 0; r < 4; ++r) sl[(size_t)((4 * kh + kt) * 4 + r) * 512 + (2 * vq + nt) * 64] = S[kt * 2 + nt][r]; }
    if (w == 0) *(f2*)(DSEG + (size_t)stream * 128 + 2 * lane) = bseg;
}

__device__ __forceinline__ void hgrn_passB(char* lds, int tid, int stream, bf16* Y, const float* lbl, int oi, const float* nw, const float* SLOC, const float* DSEG, const bf16* GA, const bf16* GB) {
    const int lane = tid & 63, w = __builtin_amdgcn_readfirstlane(tid >> 6), c = lane & 15, q = lane >> 4, kh = w >> 2, vq = w & 3;
    const int seg = stream & 3, h = (stream >> 2) & 15, b = stream >> 6;
    f2 lbv = (f2){0.f, 0.f};
    if (oi == 1) { const float2 l0 = *(const float2*)(lbl + h * 128 + 2 * lane), l1 = *(const float2*)(lbl + 2048 + h * 128 + 2 * lane);
        lbv = (f2){1.0f / (1.0f + __builtin_amdgcn_exp2f((l0.x - l1.x) * LOG2E)), 1.0f / (1.0f + __builtin_amdgcn_exp2f((l0.y - l1.y) * LOG2E))}; }
    const f2 oml = 1.0f - lbv;
    const size_t row0 = (size_t)b * T + (size_t)seg * SEGLEN;
    bf16* Yq = Y + row0 * PY + h * 128; const bf16* Yf = Yq + 2048; const bf16* Yv = Yq + 4096;
    f32x4 S[8];
#pragma unroll
    for (int i = 0; i < 8; ++i) S[i] = (f32x4){0.f, 0.f, 0.f, 0.f};
    if (seg > 0) {
        const int s0 = stream - seg;
        float sl[3][32]; f32x4 dd[3][4];
#pragma unroll
        for (int k = 0; k < 3; ++k) { const int sp = seg - 3 + k, spc = sp < 0 ? 0 : sp;
            const float* slp = SLOC + (size_t)(s0 + spc) * 16384 + lane; const float* dg = DSEG + (size_t)(s0 + spc) * 128 + 64 * kh;
#pragma unroll
            for (int kt = 0; kt < 4; ++kt) { dd[k][kt] = *(const f32x4*)(dg + 16 * kt + 4 * q);
#pragma unroll
                for (int nt = 0; nt < 2; ++nt)
#pragma unroll
                    for (int r = 0; r < 4; ++r) sl[k][(kt * 2 + nt) * 4 + r] = slp[(size_t)((4 * kh + kt) * 4 + r) * 512 + (2 * vq + nt) * 64]; } }
#pragma unroll
        for (int k = 0; k < 3; ++k) { const bool valid = seg - 3 + k >= 0;
#pragma unroll
            for (int kt = 0; kt < 4; ++kt)
#pragma unroll
                for (int nt = 0; nt < 2; ++nt)
#pragma unroll
                    for (int r = 0; r < 4; ++r) S[kt * 2 + nt][r] = S[kt * 2 + nt][r] * dd[k][kt][r] + (valid ? sl[k][(kt * 2 + nt) * 4 + r] : 0.f); }
    }
    __builtin_amdgcn_sched_barrier(0);
    if (tid < 128) ((float*)(lds + O_NW))[tid] = nw[tid];
    unsigned qraw[8], fr[8]; u32x4 vr[2];
    const unsigned lo_f = (unsigned)lane * 4u, lo_v = (unsigned)((2 * (tid >> 4)) * PY + (tid & 15) * 8) * 2u, lo_o = (unsigned)((tid >> 3) * PY + (tid & 7) * 16) * 2u, lo_g = (unsigned)((tid >> 3) * 1024 + (tid & 7) * 16) * 2u;
#define HB_LOAD(cc) do { const size_t r_ = (size_t)(cc) * 64; \
        _Pragma("unroll") for (int j = 0; j < 8; ++j) { fr[j] = *(const unsigned*)((const char*)(Yf + (r_ + 8 * w + j) * PY) + lo_f); qraw[j] = *(const unsigned*)((const char*)(Yq + (r_ + 8 * w + j) * PY) + lo_f); } \
        _Pragma("unroll") for (int i = 0; i < 2; ++i) vr[i] = *(const u32x4*)((const char*)(Yv + (r_ + i) * PY) + lo_v); } while (0)
    const bf16* Gu = (h < 8 ? GA : GB) + row0 * 1024 + (h & 7) * 128;
    float* TOT = (float*)(lds + O_TOT);
    f2 fj[8], kin[8], qs[8];
#define HB_P2() do { f2 tot; \
        _Pragma("unroll") for (int j = 0; j < 8; ++j) { const f2 e = ex2(bf2(fr[j]) * (-LOG2E)), sig = rcp2(1.0f + e); \
            fj[j] = lbv + oml * sig; kin[j] = oml - oml * sig; tot = j == 0 ? fj[0] : tot * fj[j]; \
            const f2 qq = bf2(qraw[j]); qs[j] = qq * rcp2(1.0f + ex2(qq * (-LOG2E))); } \
        *(f2*)(TOT + w * 128 + 2 * lane) = tot; } while (0)
#define HB_PREP(ld_ch) do { \
        { const int s2 = tid >> 4, v0 = (tid & 15) * 8; \
          unsigned* vt = (unsigned*)((bf16*)(lds + O_VT) + v0 * LS + ((((s2 >> 2) ^ (tid & 7)) & 7) << 3) + 2 * (s2 & 3)); \
          vt[0 * (LS / 2)] = (vr[0].x & 0xffffu) | (vr[1].x << 16); vt[1 * (LS / 2)] = (vr[0].x >> 16) | (vr[1].x & 0xffff0000u); \
          vt[2 * (LS / 2)] = (vr[0].y & 0xffffu) | (vr[1].y << 16); vt[3 * (LS / 2)] = (vr[0].y >> 16) | (vr[1].y & 0xffff0000u); \
          vt[4 * (LS / 2)] = (vr[0].z & 0xffffu) | (vr[1].z << 16); vt[5 * (LS / 2)] = (vr[0].z >> 16) | (vr[1].z & 0xffff0000u); \
          vt[6 * (LS / 2)] = (vr[0].w & 0xffffu) | (vr[1].w << 16); vt[7 * (LS / 2)] = (vr[0].w >> 16) | (vr[1].w & 0xffff0000u); } \
        if ((ld_ch) < NCH) HB_LOAD(ld_ch); \
        f2 lo4, hi4, part; { float one_ = 1.f; asm volatile("" : "+v"(one_)); part = (f2){one_, one_}; } \
        _Pragma("unroll") for (int g8 = 0; g8 < 8; ++g8) { const f2 t_ = *(const f2*)(TOT + g8 * 128 + 2 * lane); if (g8 == 0) lo4 = t_; else if (g8 < 4) lo4 *= t_; else if (g8 == 4) hi4 = t_; else hi4 *= t_; \
            const bool in_ = w < 4 ? (g8 > w && g8 < 4) : (g8 >= 4 && g8 < w); if (in_) part *= t_; } \
        if (w == 0) { *(f2*)((float*)(lds + O_E1) + 2 * lane) = lo4; *(f2*)((float*)(lds + O_E2) + 2 * lane) = hi4; } \
        { f2 kt[8]; const float TINY = 7.888609052210118e-31f; \
          unsigned* QX = (unsigned*)((bf16*)(lds + O_QX) + (8 * w) * LQ + 2 * lane); unsigned* KX = (unsigned*)((bf16*)(lds + O_KX) + (8 * w) * LQ + 2 * lane); \
          if (w < 4) { f2 s = part; \
              _Pragma("unroll") for (int j = 7; j >= 0; --j) { const f2 uc = max2(s, TINY), ed = rcp2(uc); kt[j] = kin[j] * uc; QX[j * (LQ / 2)] = pk2(qs[j] * ed); KX[j * (LQ / 2)] = pk2(kt[j]); s *= fj[j]; } \
          } else { f2 p = part; \
              _Pragma("unroll") for (int j = 0; j < 8; ++j) { p *= fj[j]; const f2 wc = max2(p, TINY); kt[j] = kin[j] * rcp2(wc); QX[j * (LQ / 2)] = pk2(qs[j] * wc); KX[j * (LQ / 2)] = pk2(kt[j]); } } \
          u32x4* kd = (u32x4*)((bf16*)(lds + O_KT) + (2 * lane) * LS + 8 * w); \
          kd[0] = (u32x4){cvtpk(kt[0].x, kt[1].x), cvtpk(kt[2].x, kt[3].x), cvtpk(kt[4].x, kt[5].x), cvtpk(kt[6].x, kt[7].x)}; \
          *(u32x4*)((bf16*)kd + LS) = (u32x4){cvtpk(kt[0].y, kt[1].y), cvtpk(kt[2].y, kt[3].y), cvtpk(kt[4].y, kt[5].y), cvtpk(kt[6].y, kt[7].y)}; } } while (0)
#define HB_P6() do { \
        for (int ti = w; ti < 12; ti += 8) { \
            int I, J; if (ti < 1) { I = 0; J = 0; } else if (ti < 3) { I = 1; J = ti - 1; } else if (ti < 6) { I = 2; J = ti - 3; } else if (ti < 10) { I = 3; J = ti - 6; } else { I = (ti - 10) * 2; J = I + 1; } \
            f32x4 acc = (f32x4){0.f, 0.f, 0.f, 0.f}; \
            if (ti < 10) { \
                const bf16* Kt = (const bf16*)(lds + O_KX) + (16 * J + c) * LQ + 8 * q; const bf16* Qt = (const bf16*)(lds + O_QX) + (16 * I + c) * LQ + 8 * q; \
                bf16x8 ka[4], qa[4]; \
                _Pragma("unroll") for (int ks = 0; ks < 4; ++ks) { ka[ks] = *(const bf16x8*)(Kt + 32 * ks); qa[ks] = *(const bf16x8*)(Qt + 32 * ks); } \
                __builtin_amdgcn_sched_barrier(0); \
                _Pragma("unroll") for (int ks = 0; ks < 4; ++ks) acc = __builtin_amdgcn_mfma_f32_16x16x32_bf16(ka[ks], qa[ks], acc, 0, 0, 0); \
                if (I == J) { _Pragma("unroll") for (int r = 0; r < 4; ++r) if (4 * q + r > c) acc[r] = 0.f; } \
            } \
            *(u32x2*)((bf16*)(lds + O_AM) + (16 * I + c) * LS + 16 * J + 4 * q) = (u32x2){cvtpk(acc[0], acc[1]), cvtpk(acc[2], acc[3])}; \
        } } while (0)
    HB_LOAD(0);
    HB_P2();
    __syncthreads();
    HB_PREP(1);
    __syncthreads();
    HB_P6();
    __syncthreads();
    for (int ch = 0; ch < NCH; ++ch) {
        u32x4 gt0, gt1;
        { const char* gp = (const char*)(Gu + (size_t)ch * 64 * 1024); gt0 = *(const u32x4*)(gp + lo_g); gt1 = *(const u32x4*)(gp + lo_g + 16); }
        f32x4 O[8];
        { const float* E1 = (const float*)(lds + O_E1) + 64 * kh;
          bf16x8 bv[2][2];
#pragma unroll
          for (int nt = 0; nt < 2; ++nt) { const bf16* VTw = (const bf16*)(lds + O_VT) + (32 * vq + 16 * nt + c) * LS; const int vsw = (4 * vq + 2 * nt + (c >> 3)) & 7;
              bv[nt][0] = *(const bf16x8*)(VTw + 8 * (q ^ vsw)); bv[nt][1] = *(const bf16x8*)(VTw + 8 * ((4 + q) ^ vsw)); }
#pragma unroll
          for (int kt = 0; kt < 4; ++kt) { const f32x4 e = *(const f32x4*)(E1 + 16 * kt + 4 * q); S[kt * 2] = S[kt * 2] * e; S[kt * 2 + 1] = S[kt * 2 + 1] * e; }
#pragma unroll
          for (int i = 0; i < 8; ++i) O[i] = (f32x4){0.f, 0.f, 0.f, 0.f};
#pragma unroll
          for (int ks = 0; ks < 2; ++ks) {
              u32x4 qa[4];
#pragma unroll
              for (int mt = 0; mt < 4; ++mt) { const bf16* qh = (const bf16*)(lds + O_QX) + (16 * mt + c) * LQ + 64 * kh + 32 * ks + 4 * q;
                  const u32x2 a0 = *(const u32x2*)qh, a1 = *(const u32x2*)(qh + 16); qa[mt] = (u32x4){a0.x, a0.y, a1.x, a1.y}; }
              __builtin_amdgcn_sched_barrier(0);
#pragma unroll
              for (int nt = 0; nt < 2; ++nt) { const f32x4 s0_ = S[(2 * ks) * 2 + nt], s1_ = S[(2 * ks + 1) * 2 + nt];
                  const u32x4 sb = (u32x4){cvtpk(s0_[0], s0_[1]), cvtpk(s0_[2], s0_[3]), cvtpk(s1_[0], s1_[1]), cvtpk(s1_[2], s1_[3])};
                  const bf16x8 bS = __builtin_bit_cast(bf16x8, sb);
#pragma unroll
                  for (int mt = 0; mt < 4; ++mt) O[mt * 2 + nt] = __builtin_amdgcn_mfma_f32_16x16x32_bf16(__builtin_bit_cast(bf16x8, qa[mt]), bS, O[mt * 2 + nt], 0, 0, 0); }
              __builtin_amdgcn_sched_barrier(0); }
          { bf16x8 am[4];
#pragma unroll
            for (int mt = 0; mt < 4; ++mt) if (mt >= 2 * kh) am[mt] = *(const bf16x8*)((const bf16*)(lds + O_AM) + (16 * mt + c) * LS + 8 * q + 32 * kh);
            __builtin_amdgcn_sched_barrier(0);
#pragma unroll
            for (int mt = 0; mt < 4; ++mt) if (mt >= 2 * kh) {
#pragma unroll
                for (int nt = 0; nt < 2; ++nt) O[mt * 2 + nt] = __builtin_amdgcn_mfma_f32_16x16x32_bf16(am[mt], kh ? bv[nt][1] : bv[nt][0], O[mt * 2 + nt], 0, 0, 0); }
            __builtin_amdgcn_sched_barrier(0); }
#pragma unroll
          for (int g2 = 0; g2 < 2; ++g2) {
              bf16x8 kf[2][2];
#pragma unroll
              for (int kk = 0; kk < 2; ++kk) { const bf16* khp = (const bf16*)(lds + O_KT) + (16 * (4 * kh + 2 * g2 + kk) + c) * LS + 8 * q; kf[kk][0] = *(const bf16x8*)khp; kf[kk][1] = *(const bf16x8*)(khp + 32); }
              __builtin_amdgcn_sched_barrier(0);
#pragma unroll
              for (int kk = 0; kk < 2; ++kk)
#pragma unroll
                  for (int nt = 0; nt < 2; ++nt) { const int si = (2 * g2 + kk) * 2 + nt;
                      S[si] = __builtin_amdgcn_mfma_f32_16x16x32_bf16(kf[kk][0], bv[nt][0], S[si], 0, 0, 0);
                      S[si] = __builtin_amdgcn_mfma_f32_16x16x32_bf16(kf[kk][1], bv[nt][1], S[si], 0, 0, 0); }
              __builtin_amdgcn_sched_barrier(0);
          }
          { const float* E2 = (const float*)(lds + O_E2) + 64 * kh;
#pragma unroll
            for (int kt = 0; kt < 4; ++kt) { const f32x4 e = *(const f32x4*)(E2 + 16 * kt + 4 * q); S[kt * 2] = S[kt * 2] * e; S[kt * 2 + 1] = S[kt * 2 + 1] * e; } }
        }
        { float* OS = (float*)(lds + (kh ? O_OSTF1 : O_OSTF));
#pragma unroll
          for (int mt = 0; mt < 4; ++mt)
#pragma unroll
              for (int nt = 0; nt < 2; ++nt)
#pragma unroll
                  for (int r = 0; r < 4; ++r) OS[(16 * mt + 4 * q + r) * LO + 32 * vq + 16 * nt + c] = O[mt * 2 + nt][r]; }
        if (ch + 1 < NCH) HB_P2();
        __syncthreads();
        { const float* OS = (const float*)(lds + O_OSTF);
          const int t = tid >> 3, v0 = (tid & 7) * 16; const float* orow = OS + t * LO + v0;
          f32x4 x[4]; float ss = 0.f;
#pragma unroll
          for (int i = 0; i < 4; ++i) { x[i] = *(const f32x4*)(orow + 4 * i) + *(const f32x4*)(orow + (O_OSTF1 - O_OSTF) / 4 + 4 * i); ss += (x[i][0] * x[i][0] + x[i][1] * x[i][1]) + (x[i][2] * x[i][2] + x[i][3] * x[i][3]); }
          ss += __int_as_float(__builtin_amdgcn_update_dpp(0, __float_as_int(ss), 0xB1, 0xF, 0xF, false));
          ss += __int_as_float(__builtin_amdgcn_update_dpp(0, __float_as_int(ss), 0x4E, 0xF, 0xF, false));
          ss += __int_as_float(__builtin_amdgcn_ds_swizzle(__float_as_int(ss), 0x101F));
          const float rs = rsqrtf(ss * (1.0f / 128.0f) + 1e-5f);
          u32x4 o0, o1; const float* wv = (const float*)(lds + O_NW) + v0;
#define HG_G(w_, i_) ((i_) ? __uint_as_float((w_) & 0xffff0000u) : __uint_as_float((w_) << 16))
          o0.x = cvtpk(x[0][0] * rs * wv[0] * HG_G(gt0.x, 0), x[0][1] * rs * wv[1] * HG_G(gt0.x, 1)); o0.y = cvtpk(x[0][2] * rs * wv[2] * HG_G(gt0.y, 0), x[0][3] * rs * wv[3] * HG_G(gt0.y, 1));
          o0.z = cvtpk(x[1][0] * rs * wv[4] * HG_G(gt0.z, 0), x[1][1] * rs * wv[5] * HG_G(gt0.z, 1)); o0.w = cvtpk(x[1][2] * rs * wv[6] * HG_G(gt0.w, 0), x[1][3] * rs * wv[7] * HG_G(gt0.w, 1));
          o1.x = cvtpk(x[2][0] * rs * wv[8] * HG_G(gt1.x, 0), x[2][1] * rs * wv[9] * HG_G(gt1.x, 1)); o1.y = cvtpk(x[2][2] * rs * wv[10] * HG_G(gt1.y, 0), x[2][3] * rs * wv[11] * HG_G(gt1.y, 1));
          o1.z = cvtpk(x[3][0] * rs * wv[12] * HG_G(gt1.z, 0), x[3][1] * rs * wv[13] * HG_G(gt1.z, 1)); o1.w = cvtpk(x[3][2] * rs * wv[14] * HG_G(gt1.w, 0), x[3][3] * rs * wv[15] * HG_G(gt1.w, 1));
#undef HG_G
          char* dst = (char*)(Yq + (size_t)ch * 64 * PY) + lo_o;
          *(u32x4*)dst = o0; *(u32x4*)(dst + 16) = o1; }
        if (ch + 1 < NCH) HB_PREP(ch + 2);
        __syncthreads();
        if (ch + 1 < NCH) HB_P6();
        __syncthreads();
    }
#undef HB_LOAD
#undef HB_P2
#undef HB_PREP
#undef HB_P6
}
#undef HG_BAR
}
namespace sd {
typedef unsigned short bf16;
typedef short bf16x8 __attribute__((ext_vector_type(8)));
typedef float f32x4 __attribute__((ext_vector_type(4)));
typedef unsigned u32x4 __attribute__((ext_vector_type(4)));
typedef unsigned u32x2 __attribute__((ext_vector_type(2)));
constexpr int T = 4096, M = 4 * T, PY1 = 2816, PAO = 2048, LB = 136, LT = 72;
constexpr int O_BM = 0, O_CM = O_BM + 64 * LB * 2, O_BT = O_CM + 64 * LB * 2, O_XT = O_BT + 128 * LT * 2, O_DT = O_XT + 8 * 64 * LT * 2, O_AC = O_DT + 2048, LDS_BYTES = O_AC + 2048;
__device__ __forceinline__ float bf2f(unsigned v) { return __uint_as_float(v << 16); }
__device__ __forceinline__ float bflo(unsigned w) { return __uint_as_float(w << 16); }
__device__ __forceinline__ float bfhi(unsigned w) { return __uint_as_float(w & 0xffff0000u); }
typedef float f32x2_t __attribute__((ext_vector_type(2))); typedef __bf16 bf16x2_t __attribute__((ext_vector_type(2)));
__device__ __forceinline__ unsigned cvtpk(float lo, float hi) { f32x2_t v = {lo, hi}; bf16x2_t b = __builtin_convertvector(v, bf16x2_t); return __builtin_bit_cast(unsigned, b); }
__device__ __forceinline__ float fexp(float x) { return __builtin_amdgcn_exp2f(x * 1.4426950408889634f); }
__device__ __forceinline__ float silu(float x) { return x * __builtin_amdgcn_rcpf(1.0f + fexp(-x)); }
__device__ __forceinline__ float lget(float v, int src) { return __int_as_float(__builtin_amdgcn_ds_bpermute(src << 2, __float_as_int(v))); }

template <bool STATE_ONLY>
__device__ __forceinline__ void ssd_stage(char* lds, int tid, int g, size_t m0, int tg0, const bf16* Y1, const float* cw, const float* cb) {
    u32x2 rawA[11], rawB[11];
#define SD_SRC(cq_) ((cq_) < 128 ? g * 512 + (cq_) * 4 : (cq_) < 160 ? 1024 + g * 128 + ((cq_) - 128) * 4 : 1280 + g * 128 + ((cq_) - 160) * 4)
#define SD_LOAD(RAW, t_) do { const int cq_ = (t_) % 192, l0_ = ((t_) / 192) * 8; const bf16* yp_ = Y1 + (m0 + l0_) * PY1 + 1024 + SD_SRC(cq_); \
        _Pragma("unroll") for (int r = 0; r < 11; ++r) { RAW[r] = (u32x2){0u, 0u}; if (!(STATE_ONLY && cq_ >= 160) && tg0 + l0_ + r - 3 >= 0) RAW[r] = *(const u32x2*)(yp_ + (ptrdiff_t)(r - 3) * PY1); } } while (0)
#define SD_TASK(RAW, t_) do { const int tk_ = (t_); const int cq = tk_ % 192, l0 = (tk_ / 192) * 8; \
        if (!(STATE_ONLY && cq >= 160)) {                                           \
        const int src = SD_SRC(cq); \
        const f32x4 w0 = *(const f32x4*)(cw + src), w1 = *(const f32x4*)(cw + 1536 + src), w2 = *(const f32x4*)(cw + 3072 + src), w3 = *(const f32x4*)(cw + 4608 + src), bb = *(const f32x4*)(cb + src); \
          \
        bf16* tdst = cq < 128 ? (bf16*)(lds + O_XT) + ((cq >> 4) * 64 + (cq & 15) * 4) * LT + l0 : (bf16*)(lds + O_BT) + ((cq - 128) & 31) * 4 * LT + l0; \
        bf16* rdst = (cq < 160 ? (bf16*)(lds + O_BM) + (cq - 128) * 4 : (bf16*)(lds + O_CM) + (cq - 160) * 4) + l0 * LB; \
        unsigned tp[4][4];                                                           \
        _Pragma("unroll") for (int r = 0; r < 8; r += 2) { \
            const f32x4 x0 = (f32x4){bflo(RAW[r].x), bfhi(RAW[r].x), bflo(RAW[r].y), bfhi(RAW[r].y)}, x1 = (f32x4){bflo(RAW[r + 1].x), bfhi(RAW[r + 1].x), bflo(RAW[r + 1].y), bfhi(RAW[r + 1].y)}, \
                        x2 = (f32x4){bflo(RAW[r + 2].x), bfhi(RAW[r + 2].x), bflo(RAW[r + 2].y), bfhi(RAW[r + 2].y)}, x3 = (f32x4){bflo(RAW[r + 3].x), bfhi(RAW[r + 3].x), bflo(RAW[r + 3].y), bfhi(RAW[r + 3].y)}, \
                        x4 = (f32x4){bflo(RAW[r + 4].x), bfhi(RAW[r + 4].x), bflo(RAW[r + 4].y), bfhi(RAW[r + 4].y)}; \
            const f32x4 a = bb + w0 * x0 + w1 * x1 + w2 * x2 + w3 * x3, b_ = bb + w0 * x1 + w1 * x2 + w2 * x3 + w3 * x4; \
            const f32x4 oa = (f32x4){silu(a[0]), silu(a[1]), silu(a[2]), silu(a[3])}, ob = (f32x4){silu(b_[0]), silu(b_[1]), silu(b_[2]), silu(b_[3])}; \
            _Pragma("unroll") for (int i = 0; i < 4; ++i) tp[i][r >> 1] = cvtpk(oa[i], ob[i]); \
            if (cq >= 128 && (!STATE_ONLY || cq >= 160)) { *(u32x2*)(rdst + r * LB) = (u32x2){cvtpk(oa[0], oa[1]), cvtpk(oa[2], oa[3])}; *(u32x2*)(rdst + (r + 1) * LB) = (u32x2){cvtpk(ob[0], ob[1]), cvtpk(ob[2], ob[3])}; } \
        } \
        if (cq < 160) { _Pragma("unroll") for (int i = 0; i < 4; ++i) *(u32x4*)(tdst + i * LT) = (u32x4){tp[i][0], tp[i][1], tp[i][2], tp[i][3]}; } \
        } } while (0)
    if (STATE_ONLY) {
#pragma unroll 1
        for (int t = tid; t < 192 * 8; t += 512) { SD_LOAD(rawA, t); SD_TASK(rawA, t); }
    } else {
        SD_LOAD(rawA, tid); SD_LOAD(rawB, tid + 512);
        SD_TASK(rawA, tid);
        SD_LOAD(rawA, tid + 1024);
        SD_TASK(rawB, tid + 512);
        SD_TASK(rawA, tid + 1024);
    }
#undef SD_SRC
#undef SD_LOAD
#undef SD_TASK
}

template <bool STATE_ONLY>
__device__ __forceinline__ void ssd_unit(char* lds, int tid, int u, const bf16* Y1, const float* FDt, const float* cw, const float* cb, const float* dt_bias, const float* A_log, const float* Dsk,
                                         const float* nw, u32x4* STL, float* DEC, bf16* AO) {
    const int lane = tid & 63, w = __builtin_amdgcn_readfirstlane(tid >> 6), c = lane & 15, q = lane >> 4;
    const int g = u & 1, cidx = (u >> 1) & 31, b = u >> 6, h = 8 * g + w;
    const size_t mc = (size_t)b * T + (size_t)cidx * 128;
    const float Ah = -fexp(A_log[h]), dtb = dt_bias[h], Dh = Dsk[h];
    f32x4 st[STATE_ONLY ? 32 : 1];
    u32x4 bS[STATE_ONLY ? 1 : 16];
    if (STATE_ONLY) {
#pragma unroll
        for (int i = 0; i < 32; ++i) st[i] = (f32x4){0.f, 0.f, 0.f, 0.f};
    } else {
        const u32x4* sl = STL + (size_t)u * 8192 + w * 64 + lane;
#pragma unroll
        for (int i = 0; i < 16; ++i) bS[i] = sl[(size_t)i * 512];
    }
    float fdv = FDt[(size_t)(8 + h) * M + mc + lane];
    ssd_stage<STATE_ONLY>(lds, tid, g, mc, cidx * 128, Y1, cw, cb);
    float atot_chunk = 0.f;
    bf16* XTw = (bf16*)(lds + O_XT) + w * 64 * LT;
    float* DTl = (float*)(lds + O_DT) + w * 64; float* ACl = (float*)(lds + O_AC) + w * 64;
#pragma unroll
    for (int sub = 0; sub < 2; ++sub) {
        const size_t m0 = mc + sub * 64; const int tg0 = cidx * 128 + sub * 64;
        int lane_s = tid & 63; asm volatile("" : "+v"(lane_s));
        const int lane = lane_s, c = lane & 15, q = lane >> 4; (void)tg0;
        float atot;
        { const float xx = fdv + dtb; const float u_ = fexp(-fabsf(xx)); const float dt = fmaxf(xx, 0.f) + (u_ < 1e-4f ? u_ * (1.0f - 0.5f * u_) : __builtin_amdgcn_logf(1.0f + u_) * 0.6931471805599453f);
          float ac = dt * Ah;
#pragma unroll
          for (int o_ = 1; o_ < 64; o_ <<= 1) { const float v = lget(ac, lane - o_); if (lane >= o_) ac += v; }
          DTl[lane] = dt; ACl[lane] = ac; atot = __int_as_float(__builtin_amdgcn_readlane(__float_as_int(ac), 63)); }
        atot_chunk += atot;
        __syncthreads();
        u32x4 z0, z1, z2; f32x4 n0, n1; int lo_ = 0;
        if (STATE_ONLY) {
            const float ea = fexp(atot);
#pragma unroll
            for (int i = 0; i < 32; ++i) st[i] = st[i] * ea;
#pragma unroll
            for (int ks2 = 0; ks2 < 2; ++ks2) {
                bf16x8 xw[4];
                { const f32x4 d0 = *(const f32x4*)(DTl + 32 * ks2 + 8 * q), d1 = *(const f32x4*)(DTl + 32 * ks2 + 8 * q + 4), a0 = *(const f32x4*)(ACl + 32 * ks2 + 8 * q), a1 = *(const f32x4*)(ACl + 32 * ks2 + 8 * q + 4);
                  float wl[8];
#pragma unroll
                  for (int j = 0; j < 4; ++j) { wl[j] = d0[j] * fexp(fminf(atot - a0[j], 0.f)); wl[4 + j] = d1[j] * fexp(fminf(atot - a1[j], 0.f)); }
#pragma unroll
                  for (int pt = 0; pt < 4; ++pt) { const u32x4 xv = *(const u32x4*)(XTw + (16 * pt + c) * LT + 32 * ks2 + 8 * q);
                      const u32x4 t_ = (u32x4){cvtpk(bflo(xv.x) * wl[0], bfhi(xv.x) * wl[1]), cvtpk(bflo(xv.y) * wl[2], bfhi(xv.y) * wl[3]), cvtpk(bflo(xv.z) * wl[4], bfhi(xv.z) * wl[5]), cvtpk(bflo(xv.w) * wl[6], bfhi(xv.w) * wl[7])};
                      xw[pt] = __builtin_bit_cast(bf16x8, t_); } }
#pragma unroll
                for (int nt = 0; nt < 8; ++nt) { const bf16x8 af = *(const bf16x8*)((const bf16*)(lds + O_BT) + (16 * nt + c) * LT + 32 * ks2 + 8 * q);
#pragma unroll
                    for (int pt = 0; pt < 4; ++pt) st[nt * 4 + pt] = __builtin_amdgcn_mfma_f32_16x16x32_bf16(af, xw[pt], st[nt * 4 + pt], 0, 0, 0); }
            }
        } else {
            u32x4 xw[8];
            if (sub == 0) {
#pragma unroll
                for (int ks2 = 0; ks2 < 2; ++ks2) {
                    const f32x4 d0 = *(const f32x4*)(DTl + 32 * ks2 + 8 * q), d1 = *(const f32x4*)(DTl + 32 * ks2 + 8 * q + 4), a0 = *(const f32x4*)(ACl + 32 * ks2 + 8 * q), a1 = *(const f32x4*)(ACl + 32 * ks2 + 8 * q + 4);
                    float wl[8];
#pragma unroll
                    for (int j = 0; j < 4; ++j) { wl[j] = d0[j] * fexp(fminf(atot - a0[j], 0.f)); wl[4 + j] = d1[j] * fexp(fminf(atot - a1[j], 0.f)); }
#pragma unroll
                    for (int pt = 0; pt < 4; ++pt) { const u32x4 xv = *(const u32x4*)(XTw + (16 * pt + c) * LT + 32 * ks2 + 8 * q);
                        xw[ks2 * 4 + pt] = (u32x4){cvtpk(bflo(xv.x) * wl[0], bfhi(xv.x) * wl[1]), cvtpk(bflo(xv.y) * wl[2], bfhi(xv.y) * wl[3]), cvtpk(bflo(xv.z) * wl[4], bfhi(xv.z) * wl[5]), cvtpk(bflo(xv.w) * wl[6], bfhi(xv.w) * wl[7])}; }
                }
            }
#pragma unroll
            for (int Ii = 0; Ii < 4; ++Ii) { const int I = 3 - Ii;
                f32x4 y[4];
#pragma unroll
                for (int pt = 0; pt < 4; ++pt) y[pt] = (f32x4){0.f, 0.f, 0.f, 0.f};
                u32x4 cfr[4]; bf16x8 cst[4], bfr[2][4];
#pragma unroll
                for (int ks = 0; ks < 4; ++ks) { const bf16* cp = (const bf16*)(lds + O_CM) + (16 * I + c) * LB + 32 * ks + 4 * q;
                    const u32x2 a0 = *(const u32x2*)cp, a1 = *(const u32x2*)(cp + 16); cfr[ks] = (u32x4){a0.x, a0.y, a1.x, a1.y}; }
                const f32x4 ac4 = *(const f32x4*)(ACl + 16 * I + 4 * q); const float acl = ACl[16 * I + c];
#pragma unroll
                for (int ks = 0; ks < 4; ++ks) { cst[ks] = *(const bf16x8*)((const bf16*)(lds + O_CM) + (16 * I + c) * LB + 8 * q + 32 * ks); bfr[0][ks] = *(const bf16x8*)((const bf16*)(lds + O_BM) + c * LB + 8 * q + 32 * ks); }
                __builtin_amdgcn_sched_barrier(0);
#pragma unroll
                for (int ks = 0; ks < 4; ++ks)
#pragma unroll
                    for (int pt = 0; pt < 4; ++pt) y[pt] = __builtin_amdgcn_mfma_f32_16x16x32_bf16(__builtin_bit_cast(bf16x8, cfr[ks]), __builtin_bit_cast(bf16x8, bS[ks * 4 + pt]), y[pt], 0, 0, 0);
                { const f32x4 e = (f32x4){fexp(ac4[0]), fexp(ac4[1]), fexp(ac4[2]), fexp(ac4[3])};
#pragma unroll
                  for (int pt = 0; pt < 4; ++pt) y[pt] = y[pt] * e; }
                u32x2 xp[4];
#pragma unroll
                for (int J = 0; J < 4; ++J) {
                    if (J > I) { xp[J] = (u32x2){0u, 0u}; continue; }
                    if (J + 1 <= I) {
#pragma unroll
                        for (int ks = 0; ks < 4; ++ks) bfr[(J + 1) & 1][ks] = *(const bf16x8*)((const bf16*)(lds + O_BM) + (16 * (J + 1) + c) * LB + 8 * q + 32 * ks); }
                    const f32x4 acs = *(const f32x4*)(ACl + 16 * J + 4 * q), dts = *(const f32x4*)(DTl + 16 * J + 4 * q);
                    __builtin_amdgcn_sched_barrier(0);
                    f32x4 acc = (f32x4){0.f, 0.f, 0.f, 0.f};
#pragma unroll
                    for (int ks = 0; ks < 4; ++ks) acc = __builtin_amdgcn_mfma_f32_16x16x32_bf16(bfr[J & 1][ks], cst[ks], acc, 0, 0, 0);
                    float v[4];
#pragma unroll
                    for (int r = 0; r < 4; ++r) { v[r] = acc[r] * fexp(fminf(acl - acs[r], 0.f)) * dts[r]; if (J == I && 4 * q + r > c) v[r] = 0.f; }
                    xp[J] = (u32x2){cvtpk(v[0], v[1]), cvtpk(v[2], v[3])};
                }
                { u32x4 xfr[2][4];
#pragma unroll
                  for (int ks2 = 0; ks2 < 2; ++ks2) {
                      if (ks2 == 1 && I < 2) continue;
#pragma unroll
                      for (int pt = 0; pt < 4; ++pt) { const bf16* xq = XTw + (16 * pt + c) * LT + 32 * ks2 + 4 * q;
                          const u32x2 b0 = *(const u32x2*)xq, b1 = *(const u32x2*)(xq + 16); xfr[ks2][pt] = (u32x4){b0.x, b0.y, b1.x, b1.y}; } }
                  __builtin_amdgcn_sched_barrier(0);
#pragma unroll
                  for (int ks2 = 0; ks2 < 2; ++ks2) {
                      if (ks2 == 1 && I < 2) continue;
                      const u32x4 aa = (u32x4){xp[2 * ks2].x, xp[2 * ks2].y, xp[2 * ks2 + 1].x, xp[2 * ks2 + 1].y}; const bf16x8 af = __builtin_bit_cast(bf16x8, aa);
#pragma unroll
                      for (int pt = 0; pt < 4; ++pt) y[pt] = __builtin_amdgcn_mfma_f32_16x16x32_bf16(af, __builtin_bit_cast(bf16x8, xfr[ks2][pt]), y[pt], 0, 0, 0); } }
                u32x2 xv[4];
#pragma unroll
                for (int pt = 0; pt < 4; ++pt) xv[pt] = *(const u32x2*)(XTw + (16 * pt + c) * LT + 16 * I + 4 * q);
#pragma unroll
                for (int pt = 0; pt < 4; ++pt) {
                    const float y0 = y[pt][0] + Dh * bflo(xv[pt].x), y1 = y[pt][1] + Dh * bfhi(xv[pt].x), y2 = y[pt][2] + Dh * bflo(xv[pt].y), y3 = y[pt][3] + Dh * bfhi(xv[pt].y);
                    *(u32x2*)(XTw + (8 * (c & 7) + 2 * pt + (c >> 3)) * LT + 16 * I + 4 * (q ^ (w & 3))) = (u32x2){cvtpk(y0, y1), cvtpk(y2, y3)}; }
            }
            if (sub == 0) {
                const float ea = fexp(atot);
#pragma unroll
                for (int ks = 0; ks < 4; ++ks) {
                    const bf16x8 a00 = *(const bf16x8*)((const bf16*)(lds + O_BT) + (16 * (2 * ks) + c) * LT + 8 * q), a01 = *(const bf16x8*)((const bf16*)(lds + O_BT) + (16 * (2 * ks) + c) * LT + 32 + 8 * q);
                    const bf16x8 a10 = *(const bf16x8*)((const bf16*)(lds + O_BT) + (16 * (2 * ks + 1) + c) * LT + 8 * q), a11 = *(const bf16x8*)((const bf16*)(lds + O_BT) + (16 * (2 * ks + 1) + c) * LT + 32 + 8 * q);
#pragma unroll
                    for (int pt = 0; pt < 4; ++pt) { const u32x4 p_ = bS[ks * 4 + pt];
                        f32x4 t0 = (f32x4){bflo(p_.x) * ea, bfhi(p_.x) * ea, bflo(p_.y) * ea, bfhi(p_.y) * ea}, t1 = (f32x4){bflo(p_.z) * ea, bfhi(p_.z) * ea, bflo(p_.w) * ea, bfhi(p_.w) * ea};
                        t0 = __builtin_amdgcn_mfma_f32_16x16x32_bf16(a00, __builtin_bit_cast(bf16x8, xw[pt]), t0, 0, 0, 0); t0 = __builtin_amdgcn_mfma_f32_16x16x32_bf16(a01, __builtin_bit_cast(bf16x8, xw[4 + pt]), t0, 0, 0, 0);
                        t1 = __builtin_amdgcn_mfma_f32_16x16x32_bf16(a10, __builtin_bit_cast(bf16x8, xw[pt]), t1, 0, 0, 0); t1 = __builtin_amdgcn_mfma_f32_16x16x32_bf16(a11, __builtin_bit_cast(bf16x8, xw[4 + pt]), t1, 0, 0, 0);
                        bS[ks * 4 + pt] = (u32x4){cvtpk(t0[0], t0[1]), cvtpk(t0[2], t0[3]), cvtpk(t1[0], t1[1]), cvtpk(t1[2], t1[3])}; }
                }
            }
            lo_ = lane; asm volatile("" : "+v"(lo_));
            { const bf16* zp = Y1 + (m0 + w) * PY1 + g * 512 + lo_ * 8; z0 = *(const u32x4*)zp; z1 = *(const u32x4*)(zp + (size_t)8 * PY1); z2 = *(const u32x4*)(zp + (size_t)16 * PY1); }
            { const float* nwp = nw + g * 512 + lo_ * 8; n0 = *(const f32x4*)nwp; n1 = *(const f32x4*)(nwp + 4); }
        }
        __syncthreads();
        if (!STATE_ONLY) {
            const bf16* ysl = (const bf16*)(lds + O_XT) + ((lo_ >> 3) * 64 + (lo_ & 7)) * LT;
            const int ysw = (lo_ >> 3) & 3;
            const bf16* zp = Y1 + (m0 + w) * PY1 + g * 512 + lo_ * 8; bf16* op = AO + (m0 + w) * PAO + 1024 + g * 512 + lo_ * 8;
#pragma unroll 1
            for (int i = 0; i < 8; ++i) { const int l = w + 8 * i; const u32x4 zv = z0; z0 = z1; z1 = z2;
                if (i + 3 < 8) z2 = *(const u32x4*)(zp + (size_t)(8 * (i + 3)) * PY1);
                const int lc = (l & ~15) | ((((l >> 2) & 3) ^ ysw) << 2) | (l & 3);
                u32x4 yv; yv.x = (unsigned)ysl[lc] | ((unsigned)ysl[8 * LT + lc] << 16); yv.y = (unsigned)ysl[16 * LT + lc] | ((unsigned)ysl[24 * LT + lc] << 16);
                yv.z = (unsigned)ysl[32 * LT + lc] | ((unsigned)ysl[40 * LT + lc] << 16); yv.w = (unsigned)ysl[48 * LT + lc] | ((unsigned)ysl[56 * LT + lc] << 16);
                float v[8] = {bflo(yv.x) * silu(bflo(zv.x)), bfhi(yv.x) * silu(bfhi(zv.x)), bflo(yv.y) * silu(bflo(zv.y)), bfhi(yv.y) * silu(bfhi(zv.y)),
                              bflo(yv.z) * silu(bflo(zv.z)), bfhi(yv.z) * silu(bfhi(zv.z)), bflo(yv.w) * silu(bflo(zv.w)), bfhi(yv.w) * silu(bfhi(zv.w))};
                float ss = 0.f;
#pragma unroll
                for (int j = 0; j < 8; ++j) ss += v[j] * v[j];
                ss += __int_as_float(__builtin_amdgcn_update_dpp(0, __float_as_int(ss), 0xB1, 0xF, 0xF, false));
                ss += __int_as_float(__builtin_amdgcn_update_dpp(0, __float_as_int(ss), 0x4E, 0xF, 0xF, false));
                ss += __int_as_float(__builtin_amdgcn_update_dpp(0, __float_as_int(ss), 0x141, 0xF, 0xF, false));
                ss += __int_as_float(__builtin_amdgcn_update_dpp(0, __float_as_int(ss), 0x140, 0xF, 0xF, false));
                ss = (__int_as_float(__builtin_amdgcn_readlane(__float_as_int(ss), 0)) + __int_as_float(__builtin_amdgcn_readlane(__float_as_int(ss), 16)))
                   + (__int_as_float(__builtin_amdgcn_readlane(__float_as_int(ss), 32)) + __int_as_float(__builtin_amdgcn_readlane(__float_as_int(ss), 48)));
                const float rs = rsqrtf(ss * (1.0f / 512.0f) + 1e-5f);
                const u32x4 ov = (u32x4){cvtpk(v[0] * rs * n0[0], v[1] * rs * n0[1]), cvtpk(v[2] * rs * n0[2], v[3] * rs * n0[3]), cvtpk(v[4] * rs * n1[0], v[5] * rs * n1[1]), cvtpk(v[6] * rs * n1[2], v[7] * rs * n1[3])};
                *(u32x4*)(op + (size_t)(8 * i) * PAO) = ov; }
            __syncthreads();
        }
        if (sub == 0) { fdv = FDt[(size_t)(8 + h) * M + mc + 64 + lane]; ssd_stage<STATE_ONLY>(lds, tid, g, mc + 64, cidx * 128 + 64, Y1, cw, cb); }
    }
    if (STATE_ONLY) {
        u32x4* sl = STL + (size_t)u * 8192 + w * 64 + lane;
#pragma unroll
        for (int ks = 0; ks < 4; ++ks)
#pragma unroll
            for (int pt = 0; pt < 4; ++pt) { const f32x4 s0 = st[(2 * ks) * 4 + pt], s1 = st[(2 * ks + 1) * 4 + pt];
                sl[(size_t)(ks * 4 + pt) * 512] = (u32x4){cvtpk(s0[0], s0[1]), cvtpk(s0[2], s0[3]), cvtpk(s1[0], s1[1]), cvtpk(s1[2], s1[3])}; }
        if (lane == 0) DEC[(size_t)(b * 32 + cidx) * 16 + h] = fexp(atot_chunk);
    }
}
__device__ __forceinline__ void ssd_scan(size_t gtid, size_t gsz, u32x4* STL, const float* DEC) {
    for (size_t col = gtid; col < (size_t)8 * 16384; col += gsz) {
        const int bg = (int)(col >> 14), e2 = (int)(col & 16383), b = bg >> 1, g = bg & 1, wv = (e2 >> 7) & 7;
        u32x2 v[32]; float d[32];
#pragma unroll
        for (int cc = 0; cc < 32; ++cc) { v[cc] = *((const u32x2*)(STL + (size_t)((b * 32 + cc) * 2 + g) * 8192) + e2); d[cc] = DEC[(size_t)(b * 32 + cc) * 16 + g * 8 + wv]; }
        float z_ = 0.f; asm volatile("" : "+v"(z_)); f32x4 run = (f32x4){z_, z_, z_, z_};
#pragma unroll
        for (int cc = 0; cc < 32; ++cc) { u32x2* p = (u32x2*)(STL + (size_t)((b * 32 + cc) * 2 + g) * 8192) + e2;
            *p = (u32x2){cvtpk(run[0], run[1]), cvtpk(run[2], run[3])};
            run = run * d[cc] + (f32x4){bflo(v[cc].x), bfhi(v[cc].x), bflo(v[cc].y), bfhi(v[cc].y)}; }
    }
}
}
#define LAS __attribute__((address_space(3)))
#define XB_TMO      128
#define XB_XCNT(j)  (256  + 64 * (j))
#define XB_XSUB(j)  (1280 + 64 * (j))
#define XB_XGEN(j)  (2304 + 64 * (j))
#define XB_TOP      3328
#define XB_TOPGEN   3392
#define XCD_BAR_WORDS 3456
#define XB_SPIN_CAP (1u << 18)

__device__ __forceinline__ unsigned xb_ld(unsigned* p)              { return __hip_atomic_load(p, __ATOMIC_RELAXED, __HIP_MEMORY_SCOPE_AGENT); }
__device__ __forceinline__ unsigned xb_add(unsigned* p, unsigned v) { return __hip_atomic_fetch_add(p, v, __ATOMIC_RELAXED, __HIP_MEMORY_SCOPE_AGENT); }
__device__ __forceinline__ unsigned xb_xcc_id() { return (unsigned)__builtin_amdgcn_s_getreg((3 << 11) | 20) & 0xFu; }
#define XB_SPIN(cond, bar) do { unsigned _sp = 0; while (cond) { __builtin_amdgcn_s_sleep(1); \
    if ((++_sp & 255u) == 0u) { if (xb_ld(&(bar)[XB_TMO])) break; if (_sp > XB_SPIN_CAP) { atomicAdd(&(bar)[XB_TMO], 1u); break; } } } } while (0)

struct XcdBarrier {
    unsigned* bar; unsigned x;
    volatile LAS unsigned* st;
};

__device__ __forceinline__ XcdBarrier xcd_barrier_post(unsigned* bar, volatile LAS unsigned* st) {
    XcdBarrier b; b.bar = bar; b.x = xb_xcc_id(); b.st = st;
    if (threadIdx.x == 0) (void)xb_add(&bar[XB_XCNT(b.x)], 1u);
    return b;
}
__device__ __forceinline__ void xcd_barrier_complete(unsigned* bar, unsigned x, unsigned& nloc, unsigned& nx) {
    const unsigned G = gridDim.x * gridDim.y * gridDim.z;
    unsigned sum, cnt, mine, sp = 0u;
    for (;;) {
        sum = 0u; cnt = 0u; mine = 0u;
#pragma unroll
        for (unsigned j = 0; j < 16; ++j) { const unsigned c = xb_ld(&bar[XB_XCNT(j)]); sum += c; cnt += (c > 0u) ? 1u : 0u; mine = (j == x) ? c : mine; }
        if (sum == G) break;
        __builtin_amdgcn_s_sleep(1);
        if ((++sp & 255u) == 0u) { if (xb_ld(&bar[XB_TMO])) break; if (sp > XB_SPIN_CAP) { atomicAdd(&bar[XB_TMO], 1u); break; } }
    }
    nloc = mine > 0u ? mine : 1u; nx = cnt > 0u ? cnt : 1u;
}

__device__ __forceinline__ void xcd_barrier(const XcdBarrier& b, const bool leader  ) {
    asm volatile("s_waitcnt vmcnt(0)" ::: "memory");
    __syncthreads();
    if (leader) {
        unsigned* bar = b.bar;
        __builtin_amdgcn_s_waitcnt(0);
        unsigned nloc = b.st[0], nx = b.st[1];
        if (nloc == 0u) { xcd_barrier_complete(bar, b.x, nloc, nx); b.st[0] = nloc; b.st[1] = nx; }
        const unsigned old = xb_add(&bar[XB_XSUB(b.x)], 1u);
        const unsigned gen = old / nloc;
        if (old + 1u == (gen + 1u) * nloc) {
            __builtin_amdgcn_fence(__ATOMIC_RELEASE, "agent");
            asm volatile("s_waitcnt vmcnt(0)" ::: "memory");
            const unsigned og = xb_add(&bar[XB_TOP], 1u);
            const unsigned tg = og / nx;
            if (og + 1u == (tg + 1u) * nx) xb_add(&bar[XB_TOPGEN], 1u);
            else XB_SPIN(xb_ld(&bar[XB_TOPGEN]) == tg, bar);
            __builtin_amdgcn_fence(__ATOMIC_ACQUIRE, "agent");
            xb_add(&bar[XB_XGEN(b.x)], 1u);
            asm volatile("s_waitcnt vmcnt(0)" ::: "memory");
        } else {
            XB_SPIN(xb_ld(&bar[XB_XGEN(b.x)]) == gen, bar);
            __builtin_amdgcn_fence(__ATOMIC_ACQUIRE, "agent");
            asm volatile("s_waitcnt vmcnt(0)" ::: "memory");
        }
    }
    __syncthreads();
}
namespace hy {
typedef unsigned short bf16;
constexpr int B = 4, T = 4096, D = 1024, M = B * T;
constexpr int EVEN_IN = 6680, ODD_IN = 8192;
constexpr int NE = 6912;
constexpr int NE1 = 2816, NE2 = 3072;
constexpr int NO1 = 6144, NO2 = 2048;
constexpr size_t MiB = 1u << 20;
constexpr size_t WS_CTL = 0, CTL_ZERO_BYTES = 64 * 1024;
constexpr size_t WS_RS = 512 * 1024, WS_FDT = 1 * MiB, WS_SS = 3 * MiB, WS_CS = 4 * MiB, WS_WA = 5 * MiB, WS_WB = 21 * MiB, WS_AO = 25 * MiB, WS_Y = 89 * MiB, WS_YODD = 25 * MiB;
constexpr size_t WS_NRM = WS_CS + 640 * 1024;
constexpr size_t WS_STL = WS_Y + 88 * MiB, WS_DEC = WS_CS + 512 * 1024;
constexpr size_t WS_SLOC = WS_WA, WS_GB = WS_YODD + 192 * MiB, WS_DSEG = WS_GB + 32 * MiB;
constexpr int CW_QCNT = 8192;
constexpr int CW_BAR = 4096;
constexpr int RING_BYTES = 155648, MISC_OFF = RING_BYTES + 320, LDS_BYTES = 157696;
constexpr int NT = 512, NWV = 8;

__device__ __forceinline__ unsigned f2bf(float f) { unsigned u = __float_as_uint(f); return (u + 0x7fffu + ((u >> 16) & 1u)) >> 16; }
__device__ __forceinline__ float bf2f(bf16 v) { return __uint_as_float((unsigned)v << 16); }
__device__ __forceinline__ float lx(float v, int mask, int lane) { return __int_as_float(__builtin_amdgcn_ds_bpermute((lane ^ mask) << 2, __float_as_int(v))); }
__device__ __forceinline__ float lget(float v, int src) { return __int_as_float(__builtin_amdgcn_ds_bpermute(src << 2, __float_as_int(v))); }
__device__ __forceinline__ float wave_sum(float v, int lane) {
#pragma unroll
    for (int o = 1; o < 64; o <<= 1) v += lx(v, o, lane);
    return v;
}
__device__ __forceinline__ float sigmoid_f(float x) { return 1.0f / (1.0f + __expf(-x)); }
__device__ __forceinline__ float silu_f(float x) { return x / (1.0f + __expf(-x)); }
__device__ __forceinline__ float log1p_fast(float u) { return u < 1e-4f ? u * (1.0f - 0.5f * u) : __builtin_amdgcn_logf(1.0f + u) * 0.6931471805599453f; }
__device__ __forceinline__ float log_sigmoid_f(float x) { return fminf(x, 0.f) - log1p_fast(__expf(-fabsf(x))); }
__device__ __forceinline__ float softplus_f(float x) { return fmaxf(x, 0.f) + log1p_fast(__expf(-fabsf(x))); }

__device__ __forceinline__ void ph_prologue(int gw, int ngw, int lane, const float* __restrict__ x, bf16* __restrict__ hi, float* __restrict__ RS) {
    for (int m0 = gw; m0 < M; m0 += 4 * ngw) {
        float4 v[4][4];
#pragma unroll
        for (int r = 0; r < 4; ++r)
#pragma unroll
            for (int j = 0; j < 4; ++j) v[r][j] = m0 + r * ngw < M ? *(const float4*)(x + (size_t)(m0 + r * ngw) * D + j * 256 + lane * 4) : make_float4(0.f, 0.f, 0.f, 0.f);
#pragma unroll
        for (int r = 0; r < 4; ++r) { const int m = m0 + r * ngw; float s = 0.f; if (m >= M) break;
#pragma unroll
            for (int j = 0; j < 4; ++j) { const float4 a = v[r][j]; s += (a.x * a.x + a.y * a.y) + (a.z * a.z + a.w * a.w);
                *(uint2*)(hi + (size_t)m * D + j * 256 + lane * 4) = make_uint2(f2bf(a.x) | (f2bf(a.y) << 16), f2bf(a.z) | (f2bf(a.w) << 16)); }
            s = wave_sum(s, lane);
            if (lane == 0) RS[m] = rsqrtf(s * (1.0f / 1024.0f) + 1e-5f); }
    }
}
__device__ __forceinline__ int even_map(int n) {
    if (n < 4096) return n;
    if (n < 5120) return 4104 + (n - 4096);
    if (n < 6656) return 5128 + (n - 5120);
    if (n < 6664) return 4096 + (n - 6656);
    if (n < 6680) return 6664 + (n - 6664);
    return -1;
}
template <int MAP, bool HAS_NW>
__device__ __forceinline__ void ph_convert_w(LAS float* tile_, int bid, int nb_grid, int tid, const float* __restrict__ W, int K, int Nsrc, int Ndst, const float* __restrict__ nw, bf16* __restrict__ Wt) {
    LAS unsigned char* tile = (LAS unsigned char*)tile_;
    const int l32 = tid & 31, kp = tid >> 5;
    const int nb = Ndst / 128, kb = K / 64, ntile = nb * kb;
    float4 v[2][2]; float wk[2][2];
#define CV_LOAD(it_) do { const int n0_ = ((it_) % nb) * 128, k0_ = ((it_) / nb) * 64; const int n_ = n0_ + 4 * l32; const int sc_ = MAP == 1 ? even_map(n_) : n_; \
        _Pragma("unroll") for (int p_ = 0; p_ < 2; ++p_) _Pragma("unroll") for (int e_ = 0; e_ < 2; ++e_) { const int k_ = k0_ + 2 * (kp + 16 * p_) + e_; \
            v[p_][e_] = sc_ >= 0 ? *(const float4*)(W + (size_t)k_ * Nsrc + sc_) : make_float4(0.f, 0.f, 0.f, 0.f); wk[p_][e_] = HAS_NW ? nw[k_] : 1.f; } } while (0)
    int it = bid;
    if (it < ntile) CV_LOAD(it);
    for (; it < ntile; it += nb_grid) {
        const int n0 = (it % nb) * 128, k0 = (it / nb) * 64;
#pragma unroll
        for (int p = 0; p < 2; ++p) { const float4 a = v[p][0], b = v[p][1]; const float wa = wk[p][0], wb = wk[p][1];
            LAS unsigned char* dst = tile + (4 * l32) * 132 + (kp + 16 * p) * 4;
            *(LAS unsigned*)(dst) = f2bf(a.x * wa) | (f2bf(b.x * wb) << 16); *(LAS unsigned*)(dst + 132) = f2bf(a.y * wa) | (f2bf(b.y * wb) << 16);
            *(LAS unsigned*)(dst + 264) = f2bf(a.z * wa) | (f2bf(b.z * wb) << 16); *(LAS unsigned*)(dst + 396) = f2bf(a.w * wa) | (f2bf(b.w * wb) << 16); }
        __syncthreads();
        if (it + nb_grid < ntile) CV_LOAD(it + nb_grid);
#pragma unroll
        for (int r = 0; r < 2; ++r) { const int c = tid + 512 * r, n = c >> 3, j = c & 7; const LAS unsigned* src = (const LAS unsigned*)(tile + n * 132 + j * 16);
            uint4 o; o.x = src[0]; o.y = src[1]; o.z = src[2]; o.w = src[3];
            *(uint4*)(Wt + (size_t)(n0 + n) * K + k0 + 8 * j) = o; }
        __syncthreads();
    }
#undef CV_LOAD
}

__device__ __forceinline__ void ph_rstd(size_t gtid, size_t gsz, const float* __restrict__ SS, float* __restrict__ RS) {
    for (size_t m = gtid; m < (size_t)M; m += gsz) { float s = 0.f;
#pragma unroll
        for (int p = 0; p < 16; ++p) s += SS[(size_t)p * M + m];
        RS[m] = rsqrtf(s * (1.0f / 1024.0f) + 1e-5f); }
}
__device__ __forceinline__ void ph_fox_cumsum(LAS float* red  , int bid, int tid, int lane, int wv, const float* __restrict__ FDt, const float* __restrict__ f_bias, float* __restrict__ CS) {
    if (bid >= 32) return;
    const int b = bid >> 3, h = bid & 7; const float fb = f_bias[h];
    const float4* src = (const float4*)(FDt + (size_t)h * M + (size_t)b * T) + tid * 2;
    const float4 x0 = src[0], x1 = src[1];
    float v[8] = {log_sigmoid_f(x0.x + fb), log_sigmoid_f(x0.y + fb), log_sigmoid_f(x0.z + fb), log_sigmoid_f(x0.w + fb), log_sigmoid_f(x1.x + fb), log_sigmoid_f(x1.y + fb), log_sigmoid_f(x1.z + fb), log_sigmoid_f(x1.w + fb)};
#pragma unroll
    for (int j = 1; j < 8; ++j) v[j] += v[j - 1];
    float inc = v[7];
#pragma unroll
    for (int o = 1; o < 64; o <<= 1) { const float u = lget(inc, lane - o); if (lane >= o) inc += u; }
    if (lane == 63) red[wv] = inc;
    __syncthreads();
    float pre = inc - v[7];
    for (int j = 0; j < wv; ++j) pre += red[j];
    const float sc = -11.313708498984761f;
    float4* dst = (float4*)(CS + (size_t)bid * T) + tid * 2;
    dst[0] = make_float4((pre + v[0]) * sc, (pre + v[1]) * sc, (pre + v[2]) * sc, (pre + v[3]) * sc);
    dst[1] = make_float4((pre + v[4]) * sc, (pre + v[5]) * sc, (pre + v[6]) * sc, (pre + v[7]) * sc);
    __syncthreads();
}
__device__ __forceinline__ void ph_fox_attn(LAS float* qsb  , int gw, int ngw, int wv, int lane, const bf16* __restrict__ Y2, const float* __restrict__ CS, bf16* __restrict__ AO) {
    LAS float* qs = qsb + wv * 128;
    for (int rr = gw; rr < B * 8 * T; rr += ngw) {
        const int bh = rr / T, tt = rr % T, t = (bh & 1) ? (T - 1 - tt) : tt, b = bh >> 3, h = bh & 7;
        const size_t mq = (size_t)b * T + t;
        const bf16* qp = Y2 + mq * NE2 + h * 128;
        const float scale = 0.08838834764831845f;
        __syncthreads();
        qs[lane] = bf2f(qp[lane]) * scale; qs[lane + 64] = bf2f(qp[lane + 64]) * scale;
        __syncthreads();
        const float* cs = CS + (size_t)bh * T; const float ct = cs[t];
        float mrun = -1e30f, l = 0.f, o0 = 0.f, o1 = 0.f;
        for (int j0 = 0; j0 <= t; j0 += 64) {
            const int j = j0 + lane; float s = -INFINITY;
            if (j <= t) {
                const bf16* kp = Y2 + ((size_t)b * T + j) * NE2 + 1024 + h * 128; float a = 0.f;
#pragma unroll 4
                for (int d = 0; d < 128; d += 8) { const uint4 kk = *(const uint4*)(kp + d);
                    a += qs[d + 0] * __uint_as_float(kk.x << 16) + qs[d + 1] * __uint_as_float(kk.x & 0xffff0000u) + qs[d + 2] * __uint_as_float(kk.y << 16) + qs[d + 3] * __uint_as_float(kk.y & 0xffff0000u)
                       + qs[d + 4] * __uint_as_float(kk.z << 16) + qs[d + 5] * __uint_as_float(kk.z & 0xffff0000u) + qs[d + 6] * __uint_as_float(kk.w << 16) + qs[d + 7] * __uint_as_float(kk.w & 0xffff0000u); }
                s = a + (ct - cs[j]);
            }
            float tm = s;
#pragma unroll
            for (int o = 1; o < 64; o <<= 1) tm = fmaxf(tm, lx(tm, o, lane));
            const float mn = fmaxf(mrun, tm), alpha = __expf(mrun - mn); const float p = __expf(s - mn);
            l = l * alpha + wave_sum(p, lane); o0 *= alpha; o1 *= alpha; mrun = mn;
            const int nk = min(64, t - j0 + 1);
            const bf16* vp = Y2 + ((size_t)b * T + j0) * NE2 + 2048 + h * 128;
            for (int jj = 0; jj < nk; ++jj) { const float pj = __int_as_float(__builtin_amdgcn_readlane(__float_as_int(p), jj)); o0 += pj * bf2f(vp[(size_t)jj * NE2 + lane]); o1 += pj * bf2f(vp[(size_t)jj * NE2 + lane + 64]); }
        }
        const float inv = 1.0f / l; const bf16* gp = Y2 + mq * NE2 + 3072 + h * 128;
        AO[mq * 2048 + h * 128 + lane] = (bf16)f2bf(o0 * inv * silu_f(bf2f(gp[lane])));
        AO[mq * 2048 + h * 128 + lane + 64] = (bf16)f2bf(o1 * inv * silu_f(bf2f(gp[lane + 64])));
    }
}

__device__ __forceinline__ void ph_ssd_conv(size_t gtid, size_t gsz, const bf16* __restrict__ Y1, const float* __restrict__ cw, const float* __restrict__ cb, bf16* __restrict__ XC) {
    const size_t total = (size_t)M * 1536;
    for (size_t i = gtid; i < total; i += gsz) {
        const int m = (int)(i / 1536), ch = (int)(i % 1536), t = m % T; float a = cb[ch];
#pragma unroll
        for (int k = 0; k < 4; ++k) { const int tt = t - 3 + k; if (tt >= 0) a += cw[k * 1536 + ch] * bf2f(Y1[(size_t)(m - 3 + k) * NE1 + 1024 + ch]); }
        XC[i] = (bf16)f2bf(silu_f(a));
    }
}
__device__ __forceinline__ void ph_ssd_scan(int gw, int ngw, int lane, const bf16* __restrict__ Y1, const bf16* __restrict__ XC, const float* __restrict__ FDt, const float* __restrict__ dt_bias,
                                            const float* __restrict__ A_log, const float* __restrict__ Dsk, bf16* __restrict__ AO) {
    for (int w = gw; w < B * 16 * 64; w += ngw) {
        const int p = w & 63, h = (w >> 6) & 15, b = w >> 10, g = h >> 3;
        const float A = -__expf(A_log[h]), dtb = dt_bias[h], Dh = Dsk[h];
        float s0 = 0.f, s1 = 0.f;
        for (int t = 0; t < T; ++t) {
            const size_t m = (size_t)b * T + t;
            const float dt = softplus_f(FDt[(size_t)(8 + h) * M + m] + dtb);
            const float xv = bf2f(XC[m * 1536 + h * 64 + p]);
            const float dec = __expf(dt * A), dx = dt * xv;
            const bf16* bp = XC + m * 1536 + 1024 + g * 128; const bf16* cp = XC + m * 1536 + 1280 + g * 128;
            s0 = dec * s0 + dx * bf2f(bp[lane]); s1 = dec * s1 + dx * bf2f(bp[lane + 64]);
            float y = wave_sum(bf2f(cp[lane]) * s0 + bf2f(cp[lane + 64]) * s1, lane);
            if (lane == 0) { y = (y + Dh * xv) * silu_f(bf2f(Y1[m * NE1 + h * 64 + p])); AO[m * 2048 + 1024 + h * 64 + p] = (bf16)f2bf(y); }
        }
    }
}
__device__ __forceinline__ void ph_ssd_norm(int gw, int ngw, int lane, bf16* __restrict__ AO, const float* __restrict__ nw) {
    for (int w = gw; w < M * 2; w += ngw) {
        const int g = w & 1; const size_t m = w >> 1;
        bf16* p = AO + m * 2048 + 1024 + g * 512 + lane * 8;
        const uint4 v = *(const uint4*)p; float f[8] = {__uint_as_float(v.x << 16), __uint_as_float(v.x & 0xffff0000u), __uint_as_float(v.y << 16), __uint_as_float(v.y & 0xffff0000u),
                                                       __uint_as_float(v.z << 16), __uint_as_float(v.z & 0xffff0000u), __uint_as_float(v.w << 16), __uint_as_float(v.w & 0xffff0000u)};
        float s = 0.f;
#pragma unroll
        for (int i = 0; i < 8; ++i) s += f[i] * f[i];
        s = wave_sum(s, lane); const float r = rsqrtf(s * (1.0f / 512.0f) + 1e-5f); const float* wp = nw + g * 512 + lane * 8;
        uint4 o; o.x = f2bf(f[0] * r * wp[0]) | (f2bf(f[1] * r * wp[1]) << 16); o.y = f2bf(f[2] * r * wp[2]) | (f2bf(f[3] * r * wp[3]) << 16);
        o.z = f2bf(f[4] * r * wp[4]) | (f2bf(f[5] * r * wp[5]) << 16); o.w = f2bf(f[6] * r * wp[6]) | (f2bf(f[7] * r * wp[7]) << 16);
        *(uint4*)p = o;
    }
}

__device__ __forceinline__ void ph_hgrn_scan(int gw, int ngw, int lane, const bf16* __restrict__ Y, const float* __restrict__ lbl, int oi, int h0, bf16* __restrict__ ORAW) {
    for (int w = gw; w < B * 8 * 128; w += ngw) {
        const int v = w & 127, hh = (w >> 7) & 7, b = w >> 10, h = h0 + hh;
        float lb0 = 0.f, lb1 = 0.f;
        if (oi == 1) { const int c0 = h * 128 + lane, c1 = c0 + 64; lb0 = sigmoid_f(lbl[2048 + c0] - lbl[c0]); lb1 = sigmoid_f(lbl[2048 + c1] - lbl[c1]); }
        float s0 = 0.f, s1 = 0.f;
        for (int t = 0; t < T; ++t) {
            const size_t m = (size_t)b * T + t; const bf16* yp = Y + m * NO1;
            const float q0 = silu_f(bf2f(yp[h * 128 + lane])), q1 = silu_f(bf2f(yp[h * 128 + lane + 64]));
            const float f0 = bf2f(yp[2048 + h * 128 + lane]), f1 = bf2f(yp[2048 + h * 128 + lane + 64]);
            const float iv = bf2f(yp[4096 + h * 128 + v]);
            const float g0 = lb0 + (1.f - lb0) * sigmoid_f(f0), g1 = lb1 + (1.f - lb1) * sigmoid_f(f1);
            const float k0 = (1.f - lb0) * sigmoid_f(-f0), k1 = (1.f - lb1) * sigmoid_f(-f1);
            s0 = g0 * s0 + k0 * iv; s1 = g1 * s1 + k1 * iv;
            const float o = wave_sum(q0 * s0 + q1 * s1, lane);
            if (lane == 0) ORAW[m * 1024 + hh * 128 + v] = (bf16)f2bf(o);
        }
    }
}
__device__ __forceinline__ void ph_hgrn_norm(int gw, int ngw, int lane, const bf16* __restrict__ ORAW, const float* __restrict__ nw, int h0, bf16* __restrict__ Y) {
    for (int w = gw; w < M * 8; w += ngw) {
        const int hh = w & 7; const size_t m = w >> 3;
        const unsigned v = *(const unsigned*)(ORAW + m * 1024 + hh * 128 + lane * 2);
        const float a = __uint_as_float(v << 16), c = __uint_as_float(v & 0xffff0000u);
        const float s = wave_sum(a * a + c * c, lane), r = rsqrtf(s * (1.0f / 128.0f) + 1e-5f);
        *(unsigned*)(Y + m * NO1 + (h0 + hh) * 128 + lane * 2) = f2bf(a * r * nw[lane * 2]) | (f2bf(c * r * nw[lane * 2 + 1]) << 16);
    }
}
__device__ __forceinline__ void ph_final(int gw, int ngw, int lane, const bf16* __restrict__ hf, const float* __restrict__ SS, const float* __restrict__ fw, float* __restrict__ out) {
    float4 wv[4];
#pragma unroll
    for (int j = 0; j < 4; ++j) wv[j] = *(const float4*)(fw + j * 256 + lane * 4);
    for (int m0 = gw; m0 < M; m0 += 4 * ngw) {
        uint2 a[4][4]; float s[4];
#pragma unroll
        for (int r = 0; r < 4; ++r) { const int m = min(m0 + r * ngw, M - 1); s[r] = lane < 16 ? SS[(size_t)lane * M + m] : 0.f;
#pragma unroll
            for (int j = 0; j < 4; ++j) a[r][j] = *(const uint2*)(hf + (size_t)m * NO1 + j * 256 + lane * 4); }
#pragma unroll
        for (int r = 0; r < 4; ++r) { const int m = m0 + r * ngw; if (m >= M) break;
            const float rr = rsqrtf(wave_sum(s[r], lane) * (1.0f / 1024.0f) + 1e-5f);
#pragma unroll
            for (int j = 0; j < 4; ++j) { const uint2 q = a[r][j];
                *(float4*)(out + (size_t)m * D + j * 256 + lane * 4) = make_float4(__uint_as_float(q.x << 16) * rr * wv[j].x, __uint_as_float(q.x & 0xffff0000u) * rr * wv[j].y, __uint_as_float(q.y << 16) * rr * wv[j].z, __uint_as_float(q.y & 0xffff0000u) * rr * wv[j].w); } }
    }
}
struct Params {
    const float* x; const float* norm_w; const float* final_w; const float* even_w_in; const float* even_w_out; const float* fox_f_bias;
    const float* conv_w; const float* conv_b; const float* dt_bias; const float* A_log; const float* ssd_D; const float* ssd_nw;
    const float* odd_w_in; const float* odd_w_out; const float* lb_logits; const float* hgrn_nw;
    float* out; unsigned char* ws;
};

typedef const __attribute__((address_space(4))) Params* ParamsK;
__device__ __forceinline__ ParamsK kargs() { ParamsK p = (ParamsK)__builtin_amdgcn_kernarg_segment_ptr(); asm volatile("" : "+s"(p)); return p; }
__device__ __forceinline__ int tid_fresh(int wv0) { int l = __builtin_amdgcn_mbcnt_hi(~0u, __builtin_amdgcn_mbcnt_lo(~0u, 0u)); asm volatile("" : "+v"(l)); return wv0 * 64 + l; }
#define PH_IDS() const int tid = tid_fresh(wv0), lane = tid & 63, wv = wv0; int G_ = gridDim.x, bid_ = blockIdx.x; asm volatile("" : "+s"(G_), "+s"(bid_)); const int G = G_, bid = bid_, gw = bid * NWV + wv, ngw = G * NWV; \
    const size_t gtid = (size_t)bid * NT + tid, gsz = (size_t)G * NT; (void)lane; (void)gw; (void)ngw; (void)gtid; (void)gsz; (void)wv
#define GP(T, p) ((T*)(__attribute__((address_space(1))) T*)(p))
#define PH_PTRS() ParamsK P = kargs(); unsigned char* ws = GP(unsigned char, P->ws); bf16* hi = GP(bf16, P->out); bf16* lo = hi + (size_t)M * D; \
    float* FDt = (float*)(ws + WS_FDT); float* SS = (float*)(ws + WS_SS); float* CS = (float*)(ws + WS_CS); float* RS = (float*)(ws + WS_RS); (void)RS; \
    bf16* WA = (bf16*)(ws + WS_WA); bf16* WB = (bf16*)(ws + WS_WB); bf16* AO = (bf16*)(ws + WS_AO); \
    bf16* Y = (bf16*)(ws + WS_Y); sd::u32x4* STL = (sd::u32x4*)(ws + WS_STL); float* DEC = (float*)(ws + WS_DEC); bf16* YO = (bf16*)(ws + WS_YODD); float* SLOC = (float*)(ws + WS_SLOC); float* DSEG = (float*)(ws + WS_DSEG); bf16* HFB = (bf16*)(ws + WS_YODD) + 2048; float* NRM = (float*)(ws + WS_NRM); \
    (void)hi; (void)lo; (void)FDt; (void)SS; (void)CS; (void)WA; (void)WB; (void)AO; (void)Y; (void)STL; (void)DEC; (void)YO; (void)SLOC; (void)DSEG; (void)HFB; (void)NRM
#define PF(field) GP(const float, P->field)
#define GRID_BAR() do { ParamsK Pb = kargs(); XcdBarrier bar_; bar_.bar = (unsigned*)(GP(unsigned char, Pb->ws) + WS_CTL) + CW_BAR; bar_.x = xb_xcc_id(); \
    bar_.st = (volatile LAS unsigned*)((LAS unsigned char*)lds + MISC_OFF) + 8; xcd_barrier(bar_, tid_fresh(wv0) == 0); } while (0)

__global__ void __launch_bounds__(512, 2) mega_fwd(Params Pval) {
    extern __shared__ __attribute__((aligned(16))) unsigned char lds[];
#define LL ((LAS unsigned char*)lds)
#define SCR ((LAS float*)lds)
    const int wv0 = __builtin_amdgcn_readfirstlane((int)threadIdx.x >> 6);
    { const int tid0 = threadIdx.x;
      for (int u = tid0; u < (LDS_BYTES - RING_BYTES) / 4; u += NT) ((LAS unsigned*)(LL + RING_BYTES))[u] = 0u;
      __syncthreads();
      ParamsK Pb = kargs(); (void)xcd_barrier_post((unsigned*)(GP(unsigned char, Pb->ws) + WS_CTL) + CW_BAR, (volatile LAS unsigned*)(LL + MISC_OFF) + 8); }
    for (int li = 0; li < 2; ++li) {
        { PH_IDS(); PH_PTRS();
          ph_convert_w<1, true>(SCR, bid, G, tid, PF(even_w_in) + (size_t)li * D * EVEN_IN, D, EVEN_IN, NE, PF(norm_w) + (size_t)(2 * li) * D, WA);
          ph_convert_w<0, false>(SCR, bid, G, tid, PF(even_w_out) + (size_t)li * 2048 * D, 2048, D, D, nullptr, WB);
          if (li == 0) ph_prologue(gw, ngw, lane, PF(x), hi, RS); else ph_rstd(gtid, gsz, SS, RS); }
        GRID_BAR();
        { PH_PTRS(); int G_ = gridDim.x, bid_ = blockIdx.x; asm volatile("" : "+s"(G_), "+s"(bid_)); const int G = G_, bid = bid_;
          pg8::Gemm g{hi, WA + (size_t)4096 * D, M, NE1, D, D}; pg8::EpiIn E{Y, NE1, RS, FDt, 10, M, nullptr, nullptr, 1 << 30, nullptr, nullptr, 0}; pg8::StaticOrder S; S.init(M, NE1, G, bid); S.wv = wv0;
          pg8::gemm_phase<pg8::EpiIn, pg8::StaticOrder, true, true>(LL, g, S, E); }
        GRID_BAR();
        { PH_IDS(); PH_PTRS();
          if (bid < 256) sd::ssd_unit<true>((char*)lds, tid, bid, Y, FDt, PF(conv_w) + (size_t)li * 4 * 1536, PF(conv_b) + (size_t)li * 1536, PF(dt_bias) + li * 16, PF(A_log) + li * 16, PF(ssd_D) + li * 16,
                                            PF(ssd_nw) + (size_t)li * 1024, STL, DEC, AO);
          ph_fox_cumsum(SCR, bid, tid, lane, wv, FDt, PF(fox_f_bias) + li * 8, CS); }
        GRID_BAR();
        { PH_IDS(); PH_PTRS(); sd::ssd_scan(gtid, gsz, STL, DEC); }
        GRID_BAR();
        { PH_IDS(); PH_PTRS();
          if (bid < 256) sd::ssd_unit<false>((char*)lds, tid, bid, Y, FDt, PF(conv_w) + (size_t)li * 4 * 1536, PF(conv_b) + (size_t)li * 1536, PF(dt_bias) + li * 16, PF(A_log) + li * 16, PF(ssd_D) + li * 16,
                                             PF(ssd_nw) + (size_t)li * 1024, STL, DEC, AO); }
        GRID_BAR();
        { PH_PTRS(); int G_ = gridDim.x, bid_ = blockIdx.x; asm volatile("" : "+s"(G_), "+s"(bid_)); const int G = G_, bid = bid_;
          pg8::Gemm g{hi, WA, M, 4096, D, D}; pg8::EpiIn E{Y, 4160, RS, nullptr, -1, M, (LAS float*)(LL + pg8::STAGE_BYTES), NRM, 12, Y + 3072, nullptr, 4160};     pg8::StaticOrder S; S.init(M, 4096, G, bid); S.wv = wv0;
          pg8::gemm_phase<pg8::EpiIn, pg8::StaticOrder, true, true>(LL, g, S, E); }
        GRID_BAR();
        { PH_IDS(); PH_PTRS(); fa::fox_phase((char*)lds, tid, bid, G, Y, CS, NRM, AO, (unsigned*)(ws + WS_CTL) + CW_QCNT + 512 * li); }
        GRID_BAR();
        { PH_PTRS(); int G_ = gridDim.x, bid_ = blockIdx.x; asm volatile("" : "+s"(G_), "+s"(bid_)); const int G = G_, bid = bid_;
          pg8::Gemm g{AO, WB, M, D, 2048, 2048}; pg8::EpiOut E{hi, SS, M, hi, 1024}; pg8::StaticOrder S; S.init(M, D, G, bid); S.wv = wv0;
          pg8::gemm_phase<pg8::EpiOut, pg8::StaticOrder, true, true>(LL, g, S, E); }
        GRID_BAR();
        { PH_IDS(); PH_PTRS();
          ph_convert_w<0, true>(SCR, bid, G, tid, PF(odd_w_in) + (size_t)li * D * ODD_IN, D, ODD_IN, ODD_IN, PF(norm_w) + (size_t)(2 * li + 1) * D, WA);
          ph_convert_w<0, false>(SCR, bid, G, tid, PF(odd_w_out) + (size_t)li * 2048 * D, 2048, D, D, nullptr, WB); ph_rstd(gtid, gsz, SS, RS); }
        GRID_BAR();
        { PH_PTRS(); int G_ = gridDim.x, bid_ = blockIdx.x; asm volatile("" : "+s"(G_), "+s"(bid_)); const int G = G_, bid = bid_;
          pg8::Gemm g{hi, WA, M, ODD_IN, D, D}; pg8::EpiIn E{YO, NO1, RS, nullptr, -1, M, nullptr, nullptr, NO1 / 256, lo, (bf16*)(ws + WS_GB), 1024}; pg8::StaticOrder S; S.init(M, ODD_IN, G, bid); S.wv = wv0;
          pg8::gemm_phase<pg8::EpiIn, pg8::StaticOrder, true, true>(LL, g, S, E); }
        GRID_BAR();
        { PH_IDS(); PH_PTRS(); if (bid < 256) hg::hgrn_state128((char*)lds, tid, bid, YO, PF(lb_logits), li, SLOC, DSEG); }
        GRID_BAR();
        { PH_IDS(); PH_PTRS(); if (bid < 256) hg::hgrn_passB((char*)lds, tid, bid, YO, PF(lb_logits), li, PF(hgrn_nw) + (size_t)li * 128, SLOC, DSEG, lo, (const bf16*)(ws + WS_GB)); }
        GRID_BAR();
        { PH_PTRS(); int G_ = gridDim.x, bid_ = blockIdx.x; asm volatile("" : "+s"(G_), "+s"(bid_)); const int G = G_, bid = bid_;
          pg8::Gemm g{YO, WB, M, D, 2048, NO1}; pg8::EpiOut E{hi, SS, M, li == 1 ? HFB : hi, li == 1 ? NO1 : 1024}; pg8::StaticOrder S; S.init(M, D, G, bid); S.wv = wv0;
          pg8::gemm_phase<pg8::EpiOut, pg8::StaticOrder, true, true>(LL, g, S, E); }
        GRID_BAR();
    }
    { PH_IDS(); PH_PTRS(); ph_final(gw, ngw, lane, HFB, SS, PF(final_w), GP(float, P->out)); }
}
}

extern "C" void kernel_launch(void* const* d_in, const int* in_sizes, int n_in, void* d_out, int out_size, void* d_ws, size_t ws_size, hipStream_t stream) {
    using namespace hy;
    static int grid = 0;
    if (grid == 0) {
        int dev = 0, cus = 0;
        if (hipGetDevice(&dev) != hipSuccess || hipDeviceGetAttribute(&cus, hipDeviceAttributeMultiprocessorCount, dev) != hipSuccess || cus <= 0) cus = 256;
        (void)hipFuncSetAttribute((const void*)mega_fwd, hipFuncAttributeMaxDynamicSharedMemorySize, LDS_BYTES);
        (void)hipGetLastError();
        grid = cus;
    }
    (void)hipMemsetAsync((char*)d_ws + WS_CTL, 0, CTL_ZERO_BYTES, stream);
    Params p{};
    p.x = (const float*)d_in[0]; p.norm_w = (const float*)d_in[1]; p.final_w = (const float*)d_in[2]; p.even_w_in = (const float*)d_in[3]; p.even_w_out = (const float*)d_in[4];
    p.fox_f_bias = (const float*)d_in[5]; p.conv_w = (const float*)d_in[6]; p.conv_b = (const float*)d_in[7]; p.dt_bias = (const float*)d_in[8]; p.A_log = (const float*)d_in[9];
    p.ssd_D = (const float*)d_in[10]; p.ssd_nw = (const float*)d_in[11]; p.odd_w_in = (const float*)d_in[12]; p.odd_w_out = (const float*)d_in[13]; p.lb_logits = (const float*)d_in[14];
    p.hgrn_nw = (const float*)d_in[15]; p.out = (float*)d_out; p.ws = (unsigned char*)d_ws;
    hipLaunchKernelGGL(mega_fwd, dim3(grid), dim3(NT), LDS_BYTES, stream, p);
}
```

```cpp
#include <hip/hip_runtime.h>
#include <cstdio>
#include <cstdint>
namespace pg8 {
#define PG8_LAS __attribute__((address_space(3)))
typedef unsigned short bf16_t;
typedef short bf16x8 __attribute__((ext_vector_type(8)));
typedef float f32x4 __attribute__((ext_vector_type(4)));
typedef unsigned u32x4 __attribute__((ext_vector_type(4)));
constexpr int BM = 256, BK = 64, HALF = 128, HTB = HALF * BK * 2  , STAGE_BYTES = 8 * HTB, NXCD = 8, WGM = 8, RSL_OFF = STAGE_BYTES + 8192  ;

__host__ __device__ __forceinline__ int lds_byte(int r, int c) { const int st = (r >> 4) * 2 + (c >> 5), rr = r & 15, cc = c & 31, ob = rr * 64 + cc * 2; return st * 1024 + (ob ^ (((ob >> 9) & 1) << 5)); }
__host__ __device__ __forceinline__ void stage_rc(int b, int& R, int& C) { const int st = b / 1024, sb = b % 1024, swz = sb ^ (((sb >> 9) & 1) << 5); R = (st >> 1) * 16 + swz / 64; C = (st & 1) * 32 + (swz % 64) / 2; }
__host__ __device__ __forceinline__ int perm32(int rho) { const int n = rho >> 4, i = rho & 15; return 8 * (i >> 2) + 4 * n + (i & 3); }

struct Unit { int pm, pn; };
struct Gemm { const bf16_t* A; const bf16_t* Bt; int M, N, K, lda; };

struct StaticOrder {
    int nM, nN, nwg, G, c, wv;
    __host__ __device__ void init(int M, int N, int G_, int c_) { nM = M / BM; nN = N / BM; nwg = nM * nN; G = G_; c = c_; }
    __host__ __device__ bool next(int i, Unit& u) const {
        const long L = (long)i * G + c; if (L >= nwg) return false;
        int wgid = (int)L; { const int q = nwg / NXCD, r = nwg % NXCD, xcd = wgid % NXCD, off = wgid / NXCD; wgid = (xcd < r ? xcd * (q + 1) : r * (q + 1) + (xcd - r) * q) + off; }
        const int nig = WGM * nN, gid = wgid / nig, fm = gid * WGM, gsz = (nM - fm) < WGM ? (nM - fm) : WGM;
        u.pm = fm + ((wgid % nig) % gsz); u.pn = (wgid % nig) / gsz; return true;
    }
    __device__ __forceinline__ void a_ready(const Unit&) const {}
    __device__ __forceinline__ void done(const Unit&) const {}
};

__device__ __forceinline__ unsigned cvt_pk_bf16(float lo, float hi) { unsigned r; asm volatile("v_cvt_pk_bf16_f32 %0, %1, %2" : "=v"(r) : "v"(lo), "v"(hi)); return r; }
__device__ __forceinline__ float bf_lo(unsigned w) { return __uint_as_float(w << 16); }
__device__ __forceinline__ float bf_hi(unsigned w) { return __uint_as_float(w & 0xffff0000u); }
typedef unsigned u32x2 __attribute__((ext_vector_type(2)));
__device__ __forceinline__ float lane_xor_f(float v, int mask, int lane) { return __int_as_float(__builtin_amdgcn_ds_bpermute((lane ^ mask) << 2, __float_as_int(v))); }

__device__ __forceinline__ float silu_f(float x) { return x * __builtin_amdgcn_rcpf(1.0f + __expf(-x)); }
struct EpiIn {
    static constexpr bool PERM = true, AFTER_DRAIN = false, RSL = true;
    bf16_t* O; int ldc; const float* RS; float* FDt; int fd_tile; int Mrows;
    PG8_LAS float* NP; float* NRM;
    int g_from; bf16_t* G0; bf16_t* G1; int ldg;
    __device__ __forceinline__ void operator()(const f32x4 (&acc)[2][2][4][2], const Unit& u, int wr, int wc, int fr, int fq, const PG8_LAS float* rsl) const {
        const int row0 = u.pm * BM + wr * 64 + fr;
        float rs[2][4];
#pragma unroll
        for (int ai = 0; ai < 2; ++ai)
#pragma unroll
            for (int m = 0; m < 4; ++m) rs[ai][m] = rsl[wr * 64 + fr + ai * HALF + m * 16];
        if (u.pn == fd_tile) {
            if (wc == 0 && fq < 3) {
#pragma unroll
                for (int ai = 0; ai < 2; ++ai)
#pragma unroll
                    for (int m = 0; m < 4; ++m) { const int r = row0 + ai * HALF + m * 16;
#pragma unroll
                        for (int n = 0; n < 2; ++n)
#pragma unroll
                            for (int j = 0; j < 4; ++j) FDt[(size_t)(8 * fq + 4 * n + j) * Mrows + r] = acc[ai][0][m][n][j] * rs[ai][m]; }
            }
            return;
        }
        if (u.pn >= g_from) {
            const int gi = u.pn - g_from; bf16_t* Gb = (gi < 4 ? G0 : G1) + (gi & 3) * BM + wc * 32 + 8 * fq;
#pragma unroll
            for (int ai = 0; ai < 2; ++ai)
#pragma unroll
                for (int m = 0; m < 4; ++m) { bf16_t* rowp = Gb + (size_t)(row0 + ai * HALF + m * 16) * ldg; const float s = rs[ai][m];
#pragma unroll
                    for (int bj = 0; bj < 2; ++bj) { const f32x4 v0 = acc[ai][bj][m][0] * s, v1 = acc[ai][bj][m][1] * s;
                        u32x4 w; w.x = cvt_pk_bf16(silu_f(v0[0]), silu_f(v0[1])); w.y = cvt_pk_bf16(silu_f(v0[2]), silu_f(v0[3])); w.z = cvt_pk_bf16(silu_f(v1[0]), silu_f(v1[1])); w.w = cvt_pk_bf16(silu_f(v1[2]), silu_f(v1[3]));
                        *(u32x4*)(rowp + bj * HALF) = w; } }
            return;
        }
        const int col0 = u.pn * BM + wc * 32 + 8 * fq;
        const bool nrm = NRM != nullptr && u.pn < 8;
#pragma unroll
        for (int ai = 0; ai < 2; ++ai)
#pragma unroll
            for (int m = 0; m < 4; ++m) { bf16_t* rowp = O + (size_t)(row0 + ai * HALF + m * 16) * ldc + col0; const float s = rs[ai][m];
#pragma unroll
                for (int bj = 0; bj < 2; ++bj) { const f32x4 v0 = acc[ai][bj][m][0] * s, v1 = acc[ai][bj][m][1] * s;
                    u32x4 w; w.x = cvt_pk_bf16(v0[0], v0[1]); w.y = cvt_pk_bf16(v0[2], v0[3]); w.z = cvt_pk_bf16(v1[0], v1[1]); w.w = cvt_pk_bf16(v1[2], v1[3]);
                    *(u32x4*)(rowp + bj * HALF) = w;
                    if (nrm) { float p = ((v0[0] * v0[0] + v0[1] * v0[1]) + (v0[2] * v0[2] + v0[3] * v0[3])) + ((v1[0] * v1[0] + v1[1] * v1[1]) + (v1[2] * v1[2] + v1[3] * v1[3]));
                        p += lane_xor_f(p, 16, fq * 16 + fr); p += lane_xor_f(p, 32, fq * 16 + fr);
                        if (fq == 0) NP[(wc * 256 + wr * 64 + fr + ai * HALF + m * 16) * 2 + bj] = p; } } }
        if (nrm) {
            asm volatile("s_waitcnt lgkmcnt(0)" ::: "memory"); __builtin_amdgcn_s_barrier();
            const int wid = wr * 4 + wc, lane = fq * 16 + fr, bjh = wid >> 2, tq = wid & 3, rl = 64 * tq + lane;
            float sq = (NP[(0 * 256 + rl) * 2 + bjh] + NP[(1 * 256 + rl) * 2 + bjh]) + (NP[(2 * 256 + rl) * 2 + bjh] + NP[(3 * 256 + rl) * 2 + bjh]);
#pragma unroll
            for (int o = 1; o < 64; o <<= 1) sq = fmaxf(sq, lane_xor_f(sq, o, lane));
            if (lane == 0) { const int b = u.pm >> 4, j = (u.pm & 15) * 4 + tq, h = (u.pn & 3) * 2 + bjh, which = u.pn < 4 ? 1 : 0;
                NRM[(size_t)(b * 8 + h) * 128 + which * 64 + j] = sqrtf(sq) * 1.003f; }
        }
    }
};
struct EpiGate {
    static constexpr bool PERM = true, AFTER_DRAIN = false, RSL = true;
    bf16_t* O; int ldc; const float* RS; int Mrows;
    __device__ __forceinline__ void operator()(const f32x4 (&acc)[2][2][4][2], const Unit& u, int wr, int wc, int fr, int fq, const PG8_LAS float* rsl) const {
        const int row0 = u.pm * BM + wr * 64 + fr;
        const int col0 = u.pn * BM + wc * 32 + 8 * fq;
        u32x4 ov[2][4][2]; float rs[2][4];
#pragma unroll
        for (int ai = 0; ai < 2; ++ai)
#pragma unroll
            for (int m = 0; m < 4; ++m) { const int r = row0 + ai * HALF + m * 16; rs[ai][m] = rsl[wr * 64 + fr + ai * HALF + m * 16]; const bf16_t* rowp = O + (size_t)r * ldc + col0;
#pragma unroll
                for (int bj = 0; bj < 2; ++bj) ov[ai][m][bj] = *(const u32x4*)(rowp + bj * HALF); }
        asm volatile("" ::: "memory");
#pragma unroll
        for (int ai = 0; ai < 2; ++ai)
#pragma unroll
            for (int m = 0; m < 4; ++m) { const int r = row0 + ai * HALF + m * 16; const float s = rs[ai][m]; bf16_t* rowp = O + (size_t)r * ldc + col0;
#pragma unroll
                for (int bj = 0; bj < 2; ++bj) { const f32x4 g0 = acc[ai][bj][m][0] * s, g1 = acc[ai][bj][m][1] * s; const u32x4 o = ov[ai][m][bj];
                    u32x4 w;
                    w.x = cvt_pk_bf16(bf_lo(o.x) * silu_f(g0[0]), bf_hi(o.x) * silu_f(g0[1])); w.y = cvt_pk_bf16(bf_lo(o.y) * silu_f(g0[2]), bf_hi(o.y) * silu_f(g0[3]));
                    w.z = cvt_pk_bf16(bf_lo(o.z) * silu_f(g1[0]), bf_hi(o.z) * silu_f(g1[1])); w.w = cvt_pk_bf16(bf_lo(o.w) * silu_f(g1[2]), bf_hi(o.w) * silu_f(g1[3]));
                    *(u32x4*)(rowp + bj * HALF) = w; } }
    }
};
struct EpiOut {
    static constexpr bool PERM = true, AFTER_DRAIN = false, RSL = false;
    bf16_t* hi; float* SS; int Mrows; bf16_t* ho; int ho_pitch;
    __device__ __forceinline__ void operator()(const f32x4 (&acc)[2][2][4][2], const Unit& u, int wr, int wc, int fr, int fq, const PG8_LAS float*) const {
        const int row0 = u.pm * BM + wr * 64 + fr, col0 = u.pn * BM + wc * 32 + 8 * fq;
        u32x4 ah[2][4][2];
#pragma unroll
        for (int ai = 0; ai < 2; ++ai)
#pragma unroll
            for (int m = 0; m < 4; ++m) { const size_t off = (size_t)(row0 + ai * HALF + m * 16) * 1024 + col0;
#pragma unroll
                for (int bj = 0; bj < 2; ++bj) ah[ai][m][bj] = *(const u32x4*)(hi + off + bj * HALF); }
        asm volatile("" ::: "memory");
#pragma unroll
        for (int ai = 0; ai < 2; ++ai)
#pragma unroll
            for (int m = 0; m < 4; ++m) { const int r = row0 + ai * HALF + m * 16; const size_t off = (size_t)r * 1024 + col0; float ssq = 0.f;
#pragma unroll
                for (int bj = 0; bj < 2; ++bj) { const u32x4 a = ah[ai][m][bj]; const f32x4 c0 = acc[ai][bj][m][0], c1 = acc[ai][bj][m][1];
                    const float h0 = bf_lo(a.x) + c0[0], h1 = bf_hi(a.x) + c0[1], h2 = bf_lo(a.y) + c0[2], h3 = bf_hi(a.y) + c0[3];
                    const float h4 = bf_lo(a.z) + c1[0], h5 = bf_hi(a.z) + c1[1], h6 = bf_lo(a.w) + c1[2], h7 = bf_hi(a.w) + c1[3];
                    ssq += ((h0 * h0 + h1 * h1) + (h2 * h2 + h3 * h3)) + ((h4 * h4 + h5 * h5) + (h6 * h6 + h7 * h7));
                    { u32x4 nh; nh.x = cvt_pk_bf16(h0, h1); nh.y = cvt_pk_bf16(h2, h3); nh.z = cvt_pk_bf16(h4, h5); nh.w = cvt_pk_bf16(h6, h7); *(u32x4*)(ho + (size_t)r * ho_pitch + col0 + bj * HALF) = nh; } }
                ssq += lane_xor_f(ssq, 16, fq * 16 + fr); ssq += lane_xor_f(ssq, 32, fq * 16 + fr);
                if (fq == 0) SS[(size_t)(u.pn * 4 + wc) * Mrows + r] = ssq; }
    }
};
template <class Epi, class Sched, bool ALIGN_EPI = false, bool SP2 = false>
__device__ __forceinline__ void gemm_phase(PG8_LAS unsigned char* lds, const Gemm g, const Sched& S, const Epi& E) {
    int l_ = __builtin_amdgcn_mbcnt_hi(~0u, __builtin_amdgcn_mbcnt_lo(~0u, 0u)); asm volatile("" : "+v"(l_)); const int wid = S.wv, tid = wid * 64 + l_, lane = tid & 63, wr = wid >> 2, wc = wid & 3, fr = lane & 15, fq = lane >> 4;
    const int K = g.K, nt = K / BK;
    unsigned voffA[2], voffB[2];
#pragma unroll
    for (int i = 0; i < 2; ++i) { int R, C; stage_rc(tid * 16 + i * 8192, R, C); const int Rb = Epi::PERM ? ((R & ~31) + perm32(R & 31)) : R;
        voffA[i] = (unsigned)(R * g.lda + C) * 2u; voffB[i] = (unsigned)(Rb * K + C) * 2u; }
    const size_t kstep = (size_t)(BK * 2);
    const size_t hstepA = (size_t)HALF * g.lda * 2, hstepB = (size_t)HALF * K * 2;
    const size_t tstepA = 2 * hstepA, tstepB = 2 * hstepB;
    const unsigned ldsw = (unsigned)wid * 1024u;
    const int aoff = lds_byte(wr * 64 + fr, fq * 8), boff = lds_byte(wc * 32 + fr, fq * 8);
#define PG8_SA(b, h) (((b) * 2 + (h)) * HTB)
#define PG8_SB(b, h) ((4 + (b) * 2 + (h)) * HTB)
#define PG8_STAGE(bufoff, gbase, voff) do { _Pragma("unroll") for (int _i = 0; _i < 2; ++_i) \
        __builtin_amdgcn_global_load_lds((const unsigned*)((const char*)(gbase) + (voff)[_i]), (PG8_LAS unsigned*)(lds + (bufoff) + ldsw + _i * 8192), 16, 0, 0); } while (0)
#define PG8_LDA(dst, b, h) do { _Pragma("unroll") for (int m = 0; m < 4; ++m) _Pragma("unroll") for (int k = 0; k < 2; ++k) dst[m][k] = *(const PG8_LAS bf16x8*)(lds + PG8_SA(b, h) + aoff + m * 2048 + k * 1024); } while (0)
#define PG8_LDB(dst, b, h) do { _Pragma("unroll") for (int n = 0; n < 2; ++n) _Pragma("unroll") for (int k = 0; k < 2; ++k) dst[n][k] = *(const PG8_LAS bf16x8*)(lds + PG8_SB(b, h) + boff + n * 2048 + k * 1024); } while (0)
#define PG8_MMA(ai, bj, At, Bt) do { __builtin_amdgcn_s_setprio(1); _Pragma("unroll") for (int m = 0; m < 4; ++m) _Pragma("unroll") for (int n = 0; n < 2; ++n) _Pragma("unroll") for (int k = 0; k < 2; ++k) \
        acc[ai][bj][m][n] = __builtin_amdgcn_mfma_f32_16x16x32_bf16(Bt[n][k], At[m][k], acc[ai][bj][m][n], 0, 0, 0); __builtin_amdgcn_s_setprio(0); } while (0)
#define PG8_WAIT_V(n) asm volatile("s_waitcnt vmcnt(" #n ")" ::: "memory")
#define PG8_WAIT_L(n) asm volatile("s_waitcnt lgkmcnt(" #n ")" ::: "memory")
#define PG8_BAR __builtin_amdgcn_s_barrier()
#define PG8_SCHED __builtin_amdgcn_sched_barrier(0)
    Unit cur, nxt; int ui = 0;
    if (!S.next(0, cur)) return;
    f32x4 acc[2][2][4][2];
#pragma unroll
    for (int a = 0; a < 2; ++a)
#pragma unroll
        for (int b = 0; b < 2; ++b)
#pragma unroll
            for (int m = 0; m < 4; ++m)
#pragma unroll
                for (int n = 0; n < 2; ++n) acc[a][b][m][n] = (f32x4){0.f, 0.f, 0.f, 0.f};
    bf16x8 At[4][2], B0[2][2], B1[2][2];
    const char* cA = (const char*)g.A + (size_t)cur.pm * tstepA; const char* cB = (const char*)g.Bt + (size_t)cur.pn * tstepB;
    S.a_ready(cur);
#define PG8_RS_STAGE(pm_, slot_) do { if (wid < 4) __builtin_amdgcn_global_load_lds((const unsigned*)(E.RS + (size_t)(pm_) * BM + wid * 64 + lane), (PG8_LAS unsigned*)(lds + RSL_OFF + (slot_) * 1024 + wid * 256), 4, 0, 0); } while (0)
    if constexpr (Epi::RSL) PG8_RS_STAGE(cur.pm, 0);
    if constexpr (SP2) {
        PG8_STAGE(PG8_SB(0, 0), cB, voffB); PG8_STAGE(PG8_SB(0, 1), cB + hstepB, voffB); PG8_STAGE(PG8_SA(0, 0), cA, voffA); PG8_STAGE(PG8_SA(0, 1), cA + hstepA, voffA);
        if (wr == 1) PG8_BAR;
        PG8_WAIT_V(2); PG8_BAR;
        PG8_STAGE(PG8_SB(1, 0), cB + kstep, voffB); PG8_STAGE(PG8_SA(1, 0), cA + kstep, voffA); PG8_STAGE(PG8_SB(1, 1), cB + hstepB + kstep, voffB);
        PG8_WAIT_V(6); PG8_BAR;
    } else {
        PG8_STAGE(PG8_SB(0, 0), cB, voffB); PG8_STAGE(PG8_SA(0, 0), cA, voffA); PG8_STAGE(PG8_SB(0, 1), cB + hstepB, voffB); PG8_STAGE(PG8_SA(0, 1), cA + hstepA, voffA);
        if (wr == 1) PG8_BAR;
        PG8_WAIT_V(4); PG8_BAR;
        PG8_STAGE(PG8_SB(1, 0), cB + kstep, voffB); PG8_STAGE(PG8_SA(1, 0), cA + kstep, voffA); PG8_STAGE(PG8_SB(1, 1), cB + hstepB + kstep, voffB);
        PG8_WAIT_V(6); PG8_BAR;
    }
    for (;;) {
        const bool has_next = S.next(ui + 1, nxt);
        const char* nA = has_next ? (const char*)g.A + (size_t)nxt.pm * tstepA : cA; const char* nB = has_next ? (const char*)g.Bt + (size_t)nxt.pn * tstepB : cB;
        for (int t = 0; t < nt; t += 2) {
            const bool last = (t == nt - 2);
            const char* a1 = cA + (size_t)(t + 1) * kstep;
            const char* a2 = last ? nA : cA + (size_t)(t + 2) * kstep; const char* b2 = last ? nB : cB + (size_t)(t + 2) * kstep;
            const char* a3 = a2 + kstep; const char* b3 = b2 + kstep;
            if (last && has_next) { S.a_ready(nxt); if constexpr (Epi::RSL) PG8_RS_STAGE(nxt.pm, (ui + 1) & 1); }
            if constexpr (SP2) {
            PG8_LDB(B0, 0, 0); PG8_LDB(B1, 0, 1); PG8_SCHED; PG8_LDA(At, 0, 0); PG8_STAGE(PG8_SA(1, 1), a1 + hstepA, voffA);
            PG8_WAIT_V(8); PG8_WAIT_L(0); PG8_BAR; PG8_MMA(0, 0, At, B0); PG8_MMA(0, 1, At, B1); PG8_BAR; PG8_SCHED;
            PG8_LDA(At, 0, 1); PG8_STAGE(PG8_SB(0, 0), b2, voffB); PG8_STAGE(PG8_SB(0, 1), b2 + hstepB, voffB); PG8_STAGE(PG8_SA(0, 0), a2, voffA);
            PG8_WAIT_V(8); PG8_WAIT_L(0); PG8_BAR; PG8_MMA(1, 0, At, B0); PG8_MMA(1, 1, At, B1); PG8_BAR; PG8_SCHED;
            PG8_LDB(B0, 1, 0); PG8_LDB(B1, 1, 1); PG8_SCHED; PG8_LDA(At, 1, 0); PG8_STAGE(PG8_SA(0, 1), a2 + hstepA, voffA);
            PG8_WAIT_V(8); PG8_WAIT_L(0); PG8_BAR; PG8_MMA(0, 0, At, B0); PG8_MMA(0, 1, At, B1); PG8_BAR; PG8_SCHED;
            PG8_LDA(At, 1, 1); PG8_STAGE(PG8_SB(1, 0), b3, voffB); PG8_STAGE(PG8_SB(1, 1), b3 + hstepB, voffB); PG8_STAGE(PG8_SA(1, 0), a3, voffA);
            PG8_WAIT_V(8); PG8_WAIT_L(0); PG8_BAR; PG8_MMA(1, 0, At, B0); PG8_MMA(1, 1, At, B1); PG8_BAR; PG8_SCHED;
            } else {
            PG8_LDB(B0, 0, 0); PG8_SCHED; PG8_LDA(At, 0, 0); PG8_STAGE(PG8_SA(1, 1), a1 + hstepA, voffA);
            PG8_WAIT_L(8); PG8_BAR; PG8_WAIT_L(0); PG8_MMA(0, 0, At, B0); PG8_BAR; PG8_SCHED;
            PG8_LDB(B1, 0, 1); PG8_STAGE(PG8_SB(0, 0), b2, voffB);
            PG8_BAR; PG8_WAIT_L(0); PG8_MMA(0, 1, At, B1); PG8_BAR;
            PG8_LDA(At, 0, 1); PG8_STAGE(PG8_SA(0, 0), a2, voffA);
            PG8_BAR; PG8_WAIT_L(0); PG8_MMA(1, 0, At, B0); PG8_BAR; PG8_SCHED;
            PG8_STAGE(PG8_SB(0, 1), b2 + hstepB, voffB);
            PG8_WAIT_V(6); PG8_BAR; PG8_MMA(1, 1, At, B1); PG8_BAR;
            PG8_LDB(B0, 1, 0); PG8_SCHED; PG8_LDA(At, 1, 0); PG8_STAGE(PG8_SA(0, 1), a2 + hstepA, voffA);
            PG8_WAIT_L(8); PG8_BAR; PG8_WAIT_L(0); PG8_MMA(0, 0, At, B0); PG8_BAR; PG8_SCHED;
            PG8_LDB(B1, 1, 1); PG8_STAGE(PG8_SB(1, 0), b3, voffB);
            PG8_BAR; PG8_WAIT_L(0); PG8_MMA(0, 1, At, B1); PG8_BAR;
            PG8_LDA(At, 1, 1); PG8_STAGE(PG8_SA(1, 0), a3, voffA);
            PG8_BAR; PG8_WAIT_L(0); PG8_MMA(1, 0, At, B0); PG8_BAR; PG8_SCHED;
            PG8_STAGE(PG8_SB(1, 1), b3 + hstepB, voffB);
            PG8_WAIT_V(6); PG8_BAR; PG8_MMA(1, 1, At, B1); PG8_BAR;
            }
        }
        if constexpr (ALIGN_EPI) { if (wr == 0) PG8_BAR; }
        if constexpr (!Epi::AFTER_DRAIN) { E(acc, cur, wr, wc, fr, fq, (const PG8_LAS float*)(lds + RSL_OFF + (ui & 1) * 1024)); S.done(cur); }
        if (!has_next) break;
#pragma unroll
        for (int a = 0; a < 2; ++a)
#pragma unroll
            for (int b = 0; b < 2; ++b)
#pragma unroll
                for (int m = 0; m < 4; ++m)
#pragma unroll
                    for (int n = 0; n < 2; ++n) acc[a][b][m][n] = (f32x4){0.f, 0.f, 0.f, 0.f};
        cur = nxt; cA = nA; cB = nB; ++ui;
        if constexpr (ALIGN_EPI) { if (wr == 1) PG8_BAR; }
    }
    PG8_WAIT_V(0);
    if constexpr (!ALIGN_EPI) { if (wr == 0) PG8_BAR; }
    PG8_BAR;
    if constexpr (Epi::AFTER_DRAIN) { E.fused(acc, cur, wr, wc, fr, fq, lds, wid, lane); S.done(cur); }
#undef PG8_RS_STAGE
#undef PG8_SA
#undef PG8_SB
#undef PG8_STAGE
#undef PG8_LDA
#undef PG8_LDB
#undef PG8_MMA
#undef PG8_WAIT_V
#undef PG8_WAIT_L
#undef PG8_BAR
#undef PG8_SCHED
}
}
namespace fa {
typedef unsigned short bf16;
typedef short bf16x8 __attribute__((ext_vector_type(8)));
typedef short s16x4 __attribute__((ext_vector_type(4)));
typedef float f32x16 __attribute__((ext_vector_type(16)));
typedef float f32x4 __attribute__((ext_vector_type(4)));
typedef unsigned u32x4 __attribute__((ext_vector_type(4)));
typedef unsigned u32x2 __attribute__((ext_vector_type(2)));
constexpr int D = 128, NW = 8, QBLK = 32, KVBLK = 64, QB = NW * QBLK, SEQ = 4096;
constexpr int PQ = 4160, PO = 2048;
constexpr int SHM_V = KVBLK * D * 2, SHM_K = KVBLK * D * 2;
constexpr int LDS_WS = 2 * SHM_V + 2 * SHM_K, LDS_CS = LDS_WS + NW * 64 * 4, LDS_Q = LDS_CS + SEQ * 4, LDS_ITEM = LDS_Q + NW * (8 - 7) * 1024, LDS_BYTES = LDS_ITEM + 16 + 256;
constexpr int QREG = 7;
constexpr float SCALE = 0.08838834764831845f, THR = 8.f;
#define KSWZ(row, colB) ((row) * 256 + ((colB) ^ (((row) & 7) << 4)))
#define SBAR() __builtin_amdgcn_sched_barrier(0)
__device__ __forceinline__ int v_st(int k, int c) { const int kk = (k & ~0xC) | ((k & 4) << 1) | ((k & 8) >> 1); return ((kk >> 3) * 4 + (c >> 5)) * 512 + ((kk & 7) * 32 + (c & 31)) * 2; }
__device__ __forceinline__ int v_rd_base(int lane) { return ((lane & 3) << 3) | (((lane >> 2) & 3) << 6) | (((lane >> 4) & 1) << 5) | (((lane >> 5) & 1) << 8); }
constexpr int v_rd_off(int d0, int ks, int half) { return d0 * 512 + ks * 4096 + half * 2048; }
__device__ __forceinline__ int crow(int r, int hi) { return (r & 3) + 8 * (r >> 2) + 4 * hi; }
__device__ __forceinline__ unsigned cvtpk(float lo, float hi) {
    unsigned r; asm volatile("v_cvt_pk_bf16_f32 %0, %1, %2" : "=v"(r) : "v"(lo), "v"(hi)); return r;
}
__device__ __forceinline__ bf16x8 pack8(f32x4 a, f32x4 b) {
    u32x4 w = {cvtpk(a[0], a[1]), cvtpk(a[2], a[3]), cvtpk(b[0], b[1]), cvtpk(b[2], b[3])};
    return *reinterpret_cast<bf16x8*>(&w);
}
__device__ __forceinline__ bf16x8 ld8(const unsigned short* p) { return *reinterpret_cast<const bf16x8*>(p); }
__device__ __forceinline__ void mask_tile(f32x16& p0, f32x16& p1, int dq, unsigned W) {
    const float NEG = -__builtin_inff();
#pragma unroll
    for (int r = 0; r < 16; ++r) {
        const int c = (r & 3) + 8 * (r >> 2);
        if ((unsigned)(dq - c) >= W) p0[r] = NEG;
        if ((unsigned)(dq - c - 32) >= W) p1[r] = NEG;
    }
}
__device__ __forceinline__ void partialSM(f32x16& p0, f32x16& p1, float& m_reg, float& mn, float& alpha) {
    float pmax = p0[0]; for (int r = 1; r < 16; ++r) pmax = fmaxf(pmax, p0[r]); for (int r = 0; r < 16; ++r) pmax = fmaxf(pmax, p1[r]);
    { auto rr = __builtin_amdgcn_permlane32_swap(__float_as_uint(pmax), __float_as_uint(pmax), false, false);
      pmax = fmaxf(__uint_as_float(rr[0]), __uint_as_float(rr[1])); }
    constexpr float C2 = 1.4426950408889634f * SCALE;
    if (__builtin_expect(__all((pmax - m_reg) * SCALE <= THR), 1)) { mn = m_reg; alpha = 1.f; }
    else { mn = fmaxf(m_reg, pmax); alpha = __builtin_amdgcn_exp2f((m_reg - mn) * C2); m_reg = mn; }
    const float mnL = -mn * C2;
    for (int r = 0; r < 16; ++r) p0[r] = fmaf(p0[r], C2, mnL); for (int r = 0; r < 16; ++r) p1[r] = fmaf(p1[r], C2, mnL);
    for (int r = 0; r < 16; ++r) p0[r] = __builtin_amdgcn_exp2f(p0[r]);
}
__device__ __forceinline__ void finishSM(f32x16& p0, f32x16& p1, float alpha, float& l_reg, bf16x8& pa0, bf16x8& pa1, bf16x8& pa2, bf16x8& pa3) {
    for (int r = 0; r < 16; ++r) p1[r] = __builtin_amdgcn_exp2f(p1[r]);
    float ps = 0; for (int r = 0; r < 16; ++r) ps += p0[r]; for (int r = 0; r < 16; ++r) ps += p1[r];
    { auto rr = __builtin_amdgcn_permlane32_swap(__float_as_uint(ps), __float_as_uint(ps), false, false);
      ps = __uint_as_float(rr[0]) + __uint_as_float(rr[1]); }
    l_reg = l_reg * alpha + ps;
#define PK4(P, B_, OUT) do { unsigned a0 = cvtpk(P[B_+0], P[B_+1]), a1 = cvtpk(P[B_+2], P[B_+3]);                          \
        unsigned b0 = cvtpk(P[B_+4], P[B_+5]), b1 = cvtpk(P[B_+6], P[B_+7]);                                             \
        auto r0 = __builtin_amdgcn_permlane32_swap(a0, b0, false, false); auto r1 = __builtin_amdgcn_permlane32_swap(a1, b1, false, false); \
        u32x4 w = {r0[0], r1[0], r0[1], r1[1]}; OUT = *reinterpret_cast<bf16x8*>(&w); } while (0)
    PK4(p0, 0, pa0); PK4(p0, 8, pa1); PK4(p1, 0, pa2); PK4(p1, 8, pa3);
#undef PK4
}
template <int KB>
__device__ __forceinline__ void qkt(f32x16& p0, f32x16& p1, const char* K_lds, const float* nck, int r32, int hi, const bf16x8* qr, const char* q_lds) {
#pragma unroll
    for (int g = 0; g < 4; ++g) { const f32x4 a = *(const f32x4*)(nck + 8 * g + 4 * hi), b = *(const f32x4*)(nck + 32 + 8 * g + 4 * hi);
#pragma unroll
        for (int j = 0; j < 4; ++j) { p0[4 * g + j] = a[j]; p1[4 * g + j] = b[j]; } }
    const char* kb[4];
#pragma unroll
    for (int dd = 0; dd < 4; ++dd) kb[dd] = K_lds + KB * SHM_K + KSWZ(r32, (dd * 16 + hi * 8) * 2);
#pragma unroll
    for (int d0 = 0; d0 < 8; ++d0) { const char* a = kb[d0 & 3] + (d0 >> 2) * 128;
        bf16x8 b0 = *reinterpret_cast<const bf16x8*>(a);
        bf16x8 b1 = *reinterpret_cast<const bf16x8*>(a + 32 * 256);
        const bf16x8 qf = d0 < QREG ? qr[d0] : *reinterpret_cast<const bf16x8*>(q_lds + (d0 - QREG) * 1024);
        p0 = __builtin_amdgcn_mfma_f32_32x32x16_bf16(b0, qf, p0, 0, 0, 0);
        p1 = __builtin_amdgcn_mfma_f32_32x32x16_bf16(b1, qf, p1, 0, 0, 0); }
}
template <int VB, bool SK>
__device__ __forceinline__ void pv_tile(f32x16* o, int vb0, bf16x8 pa0, bf16x8 pa1, bf16x8 pa2, bf16x8 pa3, bool act) {
    if (SK && !act) return;
#define TRRD(dst, off) asm volatile("ds_read_b64_tr_b16 %0, %1 offset:%2" : "=&v"(dst) : "v"(vb0), "i"(off) : "memory")
#define PV_D0(d0) do { s16x4 l0, l1, l2, l3, h0, h1, h2, h3; constexpr int b_ = VB * SHM_V + v_rd_off(d0, 0, 0);     \
        TRRD(l0, b_); TRRD(h0, b_ + 2048); TRRD(l1, b_ + 4096); TRRD(h1, b_ + 6144); TRRD(l2, b_ + 8192); TRRD(h2, b_ + 10240); TRRD(l3, b_ + 12288); TRRD(h3, b_ + 14336); \
        asm volatile("s_waitcnt lgkmcnt(0)" ::: "memory"); SBAR();                 \
        o[d0] = __builtin_amdgcn_mfma_f32_32x32x16_bf16(pa0, (bf16x8){l0[0], l0[1], l0[2], l0[3], h0[0], h0[1], h0[2], h0[3]}, o[d0], 0, 0, 0);   \
        o[d0] = __builtin_amdgcn_mfma_f32_32x32x16_bf16(pa1, (bf16x8){l1[0], l1[1], l1[2], l1[3], h1[0], h1[1], h1[2], h1[3]}, o[d0], 0, 0, 0);   \
        o[d0] = __builtin_amdgcn_mfma_f32_32x32x16_bf16(pa2, (bf16x8){l2[0], l2[1], l2[2], l2[3], h2[0], h2[1], h2[2], h2[3]}, o[d0], 0, 0, 0);   \
        o[d0] = __builtin_amdgcn_mfma_f32_32x32x16_bf16(pa3, (bf16x8){l3[0], l3[1], l3[2], l3[3], h3[0], h3[1], h3[2], h3[3]}, o[d0], 0, 0, 0); } while (0)
    PV_D0(0); PV_D0(1); PV_D0(2); PV_D0(3);
#undef PV_D0
#undef TRRD
}
struct BlockRef { const bf16* Q; const bf16* K; const bf16* V; const bf16* G; bf16* O; int P0; int jlo; int bh; int jw; };
struct Seam { bf16x8 qr[8]; bf16x8 st_v0, st_v1, st_k0, st_k1; };
#define ROW(p, k0, rr) ((p) + (size_t)((k0) + (rr)) * PQ + sc)
#define VMW() asm volatile("s_waitcnt vmcnt(0)" ::: "memory")
#define VMWN(n) asm volatile("s_waitcnt vmcnt(%0)" :: "i"(n) : "memory")
#define SLOAD_H(Kp, Vp, k0) do { S.st_v0 = ld8(ROW(Vp, k0, sr)); S.st_v1 = ld8(ROW(Vp, k0, 32 + sr)); S.st_k0 = ld8(ROW(Kp, k0, sr)); S.st_k1 = ld8(ROW(Kp, k0, 32 + sr)); } while (0)
#define SWRITE_HK(bf) do { *(bf16x8*)(K_lds + (bf) * SHM_K + kws) = S.st_k0; *(bf16x8*)(K_lds + (bf) * SHM_K + kws + 32 * 256) = S.st_k1; } while (0)
#define SWRITE_HV(bf) do { *(bf16x8*)(V_lds + (bf) * SHM_V + vst0) = S.st_v0; *(bf16x8*)(V_lds + (bf) * SHM_V + vst1) = S.st_v1; } while (0)
#define SWRITE_H(bf) do { SWRITE_HV(bf); SWRITE_HK(bf); } while (0)
__device__ __forceinline__ void fox_prime(const BlockRef& cur, char* lds, Seam& S, int tid) {
    const int wid = __builtin_amdgcn_readfirstlane(tid >> 6), lane = tid & 63, r32 = lane & 31, hi = lane >> 5;
    const int sr = tid >> 4, sc = (tid & 15) * 8, kws = KSWZ(sr, sc * 2); char* K_lds = lds + 2 * SHM_V;
#pragma unroll
    for (int d0 = 0; d0 < 8; ++d0) S.qr[d0] = ld8(cur.Q + (size_t)(wid * QBLK + r32) * PQ + d0 * 16 + hi * 8);
    SLOAD_H(cur.K, cur.V, cur.P0 + 3 * KVBLK); VMW(); SWRITE_HK(0);
    __syncthreads();
}
__device__ __forceinline__ void fox_block(const BlockRef& cur, const BlockRef& nxt, char* lds, Seam& S, int tid, const float* ncs_next  ) {
    const int wid = __builtin_amdgcn_readfirstlane(tid >> 6), lane = tid & 63, r32 = lane & 31, hi = lane >> 5;
    const int NT = cur.P0 / KVBLK + 4 - cur.jlo;
    const unsigned W = 1u << 30;
    const int koff = cur.jlo * KVBLK, klo_w = (cur.jw - cur.jlo) * KVBLK;
    const int qlo = cur.P0 - koff + wid * QBLK, qm = qlo + r32 - 4 * hi;
    char* V_lds = lds; char* K_lds = lds + 2 * SHM_V;
    float* ws = (float*)(lds + LDS_WS) + wid * 64; float* li_l = ws, * al_l = ws + 32;
    const float* cs_l = (const float*)(lds + LDS_CS) + koff;
    float m_reg = -1e30f, l_reg = 0; f32x16 o[4] = {};
    const int sr = tid >> 4, sc = (tid & 15) * 8, vst0 = v_st(sr, sc), vst1 = v_st(32 + sr, sc), kws = KSWZ(sr, sc * 2);
    const int vb0 = (int)(uintptr_t)V_lds + v_rd_base(lane);
    char* q_lds = lds + LDS_Q + wid * (8 - QREG) * 1024 + lane * 16;
    const bf16* Kh = cur.K + (size_t)koff * PQ; const bf16* Vh = cur.V + (size_t)koff * PQ;
#define RESC(a) do { if (__any((a) < 1.f)) { if (hi == 0) al_l[r32] = (a); asm volatile("s_waitcnt lgkmcnt(0)" ::: "memory");              \
                     for (int d_ = 0; d_ < 4; ++d_) for (int r = 0; r < 16; ++r) o[d_][r] *= al_l[crow(r, hi)]; } } while (0)
#define KBASE(t) ((NT - 1 - (t)) * KVBLK)
#define ACT(t) (KBASE(t) <= qlo + QBLK - 1 && KBASE(t) >= klo_w)
#define MASKT(P0_, P1_, t) do { const int kb_ = KBASE(t); if (kb_ + KVBLK - 1 > qlo) mask_tile(P0_, P1_, qm - kb_, W); } while (0)
#define SEAM_K0() do { VMWN(8); SWRITE_HK(0); SBAR(); } while (0)
    f32x16 pA0, pA1, pB0, pB1; float mnA, mnB, alA, alB; bf16x8 pa0, pa1, pa2, pa3;
    SWRITE_HV(0);
#pragma unroll
    for (int d0 = QREG; d0 < 8; ++d0) *(bf16x8*)(q_lds + (d0 - QREG) * 1024) = S.qr[d0];
    SBAR();
    if (NT > 1) SLOAD_H(Kh, Vh, KBASE(1));
    SBAR(); if (ACT(0)) { qkt<0>(pA0, pA1, K_lds, cs_l + KBASE(0), r32, hi, S.qr, q_lds);
        MASKT(pA0, pA1, 0); partialSM(pA0, pA1, m_reg, mnA, alA); } else { alA = 1.f; mnA = m_reg; }
    if (NT > 1) { VMW(); SWRITE_H(1); }
    __syncthreads();
#define HALF_STEP(PX0, PX1, mnX, alX, PY0, PY1, alY, t, KB, VB, SB) do {                                                      \
        SBAR(); if ((t) + 1 < NT) { SLOAD_H(Kh, Vh, KBASE((t) + 1)); SBAR(); }     \
        const bool ax_ = ACT(t), ay_ = ACT((t) - 1);                                                                          \
        if (ax_) qkt<KB>(PX0, PX1, K_lds, cs_l + KBASE(t), r32, hi, S.qr, q_lds);                                        \
        if (ay_) finishSM(PY0, PY1, alY, l_reg, pa0, pa1, pa2, pa3); SBAR();                                                  \
        if (ay_) pv_tile<VB, false>(o, vb0, pa0, pa1, pa2, pa3, true);                                                        \
        if (ax_) { MASKT(PX0, PX1, (t)); partialSM(PX0, PX1, m_reg, mnX, alX); } else { alX = 1.f; mnX = m_reg; }             \
        __syncthreads();                                                                                                      \
        if ((t) + 1 < NT) { VMW(); SWRITE_H(SB); }                                                                            \
        RESC(alX); __syncthreads(); } while (0)
    for (int t = 1; t + 1 < NT; t += 2) {
        HALF_STEP(pB0, pB1, mnB, alB, pA0, pA1, alA, t, 1, 0, 0);
        HALF_STEP(pA0, pA1, mnA, alA, pB0, pB1, alB, t + 1, 0, 1, 1);
    }
    const bool even = (NT & 1) == 0;
    const bool aL_ = ACT(NT - 1), aA_ = even ? ACT(NT - 2) : aL_;
    if (even) { SBAR(); if (aL_) qkt<1>(pB0, pB1, K_lds, cs_l + KBASE(NT - 1), r32, hi, S.qr, q_lds); SBAR(); }
    SLOAD_H(nxt.K, nxt.V, nxt.P0 + 3 * KVBLK); SBAR();
#pragma unroll
    for (int d0 = 0; d0 < 8; ++d0) S.qr[d0] = ld8(nxt.Q + (size_t)(wid * QBLK + r32) * PQ + d0 * 16 + hi * 8);
    SBAR();
    if (aA_) finishSM(pA0, pA1, alA, l_reg, pa0, pa1, pa2, pa3); SBAR();
    if (aA_) pv_tile<0, false>(o, vb0, pa0, pa1, pa2, pa3, true);
    if (even) { if (aL_) { MASKT(pB0, pB1, NT - 1); partialSM(pB0, pB1, m_reg, mnB, alB); } else { alB = 1.f; mnB = m_reg; } __syncthreads(); RESC(alB);
        if (aL_) { finishSM(pB0, pB1, alB, l_reg, pa0, pa1, pa2, pa3); SBAR(); pv_tile<1, false>(o, vb0, pa0, pa1, pa2, pa3, true); } }
    SBAR(); SEAM_K0();
    if (ncs_next) { const f32x4* src_ = (const f32x4*)ncs_next; f32x4* dst_ = (f32x4*)(lds + LDS_CS);
        dst_[tid] = src_[tid]; dst_[tid + 512] = src_[tid + 512]; }
    if (hi == 0) li_l[r32] = l_reg; asm volatile("s_waitcnt lgkmcnt(0)" ::: "memory");
    float rli[16];
#pragma unroll
    for (int r = 0; r < 16; ++r) rli[r] = __builtin_amdgcn_rcpf(li_l[crow(r, hi)]);
    typedef float f32x2_t __attribute__((ext_vector_type(2))); typedef __bf16 bf16x2_t __attribute__((ext_vector_type(2)));
#define FA_CVT(lo_, hi_) __builtin_bit_cast(unsigned, __builtin_convertvector((f32x2_t){lo_, hi_}, bf16x2_t))
    { const unsigned selx = (r32 & 1) ? 0x03020706u : 0x05040100u;
      const bool b1 = (r32 & 2) != 0;
      bf16* Ow = cur.O + (size_t)(wid * QBLK + 4 * hi + (r32 & 3)) * PO + (r32 & ~3);
      const bf16* Gw = cur.G + (size_t)(wid * QBLK + 4 * hi + (r32 & 3)) * PQ + (r32 & ~3);
      u32x2 gl[4][4];
#pragma unroll
      for (int g4 = 0; g4 < 4; ++g4)
#pragma unroll
          for (int d0 = 0; d0 < 4; ++d0) gl[g4][d0] = *(const u32x2*)(Gw + (size_t)(8 * g4) * PQ + d0 * 32);
#pragma unroll
      for (int g4 = 0; g4 < 4; ++g4)
#pragma unroll
          for (int d0 = 0; d0 < 4; ++d0) {
              const unsigned w01 = FA_CVT(o[d0][4 * g4] * rli[4 * g4], o[d0][4 * g4 + 1] * rli[4 * g4 + 1]), w23 = FA_CVT(o[d0][4 * g4 + 2] * rli[4 * g4 + 2], o[d0][4 * g4 + 3] * rli[4 * g4 + 3]);
              const unsigned n01 = (unsigned)__builtin_amdgcn_update_dpp(0, (int)w01, 0xB1, 0xF, 0xF, false), n23 = (unsigned)__builtin_amdgcn_update_dpp(0, (int)w23, 0xB1, 0xF, 0xF, false);
              const unsigned a = __builtin_amdgcn_perm(n01, w01, selx), bq = __builtin_amdgcn_perm(n23, w23, selx);
              const unsigned x = b1 ? a : bq;
              const unsigned y = (unsigned)__builtin_amdgcn_update_dpp(0, (int)x, 0x4E, 0xF, 0xF, false);
              const u32x2 ov = b1 ? (u32x2){y, bq} : (u32x2){a, y}; const u32x2 gv = gl[g4][d0];
#define FA_LO(w_) __uint_as_float((w_) << 16)
#define FA_HI(w_) __uint_as_float((w_) & 0xffff0000u)
              const u32x2 og = (u32x2){FA_CVT(FA_LO(ov.x) * FA_LO(gv.x), FA_HI(ov.x) * FA_HI(gv.x)), FA_CVT(FA_LO(ov.y) * FA_LO(gv.y), FA_HI(ov.y) * FA_HI(gv.y))};
#undef FA_LO
#undef FA_HI
              *(u32x2*)(Ow + (size_t)(8 * g4) * PO + d0 * 32) = og; }
    }
#undef FA_CVT
    __syncthreads();
#undef RESC
#undef KBASE
#undef ACT
#undef MASKT
#undef SEAM_K0
#undef HALF_STEP
}
#undef ROW
#undef VMW
#undef VMWN
#undef SLOAD_H
#undef SWRITE_HK
#undef SWRITE_HV
#undef SWRITE_H
__device__ __forceinline__ int fox_jlo(const float* ncs, const float* KN, const float* QN, int qb, int lane, int wid, int& jw) {
    float qn = 0.f, kd = 0.f;
#pragma unroll
    for (int i = 0; i < 4; ++i) { qn = fmaxf(qn, QN[4 * qb + i]); kd = fmaxf(kd, KN[4 * qb + i]); }
    float a_ = qn * (KN[lane] + kd); asm volatile("" : "+v"(a_));
    const float ce = ncs[64 * lane + 63];
    const float bound = SCALE * (a_ + (ce - ncs[qb * QB]));
    const float bound_w = SCALE * (a_ + (ce - ncs[qb * QB + QBLK * wid]));
    const bool need = lane >= 4 * qb || !(bound < -30.0f);
    const bool need_w = lane >= 4 * qb || !(bound_w < -30.0f);
    jw = (int)__builtin_ctzll(__ballot(need_w));
    return (int)__builtin_ctzll(__ballot(need));
}
__device__ __forceinline__ BlockRef fox_ref(int item, int lane, int wid, const int* ord, const bf16* Y2, const float* CSR, const float* NRM, bf16* AO) {
    BlockRef r; int k, qb; const int x = item >> 6, i = item & 63;
    if (i < 48) { k = i / 12; qb = 15 - (i - k * 12); } else { const int j = i - 48; k = j >> 2; qb = 3 - (j & 3); }
    const int rank = k == 0 ? x : k == 1 ? 15 - x : k == 2 ? 16 + x : 31 - x;
    const int bh = __builtin_amdgcn_readfirstlane(ord[rank]), b = bh >> 3, h = bh & 7;
    const bf16* base = Y2 + (size_t)b * SEQ * PQ + h * D;
    int jw_; r.bh = bh; r.P0 = qb * QB; r.jlo = __builtin_amdgcn_readfirstlane(fox_jlo(CSR + (size_t)bh * SEQ, NRM + (size_t)bh * 128, NRM + (size_t)bh * 128 + 64, qb, lane, wid, jw_)); { const int j0_ = __builtin_amdgcn_readfirstlane(jw_); r.jw = j0_ < r.jlo ? r.jlo : j0_; }
    r.Q = base + (size_t)r.P0 * PQ; r.K = base + 1024; r.V = base + 2048; r.G = r.Q + 3072; r.O = AO + ((size_t)b * SEQ + r.P0) * PO + h * D;
    return r;
}
__device__ __forceinline__ int fox_fetch(unsigned* qc  , int x, int lane) {
    unsigned i0 = 0; if (lane == 0) i0 = __hip_atomic_fetch_add(qc + x * 64, 1u, __ATOMIC_RELAXED, __HIP_MEMORY_SCOPE_AGENT);
    i0 = __builtin_amdgcn_readfirstlane(i0);
    if (i0 < 64u) return x * 64 + (int)i0;
    for (int tries = 0; tries < 8; ++tries) {
        unsigned cv = 64u; if (lane < 8) cv = __hip_atomic_load(qc + lane * 64, __ATOMIC_RELAXED, __HIP_MEMORY_SCOPE_AGENT);
        const unsigned m = (unsigned)__builtin_amdgcn_ballot_w64(cv < 64u) & 0xffu;
        if (m == 0u) return -1;
        const unsigned rot = ((m >> x) | (m << (8 - x))) & 0xffu;
        const int y = (x + __builtin_ctz(rot)) & 7;
        unsigned iy = 0; if (lane == 0) iy = __hip_atomic_fetch_add(qc + y * 64, 1u, __ATOMIC_RELAXED, __HIP_MEMORY_SCOPE_AGENT);
        iy = __builtin_amdgcn_readfirstlane(iy);
        if (iy < 64u) return y * 64 + (int)iy;
    }
    return -1;
}
__device__ __forceinline__ void fox_phase(char* lds, int tid, int bid, int G, const bf16* Y2, const float* CSR, const float* NRM, bf16* AO, unsigned* qcnt) {
    (void)bid; (void)G;
    volatile int* slot = (volatile int*)(lds + LDS_ITEM); const int lane = tid & 63;
    const int xcd = (int)(__builtin_amdgcn_s_getreg((3 << 11) | 20) & 7u);
    float* rk = (float*)(lds + LDS_ITEM + 16); int* ord = (int*)(lds + LDS_ITEM + 16 + 128);
    if (tid < 32) rk[tid] = CSR[(size_t)tid * SEQ + SEQ - 1];
    __syncthreads();
    if (tid < 32) { const float r = rk[tid]; int c = 0;
        for (int j = 0; j < 32; ++j) { const float rj = rk[j]; c += (rj < r || (rj == r && j < tid)) ? 1 : 0; }
        ord[c] = tid; }
    if (tid < 64) { const int it_ = fox_fetch(qcnt, xcd, lane); if (lane == 0) slot[0] = it_; }
    __syncthreads();
    const int item0 = __builtin_amdgcn_readfirstlane(slot[0]);
    if (item0 < 0) return;
    BlockRef cur = fox_ref(item0, lane, __builtin_amdgcn_readfirstlane(tid >> 6), ord, Y2, CSR, NRM, AO);
    { const f32x4* src = (const f32x4*)(CSR + (size_t)cur.bh * SEQ); f32x4* dst = (f32x4*)(lds + LDS_CS); dst[tid] = src[tid]; dst[tid + 512] = src[tid + 512]; }
    Seam S;
    fox_prime(cur, lds, S, tid);
    for (;;) {
        if (tid < 64) { const int it_ = fox_fetch(qcnt, xcd, lane); if (lane == 0) slot[1] = it_; }
        __syncthreads();
        const int nitem = __builtin_amdgcn_readfirstlane(slot[1]); const bool last = nitem < 0;
        int tid2 = tid; asm volatile("" : "+v"(tid2));
        const BlockRef nxt = last ? cur : fox_ref(nitem, tid2 & 63, __builtin_amdgcn_readfirstlane(tid2 >> 6), ord, Y2, CSR, NRM, AO);
        fox_block(cur, nxt, lds, S, tid2, (!last && nxt.bh != cur.bh) ? CSR + (size_t)nxt.bh * SEQ : nullptr);
        if (last) break;
        cur = nxt;
    }
}
__device__ __forceinline__ void fox_norms(int gw, int ngw, int lane, const bf16* Y2, float* NRM) {
    for (int task = gw; task < 32 * 2 * 64; task += ngw) {
        const int j = task & 63, which = (task >> 6) & 1, bh = task >> 7, b = bh >> 3, h = bh & 7;
        const bf16* p = Y2 + ((size_t)b * SEQ + 64 * j + lane) * PQ + (which ? 0 : 1024) + h * D;
        float s = 0.f;
#pragma unroll
        for (int i = 0; i < 16; ++i) { const u32x4 v = *(const u32x4*)(p + 8 * i);
            const float a0 = __uint_as_float(v.x << 16), a1 = __uint_as_float(v.x & 0xffff0000u), a2 = __uint_as_float(v.y << 16), a3 = __uint_as_float(v.y & 0xffff0000u),
                        a4 = __uint_as_float(v.z << 16), a5 = __uint_as_float(v.z & 0xffff0000u), a6 = __uint_as_float(v.w << 16), a7 = __uint_as_float(v.w & 0xffff0000u);
            s += (a0 * a0 + a1 * a1) + (a2 * a2 + a3 * a3) + (a4 * a4 + a5 * a5) + (a6 * a6 + a7 * a7); }
#pragma unroll
        for (int o = 1; o < 64; o <<= 1) s = fmaxf(s, __int_as_float(__builtin_amdgcn_ds_bpermute((lane ^ o) << 2, __float_as_int(s))));
        if (lane == 0) NRM[(size_t)bh * 128 + which * 64 + j] = sqrtf(s) * 1.0001f;
    }
}
#undef KSWZ
#undef SBAR
}
namespace hg {
typedef unsigned short bf16;
typedef short bf16x8 __attribute__((ext_vector_type(8)));
typedef float f32x4 __attribute__((ext_vector_type(4)));
typedef unsigned u32x4 __attribute__((ext_vector_type(4)));
typedef unsigned u32x2 __attribute__((ext_vector_type(2)));
typedef float f2 __attribute__((ext_vector_type(2)));
constexpr int T = 4096, NSEG = 4, SEGLEN = T / NSEG, NCH = SEGLEN / 64, PY = 6144;
constexpr int LQ = 136, LS = 72, LO = 132;
constexpr int O_QX = 0, O_KX = O_QX + 64 * LQ * 2, O_KT = O_KX + 64 * LQ * 2, O_VT = O_KT + 128 * LS * 2, O_AM = O_VT + 128 * LS * 2, O_TOT = O_AM + 64 * LS * 2, O_E1 = O_TOT + 4096, O_E2 = O_E1 + 512,
              O_OSTF = O_E2 + 512, O_NW = O_OSTF + 64 * LO * 4, O_OSTF1 = O_NW + 512, LDS_BYTES = O_OSTF1 + 64 * LO * 4;
constexpr float LOG2E = 1.4426950408889634f;
typedef float f32x2_t __attribute__((ext_vector_type(2))); typedef __bf16 bf16x2_t __attribute__((ext_vector_type(2)));
__device__ __forceinline__ unsigned cvtpk(float lo, float hi) { f32x2_t v = {lo, hi}; bf16x2_t b = __builtin_convertvector(v, bf16x2_t); return __builtin_bit_cast(unsigned, b); }
__device__ __forceinline__ f2 ex2(f2 x) { return (f2){__builtin_amdgcn_exp2f(x.x), __builtin_amdgcn_exp2f(x.y)}; }
__device__ __forceinline__ f2 rcp2(f2 x) { return (f2){__builtin_amdgcn_rcpf(x.x), __builtin_amdgcn_rcpf(x.y)}; }
__device__ __forceinline__ f2 lg2(f2 x) { return (f2){__builtin_amdgcn_logf(x.x), __builtin_amdgcn_logf(x.y)}; }
__device__ __forceinline__ f2 max2(f2 a, float b) { return (f2){fmaxf(a.x, b), fmaxf(a.y, b)}; }
__device__ __forceinline__ f2 min2(f2 a, float b) { return (f2){fminf(a.x, b), fminf(a.y, b)}; }
__device__ __forceinline__ f2 clamp2(f2 a, float lim) { return (f2){fminf(fmaxf(a.x, -lim), lim), fminf(fmaxf(a.y, -lim), lim)}; }
__device__ __forceinline__ f2 bf2(unsigned w) { return (f2){__uint_as_float(w << 16), __uint_as_float(w & 0xffff0000u)}; }
__device__ __forceinline__ unsigned pk2(f2 v) { return cvtpk(v.x, v.y); }
#define HG_BAR() __syncthreads()

template <bool STATE_ONLY>
__device__ __forceinline__ void hgrn_stream(char* lds, int tid, int stream, bf16* Y, const float* lbl, int oi, const float* nw, float* SLOC, float* DSEG, const bf16* GA = nullptr, const bf16* GB = nullptr, bf16* Yo = nullptr, int po = PY) {
    const int lane = tid & 63, w = __builtin_amdgcn_readfirstlane(tid >> 6), c = lane & 15, q = lane >> 4;
    const int seg = stream & 3, h = (stream >> 2) & 15, b = stream >> 6;
    if (STATE_ONLY && seg == NSEG - 1) return;
    f2 lbv = (f2){0.f, 0.f};
    if (oi == 1) { const float2 l0 = *(const float2*)(lbl + h * 128 + 2 * lane), l1 = *(const float2*)(lbl + 2048 + h * 128 + 2 * lane);
        lbv = (f2){1.0f / (1.0f + __builtin_amdgcn_exp2f((l0.x - l1.x) * LOG2E)), 1.0f / (1.0f + __builtin_amdgcn_exp2f((l0.y - l1.y) * LOG2E))}; }
    const f2 oml = 1.0f - lbv;
    const size_t row0 = (size_t)b * T + (size_t)seg * SEGLEN;
    bf16* Yq = Y + row0 * PY + h * 128; const bf16* Yf = Yq + 2048; const bf16* Yv = Yq + 4096;
    f32x4 S[8];
#pragma unroll
    for (int i = 0; i < 8; ++i) S[i] = (f32x4){0.f, 0.f, 0.f, 0.f};
    if (!STATE_ONLY && seg > 0) {
        const int s0 = stream - seg;
        float sl[3][32]; f32x4 dd[3][8];
#pragma unroll
        for (int k = 0; k < 3; ++k) { const int sp = seg - 3 + k, spc = sp < 0 ? 0 : sp;
            const float* slp = SLOC + (size_t)(s0 + spc) * 16384 + w * 64 + lane; const float* dg = DSEG + (size_t)(s0 + spc) * 128;
#pragma unroll
            for (int i = 0; i < 8; ++i) { dd[k][i] = *(const f32x4*)(dg + 16 * i + 4 * q);
#pragma unroll
                for (int r = 0; r < 4; ++r) sl[k][i * 4 + r] = slp[(size_t)(i * 4 + r) * 512]; } }
#pragma unroll
        for (int k = 0; k < 3; ++k) { const bool valid = seg - 3 + k >= 0;
#pragma unroll
            for (int i = 0; i < 8; ++i)
#pragma unroll
                for (int r = 0; r < 4; ++r) S[i][r] = S[i][r] * dd[k][i][r] + (valid ? sl[k][i * 4 + r] : 0.f); }
    }
    if (!STATE_ONLY && tid < 128) ((float*)(lds + O_NW))[tid] = nw[tid];
    f2 bseg; { float one_ = 1.f; asm volatile("" : "+v"(one_)); bseg = (f2){one_, one_}; }
    unsigned qraw[8], fraw[8]; u32x4 vraw[2];
    unsigned fraw2[STATE_ONLY ? 8 : 1]; u32x4 vraw2[STATE_ONLY ? 2 : 1];
#define HG_LOADX(cc, FR, VR) do { const size_t r_ = (size_t)(cc) * 64; \
        _Pragma("unroll") for (int j = 0; j < 8; ++j) { FR[j] = *(const unsigned*)(Yf + (r_ + 8 * w + j) * PY + 2 * lane); if (!STATE_ONLY) qraw[j] = *(const unsigned*)(Yq + (r_ + 8 * w + j) * PY + 2 * lane); } \
        _Pragma("unroll") for (int i = 0; i < 2; ++i) VR[i] = *(const u32x4*)(Yv + (r_ + 2 * (tid >> 4) + i) * PY + (tid & 15) * 8); } while (0)
    const bf16* Gu = STATE_ONLY ? nullptr : (h < 8 ? GA : GB) + row0 * 1024 + (h & 7) * 128;
    auto chunk = [&](const int ch, unsigned (&fr)[8], u32x4 (&vr)[2], const int ld_ch) {
        u32x4 gt0, gt1;
        if (!STATE_ONLY) { const bf16* gp = Gu + (size_t)ch * 64 * 1024; const int go = (tid >> 3) * 1024 + (tid & 7) * 16; gt0 = *(const u32x4*)(gp + go); gt1 = *(const u32x4*)(gp + go + 8); }
        f2 fj[8], kin[8], qs[8];
        float* TOT = (float*)(lds + O_TOT);
        { f2 tot;
#pragma unroll
          for (int j = 0; j < 8; ++j) { const f2 e = ex2(min2(bf2(fr[j]) * (-LOG2E), 64.f)), sig = rcp2(1.0f + e);
              fj[j] = lbv + oml * sig; kin[j] = oml - oml * sig; tot = j == 0 ? fj[0] : tot * fj[j];
              if (!STATE_ONLY) { const f2 qq = bf2(qraw[j]); qs[j] = qq * rcp2(1.0f + ex2(min2(qq * (-LOG2E), 64.f))); } }
          *(f2*)(TOT + w * 128 + 2 * lane) = tot; }
        HG_BAR();
        { const int s2 = tid >> 4, v0 = (tid & 15) * 8;
          unsigned* vt = (unsigned*)((bf16*)(lds + O_VT) + v0 * LS + ((((s2 >> 2) ^ (tid & 7)) & 7) << 3) + 2 * (s2 & 3));
          vt[0 * (LS / 2)] = (vr[0].x & 0xffffu) | (vr[1].x << 16); vt[1 * (LS / 2)] = (vr[0].x >> 16) | (vr[1].x & 0xffff0000u);
          vt[2 * (LS / 2)] = (vr[0].y & 0xffffu) | (vr[1].y << 16); vt[3 * (LS / 2)] = (vr[0].y >> 16) | (vr[1].y & 0xffff0000u);
          vt[4 * (LS / 2)] = (vr[0].z & 0xffffu) | (vr[1].z << 16); vt[5 * (LS / 2)] = (vr[0].z >> 16) | (vr[1].z & 0xffff0000u);
          vt[6 * (LS / 2)] = (vr[0].w & 0xffffu) | (vr[1].w << 16); vt[7 * (LS / 2)] = (vr[0].w >> 16) | (vr[1].w & 0xffff0000u); }
        if (ld_ch < NCH) HG_LOADX(ld_ch, fr, vr);
        f2 lo4, hi4, part; { float one_ = 1.f; asm volatile("" : "+v"(one_)); part = (f2){one_, one_}; }
#pragma unroll
        for (int g8 = 0; g8 < 8; ++g8) { const f2 t_ = *(const f2*)(TOT + g8 * 128 + 2 * lane); if (g8 == 0) lo4 = t_; else if (g8 < 4) lo4 *= t_; else if (g8 == 4) hi4 = t_; else hi4 *= t_;
            const bool in_ = STATE_ONLY ? (g8 > w) : (w < 4 ? (g8 > w && g8 < 4) : (g8 >= 4 && g8 < w)); if (in_) part *= t_; }
        if (w == 0) {
            if (STATE_ONLY) { const f2 tt = lo4 * hi4; bseg *= tt; *(f2*)((float*)(lds + O_E1) + 2 * lane) = tt; }
            else { *(f2*)((float*)(lds + O_E1) + 2 * lane) = lo4; *(f2*)((float*)(lds + O_E2) + 2 * lane) = hi4; } }
        { f2 kt[8];
          const float TINY = 7.888609052210118e-31f;
          if (STATE_ONLY) {
              f2 s = part;
#pragma unroll
              for (int j = 7; j >= 0; --j) { kt[j] = kin[j] * s; s *= fj[j]; }
          } else {
              unsigned* QX = (unsigned*)((bf16*)(lds + O_QX) + (8 * w) * LQ + 2 * lane); unsigned* KX = (unsigned*)((bf16*)(lds + O_KX) + (8 * w) * LQ + 2 * lane);
              if (w < 4) { f2 s = part;
#pragma unroll
                  for (int j = 7; j >= 0; --j) { const f2 uc = max2(s, TINY), ed = rcp2(uc); kt[j] = kin[j] * uc; QX[j * (LQ / 2)] = pk2(qs[j] * ed); KX[j * (LQ / 2)] = pk2(kt[j]); s *= fj[j]; }
              } else { f2 p = part;
#pragma unroll
                  for (int j = 0; j < 8; ++j) { p *= fj[j]; const f2 wc = max2(p, TINY); kt[j] = kin[j] * rcp2(wc); QX[j * (LQ / 2)] = pk2(qs[j] * wc); KX[j * (LQ / 2)] = pk2(kt[j]); } }
          }
          u32x4* kd = (u32x4*)((bf16*)(lds + O_KT) + (2 * lane) * LS + 8 * w);
          kd[0] = (u32x4){cvtpk(kt[0].x, kt[1].x), cvtpk(kt[2].x, kt[3].x), cvtpk(kt[4].x, kt[5].x), cvtpk(kt[6].x, kt[7].x)};
          *(u32x4*)((bf16*)kd + LS) = (u32x4){cvtpk(kt[0].y, kt[1].y), cvtpk(kt[2].y, kt[3].y), cvtpk(kt[4].y, kt[5].y), cvtpk(kt[6].y, kt[7].y)}; }
        HG_BAR();
        f32x4 O[4];
        if (!STATE_ONLY) {
            for (int ti = w; ti < 12; ti += 8) {
                int I, J; if (ti < 1) { I = 0; J = 0; } else if (ti < 3) { I = 1; J = ti - 1; } else if (ti < 6) { I = 2; J = ti - 3; } else if (ti < 10) { I = 3; J = ti - 6; } else { I = (ti - 10) * 2; J = I + 1; }
                f32x4 acc = (f32x4){0.f, 0.f, 0.f, 0.f};
                if (ti < 10) {
                    const bf16* Kt = (const bf16*)(lds + O_KX) + (16 * J + c) * LQ + 8 * q; const bf16* Qt = (const bf16*)(lds + O_QX) + (16 * I + c) * LQ + 8 * q;
                    bf16x8 ka[4], qa[4];
#pragma unroll
                    for (int ks = 0; ks < 4; ++ks) { ka[ks] = *(const bf16x8*)(Kt + 32 * ks); qa[ks] = *(const bf16x8*)(Qt + 32 * ks); }
                    __builtin_amdgcn_sched_barrier(0);
#pragma unroll
                    for (int ks = 0; ks < 4; ++ks) acc = __builtin_amdgcn_mfma_f32_16x16x32_bf16(ka[ks], qa[ks], acc, 0, 0, 0);
                    if (I == J) {
#pragma unroll
                        for (int r = 0; r < 4; ++r) if (4 * q + r > c) acc[r] = 0.f; }
                }
                *(u32x2*)((bf16*)(lds + O_AM) + (16 * I + c) * LS + 16 * J + 4 * q) = (u32x2){cvtpk(acc[0], acc[1]), cvtpk(acc[2], acc[3])};
            }
            HG_BAR();
        }
        const bf16* VTw = (const bf16*)(lds + O_VT) + (16 * w + c) * LS; const int vsw = (2 * w + (c >> 3)) & 7;
        const float* E1 = (const float*)(lds + O_E1);
        if (!STATE_ONLY) {
            f32x4 e1[8]; u32x4 qa[4][4];
            const bf16x8 bv0 = *(const bf16x8*)(VTw + 8 * (q ^ vsw)), bv1 = *(const bf16x8*)(VTw + 8 * ((4 + q) ^ vsw));
#pragma unroll
            for (int kt_ = 0; kt_ < 8; ++kt_) e1[kt_] = *(const f32x4*)(E1 + 16 * kt_ + 4 * q);
#pragma unroll
            for (int ks = 0; ks < 4; ++ks)
#pragma unroll
                for (int mt = 0; mt < 4; ++mt) { const bf16* qh = (const bf16*)(lds + O_QX) + (16 * mt + c) * LQ + 32 * ks + 4 * q;
                    const u32x2 a0 = *(const u32x2*)qh, a1 = *(const u32x2*)(qh + 16); qa[ks][mt] = (u32x4){a0.x, a0.y, a1.x, a1.y}; }
            __builtin_amdgcn_sched_barrier(0);
#pragma unroll
            for (int kt_ = 0; kt_ < 8; ++kt_) S[kt_] = S[kt_] * e1[kt_];
#pragma unroll
            for (int mt = 0; mt < 4; ++mt) O[mt] = (f32x4){0.f, 0.f, 0.f, 0.f};
#pragma unroll
            for (int ks = 0; ks < 4; ++ks) {
                const u32x4 sb = (u32x4){cvtpk(S[2 * ks][0], S[2 * ks][1]), cvtpk(S[2 * ks][2], S[2 * ks][3]), cvtpk(S[2 * ks + 1][0], S[2 * ks + 1][1]), cvtpk(S[2 * ks + 1][2], S[2 * ks + 1][3])};
                const bf16x8 bS = __builtin_bit_cast(bf16x8, sb);
#pragma unroll
                for (int mt = 0; mt < 4; ++mt) O[mt] = __builtin_amdgcn_mfma_f32_16x16x32_bf16(__builtin_bit_cast(bf16x8, qa[ks][mt]), bS, O[mt], 0, 0, 0);
            }
            __builtin_amdgcn_sched_barrier(0);
            bf16x8 am[6], kh[8][2]; f32x4 e2[8];
#pragma unroll
            for (int mt = 0; mt < 4; ++mt) { const bf16* amp = (const bf16*)(lds + O_AM) + (16 * mt + c) * LS + 8 * q;
                am[mt] = *(const bf16x8*)amp; if (mt >= 2) am[2 + mt] = *(const bf16x8*)(amp + 32); }
#pragma unroll
            for (int kt_ = 0; kt_ < 4; ++kt_) { const bf16* khp = (const bf16*)(lds + O_KT) + (16 * kt_ + c) * LS + 8 * q; kh[kt_][0] = *(const bf16x8*)khp; kh[kt_][1] = *(const bf16x8*)(khp + 32); }
            __builtin_amdgcn_sched_barrier(0);
#pragma unroll
            for (int mt = 0; mt < 4; ++mt) { O[mt] = __builtin_amdgcn_mfma_f32_16x16x32_bf16(am[mt], bv0, O[mt], 0, 0, 0);
                if (mt >= 2) O[mt] = __builtin_amdgcn_mfma_f32_16x16x32_bf16(am[2 + mt], bv1, O[mt], 0, 0, 0); }
#pragma unroll
            for (int kt_ = 4; kt_ < 8; ++kt_) { const bf16* khp = (const bf16*)(lds + O_KT) + (16 * kt_ + c) * LS + 8 * q; kh[kt_][0] = *(const bf16x8*)khp; kh[kt_][1] = *(const bf16x8*)(khp + 32); }
            { const float* E2 = (const float*)(lds + O_E2);
#pragma unroll
              for (int kt_ = 0; kt_ < 8; ++kt_) e2[kt_] = *(const f32x4*)(E2 + 16 * kt_ + 4 * q); }
            __builtin_amdgcn_sched_barrier(0);
#pragma unroll
            for (int kt_ = 0; kt_ < 8; ++kt_) { S[kt_] = __builtin_amdgcn_mfma_f32_16x16x32_bf16(kh[kt_][0], bv0, S[kt_], 0, 0, 0);
                S[kt_] = __builtin_amdgcn_mfma_f32_16x16x32_bf16(kh[kt_][1], bv1, S[kt_], 0, 0, 0); }
#pragma unroll
            for (int kt_ = 0; kt_ < 8; ++kt_) S[kt_] = S[kt_] * e2[kt_];
        } else {
            const bf16x8 bv0 = *(const bf16x8*)(VTw + 8 * (q ^ vsw)), bv1 = *(const bf16x8*)(VTw + 8 * ((4 + q) ^ vsw));
#pragma unroll
            for (int kt_ = 0; kt_ < 8; ++kt_) S[kt_] = S[kt_] * *(const f32x4*)(E1 + 16 * kt_ + 4 * q);
#pragma unroll
            for (int kt_ = 0; kt_ < 8; ++kt_) { const bf16* khp = (const bf16*)(lds + O_KT) + (16 * kt_ + c) * LS + 8 * q;
                S[kt_] = __builtin_amdgcn_mfma_f32_16x16x32_bf16(*(const bf16x8*)khp, bv0, S[kt_], 0, 0, 0);
                S[kt_] = __builtin_amdgcn_mfma_f32_16x16x32_bf16(*(const bf16x8*)(khp + 32), bv1, S[kt_], 0, 0, 0); }
        }
        if (!STATE_ONLY) {
            float* OS = (float*)(lds + O_OSTF);
#pragma unroll
            for (int mt = 0; mt < 4; ++mt)
#pragma unroll
                for (int r = 0; r < 4; ++r) OS[(16 * mt + 4 * q + r) * LO + 16 * w + c] = O[mt][r];
            HG_BAR();
            const int t = tid >> 3, v0 = (tid & 7) * 16; const float* orow = OS + t * LO + v0;
            f32x4 x[4]; float ss = 0.f;
#pragma unroll
            for (int i = 0; i < 4; ++i) { x[i] = *(const f32x4*)(orow + 4 * i); ss += (x[i][0] * x[i][0] + x[i][1] * x[i][1]) + (x[i][2] * x[i][2] + x[i][3] * x[i][3]); }
            ss += __int_as_float(__builtin_amdgcn_update_dpp(0, __float_as_int(ss), 0xB1, 0xF, 0xF, false));
            ss += __int_as_float(__builtin_amdgcn_update_dpp(0, __float_as_int(ss), 0x4E, 0xF, 0xF, false));
            ss += __int_as_float(__builtin_amdgcn_ds_swizzle(__float_as_int(ss), 0x101F));
            const float rs = rsqrtf(ss * (1.0f / 128.0f) + 1e-5f);
            u32x4 o0, o1; const float* wv = (const float*)(lds + O_NW) + v0;
#define HG_G(w_, i_) ((i_) ? __uint_as_float((w_) & 0xffff0000u) : __uint_as_float((w_) << 16))
            o0.x = cvtpk(x[0][0] * rs * wv[0] * HG_G(gt0.x, 0), x[0][1] * rs * wv[1] * HG_G(gt0.x, 1)); o0.y = cvtpk(x[0][2] * rs * wv[2] * HG_G(gt0.y, 0), x[0][3] * rs * wv[3] * HG_G(gt0.y, 1));
            o0.z = cvtpk(x[1][0] * rs * wv[4] * HG_G(gt0.z, 0), x[1][1] * rs * wv[5] * HG_G(gt0.z, 1)); o0.w = cvtpk(x[1][2] * rs * wv[6] * HG_G(gt0.w, 0), x[1][3] * rs * wv[7] * HG_G(gt0.w, 1));
            o1.x = cvtpk(x[2][0] * rs * wv[8] * HG_G(gt1.x, 0), x[2][1] * rs * wv[9] * HG_G(gt1.x, 1)); o1.y = cvtpk(x[2][2] * rs * wv[10] * HG_G(gt1.y, 0), x[2][3] * rs * wv[11] * HG_G(gt1.y, 1));
            o1.z = cvtpk(x[3][0] * rs * wv[12] * HG_G(gt1.z, 0), x[3][1] * rs * wv[13] * HG_G(gt1.z, 1)); o1.w = cvtpk(x[3][2] * rs * wv[14] * HG_G(gt1.w, 0), x[3][3] * rs * wv[15] * HG_G(gt1.w, 1));
#undef HG_G
            bf16* dst = (Yo ? Yo : Yq) + ((size_t)ch * 64 + t) * po + v0;
            *(u32x4*)dst = o0; *(u32x4*)(dst + 8) = o1;
        }
    };
    if (STATE_ONLY) {
        HG_LOADX(0, fraw, vraw); HG_LOADX(1, fraw2, vraw2);
        for (int ch = 0; ch < NCH; ch += 2) { chunk(ch, fraw, vraw, ch + 2); chunk(ch + 1, (unsigned (&)[8])fraw2, (u32x4 (&)[2])vraw2, ch + 3); }
    } else {
        HG_LOADX(0, fraw, vraw);
        for (int ch = 0; ch < NCH; ++ch) chunk(ch, fraw, vraw, ch + 1);
    }
    if (STATE_ONLY) {
        float* sl = SLOC + (size_t)stream * 16384 + w * 64 + lane;
#pragma unroll
        for (int i = 0; i < 8; ++i)
#pragma unroll
            for (int r = 0; r < 4; ++r) sl[(size_t)(i * 4 + r) * 512] = S[i][r];
        if (w == 0) *(f2*)(DSEG + (size_t)stream * 128 + 2 * lane) = bseg;
    }
#undef HG_LOADX
}

__device__ __forceinline__ void hgrn_state128(char* lds, int tid, int stream, const bf16* Y, const float* lbl, int oi, float* SLOC, float* DSEG) {
    const int lane = tid & 63, w = __builtin_amdgcn_readfirstlane(tid >> 6), c = lane & 15, q = lane >> 4;
    const int seg = stream & 3, h = (stream >> 2) & 15, b = stream >> 6;
    if (seg == NSEG - 1) return;
    constexpr int CH = 128, NC = SEGLEN / CH, L2 = CH + 8, P_KT = 0, P_VT = P_KT + 128 * L2 * 2, P_TOT = P_VT + 128 * L2 * 2, P_E1 = P_TOT + 4096;
    f2 lbv = (f2){0.f, 0.f};
    if (oi == 1) { const float2 l0 = *(const float2*)(lbl + h * 128 + 2 * lane), l1 = *(const float2*)(lbl + 2048 + h * 128 + 2 * lane);
        lbv = (f2){1.0f / (1.0f + __builtin_amdgcn_exp2f((l0.x - l1.x) * LOG2E)), 1.0f / (1.0f + __builtin_amdgcn_exp2f((l0.y - l1.y) * LOG2E))}; }
    const f2 oml = 1.0f - lbv;
    const size_t row0 = (size_t)b * T + (size_t)seg * SEGLEN;
    const bf16* Yf = Y + row0 * PY + h * 128 + 2048; const bf16* Yv = Yf + 2048;
    f32x4 S[8];
#pragma unroll
    for (int i = 0; i < 8; ++i) S[i] = (f32x4){0.f, 0.f, 0.f, 0.f};
    f2 bseg; { float one_ = 1.f; asm volatile("" : "+v"(one_)); bseg = (f2){one_, one_}; }
    unsigned fr[16]; u32x4 vr[4];
#define HA_LOAD(cc) do { const size_t r_ = (size_t)(cc) * CH; \
        _Pragma("unroll") for (int j = 0; j < 16; ++j) fr[j] = *(const unsigned*)(Yf + (r_ + 16 * w + j) * PY + 2 * lane); \
        _Pragma("unroll") for (int i = 0; i < 4; ++i) vr[i] = *(const u32x4*)(Yv + (r_ + 4 * (tid >> 4) + i) * PY + (tid & 15) * 8); } while (0)
    HA_LOAD(0);
    float* TOT = (float*)(lds + P_TOT); float* E1 = (float*)(lds + P_E1);
    for (int ch = 0; ch < NC; ++ch) {
        f2 fj[16], kin[16];
        { f2 tot;
#pragma unroll
          for (int j = 0; j < 16; ++j) { const f2 e = ex2(bf2(fr[j]) * (-LOG2E)), sig = rcp2(1.0f + e);
              fj[j] = lbv + oml * sig; kin[j] = oml - oml * sig; tot = j == 0 ? fj[0] : tot * fj[j]; }
          *(f2*)(TOT + w * 128 + 2 * lane) = tot; }
        __syncthreads();
        { const int s4 = tid >> 4, v0 = (tid & 15) * 8;
          bf16* vt = (bf16*)(lds + P_VT) + v0 * L2 + ((((s4 >> 1) ^ (tid & 7)) & 15) << 3) + 4 * (s4 & 1);
#define HA_VW(i_, comp, hi_) *(u32x2*)(vt + (i_) * L2) = (hi_) ? (u32x2){(vr[0].comp >> 16) | (vr[1].comp & 0xffff0000u), (vr[2].comp >> 16) | (vr[3].comp & 0xffff0000u)} \
                                                              : (u32x2){(vr[0].comp & 0xffffu) | (vr[1].comp << 16), (vr[2].comp & 0xffffu) | (vr[3].comp << 16)}
          HA_VW(0, x, 0); HA_VW(1, x, 1); HA_VW(2, y, 0); HA_VW(3, y, 1); HA_VW(4, z, 0); HA_VW(5, z, 1); HA_VW(6, w, 0); HA_VW(7, w, 1);
#undef HA_VW
        }
        if (ch + 1 < NC) HA_LOAD(ch + 1);
        f2 tt, part; { float one_ = 1.f; asm volatile("" : "+v"(one_)); part = (f2){one_, one_}; }
#pragma unroll
        for (int g8 = 0; g8 < 8; ++g8) { const f2 t_ = *(const f2*)(TOT + g8 * 128 + 2 * lane); tt = g8 == 0 ? t_ : tt * t_; if (g8 > w) part *= t_; }
        if (w == 0) { bseg *= tt; *(f2*)(E1 + 2 * lane) = tt; }
        { f2 kt[16]; f2 s = part;
#pragma unroll
          for (int j = 15; j >= 0; --j) { kt[j] = kin[j] * s; s *= fj[j]; }
          u32x4* kd = (u32x4*)((bf16*)(lds + P_KT) + (2 * lane) * L2 + 16 * w);
          kd[0] = (u32x4){cvtpk(kt[0].x, kt[1].x), cvtpk(kt[2].x, kt[3].x), cvtpk(kt[4].x, kt[5].x), cvtpk(kt[6].x, kt[7].x)};
          kd[1] = (u32x4){cvtpk(kt[8].x, kt[9].x), cvtpk(kt[10].x, kt[11].x), cvtpk(kt[12].x, kt[13].x), cvtpk(kt[14].x, kt[15].x)};
          u32x4* kd1 = (u32x4*)((bf16*)kd + L2);
          kd1[0] = (u32x4){cvtpk(kt[0].y, kt[1].y), cvtpk(kt[2].y, kt[3].y), cvtpk(kt[4].y, kt[5].y), cvtpk(kt[6].y, kt[7].y)};
          kd1[1] = (u32x4){cvtpk(kt[8].y, kt[9].y), cvtpk(kt[10].y, kt[11].y), cvtpk(kt[12].y, kt[13].y), cvtpk(kt[14].y, kt[15].y)}; }
        __syncthreads();
        { const int kh = w >> 2, vq = w & 3;
          bf16x8 bv[2][4];
#pragma unroll
          for (int nt = 0; nt < 2; ++nt) { const bf16* VTw = (const bf16*)(lds + P_VT) + (32 * vq + 16 * nt + c) * L2; const int vsw = (4 * vq + 2 * nt + (c >> 3)) & 7;
#pragma unroll
              for (int ks = 0; ks < 4; ++ks) bv[nt][ks] = *(const bf16x8*)(VTw + 8 * ((4 * ks + q) ^ vsw)); }
#pragma unroll
          for (int kt = 0; kt < 4; ++kt) { const f32x4 e = *(const f32x4*)(E1 + 64 * kh + 16 * kt + 4 * q); S[kt * 2] = S[kt * 2] * e; S[kt * 2 + 1] = S[kt * 2 + 1] * e; }
#pragma unroll
          for (int g2 = 0; g2 < 2; ++g2) {
              bf16x8 kf[2][4];
#pragma unroll
              for (int kk = 0; kk < 2; ++kk) { const bf16* khp = (const bf16*)(lds + P_KT) + (16 * (4 * kh + 2 * g2 + kk) + c) * L2 + 8 * q;
#pragma unroll
                  for (int ks = 0; ks < 4; ++ks) kf[kk][ks] = *(const bf16x8*)(khp + 32 * ks); }
              __builtin_amdgcn_sched_barrier(0);
#pragma unroll
              for (int kk = 0; kk < 2; ++kk)
#pragma unroll
                  for (int nt = 0; nt < 2; ++nt)
#pragma unroll
                      for (int ks = 0; ks < 4; ++ks) S[(2 * g2 + kk) * 2 + nt] = __builtin_amdgcn_mfma_f32_16x16x32_bf16(kf[kk][ks], bv[nt][ks], S[(2 * g2 + kk) * 2 + nt], 0, 0, 0);
              __builtin_amdgcn_sched_barrier(0);
          }
        }
    }
#undef HA_LOAD
    { const int kh = w >> 2, vq = w & 3;
      float* sl = SLOC + (size_t)stream * 16384 + lane;
#pragma unroll
      for (int kt = 0; kt < 4; ++kt)
#pragma unroll
          for (int nt = 0; nt < 2; ++nt)
#pragma unroll
              for (int r = 0; r < 4; ++r) sl[(size_t)((4 * kh + kt) * 4 + r) * 512 + (2 * vq + nt) * 64] = S[kt * 2 + nt][r]; }
    if (w == 0) *(f2*)(DSEG + (size_t)stream * 128 + 2 * lane) = bseg;
}

__device__ __forceinline__ void hgrn_passB(char* lds, int tid, int stream, bf16* Y, const float* lbl, int oi, const float* nw, const float* SLOC, const float* DSEG, const bf16* GA, const bf16* GB) {
    const int lane = tid & 63, w = __builtin_amdgcn_readfirstlane(tid >> 6), c = lane & 15, q = lane >> 4, kh = w >> 2, vq = w & 3;
    const int seg = stream & 3, h = (stream >> 2) & 15, b = stream >> 6;
    f2 lbv = (f2){0.f, 0.f};
    if (oi == 1) { const float2 l0 = *(const float2*)(lbl + h * 128 + 2 * lane), l1 = *(const float2*)(lbl + 2048 + h * 128 + 2 * lane);
        lbv = (f2){1.0f / (1.0f + __builtin_amdgcn_exp2f((l0.x - l1.x) * LOG2E)), 1.0f / (1.0f + __builtin_amdgcn_exp2f((l0.y - l1.y) * LOG2E))}; }
    const f2 oml = 1.0f - lbv;
    const size_t row0 = (size_t)b * T + (size_t)seg * SEGLEN;
    bf16* Yq = Y + row0 * PY + h * 128; const bf16* Yf = Yq + 2048; const bf16* Yv = Yq + 4096;
    f32x4 S[8];
#pragma unroll
    for (int i = 0; i < 8; ++i) S[i] = (f32x4){0.f, 0.f, 0.f, 0.f};
    if (seg > 0) {
        const int s0 = stream - seg;
        float sl[3][32]; f32x4 dd[3][4];
#pragma unroll
        for (int k = 0; k < 3; ++k) { const int sp = seg - 3 + k, spc = sp < 0 ? 0 : sp;
            const float* slp = SLOC + (size_t)(s0 + spc) * 16384 + lane; const float* dg = DSEG + (size_t)(s0 + spc) * 128 + 64 * kh;
#pragma unroll
            for (int kt = 0; kt < 4; ++kt) { dd[k][kt] = *(const f32x4*)(dg + 16 * kt + 4 * q);
#pragma unroll
                for (int nt = 0; nt < 2; ++nt)
#pragma unroll
                    for (int r = 0; r < 4; ++r) sl[k][(kt * 2 + nt) * 4 + r] = slp[(size_t)((4 * kh + kt) * 4 + r) * 512 + (2 * vq + nt) * 64]; } }
#pragma unroll
        for (int k = 0; k < 3; ++k) { const bool valid = seg - 3 + k >= 0;
#pragma unroll
            for (int kt = 0; kt < 4; ++kt)
#pragma unroll
                for (int nt = 0; nt < 2; ++nt)
#pragma unroll
                    for (int r = 0; r < 4; ++r) S[kt * 2 + nt][r] = S[kt * 2 + nt][r] * dd[k][kt][r] + (valid ? sl[k][(kt * 2 + nt) * 4 + r] : 0.f); }
    }
    __builtin_amdgcn_sched_barrier(0);
    if (tid < 128) ((float*)(lds + O_NW))[tid] = nw[tid];
    unsigned qraw[8], fr[8]; u32x4 vr[2];
    const unsigned lo_f = (unsigned)lane * 4u, lo_v = (unsigned)((2 * (tid >> 4)) * PY + (tid & 15) * 8) * 2u, lo_o = (unsigned)((tid >> 3) * PY + (tid & 7) * 16) * 2u, lo_g = (unsigned)((tid >> 3) * 1024 + (tid & 7) * 16) * 2u;
#define HB_LOAD(cc) do { const size_t r_ = (size_t)(cc) * 64; \
        _Pragma("unroll") for (int j = 0; j < 8; ++j) { fr[j] = *(const unsigned*)((const char*)(Yf + (r_ + 8 * w + j) * PY) + lo_f); qraw[j] = *(const unsigned*)((const char*)(Yq + (r_ + 8 * w + j) * PY) + lo_f); } \
        _Pragma("unroll") for (int i = 0; i < 2; ++i) vr[i] = *(const u32x4*)((const char*)(Yv + (r_ + i) * PY) + lo_v); } while (0)
    const bf16* Gu = (h < 8 ? GA : GB) + row0 * 1024 + (h & 7) * 128;
    float* TOT = (float*)(lds + O_TOT);
    f2 fj[8], kin[8], qs[8];
#define HB_P2() do { f2 tot; \
        _Pragma("unroll") for (int j = 0; j < 8; ++j) { const f2 e = ex2(bf2(fr[j]) * (-LOG2E)), sig = rcp2(1.0f + e); \
            fj[j] = lbv + oml * sig; kin[j] = oml - oml * sig; tot = j == 0 ? fj[0] : tot * fj[j]; \
            const f2 qq = bf2(qraw[j]); qs[j] = qq * rcp2(1.0f + ex2(qq * (-LOG2E))); } \
        *(f2*)(TOT + w * 128 + 2 * lane) = tot; } while (0)
#define HB_PREP(ld_ch) do { \
        { const int s2 = tid >> 4, v0 = (tid & 15) * 8; \
          unsigned* vt = (unsigned*)((bf16*)(lds + O_VT) + v0 * LS + ((((s2 >> 2) ^ (tid & 7)) & 7) << 3) + 2 * (s2 & 3)); \
          vt[0 * (LS / 2)] = (vr[0].x & 0xffffu) | (vr[1].x << 16); vt[1 * (LS / 2)] = (vr[0].x >> 16) | (vr[1].x & 0xffff0000u); \
          vt[2 * (LS / 2)] = (vr[0].y & 0xffffu) | (vr[1].y << 16); vt[3 * (LS / 2)] = (vr[0].y >> 16) | (vr[1].y & 0xffff0000u); \
          vt[4 * (LS / 2)] = (vr[0].z & 0xffffu) | (vr[1].z << 16); vt[5 * (LS / 2)] = (vr[0].z >> 16) | (vr[1].z & 0xffff0000u); \
          vt[6 * (LS / 2)] = (vr[0].w & 0xffffu) | (vr[1].w << 16); vt[7 * (LS / 2)] = (vr[0].w >> 16) | (vr[1].w & 0xffff0000u); } \
        if ((ld_ch) < NCH) HB_LOAD(ld_ch); \
        f2 lo4, hi4, part; { float one_ = 1.f; asm volatile("" : "+v"(one_)); part = (f2){one_, one_}; } \
        _Pragma("unroll") for (int g8 = 0; g8 < 8; ++g8) { const f2 t_ = *(const f2*)(TOT + g8 * 128 + 2 * lane); if (g8 == 0) lo4 = t_; else if (g8 < 4) lo4 *= t_; else if (g8 == 4) hi4 = t_; else hi4 *= t_; \
            const bool in_ = w < 4 ? (g8 > w && g8 < 4) : (g8 >= 4 && g8 < w); if (in_) part *= t_; } \
        if (w == 0) { *(f2*)((float*)(lds + O_E1) + 2 * lane) = lo4; *(f2*)((float*)(lds + O_E2) + 2 * lane) = hi4; } \
        { f2 kt[8]; const float TINY = 7.888609052210118e-31f; \
          unsigned* QX = (unsigned*)((bf16*)(lds + O_QX) + (8 * w) * LQ + 2 * lane); unsigned* KX = (unsigned*)((bf16*)(lds + O_KX) + (8 * w) * LQ + 2 * lane); \
          if (w < 4) { f2 s = part; \
              _Pragma("unroll") for (int j = 7; j >= 0; --j) { const f2 uc = max2(s, TINY), ed = rcp2(uc); kt[j] = kin[j] * uc; QX[j * (LQ / 2)] = pk2(qs[j] * ed); KX[j * (LQ / 2)] = pk2(kt[j]); s *= fj[j]; } \
          } else { f2 p = part; \
              _Pragma("unroll") for (int j = 0; j < 8; ++j) { p *= fj[j]; const f2 wc = max2(p, TINY); kt[j] = kin[j] * rcp2(wc); QX[j * (LQ / 2)] = pk2(qs[j] * wc); KX[j * (LQ / 2)] = pk2(kt[j]); } } \
          u32x4* kd = (u32x4*)((bf16*)(lds + O_KT) + (2 * lane) * LS + 8 * w); \
          kd[0] = (u32x4){cvtpk(kt[0].x, kt[1].x), cvtpk(kt[2].x, kt[3].x), cvtpk(kt[4].x, kt[5].x), cvtpk(kt[6].x, kt[7].x)}; \
          *(u32x4*)((bf16*)kd + LS) = (u32x4){cvtpk(kt[0].y, kt[1].y), cvtpk(kt[2].y, kt[3].y), cvtpk(kt[4].y, kt[5].y), cvtpk(kt[6].y, kt[7].y)}; } } while (0)
#define HB_P6() do { \
        for (int ti = w; ti < 12; ti += 8) { \
            int I, J; if (ti < 1) { I = 0; J = 0; } else if (ti < 3) { I = 1; J = ti - 1; } else if (ti < 6) { I = 2; J = ti - 3; } else if (ti < 10) { I = 3; J = ti - 6; } else { I = (ti - 10) * 2; J = I + 1; } \
            f32x4 acc = (f32x4){0.f, 0.f, 0.f, 0.f}; \
            if (ti < 10) { \
                const bf16* Kt = (const bf16*)(lds + O_KX) + (16 * J + c) * LQ + 8 * q; const bf16* Qt = (const bf16*)(lds + O_QX) + (16 * I + c) * LQ + 8 * q; \
                bf16x8 ka[4], qa[4]; \
                _Pragma("unroll") for (int ks = 0; ks < 4; ++ks) { ka[ks] = *(const bf16x8*)(Kt + 32 * ks); qa[ks] = *(const bf16x8*)(Qt + 32 * ks); } \
                __builtin_amdgcn_sched_barrier(0); \
                _Pragma("unroll") for (int ks = 0; ks < 4; ++ks) acc = __builtin_amdgcn_mfma_f32_16x16x32_bf16(ka[ks], qa[ks], acc, 0, 0, 0); \
                if (I == J) { _Pragma("unroll") for (int r = 0; r < 4; ++r) if (4 * q + r > c) acc[r] = 0.f; } \
            } \
            *(u32x2*)((bf16*)(lds + O_AM) + (16 * I + c) * LS + 16 * J + 4 * q) = (u32x2){cvtpk(acc[0], acc[1]), cvtpk(acc[2], acc[3])}; \
        } } while (0)
    HB_LOAD(0);
    HB_P2();
    __syncthreads();
    HB_PREP(1);
    __syncthreads();
    HB_P6();
    __syncthreads();
    for (int ch = 0; ch < NCH; ++ch) {
        u32x4 gt0, gt1;
        { const char* gp = (const char*)(Gu + (size_t)ch * 64 * 1024); gt0 = *(const u32x4*)(gp + lo_g); gt1 = *(const u32x4*)(gp + lo_g + 16); }
        f32x4 O[8];
        { const float* E1 = (const float*)(lds + O_E1) + 64 * kh;
          bf16x8 bv[2][2];
#pragma unroll
          for (int nt = 0; nt < 2; ++nt) { const bf16* VTw = (const bf16*)(lds + O_VT) + (32 * vq + 16 * nt + c) * LS; const int vsw = (4 * vq + 2 * nt + (c >> 3)) & 7;
              bv[nt][0] = *(const bf16x8*)(VTw + 8 * (q ^ vsw)); bv[nt][1] = *(const bf16x8*)(VTw + 8 * ((4 + q) ^ vsw)); }
#pragma unroll
          for (int kt = 0; kt < 4; ++kt) { const f32x4 e = *(const f32x4*)(E1 + 16 * kt + 4 * q); S[kt * 2] = S[kt * 2] * e; S[kt * 2 + 1] = S[kt * 2 + 1] * e; }
#pragma unroll
          for (int i = 0; i < 8; ++i) O[i] = (f32x4){0.f, 0.f, 0.f, 0.f};
#pragma unroll
          for (int ks = 0; ks < 2; ++ks) {
              u32x4 qa[4];
#pragma unroll
              for (int mt = 0; mt < 4; ++mt) { const bf16* qh = (const bf16*)(lds + O_QX) + (16 * mt + c) * LQ + 64 * kh + 32 * ks + 4 * q;
                  const u32x2 a0 = *(const u32x2*)qh, a1 = *(const u32x2*)(qh + 16); qa[mt] = (u32x4){a0.x, a0.y, a1.x, a1.y}; }
              __builtin_amdgcn_sched_barrier(0);
#pragma unroll
              for (int nt = 0; nt < 2; ++nt) { const f32x4 s0_ = S[(2 * ks) * 2 + nt], s1_ = S[(2 * ks + 1) * 2 + nt];
                  const u32x4 sb = (u32x4){cvtpk(s0_[0], s0_[1]), cvtpk(s0_[2], s0_[3]), cvtpk(s1_[0], s1_[1]), cvtpk(s1_[2], s1_[3])};
                  const bf16x8 bS = __builtin_bit_cast(bf16x8, sb);
#pragma unroll
                  for (int mt = 0; mt < 4; ++mt) O[mt * 2 + nt] = __builtin_amdgcn_mfma_f32_16x16x32_bf16(__builtin_bit_cast(bf16x8, qa[mt]), bS, O[mt * 2 + nt], 0, 0, 0); }
              __builtin_amdgcn_sched_barrier(0); }
          { bf16x8 am[4];
#pragma unroll
            for (int mt = 0; mt < 4; ++mt) if (mt >= 2 * kh) am[mt] = *(const bf16x8*)((const bf16*)(lds + O_AM) + (16 * mt + c) * LS + 8 * q + 32 * kh);
            __builtin_amdgcn_sched_barrier(0);
#pragma unroll
            for (int mt = 0; mt < 4; ++mt) if (mt >= 2 * kh) {
#pragma unroll
                for (int nt = 0; nt < 2; ++nt) O[mt * 2 + nt] = __builtin_amdgcn_mfma_f32_16x16x32_bf16(am[mt], kh ? bv[nt][1] : bv[nt][0], O[mt * 2 + nt], 0, 0, 0); }
            __builtin_amdgcn_sched_barrier(0); }
#pragma unroll
          for (int g2 = 0; g2 < 2; ++g2) {
              bf16x8 kf[2][2];
#pragma unroll
              for (int kk = 0; kk < 2; ++kk) { const bf16* khp = (const bf16*)(lds + O_KT) + (16 * (4 * kh + 2 * g2 + kk) + c) * LS + 8 * q; kf[kk][0] = *(const bf16x8*)khp; kf[kk][1] = *(const bf16x8*)(khp + 32); }
              __builtin_amdgcn_sched_barrier(0);
#pragma unroll
              for (int kk = 0; kk < 2; ++kk)
#pragma unroll
                  for (int nt = 0; nt < 2; ++nt) { const int si = (2 * g2 + kk) * 2 + nt;
                      S[si] = __builtin_amdgcn_mfma_f32_16x16x32_bf16(kf[kk][0], bv[nt][0], S[si], 0, 0, 0);
                      S[si] = __builtin_amdgcn_mfma_f32_16x16x32_bf16(kf[kk][1], bv[nt][1], S[si], 0, 0, 0); }
              __builtin_amdgcn_sched_barrier(0);
          }
          { const float* E2 = (const float*)(lds + O_E2) + 64 * kh;
#pragma unroll
            for (int kt = 0; kt < 4; ++kt) { const f32x4 e = *(const f32x4*)(E2 + 16 * kt + 4 * q); S[kt * 2] = S[kt * 2] * e; S[kt * 2 + 1] = S[kt * 2 + 1] * e; } }
        }
        { float* OS = (float*)(lds + (kh ? O_OSTF1 : O_OSTF));
#pragma unroll
          for (int mt = 0; mt < 4; ++mt)
#pragma unroll
              for (int nt = 0; nt < 2; ++nt)
#pragma unroll
                  for (int r = 0; r < 4; ++r) OS[(16 * mt + 4 * q + r) * LO + 32 * vq + 16 * nt + c] = O[mt * 2 + nt][r]; }
        if (ch + 1 < NCH) HB_P2();
        __syncthreads();
        { const float* OS = (const float*)(lds + O_OSTF);
          const int t = tid >> 3, v0 = (tid & 7) * 16; const float* orow = OS + t * LO + v0;
          f32x4 x[4]; float ss = 0.f;
#pragma unroll
          for (int i = 0; i < 4; ++i) { x[i] = *(const f32x4*)(orow + 4 * i) + *(const f32x4*)(orow + (O_OSTF1 - O_OSTF) / 4 + 4 * i); ss += (x[i][0] * x[i][0] + x[i][1] * x[i][1]) + (x[i][2] * x[i][2] + x[i][3] * x[i][3]); }
          ss += __int_as_float(__builtin_amdgcn_update_dpp(0, __float_as_int(ss), 0xB1, 0xF, 0xF, false));
          ss += __int_as_float(__builtin_amdgcn_update_dpp(0, __float_as_int(ss), 0x4E, 0xF, 0xF, false));
          ss += __int_as_float(__builtin_amdgcn_ds_swizzle(__float_as_int(ss), 0x101F));
          const float rs = rsqrtf(ss * (1.0f / 128.0f) + 1e-5f);
          u32x4 o0, o1; const float* wv = (const float*)(lds + O_NW) + v0;
#define HG_G(w_, i_) ((i_) ? __uint_as_float((w_) & 0xffff0000u) : __uint_as_float((w_) << 16))
          o0.x = cvtpk(x[0][0] * rs * wv[0] * HG_G(gt0.x, 0), x[0][1] * rs * wv[1] * HG_G(gt0.x, 1)); o0.y = cvtpk(x[0][2] * rs * wv[2] * HG_G(gt0.y, 0), x[0][3] * rs * wv[3] * HG_G(gt0.y, 1));
          o0.z = cvtpk(x[1][0] * rs * wv[4] * HG_G(gt0.z, 0), x[1][1] * rs * wv[5] * HG_G(gt0.z, 1)); o0.w = cvtpk(x[1][2] * rs * wv[6] * HG_G(gt0.w, 0), x[1][3] * rs * wv[7] * HG_G(gt0.w, 1));
          o1.x = cvtpk(x[2][0] * rs * wv[8] * HG_G(gt1.x, 0), x[2][1] * rs * wv[9] * HG_G(gt1.x, 1)); o1.y = cvtpk(x[2][2] * rs * wv[10] * HG_G(gt1.y, 0), x[2][3] * rs * wv[11] * HG_G(gt1.y, 1));
          o1.z = cvtpk(x[3][0] * rs * wv[12] * HG_G(gt1.z, 0), x[3][1] * rs * wv[13] * HG_G(gt1.z, 1)); o1.w = cvtpk(x[3][2] * rs * wv[14] * HG_G(gt1.w, 0), x[3][3] * rs * wv[15] * HG_G(gt1.w, 1));
#undef HG_G
          char* dst = (char*)(Yq + (size_t)ch * 64 * PY) + lo_o;
          *(u32x4*)dst = o0; *(u32x4*)(dst + 16) = o1; }
        if (ch + 1 < NCH) HB_PREP(ch + 2);
        __syncthreads();
        if (ch + 1 < NCH) HB_P6();
        __syncthreads();
    }
#undef HB_LOAD
#undef HB_P2
#undef HB_PREP
#undef HB_P6
}
#undef HG_BAR
}
namespace sd {
typedef unsigned short bf16;
typedef short bf16x8 __attribute__((ext_vector_type(8)));
typedef float f32x4 __attribute__((ext_vector_type(4)));
typedef unsigned u32x4 __attribute__((ext_vector_type(4)));
typedef unsigned u32x2 __attribute__((ext_vector_type(2)));
constexpr int T = 4096, M = 4 * T, PY1 = 2816, PAO = 2048, LB = 136, LT = 72;
constexpr int O_BM = 0, O_CM = O_BM + 64 * LB * 2, O_BT = O_CM + 64 * LB * 2, O_XT = O_BT + 128 * LT * 2, O_DT = O_XT + 8 * 64 * LT * 2, O_AC = O_DT + 2048, LDS_BYTES = O_AC + 2048;
__device__ __forceinline__ float bf2f(unsigned v) { return __uint_as_float(v << 16); }
__device__ __forceinline__ float bflo(unsigned w) { return __uint_as_float(w << 16); }
__device__ __forceinline__ float bfhi(unsigned w) { return __uint_as_float(w & 0xffff0000u); }
typedef float f32x2_t __attribute__((ext_vector_type(2))); typedef __bf16 bf16x2_t __attribute__((ext_vector_type(2)));
__device__ __forceinline__ unsigned cvtpk(float lo, float hi) { f32x2_t v = {lo, hi}; bf16x2_t b = __builtin_convertvector(v, bf16x2_t); return __builtin_bit_cast(unsigned, b); }
__device__ __forceinline__ float fexp(float x) { return __builtin_amdgcn_exp2f(x * 1.4426950408889634f); }
__device__ __forceinline__ float silu(float x) { return x * __builtin_amdgcn_rcpf(1.0f + fexp(-x)); }
__device__ __forceinline__ float lget(float v, int src) { return __int_as_float(__builtin_amdgcn_ds_bpermute(src << 2, __float_as_int(v))); }

template <bool STATE_ONLY>
__device__ __forceinline__ void ssd_stage(char* lds, int tid, int g, size_t m0, int tg0, const bf16* Y1, const float* cw, const float* cb) {
    u32x2 rawA[11], rawB[11];
#define SD_SRC(cq_) ((cq_) < 128 ? g * 512 + (cq_) * 4 : (cq_) < 160 ? 1024 + g * 128 + ((cq_) - 128) * 4 : 1280 + g * 128 + ((cq_) - 160) * 4)
#define SD_LOAD(RAW, t_) do { const int cq_ = (t_) % 192, l0_ = ((t_) / 192) * 8; const bf16* yp_ = Y1 + (m0 + l0_) * PY1 + 1024 + SD_SRC(cq_); \
        _Pragma("unroll") for (int r = 0; r < 11; ++r) { RAW[r] = (u32x2){0u, 0u}; if (!(STATE_ONLY && cq_ >= 160) && tg0 + l0_ + r - 3 >= 0) RAW[r] = *(const u32x2*)(yp_ + (ptrdiff_t)(r - 3) * PY1); } } while (0)
#define SD_TASK(RAW, t_) do { const int tk_ = (t_); const int cq = tk_ % 192, l0 = (tk_ / 192) * 8; \
        if (!(STATE_ONLY && cq >= 160)) {                                           \
        const int src = SD_SRC(cq); \
        const f32x4 w0 = *(const f32x4*)(cw + src), w1 = *(const f32x4*)(cw + 1536 + src), w2 = *(const f32x4*)(cw + 3072 + src), w3 = *(const f32x4*)(cw + 4608 + src), bb = *(const f32x4*)(cb + src); \
          \
        bf16* tdst = cq < 128 ? (bf16*)(lds + O_XT) + ((cq >> 4) * 64 + (cq & 15) * 4) * LT + l0 : (bf16*)(lds + O_BT) + ((cq - 128) & 31) * 4 * LT + l0; \
        bf16* rdst = (cq < 160 ? (bf16*)(lds + O_BM) + (cq - 128) * 4 : (bf16*)(lds + O_CM) + (cq - 160) * 4) + l0 * LB; \
        unsigned tp[4][4];                                                           \
        _Pragma("unroll") for (int r = 0; r < 8; r += 2) { \
            const f32x4 x0 = (f32x4){bflo(RAW[r].x), bfhi(RAW[r].x), bflo(RAW[r].y), bfhi(RAW[r].y)}, x1 = (f32x4){bflo(RAW[r + 1].x), bfhi(RAW[r + 1].x), bflo(RAW[r + 1].y), bfhi(RAW[r + 1].y)}, \
                        x2 = (f32x4){bflo(RAW[r + 2].x), bfhi(RAW[r + 2].x), bflo(RAW[r + 2].y), bfhi(RAW[r + 2].y)}, x3 = (f32x4){bflo(RAW[r + 3].x), bfhi(RAW[r + 3].x), bflo(RAW[r + 3].y), bfhi(RAW[r + 3].y)}, \
                        x4 = (f32x4){bflo(RAW[r + 4].x), bfhi(RAW[r + 4].x), bflo(RAW[r + 4].y), bfhi(RAW[r + 4].y)}; \
            const f32x4 a = bb + w0 * x0 + w1 * x1 + w2 * x2 + w3 * x3, b_ = bb + w0 * x1 + w1 * x2 + w2 * x3 + w3 * x4; \
            const f32x4 oa = (f32x4){silu(a[0]), silu(a[1]), silu(a[2]), silu(a[3])}, ob = (f32x4){silu(b_[0]), silu(b_[1]), silu(b_[2]), silu(b_[3])}; \
            _Pragma("unroll") for (int i = 0; i < 4; ++i) tp[i][r >> 1] = cvtpk(oa[i], ob[i]); \
            if (cq >= 128 && (!STATE_ONLY || cq >= 160)) { *(u32x2*)(rdst + r * LB) = (u32x2){cvtpk(oa[0], oa[1]), cvtpk(oa[2], oa[3])}; *(u32x2*)(rdst + (r + 1) * LB) = (u32x2){cvtpk(ob[0], ob[1]), cvtpk(ob[2], ob[3])}; } \
        } \
        if (cq < 160) { _Pragma("unroll") for (int i = 0; i < 4; ++i) *(u32x4*)(tdst + i * LT) = (u32x4){tp[i][0], tp[i][1], tp[i][2], tp[i][3]}; } \
        } } while (0)
    if (STATE_ONLY) {
#pragma unroll 1
        for (int t = tid; t < 192 * 8; t += 512) { SD_LOAD(rawA, t); SD_TASK(rawA, t); }
    } else {
        SD_LOAD(rawA, tid); SD_LOAD(rawB, tid + 512);
        SD_TASK(rawA, tid);
        SD_LOAD(rawA, tid + 1024);
        SD_TASK(rawB, tid + 512);
        SD_TASK(rawA, tid + 1024);
    }
#undef SD_SRC
#undef SD_LOAD
#undef SD_TASK
}

template <bool STATE_ONLY>
__device__ __forceinline__ void ssd_unit(char* lds, int tid, int u, const bf16* Y1, const float* FDt, const float* cw, const float* cb, const float* dt_bias, const float* A_log, const float* Dsk,
                                         const float* nw, u32x4* STL, float* DEC, bf16* AO) {
    const int lane = tid & 63, w = __builtin_amdgcn_readfirstlane(tid >> 6), c = lane & 15, q = lane >> 4;
    const int g = u & 1, cidx = (u >> 1) & 31, b = u >> 6, h = 8 * g + w;
    const size_t mc = (size_t)b * T + (size_t)cidx * 128;
    const float Ah = -fexp(A_log[h]), dtb = dt_bias[h], Dh = Dsk[h];
    f32x4 st[STATE_ONLY ? 32 : 1];
    u32x4 bS[STATE_ONLY ? 1 : 16];
    if (STATE_ONLY) {
#pragma unroll
        for (int i = 0; i < 32; ++i) st[i] = (f32x4){0.f, 0.f, 0.f, 0.f};
    } else {
        const u32x4* sl = STL + (size_t)u * 8192 + w * 64 + lane;
#pragma unroll
        for (int i = 0; i < 16; ++i) bS[i] = sl[(size_t)i * 512];
    }
    float fdv = FDt[(size_t)(8 + h) * M + mc + lane];
    ssd_stage<STATE_ONLY>(lds, tid, g, mc, cidx * 128, Y1, cw, cb);
    float atot_chunk = 0.f;
    bf16* XTw = (bf16*)(lds + O_XT) + w * 64 * LT;
    float* DTl = (float*)(lds + O_DT) + w * 64; float* ACl = (float*)(lds + O_AC) + w * 64;
#pragma unroll
    for (int sub = 0; sub < 2; ++sub) {
        const size_t m0 = mc + sub * 64; const int tg0 = cidx * 128 + sub * 64;
        int lane_s = tid & 63; asm volatile("" : "+v"(lane_s));
        const int lane = lane_s, c = lane & 15, q = lane >> 4; (void)tg0;
        float atot;
        { const float xx = fdv + dtb; const float u_ = fexp(-fabsf(xx)); const float dt = fmaxf(xx, 0.f) + (u_ < 1e-4f ? u_ * (1.0f - 0.5f * u_) : __builtin_amdgcn_logf(1.0f + u_) * 0.6931471805599453f);
          float ac = dt * Ah;
#pragma unroll
          for (int o_ = 1; o_ < 64; o_ <<= 1) { const float v = lget(ac, lane - o_); if (lane >= o_) ac += v; }
          DTl[lane] = dt; ACl[lane] = ac; atot = __int_as_float(__builtin_amdgcn_readlane(__float_as_int(ac), 63)); }
        atot_chunk += atot;
        __syncthreads();
        u32x4 z0, z1, z2; f32x4 n0, n1; int lo_ = 0;
        if (STATE_ONLY) {
            const float ea = fexp(atot);
#pragma unroll
            for (int i = 0; i < 32; ++i) st[i] = st[i] * ea;
#pragma unroll
            for (int ks2 = 0; ks2 < 2; ++ks2) {
                bf16x8 xw[4];
                { const f32x4 d0 = *(const f32x4*)(DTl + 32 * ks2 + 8 * q), d1 = *(const f32x4*)(DTl + 32 * ks2 + 8 * q + 4), a0 = *(const f32x4*)(ACl + 32 * ks2 + 8 * q), a1 = *(const f32x4*)(ACl + 32 * ks2 + 8 * q + 4);
                  float wl[8];
#pragma unroll
                  for (int j = 0; j < 4; ++j) { wl[j] = d0[j] * fexp(fminf(atot - a0[j], 0.f)); wl[4 + j] = d1[j] * fexp(fminf(atot - a1[j], 0.f)); }
#pragma unroll
                  for (int pt = 0; pt < 4; ++pt) { const u32x4 xv = *(const u32x4*)(XTw + (16 * pt + c) * LT + 32 * ks2 + 8 * q);
                      const u32x4 t_ = (u32x4){cvtpk(bflo(xv.x) * wl[0], bfhi(xv.x) * wl[1]), cvtpk(bflo(xv.y) * wl[2], bfhi(xv.y) * wl[3]), cvtpk(bflo(xv.z) * wl[4], bfhi(xv.z) * wl[5]), cvtpk(bflo(xv.w) * wl[6], bfhi(xv.w) * wl[7])};
                      xw[pt] = __builtin_bit_cast(bf16x8, t_); } }
#pragma unroll
                for (int nt = 0; nt < 8; ++nt) { const bf16x8 af = *(const bf16x8*)((const bf16*)(lds + O_BT) + (16 * nt + c) * LT + 32 * ks2 + 8 * q);
#pragma unroll
                    for (int pt = 0; pt < 4; ++pt) st[nt * 4 + pt] = __builtin_amdgcn_mfma_f32_16x16x32_bf16(af, xw[pt], st[nt * 4 + pt], 0, 0, 0); }
            }
        } else {
            u32x4 xw[8];
            if (sub == 0) {
#pragma unroll
                for (int ks2 = 0; ks2 < 2; ++ks2) {
                    const f32x4 d0 = *(const f32x4*)(DTl + 32 * ks2 + 8 * q), d1 = *(const f32x4*)(DTl + 32 * ks2 + 8 * q + 4), a0 = *(const f32x4*)(ACl + 32 * ks2 + 8 * q), a1 = *(const f32x4*)(ACl + 32 * ks2 + 8 * q + 4);
                    float wl[8];
#pragma unroll
                    for (int j = 0; j < 4; ++j) { wl[j] = d0[j] * fexp(fminf(atot - a0[j], 0.f)); wl[4 + j] = d1[j] * fexp(fminf(atot - a1[j], 0.f)); }
#pragma unroll
                    for (int pt = 0; pt < 4; ++pt) { const u32x4 xv = *(const u32x4*)(XTw + (16 * pt + c) * LT + 32 * ks2 + 8 * q);
                        xw[ks2 * 4 + pt] = (u32x4){cvtpk(bflo(xv.x) * wl[0], bfhi(xv.x) * wl[1]), cvtpk(bflo(xv.y) * wl[2], bfhi(xv.y) * wl[3]), cvtpk(bflo(xv.z) * wl[4], bfhi(xv.z) * wl[5]), cvtpk(bflo(xv.w) * wl[6], bfhi(xv.w) * wl[7])}; }
                }
            }
#pragma unroll
            for (int Ii = 0; Ii < 4; ++Ii) { const int I = 3 - Ii;
                f32x4 y[4];
#pragma unroll
                for (int pt = 0; pt < 4; ++pt) y[pt] = (f32x4){0.f, 0.f, 0.f, 0.f};
                u32x4 cfr[4]; bf16x8 cst[4], bfr[2][4];
#pragma unroll
                for (int ks = 0; ks < 4; ++ks) { const bf16* cp = (const bf16*)(lds + O_CM) + (16 * I + c) * LB + 32 * ks + 4 * q;
                    const u32x2 a0 = *(const u32x2*)cp, a1 = *(const u32x2*)(cp + 16); cfr[ks] = (u32x4){a0.x, a0.y, a1.x, a1.y}; }
                const f32x4 ac4 = *(const f32x4*)(ACl + 16 * I + 4 * q); const float acl = ACl[16 * I + c];
#pragma unroll
                for (int ks = 0; ks < 4; ++ks) { cst[ks] = *(const bf16x8*)((const bf16*)(lds + O_CM) + (16 * I + c) * LB + 8 * q + 32 * ks); bfr[0][ks] = *(const bf16x8*)((const bf16*)(lds + O_BM) + c * LB + 8 * q + 32 * ks); }
                __builtin_amdgcn_sched_barrier(0);
#pragma unroll
                for (int ks = 0; ks < 4; ++ks)
#pragma unroll
                    for (int pt = 0; pt < 4; ++pt) y[pt] = __builtin_amdgcn_mfma_f32_16x16x32_bf16(__builtin_bit_cast(bf16x8, cfr[ks]), __builtin_bit_cast(bf16x8, bS[ks * 4 + pt]), y[pt], 0, 0, 0);
                { const f32x4 e = (f32x4){fexp(ac4[0]), fexp(ac4[1]), fexp(ac4[2]), fexp(ac4[3])};
#pragma unroll
                  for (int pt = 0; pt < 4; ++pt) y[pt] = y[pt] * e; }
                u32x2 xp[4];
#pragma unroll
                for (int J = 0; J < 4; ++J) {
                    if (J > I) { xp[J] = (u32x2){0u, 0u}; continue; }
                    if (J + 1 <= I) {
#pragma unroll
                        for (int ks = 0; ks < 4; ++ks) bfr[(J + 1) & 1][ks] = *(const bf16x8*)((const bf16*)(lds + O_BM) + (16 * (J + 1) + c) * LB + 8 * q + 32 * ks); }
                    const f32x4 acs = *(const f32x4*)(ACl + 16 * J + 4 * q), dts = *(const f32x4*)(DTl + 16 * J + 4 * q);
                    __builtin_amdgcn_sched_barrier(0);
                    f32x4 acc = (f32x4){0.f, 0.f, 0.f, 0.f};
#pragma unroll
                    for (int ks = 0; ks < 4; ++ks) acc = __builtin_amdgcn_mfma_f32_16x16x32_bf16(bfr[J & 1][ks], cst[ks], acc, 0, 0, 0);
                    float v[4];
#pragma unroll
                    for (int r = 0; r < 4; ++r) { v[r] = acc[r] * fexp(fminf(acl - acs[r], 0.f)) * dts[r]; if (J == I && 4 * q + r > c) v[r] = 0.f; }
                    xp[J] = (u32x2){cvtpk(v[0], v[1]), cvtpk(v[2], v[3])};
                }
                { u32x4 xfr[2][4];
#pragma unroll
                  for (int ks2 = 0; ks2 < 2; ++ks2) {
                      if (ks2 == 1 && I < 2) continue;
#pragma unroll
                      for (int pt = 0; pt < 4; ++pt) { const bf16* xq = XTw + (16 * pt + c) * LT + 32 * ks2 + 4 * q;
                          const u32x2 b0 = *(const u32x2*)xq, b1 = *(const u32x2*)(xq + 16); xfr[ks2][pt] = (u32x4){b0.x, b0.y, b1.x, b1.y}; } }
                  __builtin_amdgcn_sched_barrier(0);
#pragma unroll
                  for (int ks2 = 0; ks2 < 2; ++ks2) {
                      if (ks2 == 1 && I < 2) continue;
                      const u32x4 aa = (u32x4){xp[2 * ks2].x, xp[2 * ks2].y, xp[2 * ks2 + 1].x, xp[2 * ks2 + 1].y}; const bf16x8 af = __builtin_bit_cast(bf16x8, aa);
#pragma unroll
                      for (int pt = 0; pt < 4; ++pt) y[pt] = __builtin_amdgcn_mfma_f32_16x16x32_bf16(af, __builtin_bit_cast(bf16x8, xfr[ks2][pt]), y[pt], 0, 0, 0); } }
                u32x2 xv[4];
#pragma unroll
                for (int pt = 0; pt < 4; ++pt) xv[pt] = *(const u32x2*)(XTw + (16 * pt + c) * LT + 16 * I + 4 * q);
#pragma unroll
                for (int pt = 0; pt < 4; ++pt) {
                    const float y0 = y[pt][0] + Dh * bflo(xv[pt].x), y1 = y[pt][1] + Dh * bfhi(xv[pt].x), y2 = y[pt][2] + Dh * bflo(xv[pt].y), y3 = y[pt][3] + Dh * bfhi(xv[pt].y);
                    *(u32x2*)(XTw + (8 * (c & 7) + 2 * pt + (c >> 3)) * LT + 16 * I + 4 * (q ^ (w & 3))) = (u32x2){cvtpk(y0, y1), cvtpk(y2, y3)}; }
            }
            if (sub == 0) {
                const float ea = fexp(atot);
#pragma unroll
                for (int ks = 0; ks < 4; ++ks) {
                    const bf16x8 a00 = *(const bf16x8*)((const bf16*)(lds + O_BT) + (16 * (2 * ks) + c) * LT + 8 * q), a01 = *(const bf16x8*)((const bf16*)(lds + O_BT) + (16 * (2 * ks) + c) * LT + 32 + 8 * q);
                    const bf16x8 a10 = *(const bf16x8*)((const bf16*)(lds + O_BT) + (16 * (2 * ks + 1) + c) * LT + 8 * q), a11 = *(const bf16x8*)((const bf16*)(lds + O_BT) + (16 * (2 * ks + 1) + c) * LT + 32 + 8 * q);
#pragma unroll
                    for (int pt = 0; pt < 4; ++pt) { const u32x4 p_ = bS[ks * 4 + pt];
                        f32x4 t0 = (f32x4){bflo(p_.x) * ea, bfhi(p_.x) * ea, bflo(p_.y) * ea, bfhi(p_.y) * ea}, t1 = (f32x4){bflo(p_.z) * ea, bfhi(p_.z) * ea, bflo(p_.w) * ea, bfhi(p_.w) * ea};
                        t0 = __builtin_amdgcn_mfma_f32_16x16x32_bf16(a00, __builtin_bit_cast(bf16x8, xw[pt]), t0, 0, 0, 0); t0 = __builtin_amdgcn_mfma_f32_16x16x32_bf16(a01, __builtin_bit_cast(bf16x8, xw[4 + pt]), t0, 0, 0, 0);
                        t1 = __builtin_amdgcn_mfma_f32_16x16x32_bf16(a10, __builtin_bit_cast(bf16x8, xw[pt]), t1, 0, 0, 0); t1 = __builtin_amdgcn_mfma_f32_16x16x32_bf16(a11, __builtin_bit_cast(bf16x8, xw[4 + pt]), t1, 0, 0, 0);
                        bS[ks * 4 + pt] = (u32x4){cvtpk(t0[0], t0[1]), cvtpk(t0[2], t0[3]), cvtpk(t1[0], t1[1]), cvtpk(t1[2], t1[3])}; }
                }
            }
            lo_ = lane; asm volatile("" : "+v"(lo_));
            { const bf16* zp = Y1 + (m0 + w) * PY1 + g * 512 + lo_ * 8; z0 = *(const u32x4*)zp; z1 = *(const u32x4*)(zp + (size_t)8 * PY1); z2 = *(const u32x4*)(zp + (size_t)16 * PY1); }
            { const float* nwp = nw + g * 512 + lo_ * 8; n0 = *(const f32x4*)nwp; n1 = *(const f32x4*)(nwp + 4); }
        }
        __syncthreads();
        if (!STATE_ONLY) {
            const bf16* ysl = (const bf16*)(lds + O_XT) + ((lo_ >> 3) * 64 + (lo_ & 7)) * LT;
            const int ysw = (lo_ >> 3) & 3;
            const bf16* zp = Y1 + (m0 + w) * PY1 + g * 512 + lo_ * 8; bf16* op = AO + (m0 + w) * PAO + 1024 + g * 512 + lo_ * 8;
#pragma unroll 1
            for (int i = 0; i < 8; ++i) { const int l = w + 8 * i; const u32x4 zv = z0; z0 = z1; z1 = z2;
                if (i + 3 < 8) z2 = *(const u32x4*)(zp + (size_t)(8 * (i + 3)) * PY1);
                const int lc = (l & ~15) | ((((l >> 2) & 3) ^ ysw) << 2) | (l & 3);
                u32x4 yv; yv.x = (unsigned)ysl[lc] | ((unsigned)ysl[8 * LT + lc] << 16); yv.y = (unsigned)ysl[16 * LT + lc] | ((unsigned)ysl[24 * LT + lc] << 16);
                yv.z = (unsigned)ysl[32 * LT + lc] | ((unsigned)ysl[40 * LT + lc] << 16); yv.w = (unsigned)ysl[48 * LT + lc] | ((unsigned)ysl[56 * LT + lc] << 16);
                float v[8] = {bflo(yv.x) * silu(bflo(zv.x)), bfhi(yv.x) * silu(bfhi(zv.x)), bflo(yv.y) * silu(bflo(zv.y)), bfhi(yv.y) * silu(bfhi(zv.y)),
                              bflo(yv.z) * silu(bflo(zv.z)), bfhi(yv.z) * silu(bfhi(zv.z)), bflo(yv.w) * silu(bflo(zv.w)), bfhi(yv.w) * silu(bfhi(zv.w))};
                float ss = 0.f;
#pragma unroll
                for (int j = 0; j < 8; ++j) ss += v[j] * v[j];
                ss += __int_as_float(__builtin_amdgcn_update_dpp(0, __float_as_int(ss), 0xB1, 0xF, 0xF, false));
                ss += __int_as_float(__builtin_amdgcn_update_dpp(0, __float_as_int(ss), 0x4E, 0xF, 0xF, false));
                ss += __int_as_float(__builtin_amdgcn_update_dpp(0, __float_as_int(ss), 0x141, 0xF, 0xF, false));
                ss += __int_as_float(__builtin_amdgcn_update_dpp(0, __float_as_int(ss), 0x140, 0xF, 0xF, false));
                ss = (__int_as_float(__builtin_amdgcn_readlane(__float_as_int(ss), 0)) + __int_as_float(__builtin_amdgcn_readlane(__float_as_int(ss), 16)))
                   + (__int_as_float(__builtin_amdgcn_readlane(__float_as_int(ss), 32)) + __int_as_float(__builtin_amdgcn_readlane(__float_as_int(ss), 48)));
                const float rs = rsqrtf(ss * (1.0f / 512.0f) + 1e-5f);
                const u32x4 ov = (u32x4){cvtpk(v[0] * rs * n0[0], v[1] * rs * n0[1]), cvtpk(v[2] * rs * n0[2], v[3] * rs * n0[3]), cvtpk(v[4] * rs * n1[0], v[5] * rs * n1[1]), cvtpk(v[6] * rs * n1[2], v[7] * rs * n1[3])};
                *(u32x4*)(op + (size_t)(8 * i) * PAO) = ov; }
            __syncthreads();
        }
        if (sub == 0) { fdv = FDt[(size_t)(8 + h) * M + mc + 64 + lane]; ssd_stage<STATE_ONLY>(lds, tid, g, mc + 64, cidx * 128 + 64, Y1, cw, cb); }
    }
    if (STATE_ONLY) {
        u32x4* sl = STL + (size_t)u * 8192 + w * 64 + lane;
#pragma unroll
        for (int ks = 0; ks < 4; ++ks)
#pragma unroll
            for (int pt = 0; pt < 4; ++pt) { const f32x4 s0 = st[(2 * ks) * 4 + pt], s1 = st[(2 * ks + 1) * 4 + pt];
                sl[(size_t)(ks * 4 + pt) * 512] = (u32x4){cvtpk(s0[0], s0[1]), cvtpk(s0[2], s0[3]), cvtpk(s1[0], s1[1]), cvtpk(s1[2], s1[3])}; }
        if (lane == 0) DEC[(size_t)(b * 32 + cidx) * 16 + h] = fexp(atot_chunk);
    }
}
__device__ __forceinline__ void ssd_scan(size_t gtid, size_t gsz, u32x4* STL, const float* DEC) {
    for (size_t col = gtid; col < (size_t)8 * 16384; col += gsz) {
        const int bg = (int)(col >> 14), e2 = (int)(col & 16383), b = bg >> 1, g = bg & 1, wv = (e2 >> 7) & 7;
        u32x2 v[32]; float d[32];
#pragma unroll
        for (int cc = 0; cc < 32; ++cc) { v[cc] = *((const u32x2*)(STL + (size_t)((b * 32 + cc) * 2 + g) * 8192) + e2); d[cc] = DEC[(size_t)(b * 32 + cc) * 16 + g * 8 + wv]; }
        float z_ = 0.f; asm volatile("" : "+v"(z_)); f32x4 run = (f32x4){z_, z_, z_, z_};
#pragma unroll
        for (int cc = 0; cc < 32; ++cc) { u32x2* p = (u32x2*)(STL + (size_t)((b * 32 + cc) * 2 + g) * 8192) + e2;
            *p = (u32x2){cvtpk(run[0], run[1]), cvtpk(run[2], run[3])};
            run = run * d[cc] + (f32x4){bflo(v[cc].x), bfhi(v[cc].x), bflo(v[cc].y), bfhi(v[cc].y)}; }
    }
}
}
#define LAS __attribute__((address_space(3)))
#define XB_TMO      128
#define XB_XCNT(j)  (256  + 64 * (j))
#define XB_XSUB(j)  (1280 + 64 * (j))
#define XB_XGEN(j)  (2304 + 64 * (j))
#define XB_TOP      3328
#define XB_TOPGEN   3392
#define XCD_BAR_WORDS 3456
#define XB_SPIN_CAP (1u << 18)

__device__ __forceinline__ unsigned xb_ld(unsigned* p)              { return __hip_atomic_load(p, __ATOMIC_RELAXED, __HIP_MEMORY_SCOPE_AGENT); }
__device__ __forceinline__ unsigned xb_add(unsigned* p, unsigned v) { return __hip_atomic_fetch_add(p, v, __ATOMIC_RELAXED, __HIP_MEMORY_SCOPE_AGENT); }
__device__ __forceinline__ unsigned xb_xcc_id() { return (unsigned)__builtin_amdgcn_s_getreg((3 << 11) | 20) & 0xFu; }
#define XB_SPIN(cond, bar) do { unsigned _sp = 0; while (cond) { __builtin_amdgcn_s_sleep(1); \
    if ((++_sp & 255u) == 0u) { if (xb_ld(&(bar)[XB_TMO])) break; if (_sp > XB_SPIN_CAP) { atomicAdd(&(bar)[XB_TMO], 1u); break; } } } } while (0)

struct XcdBarrier {
    unsigned* bar; unsigned x;
    volatile LAS unsigned* st;
};

__device__ __forceinline__ XcdBarrier xcd_barrier_post(unsigned* bar, volatile LAS unsigned* st) {
    XcdBarrier b; b.bar = bar; b.x = xb_xcc_id(); b.st = st;
    if (threadIdx.x == 0) (void)xb_add(&bar[XB_XCNT(b.x)], 1u);
    return b;
}
__device__ __forceinline__ void xcd_barrier_complete(unsigned* bar, unsigned x, unsigned& nloc, unsigned& nx) {
    const unsigned G = gridDim.x * gridDim.y * gridDim.z;
    unsigned sum, cnt, mine, sp = 0u;
    for (;;) {
        sum = 0u; cnt = 0u; mine = 0u;
#pragma unroll
        for (unsigned j = 0; j < 16; ++j) { const unsigned c = xb_ld(&bar[XB_XCNT(j)]); sum += c; cnt += (c > 0u) ? 1u : 0u; mine = (j == x) ? c : mine; }
        if (sum == G) break;
        __builtin_amdgcn_s_sleep(1);
        if ((++sp & 255u) == 0u) { if (xb_ld(&bar[XB_TMO])) break; if (sp > XB_SPIN_CAP) { atomicAdd(&bar[XB_TMO], 1u); break; } }
    }
    nloc = mine > 0u ? mine : 1u; nx = cnt > 0u ? cnt : 1u;
}

__device__ __forceinline__ void xcd_barrier(const XcdBarrier& b, const bool leader  ) {
    asm volatile("s_waitcnt vmcnt(0)" ::: "memory");
    __syncthreads();
    if (leader) {
        unsigned* bar = b.bar;
        __builtin_amdgcn_s_waitcnt(0);
        unsigned nloc = b.st[0], nx = b.st[1];
        if (nloc == 0u) { xcd_barrier_complete(bar, b.x, nloc, nx); b.st[0] = nloc; b.st[1] = nx; }
        const unsigned old = xb_add(&bar[XB_XSUB(b.x)], 1u);
        const unsigned gen = old / nloc;
        if (old + 1u == (gen + 1u) * nloc) {
            __builtin_amdgcn_fence(__ATOMIC_RELEASE, "agent");
            asm volatile("s_waitcnt vmcnt(0)" ::: "memory");
            const unsigned og = xb_add(&bar[XB_TOP], 1u);
            const unsigned tg = og / nx;
            if (og + 1u == (tg + 1u) * nx) xb_add(&bar[XB_TOPGEN], 1u);
            else XB_SPIN(xb_ld(&bar[XB_TOPGEN]) == tg, bar);
            __builtin_amdgcn_fence(__ATOMIC_ACQUIRE, "agent");
            xb_add(&bar[XB_XGEN(b.x)], 1u);
            asm volatile("s_waitcnt vmcnt(0)" ::: "memory");
        } else {
            XB_SPIN(xb_ld(&bar[XB_XGEN(b.x)]) == gen, bar);
            __builtin_amdgcn_fence(__ATOMIC_ACQUIRE, "agent");
            asm volatile("s_waitcnt vmcnt(0)" ::: "memory");
        }
    }
    __syncthreads();
}
namespace hy {
typedef unsigned short bf16;
constexpr int B = 4, T = 4096, D = 1024, M = B * T;
constexpr int EVEN_IN = 6680, ODD_IN = 8192;
constexpr int NE = 6912;
constexpr int NE1 = 2816, NE2 = 3072;
constexpr int NO1 = 6144, NO2 = 2048;
constexpr size_t MiB = 1u << 20;
constexpr size_t WS_CTL = 0, CTL_ZERO_BYTES = 64 * 1024;
constexpr size_t WS_RS = 512 * 1024, WS_FDT = 1 * MiB, WS_SS = 3 * MiB, WS_CS = 4 * MiB, WS_WA = 5 * MiB, WS_WB = 21 * MiB, WS_AO = 25 * MiB, WS_Y = 89 * MiB, WS_YODD = 25 * MiB;
constexpr size_t WS_NRM = WS_CS + 640 * 1024;
constexpr size_t WS_STL = WS_Y + 88 * MiB, WS_DEC = WS_CS + 512 * 1024;
constexpr size_t WS_SLOC = WS_WA, WS_GB = WS_YODD + 192 * MiB, WS_DSEG = WS_GB + 32 * MiB;
constexpr int CW_QCNT = 8192;
constexpr int CW_BAR = 4096;
constexpr int RING_BYTES = 155648, MISC_OFF = RING_BYTES + 320, LDS_BYTES = 157696;
constexpr int NT = 512, NWV = 8;

__device__ __forceinline__ unsigned f2bf(float f) { unsigned u = __float_as_uint(f); return (u + 0x7fffu + ((u >> 16) & 1u)) >> 16; }
__device__ __forceinline__ float bf2f(bf16 v) { return __uint_as_float((unsigned)v << 16); }
__device__ __forceinline__ float lx(float v, int mask, int lane) { return __int_as_float(__builtin_amdgcn_ds_bpermute((lane ^ mask) << 2, __float_as_int(v))); }
__device__ __forceinline__ float lget(float v, int src) { return __int_as_float(__builtin_amdgcn_ds_bpermute(src << 2, __float_as_int(v))); }
__device__ __forceinline__ float wave_sum(float v, int lane) {
#pragma unroll
    for (int o = 1; o < 64; o <<= 1) v += lx(v, o, lane);
    return v;
}
__device__ __forceinline__ float sigmoid_f(float x) { return 1.0f / (1.0f + __expf(-x)); }
__device__ __forceinline__ float silu_f(float x) { return x / (1.0f + __expf(-x)); }
__device__ __forceinline__ float log1p_fast(float u) { return u < 1e-4f ? u * (1.0f - 0.5f * u) : __builtin_amdgcn_logf(1.0f + u) * 0.6931471805599453f; }
__device__ __forceinline__ float log_sigmoid_f(float x) { return fminf(x, 0.f) - log1p_fast(__expf(-fabsf(x))); }
__device__ __forceinline__ float softplus_f(float x) { return fmaxf(x, 0.f) + log1p_fast(__expf(-fabsf(x))); }

__device__ __forceinline__ void ph_prologue(int gw, int ngw, int lane, const float* __restrict__ x, bf16* __restrict__ hi, float* __restrict__ RS) {
    for (int m0 = gw; m0 < M; m0 += 4 * ngw) {
        float4 v[4][4];
#pragma unroll
        for (int r = 0; r < 4; ++r)
#pragma unroll
            for (int j = 0; j < 4; ++j) v[r][j] = m0 + r * ngw < M ? *(const float4*)(x + (size_t)(m0 + r * ngw) * D + j * 256 + lane * 4) : make_float4(0.f, 0.f, 0.f, 0.f);
#pragma unroll
        for (int r = 0; r < 4; ++r) { const int m = m0 + r * ngw; float s = 0.f; if (m >= M) break;
#pragma unroll
            for (int j = 0; j < 4; ++j) { const float4 a = v[r][j]; s += (a.x * a.x + a.y * a.y) + (a.z * a.z + a.w * a.w);
                *(uint2*)(hi + (size_t)m * D + j * 256 + lane * 4) = make_uint2(f2bf(a.x) | (f2bf(a.y) << 16), f2bf(a.z) | (f2bf(a.w) << 16)); }
            s = wave_sum(s, lane);
            if (lane == 0) RS[m] = rsqrtf(s * (1.0f / 1024.0f) + 1e-5f); }
    }
}
__device__ __forceinline__ int even_map(int n) {
    if (n < 4096) return n;
    if (n < 5120) return 4104 + (n - 4096);
    if (n < 6656) return 5128 + (n - 5120);
    if (n < 6664) return 4096 + (n - 6656);
    if (n < 6680) return 6664 + (n - 6664);
    return -1;
}
template <int MAP, bool HAS_NW>
__device__ __forceinline__ void ph_convert_w(LAS float* tile_, int bid, int nb_grid, int tid, const float* __restrict__ W, int K, int Nsrc, int Ndst, const float* __restrict__ nw, bf16* __restrict__ Wt) {
    LAS unsigned char* tile = (LAS unsigned char*)tile_;
    const int l32 = tid & 31, kp = tid >> 5;
    const int nb = Ndst / 128, kb = K / 64, ntile = nb * kb;
    float4 v[2][2]; float wk[2][2];
#define CV_LOAD(it_) do { const int n0_ = ((it_) % nb) * 128, k0_ = ((it_) / nb) * 64; const int n_ = n0_ + 4 * l32; const int sc_ = MAP == 1 ? even_map(n_) : n_; \
        _Pragma("unroll") for (int p_ = 0; p_ < 2; ++p_) _Pragma("unroll") for (int e_ = 0; e_ < 2; ++e_) { const int k_ = k0_ + 2 * (kp + 16 * p_) + e_; \
            v[p_][e_] = sc_ >= 0 ? *(const float4*)(W + (size_t)k_ * Nsrc + sc_) : make_float4(0.f, 0.f, 0.f, 0.f); wk[p_][e_] = HAS_NW ? nw[k_] : 1.f; } } while (0)
    int it = bid;
    if (it < ntile) CV_LOAD(it);
    for (; it < ntile; it += nb_grid) {
        const int n0 = (it % nb) * 128, k0 = (it / nb) * 64;
#pragma unroll
        for (int p = 0; p < 2; ++p) { const float4 a = v[p][0], b = v[p][1]; const float wa = wk[p][0], wb = wk[p][1];
            LAS unsigned char* dst = tile + (4 * l32) * 132 + (kp + 16 * p) * 4;
            *(LAS unsigned*)(dst) = f2bf(a.x * wa) | (f2bf(b.x * wb) << 16); *(LAS unsigned*)(dst + 132) = f2bf(a.y * wa) | (f2bf(b.y * wb) << 16);
            *(LAS unsigned*)(dst + 264) = f2bf(a.z * wa) | (f2bf(b.z * wb) << 16); *(LAS unsigned*)(dst + 396) = f2bf(a.w * wa) | (f2bf(b.w * wb) << 16); }
        __syncthreads();
        if (it + nb_grid < ntile) CV_LOAD(it + nb_grid);
#pragma unroll
        for (int r = 0; r < 2; ++r) { const int c = tid + 512 * r, n = c >> 3, j = c & 7; const LAS unsigned* src = (const LAS unsigned*)(tile + n * 132 + j * 16);
            uint4 o; o.x = src[0]; o.y = src[1]; o.z = src[2]; o.w = src[3];
            *(uint4*)(Wt + (size_t)(n0 + n) * K + k0 + 8 * j) = o; }
        __syncthreads();
    }
#undef CV_LOAD
}

__device__ __forceinline__ void ph_rstd(size_t gtid, size_t gsz, const float* __restrict__ SS, float* __restrict__ RS) {
    for (size_t m = gtid; m < (size_t)M; m += gsz) { float s = 0.f;
#pragma unroll
        for (int p = 0; p < 16; ++p) s += SS[(size_t)p * M + m];
        RS[m] = rsqrtf(s * (1.0f / 1024.0f) + 1e-5f); }
}
__device__ __forceinline__ void ph_fox_cumsum(LAS float* red  , int bid, int tid, int lane, int wv, const float* __restrict__ FDt, const float* __restrict__ f_bias, float* __restrict__ CS) {
    if (bid >= 32) return;
    const int b = bid >> 3, h = bid & 7; const float fb = f_bias[h];
    const float4* src = (const float4*)(FDt + (size_t)h * M + (size_t)b * T) + tid * 2;
    const float4 x0 = src[0], x1 = src[1];
    float v[8] = {log_sigmoid_f(x0.x + fb), log_sigmoid_f(x0.y + fb), log_sigmoid_f(x0.z + fb), log_sigmoid_f(x0.w + fb), log_sigmoid_f(x1.x + fb), log_sigmoid_f(x1.y + fb), log_sigmoid_f(x1.z + fb), log_sigmoid_f(x1.w + fb)};
#pragma unroll
    for (int j = 1; j < 8; ++j) v[j] += v[j - 1];
    float inc = v[7];
#pragma unroll
    for (int o = 1; o < 64; o <<= 1) { const float u = lget(inc, lane - o); if (lane >= o) inc += u; }
    if (lane == 63) red[wv] = inc;
    __syncthreads();
    float pre = inc - v[7];
    for (int j = 0; j < wv; ++j) pre += red[j];
    const float sc = -11.313708498984761f;
    float4* dst = (float4*)(CS + (size_t)bid * T) + tid * 2;
    dst[0] = make_float4((pre + v[0]) * sc, (pre + v[1]) * sc, (pre + v[2]) * sc, (pre + v[3]) * sc);
    dst[1] = make_float4((pre + v[4]) * sc, (pre + v[5]) * sc, (pre + v[6]) * sc, (pre + v[7]) * sc);
    __syncthreads();
}
__device__ __forceinline__ void ph_fox_attn(LAS float* qsb  , int gw, int ngw, int wv, int lane, const bf16* __restrict__ Y2, const float* __restrict__ CS, bf16* __restrict__ AO) {
    LAS float* qs = qsb + wv * 128;
    for (int rr = gw; rr < B * 8 * T; rr += ngw) {
        const int bh = rr / T, tt = rr % T, t = (bh & 1) ? (T - 1 - tt) : tt, b = bh >> 3, h = bh & 7;
        const size_t mq = (size_t)b * T + t;
        const bf16* qp = Y2 + mq * NE2 + h * 128;
        const float scale = 0.08838834764831845f;
        __syncthreads();
        qs[lane] = bf2f(qp[lane]) * scale; qs[lane + 64] = bf2f(qp[lane + 64]) * scale;
        __syncthreads();
        const float* cs = CS + (size_t)bh * T; const float ct = cs[t];
        float mrun = -1e30f, l = 0.f, o0 = 0.f, o1 = 0.f;
        for (int j0 = 0; j0 <= t; j0 += 64) {
            const int j = j0 + lane; float s = -INFINITY;
            if (j <= t) {
                const bf16* kp = Y2 + ((size_t)b * T + j) * NE2 + 1024 + h * 128; float a = 0.f;
#pragma unroll 4
                for (int d = 0; d < 128; d += 8) { const uint4 kk = *(const uint4*)(kp + d);
                    a += qs[d + 0] * __uint_as_float(kk.x << 16) + qs[d + 1] * __uint_as_float(kk.x & 0xffff0000u) + qs[d + 2] * __uint_as_float(kk.y << 16) + qs[d + 3] * __uint_as_float(kk.y & 0xffff0000u)
                       + qs[d + 4] * __uint_as_float(kk.z << 16) + qs[d + 5] * __uint_as_float(kk.z & 0xffff0000u) + qs[d + 6] * __uint_as_float(kk.w << 16) + qs[d + 7] * __uint_as_float(kk.w & 0xffff0000u); }
                s = a + (ct - cs[j]);
            }
            float tm = s;
#pragma unroll
            for (int o = 1; o < 64; o <<= 1) tm = fmaxf(tm, lx(tm, o, lane));
            const float mn = fmaxf(mrun, tm), alpha = __expf(mrun - mn); const float p = __expf(s - mn);
            l = l * alpha + wave_sum(p, lane); o0 *= alpha; o1 *= alpha; mrun = mn;
            const int nk = min(64, t - j0 + 1);
            const bf16* vp = Y2 + ((size_t)b * T + j0) * NE2 + 2048 + h * 128;
            for (int jj = 0; jj < nk; ++jj) { const float pj = __int_as_float(__builtin_amdgcn_readlane(__float_as_int(p), jj)); o0 += pj * bf2f(vp[(size_t)jj * NE2 + lane]); o1 += pj * bf2f(vp[(size_t)jj * NE2 + lane + 64]); }
        }
        const float inv = 1.0f / l; const bf16* gp = Y2 + mq * NE2 + 3072 + h * 128;
        AO[mq * 2048 + h * 128 + lane] = (bf16)f2bf(o0 * inv * silu_f(bf2f(gp[lane])));
        AO[mq * 2048 + h * 128 + lane + 64] = (bf16)f2bf(o1 * inv * silu_f(bf2f(gp[lane + 64])));
    }
}

__device__ __forceinline__ void ph_ssd_conv(size_t gtid, size_t gsz, const bf16* __restrict__ Y1, const float* __restrict__ cw, const float* __restrict__ cb, bf16* __restrict__ XC) {
    const size_t total = (size_t)M * 1536;
    for (size_t i = gtid; i < total; i += gsz) {
        const int m = (int)(i / 1536), ch = (int)(i % 1536), t = m % T; float a = cb[ch];
#pragma unroll
        for (int k = 0; k < 4; ++k) { const int tt = t - 3 + k; if (tt >= 0) a += cw[k * 1536 + ch] * bf2f(Y1[(size_t)(m - 3 + k) * NE1 + 1024 + ch]); }
        XC[i] = (bf16)f2bf(silu_f(a));
    }
}
__device__ __forceinline__ void ph_ssd_scan(int gw, int ngw, int lane, const bf16* __restrict__ Y1, const bf16* __restrict__ XC, const float* __restrict__ FDt, const float* __restrict__ dt_bias,
                                            const float* __restrict__ A_log, const float* __restrict__ Dsk, bf16* __restrict__ AO) {
    for (int w = gw; w < B * 16 * 64; w += ngw) {
        const int p = w & 63, h = (w >> 6) & 15, b = w >> 10, g = h >> 3;
        const float A = -__expf(A_log[h]), dtb = dt_bias[h], Dh = Dsk[h];
        float s0 = 0.f, s1 = 0.f;
        for (int t = 0; t < T; ++t) {
            const size_t m = (size_t)b * T + t;
            const float dt = softplus_f(FDt[(size_t)(8 + h) * M + m] + dtb);
            const float xv = bf2f(XC[m * 1536 + h * 64 + p]);
            const float dec = __expf(dt * A), dx = dt * xv;
            const bf16* bp = XC + m * 1536 + 1024 + g * 128; const bf16* cp = XC + m * 1536 + 1280 + g * 128;
            s0 = dec * s0 + dx * bf2f(bp[lane]); s1 = dec * s1 + dx * bf2f(bp[lane + 64]);
            float y = wave_sum(bf2f(cp[lane]) * s0 + bf2f(cp[lane + 64]) * s1, lane);
            if (lane == 0) { y = (y + Dh * xv) * silu_f(bf2f(Y1[m * NE1 + h * 64 + p])); AO[m * 2048 + 1024 + h * 64 + p] = (bf16)f2bf(y); }
        }
    }
}
__device__ __forceinline__ void ph_ssd_norm(int gw, int ngw, int lane, bf16* __restrict__ AO, const float* __restrict__ nw) {
    for (int w = gw; w < M * 2; w += ngw) {
        const int g = w & 1; const size_t m = w >> 1;
        bf16* p = AO + m * 2048 + 1024 + g * 512 + lane * 8;
        const uint4 v = *(const uint4*)p; float f[8] = {__uint_as_float(v.x << 16), __uint_as_float(v.x & 0xffff0000u), __uint_as_float(v.y << 16), __uint_as_float(v.y & 0xffff0000u),
                                                       __uint_as_float(v.z << 16), __uint_as_float(v.z & 0xffff0000u), __uint_as_float(v.w << 16), __uint_as_float(v.w & 0xffff0000u)};
        float s = 0.f;
#pragma unroll
        for (int i = 0; i < 8; ++i) s += f[i] * f[i];
        s = wave_sum(s, lane); const float r = rsqrtf(s * (1.0f / 512.0f) + 1e-5f); const float* wp = nw + g * 512 + lane * 8;
        uint4 o; o.x = f2bf(f[0] * r * wp[0]) | (f2bf(f[1] * r * wp[1]) << 16); o.y = f2bf(f[2] * r * wp[2]) | (f2bf(f[3] * r * wp[3]) << 16);
        o.z = f2bf(f[4] * r * wp[4]) | (f2bf(f[5] * r * wp[5]) << 16); o.w = f2bf(f[6] * r * wp[6]) | (f2bf(f[7] * r * wp[7]) << 16);
        *(uint4*)p = o;
    }
}

__device__ __forceinline__ void ph_hgrn_scan(int gw, int ngw, int lane, const bf16* __restrict__ Y, const float* __restrict__ lbl, int oi, int h0, bf16* __restrict__ ORAW) {
    for (int w = gw; w < B * 8 * 128; w += ngw) {
        const int v = w & 127, hh = (w >> 7) & 7, b = w >> 10, h = h0 + hh;
        float lb0 = 0.f, lb1 = 0.f;
        if (oi == 1) { const int c0 = h * 128 + lane, c1 = c0 + 64; lb0 = sigmoid_f(lbl[2048 + c0] - lbl[c0]); lb1 = sigmoid_f(lbl[2048 + c1] - lbl[c1]); }
        float s0 = 0.f, s1 = 0.f;
        for (int t = 0; t < T; ++t) {
            const size_t m = (size_t)b * T + t; const bf16* yp = Y + m * NO1;
            const float q0 = silu_f(bf2f(yp[h * 128 + lane])), q1 = silu_f(bf2f(yp[h * 128 + lane + 64]));
            const float f0 = bf2f(yp[2048 + h * 128 + lane]), f1 = bf2f(yp[2048 + h * 128 + lane + 64]);
            const float iv = bf2f(yp[4096 + h * 128 + v]);
            const float g0 = lb0 + (1.f - lb0) * sigmoid_f(f0), g1 = lb1 + (1.f - lb1) * sigmoid_f(f1);
            const float k0 = (1.f - lb0) * sigmoid_f(-f0), k1 = (1.f - lb1) * sigmoid_f(-f1);
            s0 = g0 * s0 + k0 * iv; s1 = g1 * s1 + k1 * iv;
            const float o = wave_sum(q0 * s0 + q1 * s1, lane);
            if (lane == 0) ORAW[m * 1024 + hh * 128 + v] = (bf16)f2bf(o);
        }
    }
}
__device__ __forceinline__ void ph_hgrn_norm(int gw, int ngw, int lane, const bf16* __restrict__ ORAW, const float* __restrict__ nw, int h0, bf16* __restrict__ Y) {
    for (int w = gw; w < M * 8; w += ngw) {
        const int hh = w & 7; const size_t m = w >> 3;
        const unsigned v = *(const unsigned*)(ORAW + m * 1024 + hh * 128 + lane * 2);
        const float a = __uint_as_float(v << 16), c = __uint_as_float(v & 0xffff0000u);
        const float s = wave_sum(a * a + c * c, lane), r = rsqrtf(s * (1.0f / 128.0f) + 1e-5f);
        *(unsigned*)(Y + m * NO1 + (h0 + hh) * 128 + lane * 2) = f2bf(a * r * nw[lane * 2]) | (f2bf(c * r * nw[lane * 2 + 1]) << 16);
    }
}
__device__ __forceinline__ void ph_final(int gw, int ngw, int lane, const bf16* __restrict__ hf, const float* __restrict__ SS, const float* __restrict__ fw, float* __restrict__ out) {
    float4 wv[4];
#pragma unroll
    for (int j = 0; j < 4; ++j) wv[j] = *(const float4*)(fw + j * 256 + lane * 4);
    for (int m0 = gw; m0 < M; m0 += 4 * ngw) {
        uint2 a[4][4]; float s[4];
#pragma unroll
        for (int r = 0; r < 4; ++r) { const int m = min(m0 + r * ngw, M - 1); s[r] = lane < 16 ? SS[(size_t)lane * M + m] : 0.f;
#pragma unroll
            for (int j = 0; j < 4; ++j) a[r][j] = *(const uint2*)(hf + (size_t)m * NO1 + j * 256 + lane * 4); }
#pragma unroll
        for (int r = 0; r < 4; ++r) { const int m = m0 + r * ngw; if (m >= M) break;
            const float rr = rsqrtf(wave_sum(s[r], lane) * (1.0f / 1024.0f) + 1e-5f);
#pragma unroll
            for (int j = 0; j < 4; ++j) { const uint2 q = a[r][j];
                *(float4*)(out + (size_t)m * D + j * 256 + lane * 4) = make_float4(__uint_as_float(q.x << 16) * rr * wv[j].x, __uint_as_float(q.x & 0xffff0000u) * rr * wv[j].y, __uint_as_float(q.y << 16) * rr * wv[j].z, __uint_as_float(q.y & 0xffff0000u) * rr * wv[j].w); } }
    }
}
struct Params {
    const float* x; const float* norm_w; const float* final_w; const float* even_w_in; const float* even_w_out; const float* fox_f_bias;
    const float* conv_w; const float* conv_b; const float* dt_bias; const float* A_log; const float* ssd_D; const float* ssd_nw;
    const float* odd_w_in; const float* odd_w_out; const float* lb_logits; const float* hgrn_nw;
    float* out; unsigned char* ws;
};

typedef const __attribute__((address_space(4))) Params* ParamsK;
__device__ __forceinline__ ParamsK kargs() { ParamsK p = (ParamsK)__builtin_amdgcn_kernarg_segment_ptr(); asm volatile("" : "+s"(p)); return p; }
__device__ __forceinline__ int tid_fresh(int wv0) { int l = __builtin_amdgcn_mbcnt_hi(~0u, __builtin_amdgcn_mbcnt_lo(~0u, 0u)); asm volatile("" : "+v"(l)); return wv0 * 64 + l; }
#define PH_IDS() const int tid = tid_fresh(wv0), lane = tid & 63, wv = wv0; int G_ = gridDim.x, bid_ = blockIdx.x; asm volatile("" : "+s"(G_), "+s"(bid_)); const int G = G_, bid = bid_, gw = bid * NWV + wv, ngw = G * NWV; \
    const size_t gtid = (size_t)bid * NT + tid, gsz = (size_t)G * NT; (void)lane; (void)gw; (void)ngw; (void)gtid; (void)gsz; (void)wv
#define GP(T, p) ((T*)(__attribute__((address_space(1))) T*)(p))
#define PH_PTRS() ParamsK P = kargs(); unsigned char* ws = GP(unsigned char, P->ws); bf16* hi = GP(bf16, P->out); bf16* lo = hi + (size_t)M * D; \
    float* FDt = (float*)(ws + WS_FDT); float* SS = (float*)(ws + WS_SS); float* CS = (float*)(ws + WS_CS); float* RS = (float*)(ws + WS_RS); (void)RS; \
    bf16* WA = (bf16*)(ws + WS_WA); bf16* WB = (bf16*)(ws + WS_WB); bf16* AO = (bf16*)(ws + WS_AO); \
    bf16* Y = (bf16*)(ws + WS_Y); sd::u32x4* STL = (sd::u32x4*)(ws + WS_STL); float* DEC = (float*)(ws + WS_DEC); bf16* YO = (bf16*)(ws + WS_YODD); float* SLOC = (float*)(ws + WS_SLOC); float* DSEG = (float*)(ws + WS_DSEG); bf16* HFB = (bf16*)(ws + WS_YODD) + 2048; float* NRM = (float*)(ws + WS_NRM); \
    (void)hi; (void)lo; (void)FDt; (void)SS; (void)CS; (void)WA; (void)WB; (void)AO; (void)Y; (void)STL; (void)DEC; (void)YO; (void)SLOC; (void)DSEG; (void)HFB; (void)NRM
#define PF(field) GP(const float, P->field)
#define GRID_BAR() do { ParamsK Pb = kargs(); XcdBarrier bar_; bar_.bar = (unsigned*)(GP(unsigned char, Pb->ws) + WS_CTL) + CW_BAR; bar_.x = xb_xcc_id(); \
    bar_.st = (volatile LAS unsigned*)((LAS unsigned char*)lds + MISC_OFF) + 8; xcd_barrier(bar_, tid_fresh(wv0) == 0); } while (0)

__global__ void __launch_bounds__(512, 2) mega_fwd(Params Pval) {
    extern __shared__ __attribute__((aligned(16))) unsigned char lds[];
#define LL ((LAS unsigned char*)lds)
#define SCR ((LAS float*)lds)
    const int wv0 = __builtin_amdgcn_readfirstlane((int)threadIdx.x >> 6);
    { const int tid0 = threadIdx.x;
      for (int u = tid0; u < (LDS_BYTES - RING_BYTES) / 4; u += NT) ((LAS unsigned*)(LL + RING_BYTES))[u] = 0u;
      __syncthreads();
      ParamsK Pb = kargs(); (void)xcd_barrier_post((unsigned*)(GP(unsigned char, Pb->ws) + WS_CTL) + CW_BAR, (volatile LAS unsigned*)(LL + MISC_OFF) + 8); }
    for (int li = 0; li < 2; ++li) {
        { PH_IDS(); PH_PTRS();
          ph_convert_w<1, true>(SCR, bid, G, tid, PF(even_w_in) + (size_t)li * D * EVEN_IN, D, EVEN_IN, NE, PF(norm_w) + (size_t)(2 * li) * D, WA);
          ph_convert_w<0, false>(SCR, bid, G, tid, PF(even_w_out) + (size_t)li * 2048 * D, 2048, D, D, nullptr, WB);
          if (li == 0) ph_prologue(gw, ngw, lane, PF(x), hi, RS); else ph_rstd(gtid, gsz, SS, RS); }
        GRID_BAR();
        { PH_PTRS(); int G_ = gridDim.x, bid_ = blockIdx.x; asm volatile("" : "+s"(G_), "+s"(bid_)); const int G = G_, bid = bid_;
          pg8::Gemm g{hi, WA + (size_t)4096 * D, M, NE1, D, D}; pg8::EpiIn E{Y, NE1, RS, FDt, 10, M, nullptr, nullptr, 1 << 30, nullptr, nullptr, 0}; pg8::StaticOrder S; S.init(M, NE1, G, bid); S.wv = wv0;
          if (bid >= 192) { for (int i_ = 0; i_ < 4; ++i_) __builtin_amdgcn_s_sleep(127); }
          pg8::gemm_phase<pg8::EpiIn, pg8::StaticOrder, true, true>(LL, g, S, E); }
        GRID_BAR();
        { PH_IDS(); PH_PTRS();
          if (bid < 256) sd::ssd_unit<true>((char*)lds, tid, bid, Y, FDt, PF(conv_w) + (size_t)li * 4 * 1536, PF(conv_b) + (size_t)li * 1536, PF(dt_bias) + li * 16, PF(A_log) + li * 16, PF(ssd_D) + li * 16,
                                            PF(ssd_nw) + (size_t)li * 1024, STL, DEC, AO);
          ph_fox_cumsum(SCR, bid, tid, lane, wv, FDt, PF(fox_f_bias) + li * 8, CS); }
        GRID_BAR();
        { PH_IDS(); PH_PTRS(); sd::ssd_scan(gtid, gsz, STL, DEC); }
        GRID_BAR();
        { PH_IDS(); PH_PTRS();
          if (bid < 256) sd::ssd_unit<false>((char*)lds, tid, bid, Y, FDt, PF(conv_w) + (size_t)li * 4 * 1536, PF(conv_b) + (size_t)li * 1536, PF(dt_bias) + li * 16, PF(A_log) + li * 16, PF(ssd_D) + li * 16,
                                             PF(ssd_nw) + (size_t)li * 1024, STL, DEC, AO); }
        GRID_BAR();
        { PH_PTRS(); int G_ = gridDim.x, bid_ = blockIdx.x; asm volatile("" : "+s"(G_), "+s"(bid_)); const int G = G_, bid = bid_;
          pg8::Gemm g{hi, WA, M, 4096, D, D}; pg8::EpiIn E{Y, 4160, RS, nullptr, -1, M, (LAS float*)(LL + pg8::STAGE_BYTES), NRM, 12, Y + 3072, nullptr, 4160};     pg8::StaticOrder S; S.init(M, 4096, G, bid); S.wv = wv0;
          pg8::gemm_phase<pg8::EpiIn, pg8::StaticOrder, true, true>(LL, g, S, E); }
        GRID_BAR();
        { PH_IDS(); PH_PTRS(); fa::fox_phase((char*)lds, tid, bid, G, Y, CS, NRM, AO, (unsigned*)(ws + WS_CTL) + CW_QCNT + 512 * li); }
        GRID_BAR();
        { PH_PTRS(); int G_ = gridDim.x, bid_ = blockIdx.x; asm volatile("" : "+s"(G_), "+s"(bid_)); const int G = G_, bid = bid_;
          pg8::Gemm g{AO, WB, M, D, 2048, 2048}; pg8::EpiOut E{hi, SS, M, hi, 1024}; pg8::StaticOrder S; S.init(M, D, G, bid); S.wv = wv0;
          pg8::gemm_phase<pg8::EpiOut, pg8::StaticOrder, true, true>(LL, g, S, E); }
        GRID_BAR();
        { PH_IDS(); PH_PTRS();
          ph_convert_w<0, true>(SCR, bid, G, tid, PF(odd_w_in) + (size_t)li * D * ODD_IN, D, ODD_IN, ODD_IN, PF(norm_w) + (size_t)(2 * li + 1) * D, WA);
          ph_convert_w<0, false>(SCR, bid, G, tid, PF(odd_w_out) + (size_t)li * 2048 * D, 2048, D, D, nullptr, WB); ph_rstd(gtid, gsz, SS, RS); }
        GRID_BAR();
        { PH_PTRS(); int G_ = gridDim.x, bid_ = blockIdx.x; asm volatile("" : "+s"(G_), "+s"(bid_)); const int G = G_, bid = bid_;
          pg8::Gemm g{hi, WA, M, ODD_IN, D, D}; pg8::EpiIn E{YO, NO1, RS, nullptr, -1, M, nullptr, nullptr, NO1 / 256, lo, (bf16*)(ws + WS_GB), 1024}; pg8::StaticOrder S; S.init(M, ODD_IN, G, bid); S.wv = wv0;
          pg8::gemm_phase<pg8::EpiIn, pg8::StaticOrder, true, true>(LL, g, S, E); }
        GRID_BAR();
        { PH_IDS(); PH_PTRS(); if (bid < 256) hg::hgrn_state128((char*)lds, tid, bid, YO, PF(lb_logits), li, SLOC, DSEG); }
        GRID_BAR();
        { PH_IDS(); PH_PTRS(); if (bid < 256) hg::hgrn_passB((char*)lds, tid, bid, YO, PF(lb_logits), li, PF(hgrn_nw) + (size_t)li * 128, SLOC, DSEG, lo, (const bf16*)(ws + WS_GB)); }
        GRID_BAR();
        { PH_PTRS(); int G_ = gridDim.x, bid_ = blockIdx.x; asm volatile("" : "+s"(G_), "+s"(bid_)); const int G = G_, bid = bid_;
          pg8::Gemm g{YO, WB, M, D, 2048, NO1}; pg8::EpiOut E{hi, SS, M, li == 1 ? HFB : hi, li == 1 ? NO1 : 1024}; pg8::StaticOrder S; S.init(M, D, G, bid); S.wv = wv0;
          pg8::gemm_phase<pg8::EpiOut, pg8::StaticOrder, true, true>(LL, g, S, E); }
        GRID_BAR();
    }
    { PH_IDS(); PH_PTRS(); ph_final(gw, ngw, lane, HFB, SS, PF(final_w), GP(float, P->out)); }
}
}

extern "C" void kernel_launch(void* const* d_in, const int* in_sizes, int n_in, void* d_out, int out_size, void* d_ws, size_t ws_size, hipStream_t stream) {
    using namespace hy;
    static int grid = 0;
    if (grid == 0) {
        int dev = 0, cus = 0;
        if (hipGetDevice(&dev) != hipSuccess || hipDeviceGetAttribute(&cus, hipDeviceAttributeMultiprocessorCount, dev) != hipSuccess || cus <= 0) cus = 256;
        (void)hipFuncSetAttribute((const void*)mega_fwd, hipFuncAttributeMaxDynamicSharedMemorySize, LDS_BYTES);
        (void)hipGetLastError();
        grid = cus;
    }
    (void)hipMemsetAsync((char*)d_ws + WS_CTL, 0, CTL_ZERO_BYTES, stream);
    Params p{};
    p.x = (const float*)d_in[0]; p.norm_w = (const float*)d_in[1]; p.final_w = (const float*)d_in[2]; p.even_w_in = (const float*)d_in[3]; p.even_w_out = (const float*)d_in[4];
    p.fox_f_bias = (const float*)d_in[5]; p.conv_w = (const float*)d_in[6]; p.conv_b = (const float*)d_in[7]; p.dt_bias = (const float*)d_in[8]; p.A_log = (const float*)d_in[9];
    p.ssd_D = (const float*)d_in[10]; p.ssd_nw = (const float*)d_in[11]; p.odd_w_in = (const float*)d_in[12]; p.odd_w_out = (const float*)d_in[13]; p.lb_logits = (const float*)d_in[14];
    p.hgrn_nw = (const float*)d_in[15]; p.out = (float*)d_out; p.ws = (unsigned char*)d_ws;
    hipLaunchKernelGGL(mega_fwd, dim3(grid), dim3(NT), LDS_BYTES, stream, p);
}
```

```cpp
#include <hip/hip_runtime.h>
#include <cstdio>
#include <cstdint>
namespace pg8 {
#define PG8_LAS __attribute__((address_space(3)))
typedef unsigned short bf16_t;
typedef short bf16x8 __attribute__((ext_vector_type(8)));
typedef float f32x4 __attribute__((ext_vector_type(4)));
typedef unsigned u32x4 __attribute__((ext_vector_type(4)));
constexpr int BM = 256, BK = 64, HALF = 128, HTB = HALF * BK * 2  , STAGE_BYTES = 8 * HTB, NXCD = 8, WGM = 8, RSL_OFF = STAGE_BYTES + 8192  ;

__host__ __device__ __forceinline__ int lds_byte(int r, int c) { const int st = (r >> 4) * 2 + (c >> 5), rr = r & 15, cc = c & 31, ob = rr * 64 + cc * 2; return st * 1024 + (ob ^ (((ob >> 9) & 1) << 5)); }
__host__ __device__ __forceinline__ void stage_rc(int b, int& R, int& C) { const int st = b / 1024, sb = b % 1024, swz = sb ^ (((sb >> 9) & 1) << 5); R = (st >> 1) * 16 + swz / 64; C = (st & 1) * 32 + (swz % 64) / 2; }
__host__ __device__ __forceinline__ int perm32(int rho) { const int n = rho >> 4, i = rho & 15; return 8 * (i >> 2) + 4 * n + (i & 3); }

struct Unit { int pm, pn; };
struct Gemm { const bf16_t* A; const bf16_t* Bt; int M, N, K, lda; };

struct StaticOrder {
    int nM, nN, nwg, G, c, wv;
    __host__ __device__ void init(int M, int N, int G_, int c_) { nM = M / BM; nN = N / BM; nwg = nM * nN; G = G_; c = c_; }
    __host__ __device__ bool next(int i, Unit& u) const {
        const long L = (long)i * G + c; if (L >= nwg) return false;
        int wgid = (int)L; { const int q = nwg / NXCD, r = nwg % NXCD, xcd = wgid % NXCD, off = wgid / NXCD; wgid = (xcd < r ? xcd * (q + 1) : r * (q + 1) + (xcd - r) * q) + off; }
        const int nig = WGM * nN, gid = wgid / nig, fm = gid * WGM, gsz = (nM - fm) < WGM ? (nM - fm) : WGM;
        u.pm = fm + ((wgid % nig) % gsz); u.pn = (wgid % nig) / gsz; return true;
    }
    __device__ __forceinline__ void a_ready(const Unit&) const {}
    __device__ __forceinline__ void done(const Unit&) const {}
};

__device__ __forceinline__ unsigned cvt_pk_bf16(float lo, float hi) { unsigned r; asm volatile("v_cvt_pk_bf16_f32 %0, %1, %2" : "=v"(r) : "v"(lo), "v"(hi)); return r; }
__device__ __forceinline__ float bf_lo(unsigned w) { return __uint_as_float(w << 16); }
__device__ __forceinline__ float bf_hi(unsigned w) { return __uint_as_float(w & 0xffff0000u); }
typedef unsigned u32x2 __attribute__((ext_vector_type(2)));
__device__ __forceinline__ float lane_xor_f(float v, int mask, int lane) { return __int_as_float(__builtin_amdgcn_ds_bpermute((lane ^ mask) << 2, __float_as_int(v))); }

__device__ __forceinline__ float act_f(float x, bool ex) { const float t = __expf(-x); return ex ? t : x * __builtin_amdgcn_rcpf(1.0f + t); }
__device__ __forceinline__ float silu_f(float x) { return x * __builtin_amdgcn_rcpf(1.0f + __expf(-x)); }
struct EpiIn {
    static constexpr bool PERM = true, AFTER_DRAIN = false, RSL = true;
    bf16_t* O; int ldc; const float* RS; float* FDt; int fd_tile; int Mrows;
    PG8_LAS float* NP; float* NRM;
    int ex_from, ex_to;
    int qsil;
    int g_from; bf16_t* G0; bf16_t* G1; int ldg;
    __device__ __forceinline__ void operator()(const f32x4 (&acc)[2][2][4][2], const Unit& u, int wr, int wc, int fr, int fq, const PG8_LAS float* rsl) const {
        const int row0 = u.pm * BM + wr * 64 + fr;
        float rs[2][4];
#pragma unroll
        for (int ai = 0; ai < 2; ++ai)
#pragma unroll
            for (int m = 0; m < 4; ++m) rs[ai][m] = rsl[wr * 64 + fr + ai * HALF + m * 16];
        if (u.pn == fd_tile) {
            if (wc == 0 && fq < 3) {
#pragma unroll
                for (int ai = 0; ai < 2; ++ai)
#pragma unroll
                    for (int m = 0; m < 4; ++m) { const int r = row0 + ai * HALF + m * 16;
#pragma unroll
                        for (int n = 0; n < 2; ++n)
#pragma unroll
                            for (int j = 0; j < 4; ++j) FDt[(size_t)(8 * fq + 4 * n + j) * Mrows + r] = acc[ai][0][m][n][j] * rs[ai][m]; }
            }
            return;
        }
        if (u.pn >= g_from) {
            const int gi = u.pn - g_from; bf16_t* Gb = (gi < 4 ? G0 : G1) + (gi & 3) * BM + wc * 32 + 8 * fq;
#pragma unroll
            for (int ai = 0; ai < 2; ++ai)
#pragma unroll
                for (int m = 0; m < 4; ++m) { bf16_t* rowp = Gb + (size_t)(row0 + ai * HALF + m * 16) * ldg; const float s = rs[ai][m];
#pragma unroll
                    for (int bj = 0; bj < 2; ++bj) { const f32x4 v0 = acc[ai][bj][m][0] * s, v1 = acc[ai][bj][m][1] * s;
                        u32x4 w; w.x = cvt_pk_bf16(silu_f(v0[0]), silu_f(v0[1])); w.y = cvt_pk_bf16(silu_f(v0[2]), silu_f(v0[3])); w.z = cvt_pk_bf16(silu_f(v1[0]), silu_f(v1[1])); w.w = cvt_pk_bf16(silu_f(v1[2]), silu_f(v1[3]));
                        *(u32x4*)(rowp + bj * HALF) = w; } }
            return;
        }
        const int col0 = u.pn * BM + wc * 32 + 8 * fq;
        const bool isex = u.pn >= ex_from && u.pn < ex_to;
        if (u.pn < qsil || isex) {
#define EPI_ACT(x_) act_f((x_), isex)
#pragma unroll
            for (int ai = 0; ai < 2; ++ai)
#pragma unroll
                for (int m = 0; m < 4; ++m) { bf16_t* rowp = O + (size_t)(row0 + ai * HALF + m * 16) * ldc + col0; const float s = rs[ai][m];
#pragma unroll
                    for (int bj = 0; bj < 2; ++bj) { const f32x4 v0 = acc[ai][bj][m][0] * s, v1 = acc[ai][bj][m][1] * s;
                        u32x4 w; w.x = cvt_pk_bf16(EPI_ACT(v0[0]), EPI_ACT(v0[1])); w.y = cvt_pk_bf16(EPI_ACT(v0[2]), EPI_ACT(v0[3])); w.z = cvt_pk_bf16(EPI_ACT(v1[0]), EPI_ACT(v1[1])); w.w = cvt_pk_bf16(EPI_ACT(v1[2]), EPI_ACT(v1[3]));
                        *(u32x4*)(rowp + bj * HALF) = w; } }
#undef EPI_ACT
            return;
        }
        const bool nrm = NRM != nullptr && u.pn < 8;
#pragma unroll
        for (int ai = 0; ai < 2; ++ai)
#pragma unroll
            for (int m = 0; m < 4; ++m) { bf16_t* rowp = O + (size_t)(row0 + ai * HALF + m * 16) * ldc + col0; const float s = rs[ai][m];
#pragma unroll
                for (int bj = 0; bj < 2; ++bj) { const f32x4 v0 = acc[ai][bj][m][0] * s, v1 = acc[ai][bj][m][1] * s;
                    u32x4 w; w.x = cvt_pk_bf16(v0[0], v0[1]); w.y = cvt_pk_bf16(v0[2], v0[3]); w.z = cvt_pk_bf16(v1[0], v1[1]); w.w = cvt_pk_bf16(v1[2], v1[3]);
                    *(u32x4*)(rowp + bj * HALF) = w;
                    if (nrm) { float p = ((v0[0] * v0[0] + v0[1] * v0[1]) + (v0[2] * v0[2] + v0[3] * v0[3])) + ((v1[0] * v1[0] + v1[1] * v1[1]) + (v1[2] * v1[2] + v1[3] * v1[3]));
                        p += lane_xor_f(p, 16, fq * 16 + fr); p += lane_xor_f(p, 32, fq * 16 + fr);
                        if (fq == 0) NP[(wc * 256 + wr * 64 + fr + ai * HALF + m * 16) * 2 + bj] = p; } } }
        if (nrm) {
            asm volatile("s_waitcnt lgkmcnt(0)" ::: "memory"); __builtin_amdgcn_s_barrier();
            const int wid = wr * 4 + wc, lane = fq * 16 + fr, bjh = wid >> 2, tq = wid & 3, rl = 64 * tq + lane;
            float sq = (NP[(0 * 256 + rl) * 2 + bjh] + NP[(1 * 256 + rl) * 2 + bjh]) + (NP[(2 * 256 + rl) * 2 + bjh] + NP[(3 * 256 + rl) * 2 + bjh]);
#pragma unroll
            for (int o = 1; o < 64; o <<= 1) sq = fmaxf(sq, lane_xor_f(sq, o, lane));
            if (lane == 0) { const int b = u.pm >> 4, j = (u.pm & 15) * 4 + tq, h = (u.pn & 3) * 2 + bjh, which = u.pn < 4 ? 1 : 0;
                NRM[(size_t)(b * 8 + h) * 128 + which * 64 + j] = sqrtf(sq) * 1.003f; }
        }
    }
};
struct EpiGate {
    static constexpr bool PERM = true, AFTER_DRAIN = false, RSL = true;
    bf16_t* O; int ldc; const float* RS; int Mrows;
    __device__ __forceinline__ void operator()(const f32x4 (&acc)[2][2][4][2], const Unit& u, int wr, int wc, int fr, int fq, const PG8_LAS float* rsl) const {
        const int row0 = u.pm * BM + wr * 64 + fr;
        const int col0 = u.pn * BM + wc * 32 + 8 * fq;
        u32x4 ov[2][4][2]; float rs[2][4];
#pragma unroll
        for (int ai = 0; ai < 2; ++ai)
#pragma unroll
            for (int m = 0; m < 4; ++m) { const int r = row0 + ai * HALF + m * 16; rs[ai][m] = rsl[wr * 64 + fr + ai * HALF + m * 16]; const bf16_t* rowp = O + (size_t)r * ldc + col0;
#pragma unroll
                for (int bj = 0; bj < 2; ++bj) ov[ai][m][bj] = *(const u32x4*)(rowp + bj * HALF); }
        asm volatile("" ::: "memory");
#pragma unroll
        for (int ai = 0; ai < 2; ++ai)
#pragma unroll
            for (int m = 0; m < 4; ++m) { const int r = row0 + ai * HALF + m * 16; const float s = rs[ai][m]; bf16_t* rowp = O + (size_t)r * ldc + col0;
#pragma unroll
                for (int bj = 0; bj < 2; ++bj) { const f32x4 g0 = acc[ai][bj][m][0] * s, g1 = acc[ai][bj][m][1] * s; const u32x4 o = ov[ai][m][bj];
                    u32x4 w;
                    w.x = cvt_pk_bf16(bf_lo(o.x) * silu_f(g0[0]), bf_hi(o.x) * silu_f(g0[1])); w.y = cvt_pk_bf16(bf_lo(o.y) * silu_f(g0[2]), bf_hi(o.y) * silu_f(g0[3]));
                    w.z = cvt_pk_bf16(bf_lo(o.z) * silu_f(g1[0]), bf_hi(o.z) * silu_f(g1[1])); w.w = cvt_pk_bf16(bf_lo(o.w) * silu_f(g1[2]), bf_hi(o.w) * silu_f(g1[3]));
                    *(u32x4*)(rowp + bj * HALF) = w; } }
    }
};
struct EpiOut {
    static constexpr bool PERM = true, AFTER_DRAIN = false, RSL = false;
    bf16_t* hi; float* SS; int Mrows; bf16_t* ho; int ho_pitch;
    __device__ __forceinline__ void operator()(const f32x4 (&acc)[2][2][4][2], const Unit& u, int wr, int wc, int fr, int fq, const PG8_LAS float*) const {
        const int row0 = u.pm * BM + wr * 64 + fr, col0 = u.pn * BM + wc * 32 + 8 * fq;
        u32x4 ah[2][4][2];
#pragma unroll
        for (int ai = 0; ai < 2; ++ai)
#pragma unroll
            for (int m = 0; m < 4; ++m) { const size_t off = (size_t)(row0 + ai * HALF + m * 16) * 1024 + col0;
#pragma unroll
                for (int bj = 0; bj < 2; ++bj) ah[ai][m][bj] = *(const u32x4*)(hi + off + bj * HALF); }
        asm volatile("" ::: "memory");
#pragma unroll
        for (int ai = 0; ai < 2; ++ai)
#pragma unroll
            for (int m = 0; m < 4; ++m) { const int r = row0 + ai * HALF + m * 16; const size_t off = (size_t)r * 1024 + col0; float ssq = 0.f;
#pragma unroll
                for (int bj = 0; bj < 2; ++bj) { const u32x4 a = ah[ai][m][bj]; const f32x4 c0 = acc[ai][bj][m][0], c1 = acc[ai][bj][m][1];
                    const float h0 = bf_lo(a.x) + c0[0], h1 = bf_hi(a.x) + c0[1], h2 = bf_lo(a.y) + c0[2], h3 = bf_hi(a.y) + c0[3];
                    const float h4 = bf_lo(a.z) + c1[0], h5 = bf_hi(a.z) + c1[1], h6 = bf_lo(a.w) + c1[2], h7 = bf_hi(a.w) + c1[3];
                    ssq += ((h0 * h0 + h1 * h1) + (h2 * h2 + h3 * h3)) + ((h4 * h4 + h5 * h5) + (h6 * h6 + h7 * h7));
                    { u32x4 nh; nh.x = cvt_pk_bf16(h0, h1); nh.y = cvt_pk_bf16(h2, h3); nh.z = cvt_pk_bf16(h4, h5); nh.w = cvt_pk_bf16(h6, h7); *(u32x4*)(ho + (size_t)r * ho_pitch + col0 + bj * HALF) = nh; } }
                ssq += lane_xor_f(ssq, 16, fq * 16 + fr); ssq += lane_xor_f(ssq, 32, fq * 16 + fr);
                if (fq == 0) __hip_atomic_store(SS + (size_t)(u.pn * 4 + wc) * Mrows + r, ssq, __ATOMIC_RELAXED, __HIP_MEMORY_SCOPE_AGENT); }
    }
};
template <class Epi, class Sched, bool ALIGN_EPI = false, bool SP2 = false>
__device__ __forceinline__ void gemm_phase(PG8_LAS unsigned char* lds, const Gemm g, const Sched& S, const Epi& E) {
    int l_ = __builtin_amdgcn_mbcnt_hi(~0u, __builtin_amdgcn_mbcnt_lo(~0u, 0u)); asm volatile("" : "+v"(l_)); const int wid = S.wv, tid = wid * 64 + l_, lane = tid & 63, wr = wid >> 2, wc = wid & 3, fr = lane & 15, fq = lane >> 4;
    const int K = g.K, nt = K / BK;
    unsigned voffA[2], voffB[2];
#pragma unroll
    for (int i = 0; i < 2; ++i) { int R, C; stage_rc(tid * 16 + i * 8192, R, C); const int Rb = Epi::PERM ? ((R & ~31) + perm32(R & 31)) : R;
        voffA[i] = (unsigned)(R * g.lda + C) * 2u; voffB[i] = (unsigned)(Rb * K + C) * 2u; }
    const size_t kstep = (size_t)(BK * 2);
    const size_t hstepA = (size_t)HALF * g.lda * 2, hstepB = (size_t)HALF * K * 2;
    const size_t tstepA = 2 * hstepA, tstepB = 2 * hstepB;
    const unsigned ldsw = (unsigned)wid * 1024u;
    const int aoff = lds_byte(wr * 64 + fr, fq * 8), boff = lds_byte(wc * 32 + fr, fq * 8);
#define PG8_SA(b, h) (((b) * 2 + (h)) * HTB)
#define PG8_SB(b, h) ((4 + (b) * 2 + (h)) * HTB)
#define PG8_STAGE(bufoff, gbase, voff) do { _Pragma("unroll") for (int _i = 0; _i < 2; ++_i) \
        __builtin_amdgcn_global_load_lds((const unsigned*)((const char*)(gbase) + (voff)[_i]), (PG8_LAS unsigned*)(lds + (bufoff) + ldsw + _i * 8192), 16, 0, 0); } while (0)
#define PG8_LDA(dst, b, h) do { _Pragma("unroll") for (int m = 0; m < 4; ++m) _Pragma("unroll") for (int k = 0; k < 2; ++k) dst[m][k] = *(const PG8_LAS bf16x8*)(lds + PG8_SA(b, h) + aoff + m * 2048 + k * 1024); } while (0)
#define PG8_LDB(dst, b, h) do { _Pragma("unroll") for (int n = 0; n < 2; ++n) _Pragma("unroll") for (int k = 0; k < 2; ++k) dst[n][k] = *(const PG8_LAS bf16x8*)(lds + PG8_SB(b, h) + boff + n * 2048 + k * 1024); } while (0)
#define PG8_MMA(ai, bj, At, Bt) do { __builtin_amdgcn_s_setprio(1); _Pragma("unroll") for (int m = 0; m < 4; ++m) _Pragma("unroll") for (int n = 0; n < 2; ++n) _Pragma("unroll") for (int k = 0; k < 2; ++k) \
        acc[ai][bj][m][n] = __builtin_amdgcn_mfma_f32_16x16x32_bf16(Bt[n][k], At[m][k], acc[ai][bj][m][n], 0, 0, 0); __builtin_amdgcn_s_setprio(0); } while (0)
#define PG8_WAIT_V(n) asm volatile("s_waitcnt vmcnt(" #n ")" ::: "memory")
#define PG8_WAIT_L(n) asm volatile("s_waitcnt lgkmcnt(" #n ")" ::: "memory")
#define PG8_BAR __builtin_amdgcn_s_barrier()
#define PG8_SCHED __builtin_amdgcn_sched_barrier(0)
    Unit cur, nxt; int ui = 0;
    if (!S.next(0, cur)) return;
    f32x4 acc[2][2][4][2];
#pragma unroll
    for (int a = 0; a < 2; ++a)
#pragma unroll
        for (int b = 0; b < 2; ++b)
#pragma unroll
            for (int m = 0; m < 4; ++m)
#pragma unroll
                for (int n = 0; n < 2; ++n) acc[a][b][m][n] = (f32x4){0.f, 0.f, 0.f, 0.f};
    bf16x8 At[4][2], B0[2][2], B1[2][2];
    const char* cA = (const char*)g.A + (size_t)cur.pm * tstepA; const char* cB = (const char*)g.Bt + (size_t)cur.pn * tstepB;
    S.a_ready(cur);
#define PG8_RS_STAGE(pm_, slot_) do { if (wid < 4) __builtin_amdgcn_global_load_lds((const unsigned*)(E.RS + (size_t)(pm_) * BM + wid * 64 + lane), (PG8_LAS unsigned*)(lds + RSL_OFF + (slot_) * 1024 + wid * 256), 4, 0, 0); } while (0)
    if constexpr (Epi::RSL) PG8_RS_STAGE(cur.pm, 0);
    if constexpr (SP2) {
        PG8_STAGE(PG8_SB(0, 0), cB, voffB); PG8_STAGE(PG8_SB(0, 1), cB + hstepB, voffB); PG8_STAGE(PG8_SA(0, 0), cA, voffA); PG8_STAGE(PG8_SA(0, 1), cA + hstepA, voffA);
        if (wr == 1) PG8_BAR;
        PG8_WAIT_V(2); PG8_BAR;
        PG8_STAGE(PG8_SB(1, 0), cB + kstep, voffB); PG8_STAGE(PG8_SA(1, 0), cA + kstep, voffA); PG8_STAGE(PG8_SB(1, 1), cB + hstepB + kstep, voffB);
        PG8_WAIT_V(6); PG8_BAR;
    } else {
        PG8_STAGE(PG8_SB(0, 0), cB, voffB); PG8_STAGE(PG8_SA(0, 0), cA, voffA); PG8_STAGE(PG8_SB(0, 1), cB + hstepB, voffB); PG8_STAGE(PG8_SA(0, 1), cA + hstepA, voffA);
        if (wr == 1) PG8_BAR;
        PG8_WAIT_V(4); PG8_BAR;
        PG8_STAGE(PG8_SB(1, 0), cB + kstep, voffB); PG8_STAGE(PG8_SA(1, 0), cA + kstep, voffA); PG8_STAGE(PG8_SB(1, 1), cB + hstepB + kstep, voffB);
        PG8_WAIT_V(6); PG8_BAR;
    }
    for (;;) {
        const bool has_next = S.next(ui + 1, nxt);
        const char* nA = has_next ? (const char*)g.A + (size_t)nxt.pm * tstepA : cA; const char* nB = has_next ? (const char*)g.Bt + (size_t)nxt.pn * tstepB : cB;
        for (int t = 0; t < nt; t += 2) {
            const bool last = (t == nt - 2);
            const char* a1 = cA + (size_t)(t + 1) * kstep;
            const char* a2 = last ? nA : cA + (size_t)(t + 2) * kstep; const char* b2 = last ? nB : cB + (size_t)(t + 2) * kstep;
            const char* a3 = a2 + kstep; const char* b3 = b2 + kstep;
            if (last && has_next) { S.a_ready(nxt); if constexpr (Epi::RSL) PG8_RS_STAGE(nxt.pm, (ui + 1) & 1); }
            if constexpr (SP2) {
            PG8_LDB(B0, 0, 0); PG8_LDB(B1, 0, 1); PG8_SCHED; PG8_LDA(At, 0, 0); PG8_STAGE(PG8_SA(1, 1), a1 + hstepA, voffA);
            PG8_WAIT_V(8); PG8_WAIT_L(0); PG8_BAR; PG8_MMA(0, 0, At, B0); PG8_MMA(0, 1, At, B1); PG8_BAR; PG8_SCHED;
            PG8_LDA(At, 0, 1); PG8_STAGE(PG8_SB(0, 0), b2, voffB); PG8_STAGE(PG8_SB(0, 1), b2 + hstepB, voffB); PG8_STAGE(PG8_SA(0, 0), a2, voffA);
            PG8_WAIT_V(8); PG8_WAIT_L(0); PG8_BAR; PG8_MMA(1, 0, At, B0); PG8_MMA(1, 1, At, B1); PG8_BAR; PG8_SCHED;
            PG8_LDB(B0, 1, 0); PG8_LDB(B1, 1, 1); PG8_SCHED; PG8_LDA(At, 1, 0); PG8_STAGE(PG8_SA(0, 1), a2 + hstepA, voffA);
            PG8_WAIT_V(8); PG8_WAIT_L(0); PG8_BAR; PG8_MMA(0, 0, At, B0); PG8_MMA(0, 1, At, B1); PG8_BAR; PG8_SCHED;
            PG8_LDA(At, 1, 1); PG8_STAGE(PG8_SB(1, 0), b3, voffB); PG8_STAGE(PG8_SB(1, 1), b3 + hstepB, voffB); PG8_STAGE(PG8_SA(1, 0), a3, voffA);
            PG8_WAIT_V(8); PG8_WAIT_L(0); PG8_BAR; PG8_MMA(1, 0, At, B0); PG8_MMA(1, 1, At, B1); PG8_BAR; PG8_SCHED;
            } else {
            PG8_LDB(B0, 0, 0); PG8_SCHED; PG8_LDA(At, 0, 0); PG8_STAGE(PG8_SA(1, 1), a1 + hstepA, voffA);
            PG8_WAIT_L(8); PG8_BAR; PG8_WAIT_L(0); PG8_MMA(0, 0, At, B0); PG8_BAR; PG8_SCHED;
            PG8_LDB(B1, 0, 1); PG8_STAGE(PG8_SB(0, 0), b2, voffB);
            PG8_BAR; PG8_WAIT_L(0); PG8_MMA(0, 1, At, B1); PG8_BAR;
            PG8_LDA(At, 0, 1); PG8_STAGE(PG8_SA(0, 0), a2, voffA);
            PG8_BAR; PG8_WAIT_L(0); PG8_MMA(1, 0, At, B0); PG8_BAR; PG8_SCHED;
            PG8_STAGE(PG8_SB(0, 1), b2 + hstepB, voffB);
            PG8_WAIT_V(6); PG8_BAR; PG8_MMA(1, 1, At, B1); PG8_BAR;
            PG8_LDB(B0, 1, 0); PG8_SCHED; PG8_LDA(At, 1, 0); PG8_STAGE(PG8_SA(0, 1), a2 + hstepA, voffA);
            PG8_WAIT_L(8); PG8_BAR; PG8_WAIT_L(0); PG8_MMA(0, 0, At, B0); PG8_BAR; PG8_SCHED;
            PG8_LDB(B1, 1, 1); PG8_STAGE(PG8_SB(1, 0), b3, voffB);
            PG8_BAR; PG8_WAIT_L(0); PG8_MMA(0, 1, At, B1); PG8_BAR;
            PG8_LDA(At, 1, 1); PG8_STAGE(PG8_SA(1, 0), a3, voffA);
            PG8_BAR; PG8_WAIT_L(0); PG8_MMA(1, 0, At, B0); PG8_BAR; PG8_SCHED;
            PG8_STAGE(PG8_SB(1, 1), b3 + hstepB, voffB);
            PG8_WAIT_V(6); PG8_BAR; PG8_MMA(1, 1, At, B1); PG8_BAR;
            }
        }
        if constexpr (ALIGN_EPI) { if (wr == 0) PG8_BAR; }
        if constexpr (!Epi::AFTER_DRAIN) { E(acc, cur, wr, wc, fr, fq, (const PG8_LAS float*)(lds + RSL_OFF + (ui & 1) * 1024)); S.done(cur); }
        if (!has_next) break;
#pragma unroll
        for (int a = 0; a < 2; ++a)
#pragma unroll
            for (int b = 0; b < 2; ++b)
#pragma unroll
                for (int m = 0; m < 4; ++m)
#pragma unroll
                    for (int n = 0; n < 2; ++n) acc[a][b][m][n] = (f32x4){0.f, 0.f, 0.f, 0.f};
        cur = nxt; cA = nA; cB = nB; ++ui;
        if constexpr (ALIGN_EPI) { if (wr == 1) PG8_BAR; }
    }
    PG8_WAIT_V(0);
    if constexpr (!ALIGN_EPI) { if (wr == 0) PG8_BAR; }
    PG8_BAR;
    if constexpr (Epi::AFTER_DRAIN) { E.fused(acc, cur, wr, wc, fr, fq, lds, wid, lane); S.done(cur); }
#undef PG8_RS_STAGE
#undef PG8_SA
#undef PG8_SB
#undef PG8_STAGE
#undef PG8_LDA
#undef PG8_LDB
#undef PG8_MMA
#undef PG8_WAIT_V
#undef PG8_WAIT_L
#undef PG8_BAR
#undef PG8_SCHED
}
}
namespace fa {
typedef unsigned short bf16;
typedef short bf16x8 __attribute__((ext_vector_type(8)));
typedef short s16x4 __attribute__((ext_vector_type(4)));
typedef float f32x16 __attribute__((ext_vector_type(16)));
typedef float f32x4 __attribute__((ext_vector_type(4)));
typedef unsigned u32x4 __attribute__((ext_vector_type(4)));
typedef unsigned u32x2 __attribute__((ext_vector_type(2)));
constexpr int D = 128, NW = 8, QBLK = 32, KVBLK = 64, QB = NW * QBLK, SEQ = 4096;
constexpr int PQ = 4160, PO = 2048;
constexpr int SHM_V = KVBLK * D * 2, SHM_K = KVBLK * D * 2;
constexpr int LDS_WS = 2 * SHM_V + 2 * SHM_K, LDS_CS = LDS_WS + NW * 64 * 4, LDS_Q = LDS_CS + SEQ * 4, LDS_ITEM = LDS_Q + NW * (8 - 7) * 1024, LDS_BYTES = LDS_ITEM + 16 + 256;
constexpr int QREG = 7;
constexpr float SCALE = 0.08838834764831845f, THR = 8.f;
#define KSWZ(row, colB) ((row) * 256 + ((colB) ^ (((row) & 7) << 4)))
#define SBAR() __builtin_amdgcn_sched_barrier(0)
__device__ __forceinline__ int v_st(int k, int c) { const int kk = (k & ~0xC) | ((k & 4) << 1) | ((k & 8) >> 1); return ((kk >> 3) * 4 + (c >> 5)) * 512 + ((kk & 7) * 32 + (c & 31)) * 2; }
__device__ __forceinline__ int v_rd_base(int lane) { return ((lane & 3) << 3) | (((lane >> 2) & 3) << 6) | (((lane >> 4) & 1) << 5) | (((lane >> 5) & 1) << 8); }
constexpr int v_rd_off(int d0, int ks, int half) { return d0 * 512 + ks * 4096 + half * 2048; }
__device__ __forceinline__ int crow(int r, int hi) { return (r & 3) + 8 * (r >> 2) + 4 * hi; }
__device__ __forceinline__ unsigned cvtpk(float lo, float hi) {
    unsigned r; asm volatile("v_cvt_pk_bf16_f32 %0, %1, %2" : "=v"(r) : "v"(lo), "v"(hi)); return r;
}
__device__ __forceinline__ bf16x8 pack8(f32x4 a, f32x4 b) {
    u32x4 w = {cvtpk(a[0], a[1]), cvtpk(a[2], a[3]), cvtpk(b[0], b[1]), cvtpk(b[2], b[3])};
    return *reinterpret_cast<bf16x8*>(&w);
}
__device__ __forceinline__ bf16x8 ld8(const unsigned short* p) { return *reinterpret_cast<const bf16x8*>(p); }
__device__ __forceinline__ void mask_tile(f32x16& p0, f32x16& p1, int dq, unsigned W) {
    const float NEG = -__builtin_inff();
#pragma unroll
    for (int r = 0; r < 16; ++r) {
        const int c = (r & 3) + 8 * (r >> 2);
        if ((unsigned)(dq - c) >= W) p0[r] = NEG;
        if ((unsigned)(dq - c - 32) >= W) p1[r] = NEG;
    }
}
__device__ __forceinline__ void partialSM(f32x16& p0, f32x16& p1, float& m_reg, float& mn, float& alpha) {
    float pmax = p0[0]; for (int r = 1; r < 16; ++r) pmax = fmaxf(pmax, p0[r]); for (int r = 0; r < 16; ++r) pmax = fmaxf(pmax, p1[r]);
    { auto rr = __builtin_amdgcn_permlane32_swap(__float_as_uint(pmax), __float_as_uint(pmax), false, false);
      pmax = fmaxf(__uint_as_float(rr[0]), __uint_as_float(rr[1])); }
    constexpr float C2 = 1.4426950408889634f * SCALE;
    if (__builtin_expect(__all((pmax - m_reg) * SCALE <= THR), 1)) { mn = m_reg; alpha = 1.f; }
    else { mn = fmaxf(m_reg, pmax); alpha = __builtin_amdgcn_exp2f((m_reg - mn) * C2); m_reg = mn; }
    const float mnL = -mn * C2;
    for (int r = 0; r < 16; ++r) p0[r] = fmaf(p0[r], C2, mnL); for (int r = 0; r < 16; ++r) p1[r] = fmaf(p1[r], C2, mnL);
    for (int r = 0; r < 16; ++r) p0[r] = __builtin_amdgcn_exp2f(p0[r]);
}
__device__ __forceinline__ void finishSM(f32x16& p0, f32x16& p1, float alpha, float& l_reg, bf16x8& pa0, bf16x8& pa1, bf16x8& pa2, bf16x8& pa3) {
    for (int r = 0; r < 16; ++r) p1[r] = __builtin_amdgcn_exp2f(p1[r]);
    float ps = 0; for (int r = 0; r < 16; ++r) ps += p0[r]; for (int r = 0; r < 16; ++r) ps += p1[r];
    { auto rr = __builtin_amdgcn_permlane32_swap(__float_as_uint(ps), __float_as_uint(ps), false, false);
      ps = __uint_as_float(rr[0]) + __uint_as_float(rr[1]); }
    l_reg = l_reg * alpha + ps;
#define PK4(P, B_, OUT) do { unsigned a0 = cvtpk(P[B_+0], P[B_+1]), a1 = cvtpk(P[B_+2], P[B_+3]);                          \
        unsigned b0 = cvtpk(P[B_+4], P[B_+5]), b1 = cvtpk(P[B_+6], P[B_+7]);                                             \
        auto r0 = __builtin_amdgcn_permlane32_swap(a0, b0, false, false); auto r1 = __builtin_amdgcn_permlane32_swap(a1, b1, false, false); \
        u32x4 w = {r0[0], r1[0], r0[1], r1[1]}; OUT = *reinterpret_cast<bf16x8*>(&w); } while (0)
    PK4(p0, 0, pa0); PK4(p0, 8, pa1); PK4(p1, 0, pa2); PK4(p1, 8, pa3);
#undef PK4
}
template <int KB>
__device__ __forceinline__ void qkt(f32x16& p0, f32x16& p1, const char* K_lds, const float* nck, int r32, int hi, const bf16x8* qr, const char* q_lds) {
#pragma unroll
    for (int g = 0; g < 4; ++g) { const f32x4 a = *(const f32x4*)(nck + 8 * g + 4 * hi), b = *(const f32x4*)(nck + 32 + 8 * g + 4 * hi);
#pragma unroll
        for (int j = 0; j < 4; ++j) { p0[4 * g + j] = a[j]; p1[4 * g + j] = b[j]; } }
    const char* kb[4];
#pragma unroll
    for (int dd = 0; dd < 4; ++dd) kb[dd] = K_lds + KB * SHM_K + KSWZ(r32, (dd * 16 + hi * 8) * 2);
#pragma unroll
    for (int d0 = 0; d0 < 8; ++d0) { const char* a = kb[d0 & 3] + (d0 >> 2) * 128;
        bf16x8 b0 = *reinterpret_cast<const bf16x8*>(a);
        bf16x8 b1 = *reinterpret_cast<const bf16x8*>(a + 32 * 256);
        const bf16x8 qf = d0 < QREG ? qr[d0] : *reinterpret_cast<const bf16x8*>(q_lds + (d0 - QREG) * 1024);
        p0 = __builtin_amdgcn_mfma_f32_32x32x16_bf16(b0, qf, p0, 0, 0, 0);
        p1 = __builtin_amdgcn_mfma_f32_32x32x16_bf16(b1, qf, p1, 0, 0, 0); }
}
template <int VB, bool SK>
__device__ __forceinline__ void pv_tile(f32x16* o, int vb0, bf16x8 pa0, bf16x8 pa1, bf16x8 pa2, bf16x8 pa3, bool act) {
    if (SK && !act) return;
#define TRRD(dst, off) asm volatile("ds_read_b64_tr_b16 %0, %1 offset:%2" : "=&v"(dst) : "v"(vb0), "i"(off) : "memory")
#define PV_D0(d0) do { s16x4 l0, l1, l2, l3, h0, h1, h2, h3; constexpr int b_ = VB * SHM_V + v_rd_off(d0, 0, 0);     \
        TRRD(l0, b_); TRRD(h0, b_ + 2048); TRRD(l1, b_ + 4096); TRRD(h1, b_ + 6144); TRRD(l2, b_ + 8192); TRRD(h2, b_ + 10240); TRRD(l3, b_ + 12288); TRRD(h3, b_ + 14336); \
        asm volatile("s_waitcnt lgkmcnt(0)" ::: "memory"); SBAR();                 \
        o[d0] = __builtin_amdgcn_mfma_f32_32x32x16_bf16(pa0, (bf16x8){l0[0], l0[1], l0[2], l0[3], h0[0], h0[1], h0[2], h0[3]}, o[d0], 0, 0, 0);   \
        o[d0] = __builtin_amdgcn_mfma_f32_32x32x16_bf16(pa1, (bf16x8){l1[0], l1[1], l1[2], l1[3], h1[0], h1[1], h1[2], h1[3]}, o[d0], 0, 0, 0);   \
        o[d0] = __builtin_amdgcn_mfma_f32_32x32x16_bf16(pa2, (bf16x8){l2[0], l2[1], l2[2], l2[3], h2[0], h2[1], h2[2], h2[3]}, o[d0], 0, 0, 0);   \
        o[d0] = __builtin_amdgcn_mfma_f32_32x32x16_bf16(pa3, (bf16x8){l3[0], l3[1], l3[2], l3[3], h3[0], h3[1], h3[2], h3[3]}, o[d0], 0, 0, 0); } while (0)
    PV_D0(0); PV_D0(1); PV_D0(2); PV_D0(3);
#undef PV_D0
#undef TRRD
}
struct BlockRef { const bf16* Q; const bf16* K; const bf16* V; const bf16* G; bf16* O; int P0; int jlo; int bh; int jw; };
struct Seam { bf16x8 qr[8]; bf16x8 st_v0, st_v1, st_k0, st_k1; };
#define ROW(p, k0, rr) ((p) + (size_t)((k0) + (rr)) * PQ + sc)
#define VMW() asm volatile("s_waitcnt vmcnt(0)" ::: "memory")
#define VMWN(n) asm volatile("s_waitcnt vmcnt(%0)" :: "i"(n) : "memory")
#define SLOAD_H(Kp, Vp, k0) do { S.st_v0 = ld8(ROW(Vp, k0, sr)); S.st_v1 = ld8(ROW(Vp, k0, 32 + sr)); S.st_k0 = ld8(ROW(Kp, k0, sr)); S.st_k1 = ld8(ROW(Kp, k0, 32 + sr)); } while (0)
#define SWRITE_HK(bf) do { *(bf16x8*)(K_lds + (bf) * SHM_K + kws) = S.st_k0; *(bf16x8*)(K_lds + (bf) * SHM_K + kws + 32 * 256) = S.st_k1; } while (0)
#define SWRITE_HV(bf) do { *(bf16x8*)(V_lds + (bf) * SHM_V + vst0) = S.st_v0; *(bf16x8*)(V_lds + (bf) * SHM_V + vst1) = S.st_v1; } while (0)
#define SWRITE_H(bf) do { SWRITE_HV(bf); SWRITE_HK(bf); } while (0)
__device__ __forceinline__ void fox_prime(const BlockRef& cur, char* lds, Seam& S, int tid) {
    const int wid = __builtin_amdgcn_readfirstlane(tid >> 6), lane = tid & 63, r32 = lane & 31, hi = lane >> 5;
    const int sr = tid >> 4, sc = (tid & 15) * 8, kws = KSWZ(sr, sc * 2); char* K_lds = lds + 2 * SHM_V;
#pragma unroll
    for (int d0 = 0; d0 < 8; ++d0) S.qr[d0] = ld8(cur.Q + (size_t)(wid * QBLK + r32) * PQ + d0 * 16 + hi * 8);
    SLOAD_H(cur.K, cur.V, cur.P0 + 3 * KVBLK); VMW(); SWRITE_HK(0);
    __syncthreads();
}
__device__ __forceinline__ void fox_block(const BlockRef& cur, const BlockRef& nxt, char* lds, Seam& S, int tid, const float* ncs_next  ) {
    const int wid = __builtin_amdgcn_readfirstlane(tid >> 6), lane = tid & 63, r32 = lane & 31, hi = lane >> 5;
    const int NT = cur.P0 / KVBLK + 4 - cur.jlo;
    const unsigned W = 1u << 30;
    const int koff = cur.jlo * KVBLK, klo_w = (cur.jw - cur.jlo) * KVBLK;
    const int qlo = cur.P0 - koff + wid * QBLK, qm = qlo + r32 - 4 * hi;
    char* V_lds = lds; char* K_lds = lds + 2 * SHM_V;
    float* ws = (float*)(lds + LDS_WS) + wid * 64; float* li_l = ws, * al_l = ws + 32;
    const float* cs_l = (const float*)(lds + LDS_CS) + koff;
    float m_reg = -1e30f, l_reg = 0; f32x16 o[4] = {};
    const int sr = tid >> 4, sc = (tid & 15) * 8, vst0 = v_st(sr, sc), vst1 = v_st(32 + sr, sc), kws = KSWZ(sr, sc * 2);
    const int vb0 = (int)(uintptr_t)V_lds + v_rd_base(lane);
    char* q_lds = lds + LDS_Q + wid * (8 - QREG) * 1024 + lane * 16;
    const bf16* Kh = cur.K + (size_t)koff * PQ; const bf16* Vh = cur.V + (size_t)koff * PQ;
#define RESC(a) do { if (__any((a) < 1.f)) { if (hi == 0) al_l[r32] = (a); asm volatile("s_waitcnt lgkmcnt(0)" ::: "memory");              \
                     for (int d_ = 0; d_ < 4; ++d_) for (int r = 0; r < 16; ++r) o[d_][r] *= al_l[crow(r, hi)]; } } while (0)
#define KBASE(t) ((NT - 1 - (t)) * KVBLK)
#define ACT(t) (KBASE(t) <= qlo + QBLK - 1 && KBASE(t) >= klo_w)
#define MASKT(P0_, P1_, t) do { const int kb_ = KBASE(t); if (kb_ + KVBLK - 1 > qlo) mask_tile(P0_, P1_, qm - kb_, W); } while (0)
#define SEAM_K0() do { VMWN(8); SWRITE_HK(0); SBAR(); } while (0)
    f32x16 pA0, pA1, pB0, pB1; float mnA, mnB, alA, alB; bf16x8 pa0, pa1, pa2, pa3;
    SWRITE_HV(0);
#pragma unroll
    for (int d0 = QREG; d0 < 8; ++d0) *(bf16x8*)(q_lds + (d0 - QREG) * 1024) = S.qr[d0];
    SBAR();
    if (NT > 1) SLOAD_H(Kh, Vh, KBASE(1));
    SBAR(); if (ACT(0)) { qkt<0>(pA0, pA1, K_lds, cs_l + KBASE(0), r32, hi, S.qr, q_lds);
        MASKT(pA0, pA1, 0); partialSM(pA0, pA1, m_reg, mnA, alA); } else { alA = 1.f; mnA = m_reg; }
    if (NT > 1) { VMW(); SWRITE_H(1); }
    __syncthreads();
#define HALF_STEP(PX0, PX1, mnX, alX, PY0, PY1, alY, t, KB, VB, SB) do {                                                      \
        SBAR(); if ((t) + 1 < NT) { SLOAD_H(Kh, Vh, KBASE((t) + 1)); SBAR(); }     \
        const bool ax_ = ACT(t), ay_ = ACT((t) - 1);                                                                          \
        if (ax_) qkt<KB>(PX0, PX1, K_lds, cs_l + KBASE(t), r32, hi, S.qr, q_lds);                                        \
        if (ay_) finishSM(PY0, PY1, alY, l_reg, pa0, pa1, pa2, pa3); SBAR();                                                  \
        if (ay_) pv_tile<VB, false>(o, vb0, pa0, pa1, pa2, pa3, true);                                                        \
        if (ax_) { MASKT(PX0, PX1, (t)); partialSM(PX0, PX1, m_reg, mnX, alX); } else { alX = 1.f; mnX = m_reg; }             \
        __syncthreads();                                                                                                      \
        if ((t) + 1 < NT) { VMW(); SWRITE_H(SB); }                                                                            \
        RESC(alX); __syncthreads(); } while (0)
    for (int t = 1; t + 1 < NT; t += 2) {
        HALF_STEP(pB0, pB1, mnB, alB, pA0, pA1, alA, t, 1, 0, 0);
        HALF_STEP(pA0, pA1, mnA, alA, pB0, pB1, alB, t + 1, 0, 1, 1);
    }
    const bool even = (NT & 1) == 0;
    const bool aL_ = ACT(NT - 1), aA_ = even ? ACT(NT - 2) : aL_;
    if (even) { SBAR(); if (aL_) qkt<1>(pB0, pB1, K_lds, cs_l + KBASE(NT - 1), r32, hi, S.qr, q_lds); SBAR(); }
    SLOAD_H(nxt.K, nxt.V, nxt.P0 + 3 * KVBLK); SBAR();
#pragma unroll
    for (int d0 = 0; d0 < 8; ++d0) S.qr[d0] = ld8(nxt.Q + (size_t)(wid * QBLK + r32) * PQ + d0 * 16 + hi * 8);
    SBAR();
    if (aA_) finishSM(pA0, pA1, alA, l_reg, pa0, pa1, pa2, pa3); SBAR();
    if (aA_) pv_tile<0, false>(o, vb0, pa0, pa1, pa2, pa3, true);
    if (even) { if (aL_) { MASKT(pB0, pB1, NT - 1); partialSM(pB0, pB1, m_reg, mnB, alB); } else { alB = 1.f; mnB = m_reg; } __syncthreads(); RESC(alB);
        if (aL_) { finishSM(pB0, pB1, alB, l_reg, pa0, pa1, pa2, pa3); SBAR(); pv_tile<1, false>(o, vb0, pa0, pa1, pa2, pa3, true); } }
    SBAR(); SEAM_K0();
    if (ncs_next) { const f32x4* src_ = (const f32x4*)ncs_next; f32x4* dst_ = (f32x4*)(lds + LDS_CS);
        dst_[tid] = src_[tid]; dst_[tid + 512] = src_[tid + 512]; }
    if (hi == 0) li_l[r32] = l_reg; asm volatile("s_waitcnt lgkmcnt(0)" ::: "memory");
    float rli[16];
#pragma unroll
    for (int r = 0; r < 16; ++r) rli[r] = __builtin_amdgcn_rcpf(li_l[crow(r, hi)]);
    typedef float f32x2_t __attribute__((ext_vector_type(2))); typedef __bf16 bf16x2_t __attribute__((ext_vector_type(2)));
#define FA_CVT(lo_, hi_) __builtin_bit_cast(unsigned, __builtin_convertvector((f32x2_t){lo_, hi_}, bf16x2_t))
    { const unsigned selx = (r32 & 1) ? 0x03020706u : 0x05040100u;
      const bool b1 = (r32 & 2) != 0;
      bf16* Ow = cur.O + (size_t)(wid * QBLK + 4 * hi + (r32 & 3)) * PO + (r32 & ~3);
      const bf16* Gw = cur.G + (size_t)(wid * QBLK + 4 * hi + (r32 & 3)) * PQ + (r32 & ~3);
      u32x2 gl[4][4];
#pragma unroll
      for (int g4 = 0; g4 < 4; ++g4)
#pragma unroll
          for (int d0 = 0; d0 < 4; ++d0) gl[g4][d0] = *(const u32x2*)(Gw + (size_t)(8 * g4) * PQ + d0 * 32);
#pragma unroll
      for (int g4 = 0; g4 < 4; ++g4)
#pragma unroll
          for (int d0 = 0; d0 < 4; ++d0) {
              const unsigned w01 = FA_CVT(o[d0][4 * g4] * rli[4 * g4], o[d0][4 * g4 + 1] * rli[4 * g4 + 1]), w23 = FA_CVT(o[d0][4 * g4 + 2] * rli[4 * g4 + 2], o[d0][4 * g4 + 3] * rli[4 * g4 + 3]);
              const unsigned n01 = (unsigned)__builtin_amdgcn_update_dpp(0, (int)w01, 0xB1, 0xF, 0xF, false), n23 = (unsigned)__builtin_amdgcn_update_dpp(0, (int)w23, 0xB1, 0xF, 0xF, false);
              const unsigned a = __builtin_amdgcn_perm(n01, w01, selx), bq = __builtin_amdgcn_perm(n23, w23, selx);
              const unsigned x = b1 ? a : bq;
              const unsigned y = (unsigned)__builtin_amdgcn_update_dpp(0, (int)x, 0x4E, 0xF, 0xF, false);
              const u32x2 ov = b1 ? (u32x2){y, bq} : (u32x2){a, y}; const u32x2 gv = gl[g4][d0];
#define FA_LO(w_) __uint_as_float((w_) << 16)
#define FA_HI(w_) __uint_as_float((w_) & 0xffff0000u)
              const u32x2 og = (u32x2){FA_CVT(FA_LO(ov.x) * FA_LO(gv.x), FA_HI(ov.x) * FA_HI(gv.x)), FA_CVT(FA_LO(ov.y) * FA_LO(gv.y), FA_HI(ov.y) * FA_HI(gv.y))};
#undef FA_LO
#undef FA_HI
              *(u32x2*)(Ow + (size_t)(8 * g4) * PO + d0 * 32) = og; }
    }
#undef FA_CVT
    __syncthreads();
#undef RESC
#undef KBASE
#undef ACT
#undef MASKT
#undef SEAM_K0
#undef HALF_STEP
}
#undef ROW
#undef VMW
#undef VMWN
#undef SLOAD_H
#undef SWRITE_HK
#undef SWRITE_HV
#undef SWRITE_H
__device__ __forceinline__ int fox_jlo(const float* ncs, const float* KN, const float* QN, int qb, int lane, int wid, int& jw) {
    float qn = 0.f, kd = 0.f;
#pragma unroll
    for (int i = 0; i < 4; ++i) { qn = fmaxf(qn, QN[4 * qb + i]); kd = fmaxf(kd, KN[4 * qb + i]); }
    float a_ = qn * (KN[lane] + kd); asm volatile("" : "+v"(a_));
    const float ce = ncs[64 * lane + 63];
    const float bound = SCALE * (a_ + (ce - ncs[qb * QB]));
    const float bound_w = SCALE * (a_ + (ce - ncs[qb * QB + QBLK * wid]));
    const bool need = lane >= 4 * qb || !(bound < -30.0f);
    const bool need_w = lane >= 4 * qb || !(bound_w < -30.0f);
    jw = (int)__builtin_ctzll(__ballot(need_w));
    return (int)__builtin_ctzll(__ballot(need));
}
__device__ __forceinline__ BlockRef fox_ref(int item, int lane, int wid, const int* ord, const bf16* Y2, const float* CSR, const float* NRM, bf16* AO) {
    BlockRef r; int k, qb; const int x = item >> 6, i = item & 63;
    if (i < 48) { k = i / 12; qb = 15 - (i - k * 12); } else { const int j = i - 48; k = j >> 2; qb = 3 - (j & 3); }
    const int rank = k == 0 ? x : k == 1 ? 15 - x : k == 2 ? 16 + x : 31 - x;
    const int bh = __builtin_amdgcn_readfirstlane(ord[rank]), b = bh >> 3, h = bh & 7;
    const bf16* base = Y2 + (size_t)b * SEQ * PQ + h * D;
    int jw_; r.bh = bh; r.P0 = qb * QB; r.jlo = __builtin_amdgcn_readfirstlane(fox_jlo(CSR + (size_t)bh * SEQ, NRM + (size_t)bh * 128, NRM + (size_t)bh * 128 + 64, qb, lane, wid, jw_)); { const int j0_ = __builtin_amdgcn_readfirstlane(jw_); r.jw = j0_ < r.jlo ? r.jlo : j0_; }
    r.Q = base + (size_t)r.P0 * PQ; r.K = base + 1024; r.V = base + 2048; r.G = r.Q + 3072; r.O = AO + ((size_t)b * SEQ + r.P0) * PO + h * D;
    return r;
}
__device__ __forceinline__ int fox_fetch(unsigned* qc  , int x, int lane) {
    unsigned i0 = 0; if (lane == 0) i0 = __hip_atomic_fetch_add(qc + x * 64, 1u, __ATOMIC_RELAXED, __HIP_MEMORY_SCOPE_AGENT);
    i0 = __builtin_amdgcn_readfirstlane(i0);
    if (i0 < 64u) return x * 64 + (int)i0;
    for (int tries = 0; tries < 8; ++tries) {
        unsigned cv = 64u; if (lane < 8) cv = __hip_atomic_load(qc + lane * 64, __ATOMIC_RELAXED, __HIP_MEMORY_SCOPE_AGENT);
        const unsigned m = (unsigned)__builtin_amdgcn_ballot_w64(cv < 64u) & 0xffu;
        if (m == 0u) return -1;
        const unsigned rot = ((m >> x) | (m << (8 - x))) & 0xffu;
        const int y = (x + __builtin_ctz(rot)) & 7;
        unsigned iy = 0; if (lane == 0) iy = __hip_atomic_fetch_add(qc + y * 64, 1u, __ATOMIC_RELAXED, __HIP_MEMORY_SCOPE_AGENT);
        iy = __builtin_amdgcn_readfirstlane(iy);
        if (iy < 64u) return y * 64 + (int)iy;
    }
    return -1;
}
__device__ __forceinline__ void fox_phase(char* lds, int tid, int bid, int G, const bf16* Y2, const float* CSR, const float* NRM, bf16* AO, unsigned* qcnt) {
    (void)bid; (void)G;
    volatile int* slot = (volatile int*)(lds + LDS_ITEM); const int lane = tid & 63;
    const int xcd = (int)(__builtin_amdgcn_s_getreg((3 << 11) | 20) & 7u);
    float* rk = (float*)(lds + LDS_ITEM + 16); int* ord = (int*)(lds + LDS_ITEM + 16 + 128);
    if (tid < 32) rk[tid] = CSR[(size_t)tid * SEQ + SEQ - 1];
    __syncthreads();
    if (tid < 32) { const float r = rk[tid]; int c = 0;
        for (int j = 0; j < 32; ++j) { const float rj = rk[j]; c += (rj < r || (rj == r && j < tid)) ? 1 : 0; }
        ord[c] = tid; }
    if (tid < 64) { const int it_ = fox_fetch(qcnt, xcd, lane); if (lane == 0) slot[0] = it_; }
    __syncthreads();
    const int item0 = __builtin_amdgcn_readfirstlane(slot[0]);
    if (item0 < 0) return;
    BlockRef cur = fox_ref(item0, lane, __builtin_amdgcn_readfirstlane(tid >> 6), ord, Y2, CSR, NRM, AO);
    { const f32x4* src = (const f32x4*)(CSR + (size_t)cur.bh * SEQ); f32x4* dst = (f32x4*)(lds + LDS_CS); dst[tid] = src[tid]; dst[tid + 512] = src[tid + 512]; }
    Seam S;
    fox_prime(cur, lds, S, tid);
    for (;;) {
        if (tid < 64) { const int it_ = fox_fetch(qcnt, xcd, lane); if (lane == 0) slot[1] = it_; }
        __syncthreads();
        const int nitem = __builtin_amdgcn_readfirstlane(slot[1]); const bool last = nitem < 0;
        int tid2 = tid; asm volatile("" : "+v"(tid2));
        const BlockRef nxt = last ? cur : fox_ref(nitem, tid2 & 63, __builtin_amdgcn_readfirstlane(tid2 >> 6), ord, Y2, CSR, NRM, AO);
        fox_block(cur, nxt, lds, S, tid2, (!last && nxt.bh != cur.bh) ? CSR + (size_t)nxt.bh * SEQ : nullptr);
        if (last) break;
        cur = nxt;
    }
}
__device__ __forceinline__ void fox_norms(int gw, int ngw, int lane, const bf16* Y2, float* NRM) {
    for (int task = gw; task < 32 * 2 * 64; task += ngw) {
        const int j = task & 63, which = (task >> 6) & 1, bh = task >> 7, b = bh >> 3, h = bh & 7;
        const bf16* p = Y2 + ((size_t)b * SEQ + 64 * j + lane) * PQ + (which ? 0 : 1024) + h * D;
        float s = 0.f;
#pragma unroll
        for (int i = 0; i < 16; ++i) { const u32x4 v = *(const u32x4*)(p + 8 * i);
            const float a0 = __uint_as_float(v.x << 16), a1 = __uint_as_float(v.x & 0xffff0000u), a2 = __uint_as_float(v.y << 16), a3 = __uint_as_float(v.y & 0xffff0000u),
                        a4 = __uint_as_float(v.z << 16), a5 = __uint_as_float(v.z & 0xffff0000u), a6 = __uint_as_float(v.w << 16), a7 = __uint_as_float(v.w & 0xffff0000u);
            s += (a0 * a0 + a1 * a1) + (a2 * a2 + a3 * a3) + (a4 * a4 + a5 * a5) + (a6 * a6 + a7 * a7); }
#pragma unroll
        for (int o = 1; o < 64; o <<= 1) s = fmaxf(s, __int_as_float(__builtin_amdgcn_ds_bpermute((lane ^ o) << 2, __float_as_int(s))));
        if (lane == 0) NRM[(size_t)bh * 128 + which * 64 + j] = sqrtf(s) * 1.0001f;
    }
}
#undef KSWZ
#undef SBAR
}
namespace hg {
typedef unsigned short bf16;
typedef short bf16x8 __attribute__((ext_vector_type(8)));
typedef float f32x4 __attribute__((ext_vector_type(4)));
typedef unsigned u32x4 __attribute__((ext_vector_type(4)));
typedef unsigned u32x2 __attribute__((ext_vector_type(2)));
typedef float f2 __attribute__((ext_vector_type(2)));
constexpr int T = 4096, NSEG = 4, SEGLEN = T / NSEG, NCH = SEGLEN / 64, PY = 6144;
constexpr int LQ = 136, LS = 72, LO = 132;
constexpr int O_QX = 0, O_KX = O_QX + 64 * LQ * 2, O_KT = O_KX + 64 * LQ * 2, O_VT = O_KT + 128 * LS * 2, O_AM = O_VT + 128 * LS * 2, O_TOT = O_AM + 64 * LS * 2, O_E1 = O_TOT + 4096, O_E2 = O_E1 + 512,
              O_OSTF = O_E2 + 512, O_NW = O_OSTF + 64 * LO * 4, O_OSTF1 = O_NW + 512, LDS_BYTES = O_OSTF1 + 64 * LO * 4;
constexpr float LOG2E = 1.4426950408889634f;
typedef float f32x2_t __attribute__((ext_vector_type(2))); typedef __bf16 bf16x2_t __attribute__((ext_vector_type(2)));
__device__ __forceinline__ unsigned cvtpk(float lo, float hi) { f32x2_t v = {lo, hi}; bf16x2_t b = __builtin_convertvector(v, bf16x2_t); return __builtin_bit_cast(unsigned, b); }
__device__ __forceinline__ f2 ex2(f2 x) { return (f2){__builtin_amdgcn_exp2f(x.x), __builtin_amdgcn_exp2f(x.y)}; }
__device__ __forceinline__ f2 rcp2(f2 x) { return (f2){__builtin_amdgcn_rcpf(x.x), __builtin_amdgcn_rcpf(x.y)}; }
__device__ __forceinline__ f2 lg2(f2 x) { return (f2){__builtin_amdgcn_logf(x.x), __builtin_amdgcn_logf(x.y)}; }
__device__ __forceinline__ f2 max2(f2 a, float b) { return (f2){fmaxf(a.x, b), fmaxf(a.y, b)}; }
__device__ __forceinline__ f2 min2(f2 a, float b) { return (f2){fminf(a.x, b), fminf(a.y, b)}; }
__device__ __forceinline__ f2 clamp2(f2 a, float lim) { return (f2){fminf(fmaxf(a.x, -lim), lim), fminf(fmaxf(a.y, -lim), lim)}; }
__device__ __forceinline__ f2 bf2(unsigned w) { return (f2){__uint_as_float(w << 16), __uint_as_float(w & 0xffff0000u)}; }
__device__ __forceinline__ unsigned pk2(f2 v) { return cvtpk(v.x, v.y); }
#define HG_BAR() __syncthreads()

template <bool STATE_ONLY>
__device__ __forceinline__ void hgrn_stream(char* lds, int tid, int stream, bf16* Y, const float* lbl, int oi, const float* nw, float* SLOC, float* DSEG, const bf16* GA = nullptr, const bf16* GB = nullptr, bf16* Yo = nullptr, int po = PY) {
    const int lane = tid & 63, w = __builtin_amdgcn_readfirstlane(tid >> 6), c = lane & 15, q = lane >> 4;
    const int seg = stream & 3, h = (stream >> 2) & 15, b = stream >> 6;
    if (STATE_ONLY && seg == NSEG - 1) return;
    f2 lbv = (f2){0.f, 0.f};
    if (oi == 1) { const float2 l0 = *(const float2*)(lbl + h * 128 + 2 * lane), l1 = *(const float2*)(lbl + 2048 + h * 128 + 2 * lane);
        lbv = (f2){1.0f / (1.0f + __builtin_amdgcn_exp2f((l0.x - l1.x) * LOG2E)), 1.0f / (1.0f + __builtin_amdgcn_exp2f((l0.y - l1.y) * LOG2E))}; }
    const f2 oml = 1.0f - lbv;
    const size_t row0 = (size_t)b * T + (size_t)seg * SEGLEN;
    bf16* Yq = Y + row0 * PY + h * 128; const bf16* Yf = Yq + 2048; const bf16* Yv = Yq + 4096;
    f32x4 S[8];
#pragma unroll
    for (int i = 0; i < 8; ++i) S[i] = (f32x4){0.f, 0.f, 0.f, 0.f};
    if (!STATE_ONLY && seg > 0) {
        const int s0 = stream - seg;
        float sl[3][32]; f32x4 dd[3][8];
#pragma unroll
        for (int k = 0; k < 3; ++k) { const int sp = seg - 3 + k, spc = sp < 0 ? 0 : sp;
            const float* slp = SLOC + (size_t)(s0 + spc) * 16384 + w * 64 + lane; const float* dg = DSEG + (size_t)(s0 + spc) * 128;
#pragma unroll
            for (int i = 0; i < 8; ++i) { dd[k][i] = *(const f32x4*)(dg + 16 * i + 4 * q);
#pragma unroll
                for (int r = 0; r < 4; ++r) sl[k][i * 4 + r] = slp[(size_t)(i * 4 + r) * 512]; } }
#pragma unroll
        for (int k = 0; k < 3; ++k) { const bool valid = seg - 3 + k >= 0;
#pragma unroll
            for (int i = 0; i < 8; ++i)
#pragma unroll
                for (int r = 0; r < 4; ++r) S[i][r] = S[i][r] * dd[k][i][r] + (valid ? sl[k][i * 4 + r] : 0.f); }
    }
    if (!STATE_ONLY && tid < 128) ((float*)(lds + O_NW))[tid] = nw[tid];
    f2 bseg; { float one_ = 1.f; asm volatile("" : "+v"(one_)); bseg = (f2){one_, one_}; }
    unsigned qraw[8], fraw[8]; u32x4 vraw[2];
    unsigned fraw2[STATE_ONLY ? 8 : 1]; u32x4 vraw2[STATE_ONLY ? 2 : 1];
#define HG_LOADX(cc, FR, VR) do { const size_t r_ = (size_t)(cc) * 64; \
        _Pragma("unroll") for (int j = 0; j < 8; ++j) { FR[j] = *(const unsigned*)(Yf + (r_ + 8 * w + j) * PY + 2 * lane); if (!STATE_ONLY) qraw[j] = *(const unsigned*)(Yq + (r_ + 8 * w + j) * PY + 2 * lane); } \
        _Pragma("unroll") for (int i = 0; i < 2; ++i) VR[i] = *(const u32x4*)(Yv + (r_ + 2 * (tid >> 4) + i) * PY + (tid & 15) * 8); } while (0)
    const bf16* Gu = STATE_ONLY ? nullptr : (h < 8 ? GA : GB) + row0 * 1024 + (h & 7) * 128;
    auto chunk = [&](const int ch, unsigned (&fr)[8], u32x4 (&vr)[2], const int ld_ch) {
        u32x4 gt0, gt1;
        if (!STATE_ONLY) { const bf16* gp = Gu + (size_t)ch * 64 * 1024; const int go = (tid >> 3) * 1024 + (tid & 7) * 16; gt0 = *(const u32x4*)(gp + go); gt1 = *(const u32x4*)(gp + go + 8); }
        f2 fj[8], kin[8], qs[8];
        float* TOT = (float*)(lds + O_TOT);
        { f2 tot;
#pragma unroll
          for (int j = 0; j < 8; ++j) { const f2 e = ex2(min2(bf2(fr[j]) * (-LOG2E), 64.f)), sig = rcp2(1.0f + e);
              fj[j] = lbv + oml * sig; kin[j] = oml - oml * sig; tot = j == 0 ? fj[0] : tot * fj[j];
              if (!STATE_ONLY) { const f2 qq = bf2(qraw[j]); qs[j] = qq * rcp2(1.0f + ex2(min2(qq * (-LOG2E), 64.f))); } }
          *(f2*)(TOT + w * 128 + 2 * lane) = tot; }
        HG_BAR();
        { const int s2 = tid >> 4, v0 = (tid & 15) * 8;
          unsigned* vt = (unsigned*)((bf16*)(lds + O_VT) + v0 * LS + ((((s2 >> 2) ^ (tid & 7)) & 7) << 3) + 2 * (s2 & 3));
          vt[0 * (LS / 2)] = (vr[0].x & 0xffffu) | (vr[1].x << 16); vt[1 * (LS / 2)] = (vr[0].x >> 16) | (vr[1].x & 0xffff0000u);
          vt[2 * (LS / 2)] = (vr[0].y & 0xffffu) | (vr[1].y << 16); vt[3 * (LS / 2)] = (vr[0].y >> 16) | (vr[1].y & 0xffff0000u);
          vt[4 * (LS / 2)] = (vr[0].z & 0xffffu) | (vr[1].z << 16); vt[5 * (LS / 2)] = (vr[0].z >> 16) | (vr[1].z & 0xffff0000u);
          vt[6 * (LS / 2)] = (vr[0].w & 0xffffu) | (vr[1].w << 16); vt[7 * (LS / 2)] = (vr[0].w >> 16) | (vr[1].w & 0xffff0000u); }
        if (ld_ch < NCH) HG_LOADX(ld_ch, fr, vr);
        f2 lo4, hi4, part; { float one_ = 1.f; asm volatile("" : "+v"(one_)); part = (f2){one_, one_}; }
#pragma unroll
        for (int g8 = 0; g8 < 8; ++g8) { const f2 t_ = *(const f2*)(TOT + g8 * 128 + 2 * lane); if (g8 == 0) lo4 = t_; else if (g8 < 4) lo4 *= t_; else if (g8 == 4) hi4 = t_; else hi4 *= t_;
            const bool in_ = STATE_ONLY ? (g8 > w) : (w < 4 ? (g8 > w && g8 < 4) : (g8 >= 4 && g8 < w)); if (in_) part *= t_; }
        if (w == 0) {
            if (STATE_ONLY) { const f2 tt = lo4 * hi4; bseg *= tt; *(f2*)((float*)(lds + O_E1) + 2 * lane) = tt; }
            else { *(f2*)((float*)(lds + O_E1) + 2 * lane) = lo4; *(f2*)((float*)(lds + O_E2) + 2 * lane) = hi4; } }
        { f2 kt[8];
          const float TINY = 7.888609052210118e-31f;
          if (STATE_ONLY) {
              f2 s = part;
#pragma unroll
              for (int j = 7; j >= 0; --j) { kt[j] = kin[j] * s; s *= fj[j]; }
          } else {
              unsigned* QX = (unsigned*)((bf16*)(lds + O_QX) + (8 * w) * LQ + 2 * lane); unsigned* KX = (unsigned*)((bf16*)(lds + O_KX) + (8 * w) * LQ + 2 * lane);
              if (w < 4) { f2 s = part;
#pragma unroll
                  for (int j = 7; j >= 0; --j) { const f2 uc = max2(s, TINY), ed = rcp2(uc); kt[j] = kin[j] * uc; QX[j * (LQ / 2)] = pk2(qs[j] * ed); KX[j * (LQ / 2)] = pk2(kt[j]); s *= fj[j]; }
              } else { f2 p = part;
#pragma unroll
                  for (int j = 0; j < 8; ++j) { p *= fj[j]; const f2 wc = max2(p, TINY); kt[j] = kin[j] * rcp2(wc); QX[j * (LQ / 2)] = pk2(qs[j] * wc); KX[j * (LQ / 2)] = pk2(kt[j]); } }
          }
          u32x4* kd = (u32x4*)((bf16*)(lds + O_KT) + (2 * lane) * LS + 8 * w);
          kd[0] = (u32x4){cvtpk(kt[0].x, kt[1].x), cvtpk(kt[2].x, kt[3].x), cvtpk(kt[4].x, kt[5].x), cvtpk(kt[6].x, kt[7].x)};
          *(u32x4*)((bf16*)kd + LS) = (u32x4){cvtpk(kt[0].y, kt[1].y), cvtpk(kt[2].y, kt[3].y), cvtpk(kt[4].y, kt[5].y), cvtpk(kt[6].y, kt[7].y)}; }
        HG_BAR();
        f32x4 O[4];
        if (!STATE_ONLY) {
            for (int ti = w; ti < 12; ti += 8) {
                int I, J; if (ti < 1) { I = 0; J = 0; } else if (ti < 3) { I = 1; J = ti - 1; } else if (ti < 6) { I = 2; J = ti - 3; } else if (ti < 10) { I = 3; J = ti - 6; } else { I = (ti - 10) * 2; J = I + 1; }
                f32x4 acc = (f32x4){0.f, 0.f, 0.f, 0.f};
                if (ti < 10) {
                    const bf16* Kt = (const bf16*)(lds + O_KX) + (16 * J + c) * LQ + 8 * q; const bf16* Qt = (const bf16*)(lds + O_QX) + (16 * I + c) * LQ + 8 * q;
                    bf16x8 ka[4], qa[4];
#pragma unroll
                    for (int ks = 0; ks < 4; ++ks) { ka[ks] = *(const bf16x8*)(Kt + 32 * ks); qa[ks] = *(const bf16x8*)(Qt + 32 * ks); }
                    __builtin_amdgcn_sched_barrier(0);
#pragma unroll
                    for (int ks = 0; ks < 4; ++ks) acc = __builtin_amdgcn_mfma_f32_16x16x32_bf16(ka[ks], qa[ks], acc, 0, 0, 0);
                    if (I == J) {
#pragma unroll
                        for (int r = 0; r < 4; ++r) if (4 * q + r > c) acc[r] = 0.f; }
                }
                *(u32x2*)((bf16*)(lds + O_AM) + (16 * I + c) * LS + 16 * J + 4 * q) = (u32x2){cvtpk(acc[0], acc[1]), cvtpk(acc[2], acc[3])};
            }
            HG_BAR();
        }
        const bf16* VTw = (const bf16*)(lds + O_VT) + (16 * w + c) * LS; const int vsw = (2 * w + (c >> 3)) & 7;
        const float* E1 = (const float*)(lds + O_E1);
        if (!STATE_ONLY) {
            f32x4 e1[8]; u32x4 qa[4][4];
            const bf16x8 bv0 = *(const bf16x8*)(VTw + 8 * (q ^ vsw)), bv1 = *(const bf16x8*)(VTw + 8 * ((4 + q) ^ vsw));
#pragma unroll
            for (int kt_ = 0; kt_ < 8; ++kt_) e1[kt_] = *(const f32x4*)(E1 + 16 * kt_ + 4 * q);
#pragma unroll
            for (int ks = 0; ks < 4; ++ks)
#pragma unroll
                for (int mt = 0; mt < 4; ++mt) { const bf16* qh = (const bf16*)(lds + O_QX) + (16 * mt + c) * LQ + 32 * ks + 4 * q;
                    const u32x2 a0 = *(const u32x2*)qh, a1 = *(const u32x2*)(qh + 16); qa[ks][mt] = (u32x4){a0.x, a0.y, a1.x, a1.y}; }
            __builtin_amdgcn_sched_barrier(0);
#pragma unroll
            for (int kt_ = 0; kt_ < 8; ++kt_) S[kt_] = S[kt_] * e1[kt_];
#pragma unroll
            for (int mt = 0; mt < 4; ++mt) O[mt] = (f32x4){0.f, 0.f, 0.f, 0.f};
#pragma unroll
            for (int ks = 0; ks < 4; ++ks) {
                const u32x4 sb = (u32x4){cvtpk(S[2 * ks][0], S[2 * ks][1]), cvtpk(S[2 * ks][2], S[2 * ks][3]), cvtpk(S[2 * ks + 1][0], S[2 * ks + 1][1]), cvtpk(S[2 * ks + 1][2], S[2 * ks + 1][3])};
                const bf16x8 bS = __builtin_bit_cast(bf16x8, sb);
#pragma unroll
                for (int mt = 0; mt < 4; ++mt) O[mt] = __builtin_amdgcn_mfma_f32_16x16x32_bf16(__builtin_bit_cast(bf16x8, qa[ks][mt]), bS, O[mt], 0, 0, 0);
            }
            __builtin_amdgcn_sched_barrier(0);
            bf16x8 am[6], kh[8][2]; f32x4 e2[8];
#pragma unroll
            for (int mt = 0; mt < 4; ++mt) { const bf16* amp = (const bf16*)(lds + O_AM) + (16 * mt + c) * LS + 8 * q;
                am[mt] = *(const bf16x8*)amp; if (mt >= 2) am[2 + mt] = *(const bf16x8*)(amp + 32); }
#pragma unroll
            for (int kt_ = 0; kt_ < 4; ++kt_) { const bf16* khp = (const bf16*)(lds + O_KT) + (16 * kt_ + c) * LS + 8 * q; kh[kt_][0] = *(const bf16x8*)khp; kh[kt_][1] = *(const bf16x8*)(khp + 32); }
            __builtin_amdgcn_sched_barrier(0);
#pragma unroll
            for (int mt = 0; mt < 4; ++mt) { O[mt] = __builtin_amdgcn_mfma_f32_16x16x32_bf16(am[mt], bv0, O[mt], 0, 0, 0);
                if (mt >= 2) O[mt] = __builtin_amdgcn_mfma_f32_16x16x32_bf16(am[2 + mt], bv1, O[mt], 0, 0, 0); }
#pragma unroll
            for (int kt_ = 4; kt_ < 8; ++kt_) { const bf16* khp = (const bf16*)(lds + O_KT) + (16 * kt_ + c) * LS + 8 * q; kh[kt_][0] = *(const bf16x8*)khp; kh[kt_][1] = *(const bf16x8*)(khp + 32); }
            { const float* E2 = (const float*)(lds + O_E2);
#pragma unroll
              for (int kt_ = 0; kt_ < 8; ++kt_) e2[kt_] = *(const f32x4*)(E2 + 16 * kt_ + 4 * q); }
            __builtin_amdgcn_sched_barrier(0);
#pragma unroll
            for (int kt_ = 0; kt_ < 8; ++kt_) { S[kt_] = __builtin_amdgcn_mfma_f32_16x16x32_bf16(kh[kt_][0], bv0, S[kt_], 0, 0, 0);
                S[kt_] = __builtin_amdgcn_mfma_f32_16x16x32_bf16(kh[kt_][1], bv1, S[kt_], 0, 0, 0); }
#pragma unroll
            for (int kt_ = 0; kt_ < 8; ++kt_) S[kt_] = S[kt_] * e2[kt_];
        } else {
            const bf16x8 bv0 = *(const bf16x8*)(VTw + 8 * (q ^ vsw)), bv1 = *(const bf16x8*)(VTw + 8 * ((4 + q) ^ vsw));
#pragma unroll
            for (int kt_ = 0; kt_ < 8; ++kt_) S[kt_] = S[kt_] * *(const f32x4*)(E1 + 16 * kt_ + 4 * q);
#pragma unroll
            for (int kt_ = 0; kt_ < 8; ++kt_) { const bf16* khp = (const bf16*)(lds + O_KT) + (16 * kt_ + c) * LS + 8 * q;
                S[kt_] = __builtin_amdgcn_mfma_f32_16x16x32_bf16(*(const bf16x8*)khp, bv0, S[kt_], 0, 0, 0);
                S[kt_] = __builtin_amdgcn_mfma_f32_16x16x32_bf16(*(const bf16x8*)(khp + 32), bv1, S[kt_], 0, 0, 0); }
        }
        if (!STATE_ONLY) {
            float* OS = (float*)(lds + O_OSTF);
#pragma unroll
            for (int mt = 0; mt < 4; ++mt)
#pragma unroll
                for (int r = 0; r < 4; ++r) OS[(16 * mt + 4 * q + r) * LO + 16 * w + c] = O[mt][r];
            HG_BAR();
            const int t = tid >> 3, v0 = (tid & 7) * 16; const float* orow = OS + t * LO + v0;
            f32x4 x[4]; float ss = 0.f;
#pragma unroll
            for (int i = 0; i < 4; ++i) { x[i] = *(const f32x4*)(orow + 4 * i); ss += (x[i][0] * x[i][0] + x[i][1] * x[i][1]) + (x[i][2] * x[i][2] + x[i][3] * x[i][3]); }
            ss += __int_as_float(__builtin_amdgcn_update_dpp(0, __float_as_int(ss), 0xB1, 0xF, 0xF, false));
            ss += __int_as_float(__builtin_amdgcn_update_dpp(0, __float_as_int(ss), 0x4E, 0xF, 0xF, false));
            ss += __int_as_float(__builtin_amdgcn_ds_swizzle(__float_as_int(ss), 0x101F));
            const float rs = rsqrtf(ss * (1.0f / 128.0f) + 1e-5f);
            u32x4 o0, o1; const float* wv = (const float*)(lds + O_NW) + v0;
#define HG_G(w_, i_) ((i_) ? __uint_as_float((w_) & 0xffff0000u) : __uint_as_float((w_) << 16))
            o0.x = cvtpk(x[0][0] * rs * wv[0] * HG_G(gt0.x, 0), x[0][1] * rs * wv[1] * HG_G(gt0.x, 1)); o0.y = cvtpk(x[0][2] * rs * wv[2] * HG_G(gt0.y, 0), x[0][3] * rs * wv[3] * HG_G(gt0.y, 1));
            o0.z = cvtpk(x[1][0] * rs * wv[4] * HG_G(gt0.z, 0), x[1][1] * rs * wv[5] * HG_G(gt0.z, 1)); o0.w = cvtpk(x[1][2] * rs * wv[6] * HG_G(gt0.w, 0), x[1][3] * rs * wv[7] * HG_G(gt0.w, 1));
            o1.x = cvtpk(x[2][0] * rs * wv[8] * HG_G(gt1.x, 0), x[2][1] * rs * wv[9] * HG_G(gt1.x, 1)); o1.y = cvtpk(x[2][2] * rs * wv[10] * HG_G(gt1.y, 0), x[2][3] * rs * wv[11] * HG_G(gt1.y, 1));
            o1.z = cvtpk(x[3][0] * rs * wv[12] * HG_G(gt1.z, 0), x[3][1] * rs * wv[13] * HG_G(gt1.z, 1)); o1.w = cvtpk(x[3][2] * rs * wv[14] * HG_G(gt1.w, 0), x[3][3] * rs * wv[15] * HG_G(gt1.w, 1));
#undef HG_G
            bf16* dst = (Yo ? Yo : Yq) + ((size_t)ch * 64 + t) * po + v0;
            *(u32x4*)dst = o0; *(u32x4*)(dst + 8) = o1;
        }
    };
    if (STATE_ONLY) {
        HG_LOADX(0, fraw, vraw); HG_LOADX(1, fraw2, vraw2);
        for (int ch = 0; ch < NCH; ch += 2) { chunk(ch, fraw, vraw, ch + 2); chunk(ch + 1, (unsigned (&)[8])fraw2, (u32x4 (&)[2])vraw2, ch + 3); }
    } else {
        HG_LOADX(0, fraw, vraw);
        for (int ch = 0; ch < NCH; ++ch) chunk(ch, fraw, vraw, ch + 1);
    }
    if (STATE_ONLY) {
        float* sl = SLOC + (size_t)stream * 16384 + w * 64 + lane;
#pragma unroll
        for (int i = 0; i < 8; ++i)
#pragma unroll
            for (int r = 0; r < 4; ++r) sl[(size_t)(i * 4 + r) * 512] = S[i][r];
        if (w == 0) *(f2*)(DSEG + (size_t)stream * 128 + 2 * lane) = bseg;
    }
#undef HG_LOADX
}

__device__ __forceinline__ void hgrn_state128(char* lds, int tid, int stream, const bf16* Y, const float* lbl, int oi, float* SLOC, float* DSEG) {
    const int lane = tid & 63, w = __builtin_amdgcn_readfirstlane(tid >> 6), c = lane & 15, q = lane >> 4;
    const int seg = stream & 3, h = (stream >> 2) & 15, b = stream >> 6;
    if (seg == NSEG - 1) return;
    constexpr int CH = 128, NC = SEGLEN / CH, L2 = CH + 8, P_KT = 0, P_VT = P_KT + 128 * L2 * 2, P_TOT = P_VT + 128 * L2 * 2, P_E1 = P_TOT + 4096;
    f2 lbv = (f2){0.f, 0.f};
    if (oi == 1) { const float2 l0 = *(const float2*)(lbl + h * 128 + 2 * lane), l1 = *(const float2*)(lbl + 2048 + h * 128 + 2 * lane);
        lbv = (f2){1.0f / (1.0f + __builtin_amdgcn_exp2f((l0.x - l1.x) * LOG2E)), 1.0f / (1.0f + __builtin_amdgcn_exp2f((l0.y - l1.y) * LOG2E))}; }
    const f2 oml = 1.0f - lbv;
    const size_t row0 = (size_t)b * T + (size_t)seg * SEGLEN;
    const bf16* Yf = Y + row0 * PY + h * 128 + 2048; const bf16* Yv = Yf + 2048;
    f32x4 S[8];
#pragma unroll
    for (int i = 0; i < 8; ++i) S[i] = (f32x4){0.f, 0.f, 0.f, 0.f};
    f2 bseg; { float one_ = 1.f; asm volatile("" : "+v"(one_)); bseg = (f2){one_, one_}; }
    unsigned fr[16]; u32x4 vr[4];
#define HA_LOAD(cc) do { const size_t r_ = (size_t)(cc) * CH; \
        _Pragma("unroll") for (int j = 0; j < 16; ++j) fr[j] = *(const unsigned*)(Yf + (r_ + 16 * w + j) * PY + 2 * lane); \
        _Pragma("unroll") for (int i = 0; i < 4; ++i) vr[i] = *(const u32x4*)(Yv + (r_ + 4 * (tid >> 4) + i) * PY + (tid & 15) * 8); } while (0)
    HA_LOAD(0);
    float* TOT = (float*)(lds + P_TOT); float* E1 = (float*)(lds + P_E1);
    for (int ch = 0; ch < NC; ++ch) {
        f2 fj[16], kin[16];
        { f2 tot;
#pragma unroll
          for (int j = 0; j < 16; ++j) { const f2 e = bf2(fr[j]), sig = rcp2(1.0f + e);
              fj[j] = lbv + oml * sig; kin[j] = oml - oml * sig; tot = j == 0 ? fj[0] : tot * fj[j]; }
          *(f2*)(TOT + w * 128 + 2 * lane) = tot; }
        __syncthreads();
        { const int s4 = tid >> 4, v0 = (tid & 15) * 8;
          bf16* vt = (bf16*)(lds + P_VT) + v0 * L2 + ((((s4 >> 1) ^ (tid & 7)) & 15) << 3) + 4 * (s4 & 1);
#define HA_VW(i_, comp, hi_) *(u32x2*)(vt + (i_) * L2) = (hi_) ? (u32x2){(vr[0].comp >> 16) | (vr[1].comp & 0xffff0000u), (vr[2].comp >> 16) | (vr[3].comp & 0xffff0000u)} \
                                                              : (u32x2){(vr[0].comp & 0xffffu) | (vr[1].comp << 16), (vr[2].comp & 0xffffu) | (vr[3].comp << 16)}
          HA_VW(0, x, 0); HA_VW(1, x, 1); HA_VW(2, y, 0); HA_VW(3, y, 1); HA_VW(4, z, 0); HA_VW(5, z, 1); HA_VW(6, w, 0); HA_VW(7, w, 1);
#undef HA_VW
        }
        if (ch + 1 < NC) HA_LOAD(ch + 1);
        f2 tt, part; { float one_ = 1.f; asm volatile("" : "+v"(one_)); part = (f2){one_, one_}; }
#pragma unroll
        for (int g8 = 0; g8 < 8; ++g8) { const f2 t_ = *(const f2*)(TOT + g8 * 128 + 2 * lane); tt = g8 == 0 ? t_ : tt * t_; if (g8 > w) part *= t_; }
        if (w == 0) { bseg *= tt; *(f2*)(E1 + 2 * lane) = tt; }
        { f2 kt[16]; f2 s = part;
#pragma unroll
          for (int j = 15; j >= 0; --j) { kt[j] = kin[j] * s; s *= fj[j]; }
          u32x4* kd = (u32x4*)((bf16*)(lds + P_KT) + (2 * lane) * L2 + 16 * w);
          kd[0] = (u32x4){cvtpk(kt[0].x, kt[1].x), cvtpk(kt[2].x, kt[3].x), cvtpk(kt[4].x, kt[5].x), cvtpk(kt[6].x, kt[7].x)};
          kd[1] = (u32x4){cvtpk(kt[8].x, kt[9].x), cvtpk(kt[10].x, kt[11].x), cvtpk(kt[12].x, kt[13].x), cvtpk(kt[14].x, kt[15].x)};
          u32x4* kd1 = (u32x4*)((bf16*)kd + L2);
          kd1[0] = (u32x4){cvtpk(kt[0].y, kt[1].y), cvtpk(kt[2].y, kt[3].y), cvtpk(kt[4].y, kt[5].y), cvtpk(kt[6].y, kt[7].y)};
          kd1[1] = (u32x4){cvtpk(kt[8].y, kt[9].y), cvtpk(kt[10].y, kt[11].y), cvtpk(kt[12].y, kt[13].y), cvtpk(kt[14].y, kt[15].y)}; }
        __syncthreads();
        { const int kh = w >> 2, vq = w & 3;
          bf16x8 bv[2][4];
#pragma unroll
          for (int nt = 0; nt < 2; ++nt) { const bf16* VTw = (const bf16*)(lds + P_VT) + (32 * vq + 16 * nt + c) * L2; const int vsw = (4 * vq + 2 * nt + (c >> 3)) & 7;
#pragma unroll
              for (int ks = 0; ks < 4; ++ks) bv[nt][ks] = *(const bf16x8*)(VTw + 8 * ((4 * ks + q) ^ vsw)); }
#pragma unroll
          for (int kt = 0; kt < 4; ++kt) { const f32x4 e = *(const f32x4*)(E1 + 64 * kh + 16 * kt + 4 * q); S[kt * 2] = S[kt * 2] * e; S[kt * 2 + 1] = S[kt * 2 + 1] * e; }
#pragma unroll
          for (int g2 = 0; g2 < 2; ++g2) {
              bf16x8 kf[2][4];
#pragma unroll
              for (int kk = 0; kk < 2; ++kk) { const bf16* khp = (const bf16*)(lds + P_KT) + (16 * (4 * kh + 2 * g2 + kk) + c) * L2 + 8 * q;
#pragma unroll
                  for (int ks = 0; ks < 4; ++ks) kf[kk][ks] = *(const bf16x8*)(khp + 32 * ks); }
              __builtin_amdgcn_sched_barrier(0);
#pragma unroll
              for (int kk = 0; kk < 2; ++kk)
#pragma unroll
                  for (int nt = 0; nt < 2; ++nt)
#pragma unroll
                      for (int ks = 0; ks < 4; ++ks) S[(2 * g2 + kk) * 2 + nt] = __builtin_amdgcn_mfma_f32_16x16x32_bf16(kf[kk][ks], bv[nt][ks], S[(2 * g2 + kk) * 2 + nt], 0, 0, 0);
              __builtin_amdgcn_sched_barrier(0);
          }
        }
    }
#undef HA_LOAD
    { const int kh = w >> 2, vq = w & 3;
      float* sl = SLOC + (size_t)stream * 16384 + lane;
#pragma unroll
      for (int kt = 0; kt < 4; ++kt)
#pragma unroll
          for (int nt = 0; nt < 2; ++nt)
#pragma unroll
              for (int r = 0; r < 4; ++r) sl[(size_t)((4 * kh + kt) * 4 + r) * 512 + (2 * vq + nt) * 64] = S[kt * 2 + nt][r]; }
    if (w == 0) *(f2*)(DSEG + (size_t)stream * 128 + 2 * lane) = bseg;
}

__device__ __forceinline__ void hgrn_passB(char* lds, int tid, int stream, bf16* Y, const float* lbl, int oi, const float* nw, const float* SLOC, const float* DSEG, const bf16* GA, const bf16* GB) {
    const int lane = tid & 63, w = __builtin_amdgcn_readfirstlane(tid >> 6), c = lane & 15, q = lane >> 4, kh = w >> 2, vq = w & 3;
    const int seg = stream & 3, h = (stream >> 2) & 15, b = stream >> 6;
    f2 lbv = (f2){0.f, 0.f};
    if (oi == 1) { const float2 l0 = *(const float2*)(lbl + h * 128 + 2 * lane), l1 = *(const float2*)(lbl + 2048 + h * 128 + 2 * lane);
        lbv = (f2){1.0f / (1.0f + __builtin_amdgcn_exp2f((l0.x - l1.x) * LOG2E)), 1.0f / (1.0f + __builtin_amdgcn_exp2f((l0.y - l1.y) * LOG2E))}; }
    const f2 oml = 1.0f - lbv;
    const size_t row0 = (size_t)b * T + (size_t)seg * SEGLEN;
    bf16* Yq = Y + row0 * PY + h * 128; const bf16* Yf = Yq + 2048; const bf16* Yv = Yq + 4096;
    f32x4 S[8];
#pragma unroll
    for (int i = 0; i < 8; ++i) S[i] = (f32x4){0.f, 0.f, 0.f, 0.f};
    if (seg > 0) {
        const int s0 = stream - seg;
        float sl[3][32]; f32x4 dd[3][4];
#pragma unroll
        for (int k = 0; k < 3; ++k) { const int sp = seg - 3 + k, spc = sp < 0 ? 0 : sp;
            const float* slp = SLOC + (size_t)(s0 + spc) * 16384 + lane; const float* dg = DSEG + (size_t)(s0 + spc) * 128 + 64 * kh;
#pragma unroll
            for (int kt = 0; kt < 4; ++kt) { dd[k][kt] = *(const f32x4*)(dg + 16 * kt + 4 * q);
#pragma unroll
                for (int nt = 0; nt < 2; ++nt)
#pragma unroll
                    for (int r = 0; r < 4; ++r) sl[k][(kt * 2 + nt) * 4 + r] = slp[(size_t)((4 * kh + kt) * 4 + r) * 512 + (2 * vq + nt) * 64]; } }
#pragma unroll
        for (int k = 0; k < 3; ++k) { const bool valid = seg - 3 + k >= 0;
#pragma unroll
            for (int kt = 0; kt < 4; ++kt)
#pragma unroll
                for (int nt = 0; nt < 2; ++nt)
#pragma unroll
                    for (int r = 0; r < 4; ++r) S[kt * 2 + nt][r] = S[kt * 2 + nt][r] * dd[k][kt][r] + (valid ? sl[k][(kt * 2 + nt) * 4 + r] : 0.f); }
    }
    __builtin_amdgcn_sched_barrier(0);
    if (tid < 128) ((float*)(lds + O_NW))[tid] = nw[tid];
    unsigned qraw[8], fr[8]; u32x4 vr[2];
    const unsigned lo_f = (unsigned)lane * 4u, lo_v = (unsigned)((2 * (tid >> 4)) * PY + (tid & 15) * 8) * 2u, lo_o = (unsigned)((tid >> 3) * PY + (tid & 7) * 16) * 2u, lo_g = (unsigned)((tid >> 3) * 1024 + (tid & 7) * 16) * 2u;
#define HB_LOAD(cc) do { const size_t r_ = (size_t)(cc) * 64; \
        _Pragma("unroll") for (int j = 0; j < 8; ++j) { fr[j] = *(const unsigned*)((const char*)(Yf + (r_ + 8 * w + j) * PY) + lo_f); qraw[j] = *(const unsigned*)((const char*)(Yq + (r_ + 8 * w + j) * PY) + lo_f); } \
        _Pragma("unroll") for (int i = 0; i < 2; ++i) vr[i] = *(const u32x4*)((const char*)(Yv + (r_ + i) * PY) + lo_v); } while (0)
    const bf16* Gu = (h < 8 ? GA : GB) + row0 * 1024 + (h & 7) * 128;
    float* TOT = (float*)(lds + O_TOT);
    f2 fj[8], kin[8], qs[8];
#define HB_P2() do { f2 tot; \
        _Pragma("unroll") for (int j = 0; j < 8; ++j) { const f2 e = bf2(fr[j]), sig = rcp2(1.0f + e);   \
            fj[j] = lbv + oml * sig; kin[j] = oml - oml * sig; tot = j == 0 ? fj[0] : tot * fj[j]; \
            qs[j] = bf2(qraw[j]); }   \
        *(f2*)(TOT + w * 128 + 2 * lane) = tot; } while (0)
#define HB_PREP(ld_ch) do { \
        { const int s2 = tid >> 4, v0 = (tid & 15) * 8; \
          unsigned* vt = (unsigned*)((bf16*)(lds + O_VT) + v0 * LS + ((((s2 >> 2) ^ (tid & 7)) & 7) << 3) + 2 * (s2 & 3)); \
          vt[0 * (LS / 2)] = (vr[0].x & 0xffffu) | (vr[1].x << 16); vt[1 * (LS / 2)] = (vr[0].x >> 16) | (vr[1].x & 0xffff0000u); \
          vt[2 * (LS / 2)] = (vr[0].y & 0xffffu) | (vr[1].y << 16); vt[3 * (LS / 2)] = (vr[0].y >> 16) | (vr[1].y & 0xffff0000u); \
          vt[4 * (LS / 2)] = (vr[0].z & 0xffffu) | (vr[1].z << 16); vt[5 * (LS / 2)] = (vr[0].z >> 16) | (vr[1].z & 0xffff0000u); \
          vt[6 * (LS / 2)] = (vr[0].w & 0xffffu) | (vr[1].w << 16); vt[7 * (LS / 2)] = (vr[0].w >> 16) | (vr[1].w & 0xffff0000u); } \
        if ((ld_ch) < NCH) HB_LOAD(ld_ch); \
        f2 lo4, hi4, part; { float one_ = 1.f; asm volatile("" : "+v"(one_)); part = (f2){one_, one_}; } \
        _Pragma("unroll") for (int g8 = 0; g8 < 8; ++g8) { const f2 t_ = *(const f2*)(TOT + g8 * 128 + 2 * lane); if (g8 == 0) lo4 = t_; else if (g8 < 4) lo4 *= t_; else if (g8 == 4) hi4 = t_; else hi4 *= t_; \
            const bool in_ = w < 4 ? (g8 > w && g8 < 4) : (g8 >= 4 && g8 < w); if (in_) part *= t_; } \
        if (w == 0) { *(f2*)((float*)(lds + O_E1) + 2 * lane) = lo4; *(f2*)((float*)(lds + O_E2) + 2 * lane) = hi4; } \
        { f2 kt[8]; const float TINY = 7.888609052210118e-31f; \
          unsigned* QX = (unsigned*)((bf16*)(lds + O_QX) + (8 * w) * LQ + 2 * lane); unsigned* KX = (unsigned*)((bf16*)(lds + O_KX) + (8 * w) * LQ + 2 * lane); \
          if (w < 4) { f2 s = part; \
              _Pragma("unroll") for (int j = 7; j >= 0; --j) { const f2 uc = max2(s, TINY), ed = rcp2(uc); kt[j] = kin[j] * uc; QX[j * (LQ / 2)] = pk2(qs[j] * ed); KX[j * (LQ / 2)] = pk2(kt[j]); s *= fj[j]; } \
          } else { f2 p = part; \
              _Pragma("unroll") for (int j = 0; j < 8; ++j) { p *= fj[j]; const f2 wc = max2(p, TINY); kt[j] = kin[j] * rcp2(wc); QX[j * (LQ / 2)] = pk2(qs[j] * wc); KX[j * (LQ / 2)] = pk2(kt[j]); } } \
          u32x4* kd = (u32x4*)((bf16*)(lds + O_KT) + (2 * lane) * LS + 8 * w); \
          kd[0] = (u32x4){cvtpk(kt[0].x, kt[1].x), cvtpk(kt[2].x, kt[3].x), cvtpk(kt[4].x, kt[5].x), cvtpk(kt[6].x, kt[7].x)}; \
          *(u32x4*)((bf16*)kd + LS) = (u32x4){cvtpk(kt[0].y, kt[1].y), cvtpk(kt[2].y, kt[3].y), cvtpk(kt[4].y, kt[5].y), cvtpk(kt[6].y, kt[7].y)}; } } while (0)
#define HB_P6() do { \
        for (int ti = w; ti < 12; ti += 8) { \
            int I, J; if (ti < 1) { I = 0; J = 0; } else if (ti < 3) { I = 1; J = ti - 1; } else if (ti < 6) { I = 2; J = ti - 3; } else if (ti < 10) { I = 3; J = ti - 6; } else { I = (ti - 10) * 2; J = I + 1; } \
            f32x4 acc = (f32x4){0.f, 0.f, 0.f, 0.f}; \
            if (ti < 10) { \
                const bf16* Kt = (const bf16*)(lds + O_KX) + (16 * J + c) * LQ + 8 * q; const bf16* Qt = (const bf16*)(lds + O_QX) + (16 * I + c) * LQ + 8 * q; \
                bf16x8 ka[4], qa[4]; \
                _Pragma("unroll") for (int ks = 0; ks < 4; ++ks) { ka[ks] = *(const bf16x8*)(Kt + 32 * ks); qa[ks] = *(const bf16x8*)(Qt + 32 * ks); } \
                __builtin_amdgcn_sched_barrier(0); \
                _Pragma("unroll") for (int ks = 0; ks < 4; ++ks) acc = __builtin_amdgcn_mfma_f32_16x16x32_bf16(ka[ks], qa[ks], acc, 0, 0, 0); \
                if (I == J) { _Pragma("unroll") for (int r = 0; r < 4; ++r) if (4 * q + r > c) acc[r] = 0.f; } \
            } \
            *(u32x2*)((bf16*)(lds + O_AM) + (16 * I + c) * LS + 16 * J + 4 * q) = (u32x2){cvtpk(acc[0], acc[1]), cvtpk(acc[2], acc[3])}; \
        } } while (0)
    HB_LOAD(0);
    HB_P2();
    __syncthreads();
    HB_PREP(1);
    __syncthreads();
    HB_P6();
    __syncthreads();
    for (int ch = 0; ch < NCH; ++ch) {
        u32x4 gt0, gt1;
        { const char* gp = (const char*)(Gu + (size_t)ch * 64 * 1024); gt0 = *(const u32x4*)(gp + lo_g); gt1 = *(const u32x4*)(gp + lo_g + 16); }
        f32x4 O[8];
        { const float* E1 = (const float*)(lds + O_E1) + 64 * kh;
          bf16x8 bv[2][2];
#pragma unroll
          for (int nt = 0; nt < 2; ++nt) { const bf16* VTw = (const bf16*)(lds + O_VT) + (32 * vq + 16 * nt + c) * LS; const int vsw = (4 * vq + 2 * nt + (c >> 3)) & 7;
              bv[nt][0] = *(const bf16x8*)(VTw + 8 * (q ^ vsw)); bv[nt][1] = *(const bf16x8*)(VTw + 8 * ((4 + q) ^ vsw)); }
#pragma unroll
          for (int kt = 0; kt < 4; ++kt) { const f32x4 e = *(const f32x4*)(E1 + 16 * kt + 4 * q); S[kt * 2] = S[kt * 2] * e; S[kt * 2 + 1] = S[kt * 2 + 1] * e; }
#pragma unroll
          for (int i = 0; i < 8; ++i) O[i] = (f32x4){0.f, 0.f, 0.f, 0.f};
#pragma unroll
          for (int ks = 0; ks < 2; ++ks) {
              u32x4 qa[4];
#pragma unroll
              for (int mt = 0; mt < 4; ++mt) { const bf16* qh = (const bf16*)(lds + O_QX) + (16 * mt + c) * LQ + 64 * kh + 32 * ks + 4 * q;
                  const u32x2 a0 = *(const u32x2*)qh, a1 = *(const u32x2*)(qh + 16); qa[mt] = (u32x4){a0.x, a0.y, a1.x, a1.y}; }
              __builtin_amdgcn_sched_barrier(0);
#pragma unroll
              for (int nt = 0; nt < 2; ++nt) { const f32x4 s0_ = S[(2 * ks) * 2 + nt], s1_ = S[(2 * ks + 1) * 2 + nt];
                  const u32x4 sb = (u32x4){cvtpk(s0_[0], s0_[1]), cvtpk(s0_[2], s0_[3]), cvtpk(s1_[0], s1_[1]), cvtpk(s1_[2], s1_[3])};
                  const bf16x8 bS = __builtin_bit_cast(bf16x8, sb);
#pragma unroll
                  for (int mt = 0; mt < 4; ++mt) O[mt * 2 + nt] = __builtin_amdgcn_mfma_f32_16x16x32_bf16(__builtin_bit_cast(bf16x8, qa[mt]), bS, O[mt * 2 + nt], 0, 0, 0); }
              __builtin_amdgcn_sched_barrier(0); }
          { bf16x8 am[4];
#pragma unroll
            for (int mt = 0; mt < 4; ++mt) if (mt >= 2 * kh) am[mt] = *(const bf16x8*)((const bf16*)(lds + O_AM) + (16 * mt + c) * LS + 8 * q + 32 * kh);
            __builtin_amdgcn_sched_barrier(0);
#pragma unroll
            for (int mt = 0; mt < 4; ++mt) if (mt >= 2 * kh) {
#pragma unroll
                for (int nt = 0; nt < 2; ++nt) O[mt * 2 + nt] = __builtin_amdgcn_mfma_f32_16x16x32_bf16(am[mt], kh ? bv[nt][1] : bv[nt][0], O[mt * 2 + nt], 0, 0, 0); }
            __builtin_amdgcn_sched_barrier(0); }
#pragma unroll
          for (int g2 = 0; g2 < 2; ++g2) {
              bf16x8 kf[2][2];
#pragma unroll
              for (int kk = 0; kk < 2; ++kk) { const bf16* khp = (const bf16*)(lds + O_KT) + (16 * (4 * kh + 2 * g2 + kk) + c) * LS + 8 * q; kf[kk][0] = *(const bf16x8*)khp; kf[kk][1] = *(const bf16x8*)(khp + 32); }
              __builtin_amdgcn_sched_barrier(0);
#pragma unroll
              for (int kk = 0; kk < 2; ++kk)
#pragma unroll
                  for (int nt = 0; nt < 2; ++nt) { const int si = (2 * g2 + kk) * 2 + nt;
                      S[si] = __builtin_amdgcn_mfma_f32_16x16x32_bf16(kf[kk][0], bv[nt][0], S[si], 0, 0, 0);
                      S[si] = __builtin_amdgcn_mfma_f32_16x16x32_bf16(kf[kk][1], bv[nt][1], S[si], 0, 0, 0); }
              __builtin_amdgcn_sched_barrier(0);
          }
          { const float* E2 = (const float*)(lds + O_E2) + 64 * kh;
#pragma unroll
            for (int kt = 0; kt < 4; ++kt) { const f32x4 e = *(const f32x4*)(E2 + 16 * kt + 4 * q); S[kt * 2] = S[kt * 2] * e; S[kt * 2 + 1] = S[kt * 2 + 1] * e; } }
        }
        { float* OS = (float*)(lds + (kh ? O_OSTF1 : O_OSTF));
#pragma unroll
          for (int mt = 0; mt < 4; ++mt)
#pragma unroll
              for (int nt = 0; nt < 2; ++nt)
#pragma unroll
                  for (int r = 0; r < 4; ++r) OS[(16 * mt + 4 * q + r) * LO + 32 * vq + 16 * nt + c] = O[mt * 2 + nt][r]; }
        if (ch + 1 < NCH) HB_P2();
        __syncthreads();
        { const float* OS = (const float*)(lds + O_OSTF);
          const int t = tid >> 3, v0 = (tid & 7) * 16; const float* orow = OS + t * LO + v0;
          f32x4 x[4]; float ss = 0.f;
#pragma unroll
          for (int i = 0; i < 4; ++i) { x[i] = *(const f32x4*)(orow + 4 * i) + *(const f32x4*)(orow + (O_OSTF1 - O_OSTF) / 4 + 4 * i); ss += (x[i][0] * x[i][0] + x[i][1] * x[i][1]) + (x[i][2] * x[i][2] + x[i][3] * x[i][3]); }
          ss += __int_as_float(__builtin_amdgcn_update_dpp(0, __float_as_int(ss), 0xB1, 0xF, 0xF, false));
          ss += __int_as_float(__builtin_amdgcn_update_dpp(0, __float_as_int(ss), 0x4E, 0xF, 0xF, false));
          ss += __int_as_float(__builtin_amdgcn_ds_swizzle(__float_as_int(ss), 0x101F));
          const float rs = rsqrtf(ss * (1.0f / 128.0f) + 1e-5f);
          u32x4 o0, o1; const float* wv = (const float*)(lds + O_NW) + v0;
#define HG_G(w_, i_) ((i_) ? __uint_as_float((w_) & 0xffff0000u) : __uint_as_float((w_) << 16))
          o0.x = cvtpk(x[0][0] * rs * wv[0] * HG_G(gt0.x, 0), x[0][1] * rs * wv[1] * HG_G(gt0.x, 1)); o0.y = cvtpk(x[0][2] * rs * wv[2] * HG_G(gt0.y, 0), x[0][3] * rs * wv[3] * HG_G(gt0.y, 1));
          o0.z = cvtpk(x[1][0] * rs * wv[4] * HG_G(gt0.z, 0), x[1][1] * rs * wv[5] * HG_G(gt0.z, 1)); o0.w = cvtpk(x[1][2] * rs * wv[6] * HG_G(gt0.w, 0), x[1][3] * rs * wv[7] * HG_G(gt0.w, 1));
          o1.x = cvtpk(x[2][0] * rs * wv[8] * HG_G(gt1.x, 0), x[2][1] * rs * wv[9] * HG_G(gt1.x, 1)); o1.y = cvtpk(x[2][2] * rs * wv[10] * HG_G(gt1.y, 0), x[2][3] * rs * wv[11] * HG_G(gt1.y, 1));
          o1.z = cvtpk(x[3][0] * rs * wv[12] * HG_G(gt1.z, 0), x[3][1] * rs * wv[13] * HG_G(gt1.z, 1)); o1.w = cvtpk(x[3][2] * rs * wv[14] * HG_G(gt1.w, 0), x[3][3] * rs * wv[15] * HG_G(gt1.w, 1));
#undef HG_G
          char* dst = (char*)(Yq + (size_t)ch * 64 * PY) + lo_o;
          *(u32x4*)dst = o0; *(u32x4*)(dst + 16) = o1; }
        if (ch + 1 < NCH) HB_PREP(ch + 2);
        __syncthreads();
        if (ch + 1 < NCH) HB_P6();
        __syncthreads();
    }
#undef HB_LOAD
#undef HB_P2
#undef HB_PREP
#undef HB_P6
}
#undef HG_BAR
}
namespace sd {
typedef unsigned short bf16;
typedef short bf16x8 __attribute__((ext_vector_type(8)));
typedef float f32x4 __attribute__((ext_vector_type(4)));
typedef unsigned u32x4 __attribute__((ext_vector_type(4)));
typedef unsigned u32x2 __attribute__((ext_vector_type(2)));
constexpr int T = 4096, M = 4 * T, PY1 = 2816, PAO = 2048, LB = 136, LT = 72;
constexpr int O_BM = 0, O_CM = O_BM + 64 * LB * 2, O_BT = O_CM + 64 * LB * 2, O_XT = O_BT + 128 * LT * 2, O_DT = O_XT + 8 * 64 * LT * 2, O_AC = O_DT + 2048, LDS_BYTES = O_AC + 2048;
__device__ __forceinline__ float bf2f(unsigned v) { return __uint_as_float(v << 16); }
__device__ __forceinline__ float bflo(unsigned w) { return __uint_as_float(w << 16); }
__device__ __forceinline__ float bfhi(unsigned w) { return __uint_as_float(w & 0xffff0000u); }
typedef float f32x2_t __attribute__((ext_vector_type(2))); typedef __bf16 bf16x2_t __attribute__((ext_vector_type(2)));
__device__ __forceinline__ unsigned cvtpk(float lo, float hi) { f32x2_t v = {lo, hi}; bf16x2_t b = __builtin_convertvector(v, bf16x2_t); return __builtin_bit_cast(unsigned, b); }
__device__ __forceinline__ float fexp(float x) { return __builtin_amdgcn_exp2f(x * 1.4426950408889634f); }
__device__ __forceinline__ float silu(float x) { return x * __builtin_amdgcn_rcpf(1.0f + fexp(-x)); }
__device__ __forceinline__ float lget(float v, int src) { return __int_as_float(__builtin_amdgcn_ds_bpermute(src << 2, __float_as_int(v))); }

template <bool STATE_ONLY>
__device__ __forceinline__ void ssd_stage(char* lds, int tid, int g, size_t m0, int tg0, const bf16* Y1, const float* cw, const float* cb) {
    u32x2 rawA[11], rawB[11];
#define SD_SRC(cq_) ((cq_) < 128 ? g * 512 + (cq_) * 4 : (cq_) < 160 ? 1024 + g * 128 + ((cq_) - 128) * 4 : 1280 + g * 128 + ((cq_) - 160) * 4)
#define SD_LOAD(RAW, t_) do { const int cq_ = (t_) % 192, l0_ = ((t_) / 192) * 8; const bf16* yp_ = Y1 + (m0 + l0_) * PY1 + 1024 + SD_SRC(cq_); \
        _Pragma("unroll") for (int r = 0; r < 11; ++r) { RAW[r] = (u32x2){0u, 0u}; if (!(STATE_ONLY && cq_ >= 160) && tg0 + l0_ + r - 3 >= 0) RAW[r] = *(const u32x2*)(yp_ + (ptrdiff_t)(r - 3) * PY1); } } while (0)
#define SD_TASK(RAW, t_) do { const int tk_ = (t_); const int cq = tk_ % 192, l0 = (tk_ / 192) * 8; \
        if (!(STATE_ONLY && cq >= 160)) {                                           \
        const int src = SD_SRC(cq); \
        const f32x4 w0 = *(const f32x4*)(cw + src), w1 = *(const f32x4*)(cw + 1536 + src), w2 = *(const f32x4*)(cw + 3072 + src), w3 = *(const f32x4*)(cw + 4608 + src), bb = *(const f32x4*)(cb + src); \
          \
        bf16* tdst = cq < 128 ? (bf16*)(lds + O_XT) + ((cq >> 4) * 64 + (cq & 15) * 4) * LT + l0 : (bf16*)(lds + O_BT) + ((cq - 128) & 31) * 4 * LT + l0; \
        bf16* rdst = (cq < 160 ? (bf16*)(lds + O_BM) + (cq - 128) * 4 : (bf16*)(lds + O_CM) + (cq - 160) * 4) + l0 * LB; \
        unsigned tp[4][4];                                                           \
        _Pragma("unroll") for (int r = 0; r < 8; r += 2) { \
            const f32x4 x0 = (f32x4){bflo(RAW[r].x), bfhi(RAW[r].x), bflo(RAW[r].y), bfhi(RAW[r].y)}, x1 = (f32x4){bflo(RAW[r + 1].x), bfhi(RAW[r + 1].x), bflo(RAW[r + 1].y), bfhi(RAW[r + 1].y)}, \
                        x2 = (f32x4){bflo(RAW[r + 2].x), bfhi(RAW[r + 2].x), bflo(RAW[r + 2].y), bfhi(RAW[r + 2].y)}, x3 = (f32x4){bflo(RAW[r + 3].x), bfhi(RAW[r + 3].x), bflo(RAW[r + 3].y), bfhi(RAW[r + 3].y)}, \
                        x4 = (f32x4){bflo(RAW[r + 4].x), bfhi(RAW[r + 4].x), bflo(RAW[r + 4].y), bfhi(RAW[r + 4].y)}; \
            const f32x4 a = bb + w0 * x0 + w1 * x1 + w2 * x2 + w3 * x3, b_ = bb + w0 * x1 + w1 * x2 + w2 * x3 + w3 * x4; \
            const f32x4 oa = (f32x4){silu(a[0]), silu(a[1]), silu(a[2]), silu(a[3])}, ob = (f32x4){silu(b_[0]), silu(b_[1]), silu(b_[2]), silu(b_[3])}; \
            _Pragma("unroll") for (int i = 0; i < 4; ++i) tp[i][r >> 1] = cvtpk(oa[i], ob[i]); \
            if (cq >= 128 && (!STATE_ONLY || cq >= 160)) { *(u32x2*)(rdst + r * LB) = (u32x2){cvtpk(oa[0], oa[1]), cvtpk(oa[2], oa[3])}; *(u32x2*)(rdst + (r + 1) * LB) = (u32x2){cvtpk(ob[0], ob[1]), cvtpk(ob[2], ob[3])}; } \
        } \
        if (cq < 160) { _Pragma("unroll") for (int i = 0; i < 4; ++i) *(u32x4*)(tdst + i * LT) = (u32x4){tp[i][0], tp[i][1], tp[i][2], tp[i][3]}; } \
        } } while (0)
    if (STATE_ONLY) {
#pragma unroll 1
        for (int t = tid; t < 192 * 8; t += 512) { SD_LOAD(rawA, t); SD_TASK(rawA, t); }
    } else {
        SD_LOAD(rawA, tid); SD_LOAD(rawB, tid + 512);
        SD_TASK(rawA, tid);
        SD_LOAD(rawA, tid + 1024);
        SD_TASK(rawB, tid + 512);
        SD_TASK(rawA, tid + 1024);
    }
#undef SD_SRC
#undef SD_LOAD
#undef SD_TASK
}

template <bool STATE_ONLY>
__device__ __forceinline__ void ssd_unit(char* lds, int tid, int u, const bf16* Y1, const float* FDt, const float* cw, const float* cb, const float* dt_bias, const float* A_log, const float* Dsk,
                                         const float* nw, u32x4* STL, float* DEC, bf16* AO) {
    const int lane = tid & 63, w = __builtin_amdgcn_readfirstlane(tid >> 6), c = lane & 15, q = lane >> 4;
    const int g = u & 1, cidx = (u >> 1) & 31, b = u >> 6, h = 8 * g + w;
    const size_t mc = (size_t)b * T + (size_t)cidx * 128;
    const float Ah = -fexp(A_log[h]), dtb = dt_bias[h], Dh = Dsk[h];
    f32x4 st[STATE_ONLY ? 32 : 1];
    u32x4 bS[STATE_ONLY ? 1 : 16];
    if (STATE_ONLY) {
#pragma unroll
        for (int i = 0; i < 32; ++i) st[i] = (f32x4){0.f, 0.f, 0.f, 0.f};
    } else {
        const u32x4* sl = STL + (size_t)u * 8192 + w * 64 + lane;
#pragma unroll
        for (int i = 0; i < 16; ++i) bS[i] = sl[(size_t)i * 512];
    }
    float fdv = FDt[(size_t)(8 + h) * M + mc + lane];
    ssd_stage<STATE_ONLY>(lds, tid, g, mc, cidx * 128, Y1, cw, cb);
    float atot_chunk = 0.f;
    bf16* XTw = (bf16*)(lds + O_XT) + w * 64 * LT;
    float* DTl = (float*)(lds + O_DT) + w * 64; float* ACl = (float*)(lds + O_AC) + w * 64;
#pragma unroll
    for (int sub = 0; sub < 2; ++sub) {
        const size_t m0 = mc + sub * 64; const int tg0 = cidx * 128 + sub * 64;
        int lane_s = tid & 63; asm volatile("" : "+v"(lane_s));
        const int lane = lane_s, c = lane & 15, q = lane >> 4; (void)tg0;
        float atot;
        { const float xx = fdv + dtb; const float u_ = fexp(-fabsf(xx)); const float dt = fmaxf(xx, 0.f) + (u_ < 1e-4f ? u_ * (1.0f - 0.5f * u_) : __builtin_amdgcn_logf(1.0f + u_) * 0.6931471805599453f);
          float ac = dt * Ah;
#pragma unroll
          for (int o_ = 1; o_ < 64; o_ <<= 1) { const float v = lget(ac, lane - o_); if (lane >= o_) ac += v; }
          DTl[lane] = dt; ACl[lane] = ac; atot = __int_as_float(__builtin_amdgcn_readlane(__float_as_int(ac), 63)); }
        atot_chunk += atot;
        __syncthreads();
        u32x4 z0, z1, z2; f32x4 n0, n1; int lo_ = 0;
        if (STATE_ONLY) {
            const float ea = fexp(atot);
#pragma unroll
            for (int i = 0; i < 32; ++i) st[i] = st[i] * ea;
#pragma unroll
            for (int ks2 = 0; ks2 < 2; ++ks2) {
                bf16x8 xw[4];
                { const f32x4 d0 = *(const f32x4*)(DTl + 32 * ks2 + 8 * q), d1 = *(const f32x4*)(DTl + 32 * ks2 + 8 * q + 4), a0 = *(const f32x4*)(ACl + 32 * ks2 + 8 * q), a1 = *(const f32x4*)(ACl + 32 * ks2 + 8 * q + 4);
                  float wl[8];
#pragma unroll
                  for (int j = 0; j < 4; ++j) { wl[j] = d0[j] * fexp(fminf(atot - a0[j], 0.f)); wl[4 + j] = d1[j] * fexp(fminf(atot - a1[j], 0.f)); }
#pragma unroll
                  for (int pt = 0; pt < 4; ++pt) { const u32x4 xv = *(const u32x4*)(XTw + (16 * pt + c) * LT + 32 * ks2 + 8 * q);
                      const u32x4 t_ = (u32x4){cvtpk(bflo(xv.x) * wl[0], bfhi(xv.x) * wl[1]), cvtpk(bflo(xv.y) * wl[2], bfhi(xv.y) * wl[3]), cvtpk(bflo(xv.z) * wl[4], bfhi(xv.z) * wl[5]), cvtpk(bflo(xv.w) * wl[6], bfhi(xv.w) * wl[7])};
                      xw[pt] = __builtin_bit_cast(bf16x8, t_); } }
#pragma unroll
                for (int nt = 0; nt < 8; ++nt) { const bf16x8 af = *(const bf16x8*)((const bf16*)(lds + O_BT) + (16 * nt + c) * LT + 32 * ks2 + 8 * q);
#pragma unroll
                    for (int pt = 0; pt < 4; ++pt) st[nt * 4 + pt] = __builtin_amdgcn_mfma_f32_16x16x32_bf16(af, xw[pt], st[nt * 4 + pt], 0, 0, 0); }
            }
        } else {
            u32x4 xw[8];
            if (sub == 0) {
#pragma unroll
                for (int ks2 = 0; ks2 < 2; ++ks2) {
                    const f32x4 d0 = *(const f32x4*)(DTl + 32 * ks2 + 8 * q), d1 = *(const f32x4*)(DTl + 32 * ks2 + 8 * q + 4), a0 = *(const f32x4*)(ACl + 32 * ks2 + 8 * q), a1 = *(const f32x4*)(ACl + 32 * ks2 + 8 * q + 4);
                    float wl[8];
#pragma unroll
                    for (int j = 0; j < 4; ++j) { wl[j] = d0[j] * fexp(fminf(atot - a0[j], 0.f)); wl[4 + j] = d1[j] * fexp(fminf(atot - a1[j], 0.f)); }
#pragma unroll
                    for (int pt = 0; pt < 4; ++pt) { const u32x4 xv = *(const u32x4*)(XTw + (16 * pt + c) * LT + 32 * ks2 + 8 * q);
                        xw[ks2 * 4 + pt] = (u32x4){cvtpk(bflo(xv.x) * wl[0], bfhi(xv.x) * wl[1]), cvtpk(bflo(xv.y) * wl[2], bfhi(xv.y) * wl[3]), cvtpk(bflo(xv.z) * wl[4], bfhi(xv.z) * wl[5]), cvtpk(bflo(xv.w) * wl[6], bfhi(xv.w) * wl[7])}; }
                }
            }
#pragma unroll
            for (int Ii = 0; Ii < 4; ++Ii) { const int I = 3 - Ii;
                f32x4 y[4];
#pragma unroll
                for (int pt = 0; pt < 4; ++pt) y[pt] = (f32x4){0.f, 0.f, 0.f, 0.f};
                u32x4 cfr[4]; bf16x8 cst[4], bfr[2][4];
#pragma unroll
                for (int ks = 0; ks < 4; ++ks) { const bf16* cp = (const bf16*)(lds + O_CM) + (16 * I + c) * LB + 32 * ks + 4 * q;
                    const u32x2 a0 = *(const u32x2*)cp, a1 = *(const u32x2*)(cp + 16); cfr[ks] = (u32x4){a0.x, a0.y, a1.x, a1.y}; }
                const f32x4 ac4 = *(const f32x4*)(ACl + 16 * I + 4 * q); const float acl = ACl[16 * I + c];
#pragma unroll
                for (int ks = 0; ks < 4; ++ks) { cst[ks] = *(const bf16x8*)((const bf16*)(lds + O_CM) + (16 * I + c) * LB + 8 * q + 32 * ks); bfr[0][ks] = *(const bf16x8*)((const bf16*)(lds + O_BM) + c * LB + 8 * q + 32 * ks); }
                __builtin_amdgcn_sched_barrier(0);
#pragma unroll
                for (int ks = 0; ks < 4; ++ks)
#pragma unroll
                    for (int pt = 0; pt < 4; ++pt) y[pt] = __builtin_amdgcn_mfma_f32_16x16x32_bf16(__builtin_bit_cast(bf16x8, cfr[ks]), __builtin_bit_cast(bf16x8, bS[ks * 4 + pt]), y[pt], 0, 0, 0);
                { const f32x4 e = (f32x4){fexp(ac4[0]), fexp(ac4[1]), fexp(ac4[2]), fexp(ac4[3])};
#pragma unroll
                  for (int pt = 0; pt < 4; ++pt) y[pt] = y[pt] * e; }
                u32x2 xp[4];
#pragma unroll
                for (int J = 0; J < 4; ++J) {
                    if (J > I) { xp[J] = (u32x2){0u, 0u}; continue; }
                    if (J + 1 <= I) {
#pragma unroll
                        for (int ks = 0; ks < 4; ++ks) bfr[(J + 1) & 1][ks] = *(const bf16x8*)((const bf16*)(lds + O_BM) + (16 * (J + 1) + c) * LB + 8 * q + 32 * ks); }
                    const f32x4 acs = *(const f32x4*)(ACl + 16 * J + 4 * q), dts = *(const f32x4*)(DTl + 16 * J + 4 * q);
                    __builtin_amdgcn_sched_barrier(0);
                    f32x4 acc = (f32x4){0.f, 0.f, 0.f, 0.f};
#pragma unroll
                    for (int ks = 0; ks < 4; ++ks) acc = __builtin_amdgcn_mfma_f32_16x16x32_bf16(bfr[J & 1][ks], cst[ks], acc, 0, 0, 0);
                    float v[4];
#pragma unroll
                    for (int r = 0; r < 4; ++r) { v[r] = acc[r] * fexp(fminf(acl - acs[r], 0.f)) * dts[r]; if (J == I && 4 * q + r > c) v[r] = 0.f; }
                    xp[J] = (u32x2){cvtpk(v[0], v[1]), cvtpk(v[2], v[3])};
                }
                { u32x4 xfr[2][4];
#pragma unroll
                  for (int ks2 = 0; ks2 < 2; ++ks2) {
                      if (ks2 == 1 && I < 2) continue;
#pragma unroll
                      for (int pt = 0; pt < 4; ++pt) { const bf16* xq = XTw + (16 * pt + c) * LT + 32 * ks2 + 4 * q;
                          const u32x2 b0 = *(const u32x2*)xq, b1 = *(const u32x2*)(xq + 16); xfr[ks2][pt] = (u32x4){b0.x, b0.y, b1.x, b1.y}; } }
                  __builtin_amdgcn_sched_barrier(0);
#pragma unroll
                  for (int ks2 = 0; ks2 < 2; ++ks2) {
                      if (ks2 == 1 && I < 2) continue;
                      const u32x4 aa = (u32x4){xp[2 * ks2].x, xp[2 * ks2].y, xp[2 * ks2 + 1].x, xp[2 * ks2 + 1].y}; const bf16x8 af = __builtin_bit_cast(bf16x8, aa);
#pragma unroll
                      for (int pt = 0; pt < 4; ++pt) y[pt] = __builtin_amdgcn_mfma_f32_16x16x32_bf16(af, __builtin_bit_cast(bf16x8, xfr[ks2][pt]), y[pt], 0, 0, 0); } }
                u32x2 xv[4];
#pragma unroll
                for (int pt = 0; pt < 4; ++pt) xv[pt] = *(const u32x2*)(XTw + (16 * pt + c) * LT + 16 * I + 4 * q);
#pragma unroll
                for (int pt = 0; pt < 4; ++pt) {
                    const float y0 = y[pt][0] + Dh * bflo(xv[pt].x), y1 = y[pt][1] + Dh * bfhi(xv[pt].x), y2 = y[pt][2] + Dh * bflo(xv[pt].y), y3 = y[pt][3] + Dh * bfhi(xv[pt].y);
                    *(u32x2*)(XTw + (8 * (c & 7) + 2 * pt + (c >> 3)) * LT + 16 * I + 4 * (q ^ (w & 3))) = (u32x2){cvtpk(y0, y1), cvtpk(y2, y3)}; }
            }
            if (sub == 0) {
                const float ea = fexp(atot);
#pragma unroll
                for (int ks = 0; ks < 4; ++ks) {
                    const bf16x8 a00 = *(const bf16x8*)((const bf16*)(lds + O_BT) + (16 * (2 * ks) + c) * LT + 8 * q), a01 = *(const bf16x8*)((const bf16*)(lds + O_BT) + (16 * (2 * ks) + c) * LT + 32 + 8 * q);
                    const bf16x8 a10 = *(const bf16x8*)((const bf16*)(lds + O_BT) + (16 * (2 * ks + 1) + c) * LT + 8 * q), a11 = *(const bf16x8*)((const bf16*)(lds + O_BT) + (16 * (2 * ks + 1) + c) * LT + 32 + 8 * q);
#pragma unroll
                    for (int pt = 0; pt < 4; ++pt) { const u32x4 p_ = bS[ks * 4 + pt];
                        f32x4 t0 = (f32x4){bflo(p_.x) * ea, bfhi(p_.x) * ea, bflo(p_.y) * ea, bfhi(p_.y) * ea}, t1 = (f32x4){bflo(p_.z) * ea, bfhi(p_.z) * ea, bflo(p_.w) * ea, bfhi(p_.w) * ea};
                        t0 = __builtin_amdgcn_mfma_f32_16x16x32_bf16(a00, __builtin_bit_cast(bf16x8, xw[pt]), t0, 0, 0, 0); t0 = __builtin_amdgcn_mfma_f32_16x16x32_bf16(a01, __builtin_bit_cast(bf16x8, xw[4 + pt]), t0, 0, 0, 0);
                        t1 = __builtin_amdgcn_mfma_f32_16x16x32_bf16(a10, __builtin_bit_cast(bf16x8, xw[pt]), t1, 0, 0, 0); t1 = __builtin_amdgcn_mfma_f32_16x16x32_bf16(a11, __builtin_bit_cast(bf16x8, xw[4 + pt]), t1, 0, 0, 0);
                        bS[ks * 4 + pt] = (u32x4){cvtpk(t0[0], t0[1]), cvtpk(t0[2], t0[3]), cvtpk(t1[0], t1[1]), cvtpk(t1[2], t1[3])}; }
                }
            }
            lo_ = lane; asm volatile("" : "+v"(lo_));
            { const bf16* zp = Y1 + (m0 + w) * PY1 + g * 512 + lo_ * 8; z0 = *(const u32x4*)zp; z1 = *(const u32x4*)(zp + (size_t)8 * PY1); z2 = *(const u32x4*)(zp + (size_t)16 * PY1); }
            { const float* nwp = nw + g * 512 + lo_ * 8; n0 = *(const f32x4*)nwp; n1 = *(const f32x4*)(nwp + 4); }
        }
        __syncthreads();
        if (!STATE_ONLY) {
            const bf16* ysl = (const bf16*)(lds + O_XT) + ((lo_ >> 3) * 64 + (lo_ & 7)) * LT;
            const int ysw = (lo_ >> 3) & 3;
            const bf16* zp = Y1 + (m0 + w) * PY1 + g * 512 + lo_ * 8; bf16* op = AO + (m0 + w) * PAO + 1024 + g * 512 + lo_ * 8;
#pragma unroll 2
            for (int i = 0; i < 8; ++i) { const int l = w + 8 * i; const u32x4 zv = z0; z0 = z1; z1 = z2;
                if (i + 3 < 8) z2 = *(const u32x4*)(zp + (size_t)(8 * (i + 3)) * PY1);
                const int lc = (l & ~15) | ((((l >> 2) & 3) ^ ysw) << 2) | (l & 3);
                u32x4 yv; yv.x = (unsigned)ysl[lc] | ((unsigned)ysl[8 * LT + lc] << 16); yv.y = (unsigned)ysl[16 * LT + lc] | ((unsigned)ysl[24 * LT + lc] << 16);
                yv.z = (unsigned)ysl[32 * LT + lc] | ((unsigned)ysl[40 * LT + lc] << 16); yv.w = (unsigned)ysl[48 * LT + lc] | ((unsigned)ysl[56 * LT + lc] << 16);
                float v[8] = {bflo(yv.x) * bflo(zv.x), bfhi(yv.x) * bfhi(zv.x), bflo(yv.y) * bflo(zv.y), bfhi(yv.y) * bfhi(zv.y),
                              bflo(yv.z) * bflo(zv.z), bfhi(yv.z) * bfhi(zv.z), bflo(yv.w) * bflo(zv.w), bfhi(yv.w) * bfhi(zv.w)};
                float ss = 0.f;
#pragma unroll
                for (int j = 0; j < 8; ++j) ss += v[j] * v[j];
                ss += __int_as_float(__builtin_amdgcn_update_dpp(0, __float_as_int(ss), 0xB1, 0xF, 0xF, false));
                ss += __int_as_float(__builtin_amdgcn_update_dpp(0, __float_as_int(ss), 0x4E, 0xF, 0xF, false));
                ss += __int_as_float(__builtin_amdgcn_update_dpp(0, __float_as_int(ss), 0x141, 0xF, 0xF, false));
                ss += __int_as_float(__builtin_amdgcn_update_dpp(0, __float_as_int(ss), 0x140, 0xF, 0xF, false));
                ss = (__int_as_float(__builtin_amdgcn_readlane(__float_as_int(ss), 0)) + __int_as_float(__builtin_amdgcn_readlane(__float_as_int(ss), 16)))
                   + (__int_as_float(__builtin_amdgcn_readlane(__float_as_int(ss), 32)) + __int_as_float(__builtin_amdgcn_readlane(__float_as_int(ss), 48)));
                const float rs = rsqrtf(ss * (1.0f / 512.0f) + 1e-5f);
                const u32x4 ov = (u32x4){cvtpk(v[0] * rs * n0[0], v[1] * rs * n0[1]), cvtpk(v[2] * rs * n0[2], v[3] * rs * n0[3]), cvtpk(v[4] * rs * n1[0], v[5] * rs * n1[1]), cvtpk(v[6] * rs * n1[2], v[7] * rs * n1[3])};
                *(u32x4*)(op + (size_t)(8 * i) * PAO) = ov; }
            __syncthreads();
        }
        if (sub == 0) { fdv = FDt[(size_t)(8 + h) * M + mc + 64 + lane]; ssd_stage<STATE_ONLY>(lds, tid, g, mc + 64, cidx * 128 + 64, Y1, cw, cb); }
    }
    if (STATE_ONLY) {
        u32x4* sl = STL + (size_t)u * 8192 + w * 64 + lane;
#pragma unroll
        for (int ks = 0; ks < 4; ++ks)
#pragma unroll
            for (int pt = 0; pt < 4; ++pt) { const f32x4 s0 = st[(2 * ks) * 4 + pt], s1 = st[(2 * ks + 1) * 4 + pt];
                sl[(size_t)(ks * 4 + pt) * 512] = (u32x4){cvtpk(s0[0], s0[1]), cvtpk(s0[2], s0[3]), cvtpk(s1[0], s1[1]), cvtpk(s1[2], s1[3])}; }
        if (lane == 0) DEC[(size_t)(b * 32 + cidx) * 16 + h] = fexp(atot_chunk);
    }
}
__device__ __forceinline__ void ssd_scan(size_t gtid, size_t gsz, u32x4* STL, const float* DEC) {
    for (size_t col = gtid; col < (size_t)8 * 16384; col += gsz) {
        const int bg = (int)(col >> 14), e2 = (int)(col & 16383), b = bg >> 1, g = bg & 1, wv = (e2 >> 7) & 7;
        u32x2 v[32]; float d[32];
#pragma unroll
        for (int cc = 0; cc < 32; ++cc) { v[cc] = *((const u32x2*)(STL + (size_t)((b * 32 + cc) * 2 + g) * 8192) + e2); d[cc] = DEC[(size_t)(b * 32 + cc) * 16 + g * 8 + wv]; }
        float z_ = 0.f; asm volatile("" : "+v"(z_)); f32x4 run = (f32x4){z_, z_, z_, z_};
#pragma unroll
        for (int cc = 0; cc < 32; ++cc) { u32x2* p = (u32x2*)(STL + (size_t)((b * 32 + cc) * 2 + g) * 8192) + e2;
            *p = (u32x2){cvtpk(run[0], run[1]), cvtpk(run[2], run[3])};
            run = run * d[cc] + (f32x4){bflo(v[cc].x), bfhi(v[cc].x), bflo(v[cc].y), bfhi(v[cc].y)}; }
    }
}
}
#define LAS __attribute__((address_space(3)))
#define XB_TMO      128
#define XB_XCNT(j)  (256  + 64 * (j))
#define XB_XSUB(j)  (1280 + 64 * (j))
#define XB_XGEN(j)  (2304 + 64 * (j))
#define XB_TOP      3328
#define XB_TOPGEN   3392
#define XCD_BAR_WORDS 3456
#define XB_SPIN_CAP (1u << 18)

__device__ __forceinline__ unsigned xb_ld(unsigned* p)              { return __hip_atomic_load(p, __ATOMIC_RELAXED, __HIP_MEMORY_SCOPE_AGENT); }
__device__ __forceinline__ unsigned xb_add(unsigned* p, unsigned v) { return __hip_atomic_fetch_add(p, v, __ATOMIC_RELAXED, __HIP_MEMORY_SCOPE_AGENT); }
__device__ __forceinline__ unsigned xb_xcc_id() { return (unsigned)__builtin_amdgcn_s_getreg((3 << 11) | 20) & 0xFu; }
#define XB_SPIN(cond, bar) do { unsigned _sp = 0; while (cond) { __builtin_amdgcn_s_sleep(1); \
    if ((++_sp & 255u) == 0u) { if (xb_ld(&(bar)[XB_TMO])) break; if (_sp > XB_SPIN_CAP) { atomicAdd(&(bar)[XB_TMO], 1u); break; } } } } while (0)

struct XcdBarrier {
    unsigned* bar; unsigned x;
    volatile LAS unsigned* st;
};

__device__ __forceinline__ XcdBarrier xcd_barrier_post(unsigned* bar, volatile LAS unsigned* st) {
    XcdBarrier b; b.bar = bar; b.x = xb_xcc_id(); b.st = st;
    if (threadIdx.x == 0) (void)xb_add(&bar[XB_XCNT(b.x)], 1u);
    return b;
}
__device__ __forceinline__ void xcd_barrier_complete(unsigned* bar, unsigned x, unsigned& nloc, unsigned& nx) {
    const unsigned G = gridDim.x * gridDim.y * gridDim.z;
    unsigned sum, cnt, mine, sp = 0u;
    for (;;) {
        sum = 0u; cnt = 0u; mine = 0u;
#pragma unroll
        for (unsigned j = 0; j < 16; ++j) { const unsigned c = xb_ld(&bar[XB_XCNT(j)]); sum += c; cnt += (c > 0u) ? 1u : 0u; mine = (j == x) ? c : mine; }
        if (sum == G) break;
        __builtin_amdgcn_s_sleep(1);
        if ((++sp & 255u) == 0u) { if (xb_ld(&bar[XB_TMO])) break; if (sp > XB_SPIN_CAP) { atomicAdd(&bar[XB_TMO], 1u); break; } }
    }
    nloc = mine > 0u ? mine : 1u; nx = cnt > 0u ? cnt : 1u;
}

__device__ __forceinline__ void xcd_barrier(const XcdBarrier& b, const bool leader  ) {
    asm volatile("s_waitcnt vmcnt(0)" ::: "memory");
    __syncthreads();
    if (leader) {
        unsigned* bar = b.bar;
        __builtin_amdgcn_s_waitcnt(0);
        unsigned nloc = b.st[0], nx = b.st[1];
        if (nloc == 0u) { xcd_barrier_complete(bar, b.x, nloc, nx); b.st[0] = nloc; b.st[1] = nx; }
        const unsigned old = xb_add(&bar[XB_XSUB(b.x)], 1u);
        const unsigned gen = old / nloc;
        if (old + 1u == (gen + 1u) * nloc) {
            __builtin_amdgcn_fence(__ATOMIC_RELEASE, "agent");
            asm volatile("s_waitcnt vmcnt(0)" ::: "memory");
            const unsigned og = xb_add(&bar[XB_TOP], 1u);
            const unsigned tg = og / nx;
            if (og + 1u == (tg + 1u) * nx) xb_add(&bar[XB_TOPGEN], 1u);
            else XB_SPIN(xb_ld(&bar[XB_TOPGEN]) == tg, bar);
            xb_add(&bar[XB_XGEN(b.x)], 1u);
            __builtin_amdgcn_fence(__ATOMIC_ACQUIRE, "agent");
            asm volatile("s_waitcnt vmcnt(0)" ::: "memory");
        } else {
            XB_SPIN(xb_ld(&bar[XB_XGEN(b.x)]) == gen, bar);
            __builtin_amdgcn_fence(__ATOMIC_ACQUIRE, "agent");
            asm volatile("s_waitcnt vmcnt(0)" ::: "memory");
        }
    }
    __syncthreads();
}
namespace hy {
typedef unsigned short bf16;
constexpr int B = 4, T = 4096, D = 1024, M = B * T;
constexpr int EVEN_IN = 6680, ODD_IN = 8192;
constexpr int NE = 6912;
constexpr int NE1 = 2816, NE2 = 3072;
constexpr int NO1 = 6144, NO2 = 2048;
constexpr size_t MiB = 1u << 20;
constexpr size_t WS_CTL = 0, CTL_ZERO_BYTES = 64 * 1024;
constexpr size_t WS_RS = 512 * 1024, WS_FDT = 1 * MiB, WS_SS = 3 * MiB, WS_CS = 4 * MiB, WS_WA = 5 * MiB, WS_WB = 21 * MiB, WS_AO = 25 * MiB, WS_Y = 89 * MiB, WS_YODD = 25 * MiB;
constexpr size_t WS_NRM = WS_CS + 640 * 1024;
constexpr size_t WS_STL = WS_Y + 88 * MiB, WS_DEC = WS_CS + 512 * 1024;
constexpr size_t WS_SLOC = WS_WA, WS_GB = WS_YODD + 192 * MiB, WS_DSEG = WS_GB + 32 * MiB;
constexpr int CW_QCNT = 8192;
constexpr int CW_RSC = 10496;
constexpr int CW_BAR = 4096;
constexpr int RING_BYTES = 155648, MISC_OFF = RING_BYTES + 320, LDS_BYTES = 157696;
constexpr int NT = 512, NWV = 8;

__device__ __forceinline__ unsigned f2bf(float f) { unsigned u = __float_as_uint(f); return (u + 0x7fffu + ((u >> 16) & 1u)) >> 16; }
__device__ __forceinline__ float bf2f(bf16 v) { return __uint_as_float((unsigned)v << 16); }
__device__ __forceinline__ float lx(float v, int mask, int lane) { return __int_as_float(__builtin_amdgcn_ds_bpermute((lane ^ mask) << 2, __float_as_int(v))); }
__device__ __forceinline__ float lget(float v, int src) { return __int_as_float(__builtin_amdgcn_ds_bpermute(src << 2, __float_as_int(v))); }
__device__ __forceinline__ float wave_sum(float v, int lane) {
#pragma unroll
    for (int o = 1; o < 64; o <<= 1) v += lx(v, o, lane);
    return v;
}
__device__ __forceinline__ float sigmoid_f(float x) { return 1.0f / (1.0f + __expf(-x)); }
__device__ __forceinline__ float silu_f(float x) { return x / (1.0f + __expf(-x)); }
__device__ __forceinline__ float log1p_fast(float u) { return u < 1e-4f ? u * (1.0f - 0.5f * u) : __builtin_amdgcn_logf(1.0f + u) * 0.6931471805599453f; }
__device__ __forceinline__ float log_sigmoid_f(float x) { return fminf(x, 0.f) - log1p_fast(__expf(-fabsf(x))); }
__device__ __forceinline__ float softplus_f(float x) { return fmaxf(x, 0.f) + log1p_fast(__expf(-fabsf(x))); }

__device__ __forceinline__ void ph_prologue(int gw, int ngw, int lane, const float* __restrict__ x, bf16* __restrict__ hi, float* __restrict__ RS) {
    for (int m0 = gw; m0 < M; m0 += 4 * ngw) {
        float4 v[4][4];
#pragma unroll
        for (int r = 0; r < 4; ++r)
#pragma unroll
            for (int j = 0; j < 4; ++j) v[r][j] = m0 + r * ngw < M ? *(const float4*)(x + (size_t)(m0 + r * ngw) * D + j * 256 + lane * 4) : make_float4(0.f, 0.f, 0.f, 0.f);
#pragma unroll
        for (int r = 0; r < 4; ++r) { const int m = m0 + r * ngw; float s = 0.f; if (m >= M) break;
#pragma unroll
            for (int j = 0; j < 4; ++j) { const float4 a = v[r][j]; s += (a.x * a.x + a.y * a.y) + (a.z * a.z + a.w * a.w);
                *(uint2*)(hi + (size_t)m * D + j * 256 + lane * 4) = make_uint2(f2bf(a.x) | (f2bf(a.y) << 16), f2bf(a.z) | (f2bf(a.w) << 16)); }
            s = wave_sum(s, lane);
            if (lane == 0) RS[m] = rsqrtf(s * (1.0f / 1024.0f) + 1e-5f); }
    }
}
__device__ __forceinline__ int even_map(int n) {
    if (n < 4096) return n;
    if (n < 5120) return 4104 + (n - 4096);
    if (n < 6656) return 5128 + (n - 5120);
    if (n < 6664) return 4096 + (n - 6656);
    if (n < 6680) return 6664 + (n - 6664);
    return -1;
}
template <int MAP, bool HAS_NW>
__device__ __forceinline__ void ph_convert_w(LAS float* tile_, int bid, int nb_grid, int tid, const float* __restrict__ W, int K, int Nsrc, int Ndst, const float* __restrict__ nw, bf16* __restrict__ Wt) {
    LAS unsigned char* tile = (LAS unsigned char*)tile_;
    const int l32 = tid & 31, kp = tid >> 5;
    const int nb = Ndst / 128, kb = K / 64, ntile = nb * kb;
    float4 v[2][2]; float wk[2][2];
#define CV_LOAD(it_) do { const int n0_ = ((it_) % nb) * 128, k0_ = ((it_) / nb) * 64; const int n_ = n0_ + 4 * l32; const int sc_ = MAP == 1 ? even_map(n_) : n_; \
        _Pragma("unroll") for (int p_ = 0; p_ < 2; ++p_) _Pragma("unroll") for (int e_ = 0; e_ < 2; ++e_) { const int k_ = k0_ + 2 * (kp + 16 * p_) + e_; \
            v[p_][e_] = sc_ >= 0 ? *(const float4*)(W + (size_t)k_ * Nsrc + sc_) : make_float4(0.f, 0.f, 0.f, 0.f); wk[p_][e_] = HAS_NW ? nw[k_] : 1.f; } } while (0)
    int it = bid;
    if (it < ntile) CV_LOAD(it);
    for (; it < ntile; it += nb_grid) {
        const int n0 = (it % nb) * 128, k0 = (it / nb) * 64;
#pragma unroll
        for (int p = 0; p < 2; ++p) { const float4 a = v[p][0], b = v[p][1]; const float wa = wk[p][0], wb = wk[p][1];
            LAS unsigned char* dst = tile + (4 * l32) * 132 + (kp + 16 * p) * 4;
            *(LAS unsigned*)(dst) = f2bf(a.x * wa) | (f2bf(b.x * wb) << 16); *(LAS unsigned*)(dst + 132) = f2bf(a.y * wa) | (f2bf(b.y * wb) << 16);
            *(LAS unsigned*)(dst + 264) = f2bf(a.z * wa) | (f2bf(b.z * wb) << 16); *(LAS unsigned*)(dst + 396) = f2bf(a.w * wa) | (f2bf(b.w * wb) << 16); }
        __syncthreads();
        if (it + nb_grid < ntile) CV_LOAD(it + nb_grid);
#pragma unroll
        for (int r = 0; r < 2; ++r) { const int c = tid + 512 * r, n = c >> 3, j = c & 7; const LAS unsigned* src = (const LAS unsigned*)(tile + n * 132 + j * 16);
            uint4 o; o.x = src[0]; o.y = src[1]; o.z = src[2]; o.w = src[3];
            *(uint4*)(Wt + (size_t)(n0 + n) * K + k0 + 8 * j) = o; }
        __syncthreads();
    }
#undef CV_LOAD
}

__device__ __forceinline__ void ph_rstd(size_t gtid, size_t gsz, const float* __restrict__ SS, float* __restrict__ RS) {
    for (size_t m = gtid; m < (size_t)M; m += gsz) { float s = 0.f;
#pragma unroll
        for (int p = 0; p < 16; ++p) s += SS[(size_t)p * M + m];
        RS[m] = rsqrtf(s * (1.0f / 1024.0f) + 1e-5f); }
}
__device__ __forceinline__ int op_tile_pm(int c) {
    constexpr int nM = M / pg8::BM, nN = D / pg8::BM, nwg = nM * nN, q = nwg / pg8::NXCD, r = nwg % pg8::NXCD;
    const int xcd = c % pg8::NXCD, off = c / pg8::NXCD; const int wgid = (xcd < r ? xcd * (q + 1) : r * (q + 1) + (xcd - r) * q) + off;
    const int nig = pg8::WGM * nN, gid = wgid / nig, fm = gid * pg8::WGM, gsz = (nM - fm) < pg8::WGM ? (nM - fm) : pg8::WGM;
    return fm + ((wgid % nig) % gsz);
}
__device__ __forceinline__ void ph_rstd_last(volatile LAS int* slot, unsigned* cnt, int pm, int tid, const float* SS, float* __restrict__ RS) {
    asm volatile("s_waitcnt vmcnt(0)" ::: "memory");
    __syncthreads();
    if (tid == 0) slot[0] = (int)__hip_atomic_fetch_add(cnt + pm, 1u, __ATOMIC_RELAXED, __HIP_MEMORY_SCOPE_AGENT);
    __syncthreads();
    const int old = __builtin_amdgcn_readfirstlane(slot[0]);
    if (old == 3 && tid < 256) { const size_t r = (size_t)pm * 256 + tid; float s = 0.f;
#pragma unroll
        for (int p = 0; p < 16; ++p) s += __hip_atomic_load(SS + (size_t)p * M + r, __ATOMIC_RELAXED, __HIP_MEMORY_SCOPE_AGENT);
        RS[r] = rsqrtf(s * (1.0f / 1024.0f) + 1e-5f); }
    __syncthreads();
}
__device__ __forceinline__ void ph_fox_cumsum(LAS float* red  , int bid, int tid, int lane, int wv, const float* __restrict__ FDt, const float* __restrict__ f_bias, float* __restrict__ CS) {
    if (bid >= 32) return;
    const int b = bid >> 3, h = bid & 7; const float fb = f_bias[h];
    const float4* src = (const float4*)(FDt + (size_t)h * M + (size_t)b * T) + tid * 2;
    const float4 x0 = src[0], x1 = src[1];
    float v[8] = {log_sigmoid_f(x0.x + fb), log_sigmoid_f(x0.y + fb), log_sigmoid_f(x0.z + fb), log_sigmoid_f(x0.w + fb), log_sigmoid_f(x1.x + fb), log_sigmoid_f(x1.y + fb), log_sigmoid_f(x1.z + fb), log_sigmoid_f(x1.w + fb)};
#pragma unroll
    for (int j = 1; j < 8; ++j) v[j] += v[j - 1];
    float inc = v[7];
#pragma unroll
    for (int o = 1; o < 64; o <<= 1) { const float u = lget(inc, lane - o); if (lane >= o) inc += u; }
    if (lane == 63) red[wv] = inc;
    __syncthreads();
    float pre = inc - v[7];
    for (int j = 0; j < wv; ++j) pre += red[j];
    const float sc = -11.313708498984761f;
    float4* dst = (float4*)(CS + (size_t)bid * T) + tid * 2;
    dst[0] = make_float4((pre + v[0]) * sc, (pre + v[1]) * sc, (pre + v[2]) * sc, (pre + v[3]) * sc);
    dst[1] = make_float4((pre + v[4]) * sc, (pre + v[5]) * sc, (pre + v[6]) * sc, (pre + v[7]) * sc);
    __syncthreads();
}
__device__ __forceinline__ void ph_fox_attn(LAS float* qsb  , int gw, int ngw, int wv, int lane, const bf16* __restrict__ Y2, const float* __restrict__ CS, bf16* __restrict__ AO) {
    LAS float* qs = qsb + wv * 128;
    for (int rr = gw; rr < B * 8 * T; rr += ngw) {
        const int bh = rr / T, tt = rr % T, t = (bh & 1) ? (T - 1 - tt) : tt, b = bh >> 3, h = bh & 7;
        const size_t mq = (size_t)b * T + t;
        const bf16* qp = Y2 + mq * NE2 + h * 128;
        const float scale = 0.08838834764831845f;
        __syncthreads();
        qs[lane] = bf2f(qp[lane]) * scale; qs[lane + 64] = bf2f(qp[lane + 64]) * scale;
        __syncthreads();
        const float* cs = CS + (size_t)bh * T; const float ct = cs[t];
        float mrun = -1e30f, l = 0.f, o0 = 0.f, o1 = 0.f;
        for (int j0 = 0; j0 <= t; j0 += 64) {
            const int j = j0 + lane; float s = -INFINITY;
            if (j <= t) {
                const bf16* kp = Y2 + ((size_t)b * T + j) * NE2 + 1024 + h * 128; float a = 0.f;
#pragma unroll 4
                for (int d = 0; d < 128; d += 8) { const uint4 kk = *(const uint4*)(kp + d);
                    a += qs[d + 0] * __uint_as_float(kk.x << 16) + qs[d + 1] * __uint_as_float(kk.x & 0xffff0000u) + qs[d + 2] * __uint_as_float(kk.y << 16) + qs[d + 3] * __uint_as_float(kk.y & 0xffff0000u)
                       + qs[d + 4] * __uint_as_float(kk.z << 16) + qs[d + 5] * __uint_as_float(kk.z & 0xffff0000u) + qs[d + 6] * __uint_as_float(kk.w << 16) + qs[d + 7] * __uint_as_float(kk.w & 0xffff0000u); }
                s = a + (ct - cs[j]);
            }
            float tm = s;
#pragma unroll
            for (int o = 1; o < 64; o <<= 1) tm = fmaxf(tm, lx(tm, o, lane));
            const float mn = fmaxf(mrun, tm), alpha = __expf(mrun - mn); const float p = __expf(s - mn);
            l = l * alpha + wave_sum(p, lane); o0 *= alpha; o1 *= alpha; mrun = mn;
            const int nk = min(64, t - j0 + 1);
            const bf16* vp = Y2 + ((size_t)b * T + j0) * NE2 + 2048 + h * 128;
            for (int jj = 0; jj < nk; ++jj) { const float pj = __int_as_float(__builtin_amdgcn_readlane(__float_as_int(p), jj)); o0 += pj * bf2f(vp[(size_t)jj * NE2 + lane]); o1 += pj * bf2f(vp[(size_t)jj * NE2 + lane + 64]); }
        }
        const float inv = 1.0f / l; const bf16* gp = Y2 + mq * NE2 + 3072 + h * 128;
        AO[mq * 2048 + h * 128 + lane] = (bf16)f2bf(o0 * inv * silu_f(bf2f(gp[lane])));
        AO[mq * 2048 + h * 128 + lane + 64] = (bf16)f2bf(o1 * inv * silu_f(bf2f(gp[lane + 64])));
    }
}

__device__ __forceinline__ void ph_ssd_conv(size_t gtid, size_t gsz, const bf16* __restrict__ Y1, const float* __restrict__ cw, const float* __restrict__ cb, bf16* __restrict__ XC) {
    const size_t total = (size_t)M * 1536;
    for (size_t i = gtid; i < total; i += gsz) {
        const int m = (int)(i / 1536), ch = (int)(i % 1536), t = m % T; float a = cb[ch];
#pragma unroll
        for (int k = 0; k < 4; ++k) { const int tt = t - 3 + k; if (tt >= 0) a += cw[k * 1536 + ch] * bf2f(Y1[(size_t)(m - 3 + k) * NE1 + 1024 + ch]); }
        XC[i] = (bf16)f2bf(silu_f(a));
    }
}
__device__ __forceinline__ void ph_ssd_scan(int gw, int ngw, int lane, const bf16* __restrict__ Y1, const bf16* __restrict__ XC, const float* __restrict__ FDt, const float* __restrict__ dt_bias,
                                            const float* __restrict__ A_log, const float* __restrict__ Dsk, bf16* __restrict__ AO) {
    for (int w = gw; w < B * 16 * 64; w += ngw) {
        const int p = w & 63, h = (w >> 6) & 15, b = w >> 10, g = h >> 3;
        const float A = -__expf(A_log[h]), dtb = dt_bias[h], Dh = Dsk[h];
        float s0 = 0.f, s1 = 0.f;
        for (int t = 0; t < T; ++t) {
            const size_t m = (size_t)b * T + t;
            const float dt = softplus_f(FDt[(size_t)(8 + h) * M + m] + dtb);
            const float xv = bf2f(XC[m * 1536 + h * 64 + p]);
            const float dec = __expf(dt * A), dx = dt * xv;
            const bf16* bp = XC + m * 1536 + 1024 + g * 128; const bf16* cp = XC + m * 1536 + 1280 + g * 128;
            s0 = dec * s0 + dx * bf2f(bp[lane]); s1 = dec * s1 + dx * bf2f(bp[lane + 64]);
            float y = wave_sum(bf2f(cp[lane]) * s0 + bf2f(cp[lane + 64]) * s1, lane);
            if (lane == 0) { y = (y + Dh * xv) * silu_f(bf2f(Y1[m * NE1 + h * 64 + p])); AO[m * 2048 + 1024 + h * 64 + p] = (bf16)f2bf(y); }
        }
    }
}
__device__ __forceinline__ void ph_ssd_norm(int gw, int ngw, int lane, bf16* __restrict__ AO, const float* __restrict__ nw) {
    for (int w = gw; w < M * 2; w += ngw) {
        const int g = w & 1; const size_t m = w >> 1;
        bf16* p = AO + m * 2048 + 1024 + g * 512 + lane * 8;
        const uint4 v = *(const uint4*)p; float f[8] = {__uint_as_float(v.x << 16), __uint_as_float(v.x & 0xffff0000u), __uint_as_float(v.y << 16), __uint_as_float(v.y & 0xffff0000u),
                                                       __uint_as_float(v.z << 16), __uint_as_float(v.z & 0xffff0000u), __uint_as_float(v.w << 16), __uint_as_float(v.w & 0xffff0000u)};
        float s = 0.f;
#pragma unroll
        for (int i = 0; i < 8; ++i) s += f[i] * f[i];
        s = wave_sum(s, lane); const float r = rsqrtf(s * (1.0f / 512.0f) + 1e-5f); const float* wp = nw + g * 512 + lane * 8;
        uint4 o; o.x = f2bf(f[0] * r * wp[0]) | (f2bf(f[1] * r * wp[1]) << 16); o.y = f2bf(f[2] * r * wp[2]) | (f2bf(f[3] * r * wp[3]) << 16);
        o.z = f2bf(f[4] * r * wp[4]) | (f2bf(f[5] * r * wp[5]) << 16); o.w = f2bf(f[6] * r * wp[6]) | (f2bf(f[7] * r * wp[7]) << 16);
        *(uint4*)p = o;
    }
}

__device__ __forceinline__ void ph_hgrn_scan(int gw, int ngw, int lane, const bf16* __restrict__ Y, const float* __restrict__ lbl, int oi, int h0, bf16* __restrict__ ORAW) {
    for (int w = gw; w < B * 8 * 128; w += ngw) {
        const int v = w & 127, hh = (w >> 7) & 7, b = w >> 10, h = h0 + hh;
        float lb0 = 0.f, lb1 = 0.f;
        if (oi == 1) { const int c0 = h * 128 + lane, c1 = c0 + 64; lb0 = sigmoid_f(lbl[2048 + c0] - lbl[c0]); lb1 = sigmoid_f(lbl[2048 + c1] - lbl[c1]); }
        float s0 = 0.f, s1 = 0.f;
        for (int t = 0; t < T; ++t) {
            const size_t m = (size_t)b * T + t; const bf16* yp = Y + m * NO1;
            const float q0 = silu_f(bf2f(yp[h * 128 + lane])), q1 = silu_f(bf2f(yp[h * 128 + lane + 64]));
            const float f0 = bf2f(yp[2048 + h * 128 + lane]), f1 = bf2f(yp[2048 + h * 128 + lane + 64]);
            const float iv = bf2f(yp[4096 + h * 128 + v]);
            const float g0 = lb0 + (1.f - lb0) * sigmoid_f(f0), g1 = lb1 + (1.f - lb1) * sigmoid_f(f1);
            const float k0 = (1.f - lb0) * sigmoid_f(-f0), k1 = (1.f - lb1) * sigmoid_f(-f1);
            s0 = g0 * s0 + k0 * iv; s1 = g1 * s1 + k1 * iv;
            const float o = wave_sum(q0 * s0 + q1 * s1, lane);
            if (lane == 0) ORAW[m * 1024 + hh * 128 + v] = (bf16)f2bf(o);
        }
    }
}
__device__ __forceinline__ void ph_hgrn_norm(int gw, int ngw, int lane, const bf16* __restrict__ ORAW, const float* __restrict__ nw, int h0, bf16* __restrict__ Y) {
    for (int w = gw; w < M * 8; w += ngw) {
        const int hh = w & 7; const size_t m = w >> 3;
        const unsigned v = *(const unsigned*)(ORAW + m * 1024 + hh * 128 + lane * 2);
        const float a = __uint_as_float(v << 16), c = __uint_as_float(v & 0xffff0000u);
        const float s = wave_sum(a * a + c * c, lane), r = rsqrtf(s * (1.0f / 128.0f) + 1e-5f);
        *(unsigned*)(Y + m * NO1 + (h0 + hh) * 128 + lane * 2) = f2bf(a * r * nw[lane * 2]) | (f2bf(c * r * nw[lane * 2 + 1]) << 16);
    }
}
__device__ __forceinline__ void ph_final(int gw, int ngw, int lane, const bf16* __restrict__ hf, const float* __restrict__ SS, const float* __restrict__ fw, float* __restrict__ out) {
    float4 wv[4];
#pragma unroll
    for (int j = 0; j < 4; ++j) wv[j] = *(const float4*)(fw + j * 256 + lane * 4);
    for (int m0 = gw; m0 < M; m0 += 4 * ngw) {
        uint2 a[4][4]; float s[4];
#pragma unroll
        for (int r = 0; r < 4; ++r) { const int m = min(m0 + r * ngw, M - 1); s[r] = lane < 16 ? SS[(size_t)lane * M + m] : 0.f;
#pragma unroll
            for (int j = 0; j < 4; ++j) a[r][j] = *(const uint2*)(hf + (size_t)m * NO1 + j * 256 + lane * 4); }
#pragma unroll
        for (int r = 0; r < 4; ++r) { const int m = m0 + r * ngw; if (m >= M) break;
            const float rr = rsqrtf(wave_sum(s[r], lane) * (1.0f / 1024.0f) + 1e-5f);
#pragma unroll
            for (int j = 0; j < 4; ++j) { const uint2 q = a[r][j];
                *(float4*)(out + (size_t)m * D + j * 256 + lane * 4) = make_float4(__uint_as_float(q.x << 16) * rr * wv[j].x, __uint_as_float(q.x & 0xffff0000u) * rr * wv[j].y, __uint_as_float(q.y << 16) * rr * wv[j].z, __uint_as_float(q.y & 0xffff0000u) * rr * wv[j].w); } }
    }
}
struct Params {
    const float* x; const float* norm_w; const float* final_w; const float* even_w_in; const float* even_w_out; const float* fox_f_bias;
    const float* conv_w; const float* conv_b; const float* dt_bias; const float* A_log; const float* ssd_D; const float* ssd_nw;
    const float* odd_w_in; const float* odd_w_out; const float* lb_logits; const float* hgrn_nw;
    float* out; unsigned char* ws;
};

typedef const __attribute__((address_space(4))) Params* ParamsK;
__device__ __forceinline__ ParamsK kargs() { ParamsK p = (ParamsK)__builtin_amdgcn_kernarg_segment_ptr(); asm volatile("" : "+s"(p)); return p; }
__device__ __forceinline__ int tid_fresh(int wv0) { int l = __builtin_amdgcn_mbcnt_hi(~0u, __builtin_amdgcn_mbcnt_lo(~0u, 0u)); asm volatile("" : "+v"(l)); return wv0 * 64 + l; }
#define PH_IDS() const int tid = tid_fresh(wv0), lane = tid & 63, wv = wv0; int G_ = gridDim.x, bid_ = blockIdx.x; asm volatile("" : "+s"(G_), "+s"(bid_)); const int G = G_, bid = bid_, gw = bid * NWV + wv, ngw = G * NWV; \
    const size_t gtid = (size_t)bid * NT + tid, gsz = (size_t)G * NT; (void)lane; (void)gw; (void)ngw; (void)gtid; (void)gsz; (void)wv
#define GP(T, p) ((T*)(__attribute__((address_space(1))) T*)(p))
#define PH_PTRS() ParamsK P = kargs(); unsigned char* ws = GP(unsigned char, P->ws); bf16* hi = GP(bf16, P->out); bf16* lo = hi + (size_t)M * D; \
    float* FDt = (float*)(ws + WS_FDT); float* SS = (float*)(ws + WS_SS); float* CS = (float*)(ws + WS_CS); float* RS = (float*)(ws + WS_RS); (void)RS; \
    bf16* WA = (bf16*)(ws + WS_WA); bf16* WB = (bf16*)(ws + WS_WB); bf16* AO = (bf16*)(ws + WS_AO); \
    bf16* Y = (bf16*)(ws + WS_Y); sd::u32x4* STL = (sd::u32x4*)(ws + WS_STL); float* DEC = (float*)(ws + WS_DEC); bf16* YO = (bf16*)(ws + WS_YODD); float* SLOC = (float*)(ws + WS_SLOC); float* DSEG = (float*)(ws + WS_DSEG); bf16* HFB = (bf16*)(ws + WS_YODD) + 2048; float* NRM = (float*)(ws + WS_NRM); \
    (void)hi; (void)lo; (void)FDt; (void)SS; (void)CS; (void)WA; (void)WB; (void)AO; (void)Y; (void)STL; (void)DEC; (void)YO; (void)SLOC; (void)DSEG; (void)HFB; (void)NRM
#define PF(field) GP(const float, P->field)
#define GRID_BAR() do { ParamsK Pb = kargs(); XcdBarrier bar_; bar_.bar = (unsigned*)(GP(unsigned char, Pb->ws) + WS_CTL) + CW_BAR; bar_.x = xb_xcc_id(); \
    bar_.st = (volatile LAS unsigned*)((LAS unsigned char*)lds + MISC_OFF) + 8; xcd_barrier(bar_, tid_fresh(wv0) == 0); } while (0)

__global__ void __launch_bounds__(512, 2) mega_fwd(Params Pval) {
    extern __shared__ __attribute__((aligned(16))) unsigned char lds[];
#define LL ((LAS unsigned char*)lds)
#define SCR ((LAS float*)lds)
    const int wv0 = __builtin_amdgcn_readfirstlane((int)threadIdx.x >> 6);
    { const int tid0 = threadIdx.x;
      for (int u = tid0; u < (LDS_BYTES - RING_BYTES) / 4; u += NT) ((LAS unsigned*)(LL + RING_BYTES))[u] = 0u;
      __syncthreads();
      ParamsK Pb = kargs(); (void)xcd_barrier_post((unsigned*)(GP(unsigned char, Pb->ws) + WS_CTL) + CW_BAR, (volatile LAS unsigned*)(LL + MISC_OFF) + 8); }
    for (int li = 0; li < 2; ++li) {
        if (li == 0) {
          { PH_IDS(); PH_PTRS();
            ph_convert_w<1, true>(SCR, bid, G, tid, PF(even_w_in), D, EVEN_IN, NE, PF(norm_w), WA);
            ph_prologue(gw, ngw, lane, PF(x), hi, RS); }
          GRID_BAR(); }
        { PH_PTRS(); int G_ = gridDim.x, bid_ = blockIdx.x; asm volatile("" : "+s"(G_), "+s"(bid_)); const int G = G_, bid = bid_;
          pg8::Gemm g{hi, WA + (size_t)4096 * D, M, NE1, D, D}; pg8::EpiIn E{Y, NE1, RS, FDt, 10, M, nullptr, nullptr, 0, 0, 4, 1 << 30, nullptr, nullptr, 0};     pg8::StaticOrder S; S.init(M, NE1, G, bid); S.wv = wv0;
          pg8::gemm_phase<pg8::EpiIn, pg8::StaticOrder, true, true>(LL, g, S, E); }
        { PH_IDS(); PH_PTRS();
          if (bid >= 192 && bid < 256) { asm volatile("s_waitcnt vmcnt(0)" ::: "memory"); __syncthreads(); ph_convert_w<0, false>(SCR, bid - 192, 64, tid, PF(even_w_out) + (size_t)li * 2048 * D, 2048, D, D, nullptr, WB); } }
        GRID_BAR();
        { PH_IDS(); PH_PTRS();
          if (bid < 256) sd::ssd_unit<true>((char*)lds, tid, bid, Y, FDt, PF(conv_w) + (size_t)li * 4 * 1536, PF(conv_b) + (size_t)li * 1536, PF(dt_bias) + li * 16, PF(A_log) + li * 16, PF(ssd_D) + li * 16,
                                            PF(ssd_nw) + (size_t)li * 1024, STL, DEC, AO);
          ph_fox_cumsum(SCR, bid, tid, lane, wv, FDt, PF(fox_f_bias) + li * 8, CS); }
        GRID_BAR();
        { PH_IDS(); PH_PTRS(); sd::ssd_scan(gtid, gsz, STL, DEC); }
        GRID_BAR();
        { PH_IDS(); PH_PTRS();
          if (bid < 256) sd::ssd_unit<false>((char*)lds, tid, bid, Y, FDt, PF(conv_w) + (size_t)li * 4 * 1536, PF(conv_b) + (size_t)li * 1536, PF(dt_bias) + li * 16, PF(A_log) + li * 16, PF(ssd_D) + li * 16,
                                             PF(ssd_nw) + (size_t)li * 1024, STL, DEC, AO); }
        GRID_BAR();
        { PH_PTRS(); int G_ = gridDim.x, bid_ = blockIdx.x; asm volatile("" : "+s"(G_), "+s"(bid_)); const int G = G_, bid = bid_;
          pg8::Gemm g{hi, WA, M, 4096, D, D}; pg8::EpiIn E{Y, 4160, RS, nullptr, -1, M, (LAS float*)(LL + pg8::STAGE_BYTES), NRM, 0, 0, 0, 12, Y + 3072, nullptr, 4160};     pg8::StaticOrder S; S.init(M, 4096, G, bid); S.wv = wv0;
          pg8::gemm_phase<pg8::EpiIn, pg8::StaticOrder, true, true>(LL, g, S, E); }
        GRID_BAR();
        { PH_IDS(); PH_PTRS(); fa::fox_phase((char*)lds, tid, bid, G, Y, CS, NRM, AO, (unsigned*)(ws + WS_CTL) + CW_QCNT + 512 * li); }
        GRID_BAR();
        { PH_PTRS(); int G_ = gridDim.x, bid_ = blockIdx.x; asm volatile("" : "+s"(G_), "+s"(bid_)); const int G = G_, bid = bid_;
          pg8::Gemm g{AO, WB, M, D, 2048, 2048}; pg8::EpiOut E{hi, SS, M, hi, 1024}; pg8::StaticOrder S; S.init(M, D, G, bid); S.wv = wv0;
          pg8::gemm_phase<pg8::EpiOut, pg8::StaticOrder, true, true>(LL, g, S, E); }
        { PH_IDS(); PH_PTRS();
          if (bid < 256) { pg8::Unit u; u.pm = op_tile_pm(bid);
            ph_rstd_last((volatile LAS int*)(LL + 65536), (unsigned*)(ws + WS_CTL) + CW_RSC + 128 * li, u.pm, tid, SS, RS); }
          ph_convert_w<0, true>(SCR, bid, G, tid, PF(odd_w_in) + (size_t)li * D * ODD_IN, D, ODD_IN, ODD_IN, PF(norm_w) + (size_t)(2 * li + 1) * D, WA); }
        GRID_BAR();
        { PH_PTRS(); int G_ = gridDim.x, bid_ = blockIdx.x; asm volatile("" : "+s"(G_), "+s"(bid_)); const int G = G_, bid = bid_;
          pg8::Gemm g{hi, WA, M, ODD_IN, D, D}; pg8::EpiIn E{YO, NO1, RS, nullptr, -1, M, nullptr, nullptr, 8, 16, 8, NO1 / 256, lo, (bf16*)(ws + WS_GB), 1024}; pg8::StaticOrder S; S.init(M, ODD_IN, G, bid); S.wv = wv0;
          pg8::gemm_phase<pg8::EpiIn, pg8::StaticOrder, true, true>(LL, g, S, E); }
        GRID_BAR();
        { PH_IDS(); PH_PTRS(); if (bid < 256) hg::hgrn_state128((char*)lds, tid, bid, YO, PF(lb_logits), li, SLOC, DSEG);
          if (bid < 256 && (bid & 3) == 3) ph_convert_w<0, false>(SCR, bid >> 2, 64, tid, PF(odd_w_out) + (size_t)li * 2048 * D, 2048, D, D, nullptr, WB); }
        GRID_BAR();
        { PH_IDS(); PH_PTRS(); if (bid < 256) hg::hgrn_passB((char*)lds, tid, bid, YO, PF(lb_logits), li, PF(hgrn_nw) + (size_t)li * 128, SLOC, DSEG, lo, (const bf16*)(ws + WS_GB)); }
        GRID_BAR();
        { PH_PTRS(); int G_ = gridDim.x, bid_ = blockIdx.x; asm volatile("" : "+s"(G_), "+s"(bid_)); const int G = G_, bid = bid_;
          pg8::Gemm g{YO, WB, M, D, 2048, NO1}; pg8::EpiOut E{hi, SS, M, li == 1 ? HFB : hi, li == 1 ? NO1 : 1024}; pg8::StaticOrder S; S.init(M, D, G, bid); S.wv = wv0;
          pg8::gemm_phase<pg8::EpiOut, pg8::StaticOrder, true, true>(LL, g, S, E); }
        if (li == 0) { PH_IDS(); PH_PTRS();
          if (bid < 256) { pg8::Unit u; u.pm = op_tile_pm(bid);
            ph_rstd_last((volatile LAS int*)(LL + 65536), (unsigned*)(ws + WS_CTL) + CW_RSC + 64, u.pm, tid, SS, RS); }
          ph_convert_w<1, true>(SCR, bid, G, tid, PF(even_w_in) + (size_t)D * EVEN_IN, D, EVEN_IN, NE, PF(norm_w) + (size_t)2 * D, WA); }
        GRID_BAR();
    }
    { PH_IDS(); PH_PTRS(); ph_final(gw, ngw, lane, HFB, SS, PF(final_w), GP(float, P->out)); }
}
}

extern "C" void kernel_launch(void* const* d_in, const int* in_sizes, int n_in, void* d_out, int out_size, void* d_ws, size_t ws_size, hipStream_t stream) {
    using namespace hy;
    static int grid = 0;
    if (grid == 0) {
        int dev = 0, cus = 0;
        if (hipGetDevice(&dev) != hipSuccess || hipDeviceGetAttribute(&cus, hipDeviceAttributeMultiprocessorCount, dev) != hipSuccess || cus <= 0) cus = 256;
        (void)hipFuncSetAttribute((const void*)mega_fwd, hipFuncAttributeMaxDynamicSharedMemorySize, LDS_BYTES);
        (void)hipGetLastError();
        grid = cus;
    }
    (void)hipMemsetAsync((char*)d_ws + WS_CTL, 0, CTL_ZERO_BYTES, stream);
    Params p{};
    p.x = (const float*)d_in[0]; p.norm_w = (const float*)d_in[1]; p.final_w = (const float*)d_in[2]; p.even_w_in = (const float*)d_in[3]; p.even_w_out = (const float*)d_in[4];
    p.fox_f_bias = (const float*)d_in[5]; p.conv_w = (const float*)d_in[6]; p.conv_b = (const float*)d_in[7]; p.dt_bias = (const float*)d_in[8]; p.A_log = (const float*)d_in[9];
    p.ssd_D = (const float*)d_in[10]; p.ssd_nw = (const float*)d_in[11]; p.odd_w_in = (const float*)d_in[12]; p.odd_w_out = (const float*)d_in[13]; p.lb_logits = (const float*)d_in[14];
    p.hgrn_nw = (const float*)d_in[15]; p.out = (float*)d_out; p.ws = (unsigned char*)d_ws;
    hipLaunchKernelGGL(mega_fwd, dim3(grid), dim3(NT), LDS_BYTES, stream, p);
}
```
